# Optimizing an MI355X kernel written in HIP

```python
import jax, jax.numpy as jnp
from jax import lax
import numpy as np

D_MODEL = 2048
BATCH = 1
SEQ = 8192
DEPTH = 4

CTX_LEN = 256
GRID_W = 64

HEAD_DIM = 128
N_HEADS = D_MODEL // HEAD_DIM
N_KV_HEADS = N_HEADS // 4
ATTN_DIM = N_HEADS * HEAD_DIM
KV_DIM = N_KV_HEADS * HEAD_DIM
Q_BLOCK = 128
ROPE_THETA = 10000.0

F_GROUPS = 4
F_DIM = D_MODEL // 2
F_GROUP_DIM = F_DIM // F_GROUPS

CONV_DIM = D_MODEL // 2
CONV_WIDTH = 3

N_BRANCH = 3
EPS = 1e-6

IN_SIZES = (
    ATTN_DIM,
    KV_DIM,
    KV_DIM,
    ATTN_DIM,
    F_DIM,
    F_DIM,
    CONV_DIM,
    CONV_DIM,
    CONV_DIM,
    CONV_DIM,
    N_BRANCH * D_MODEL,
)
IN_COLS = int(sum(IN_SIZES))
IN_OFFSETS = tuple(int(v) for v in np.cumsum(IN_SIZES)[:-1])
KV_START = ATTN_DIM
KV_END = ATTN_DIM + 2 * KV_DIM

kernel_name = "hybrid_fourier_gqa_shortconv_dit"


def rmsnorm(x, g):
    xf = x.astype(jnp.float32)
    y = xf * lax.rsqrt(jnp.mean(xf * xf, axis=-1, keepdims=True) + EPS)
    return (y * g.astype(jnp.float32)).astype(x.dtype)


def rope_axis(x, pos):
    n = x.shape[-1]
    half = n // 2
    freqs = ROPE_THETA ** (-jnp.arange(half, dtype=jnp.float32) / half)
    ang = pos.astype(jnp.float32)[:, None] * freqs[None, :]
    cos = jnp.cos(ang)[None, :, None, :]
    sin = jnp.sin(ang)[None, :, None, :]
    xf = x.astype(jnp.float32)
    x1, x2 = xf[..., :half], xf[..., half:]
    out = jnp.concatenate([x1 * cos - x2 * sin, x1 * sin + x2 * cos], axis=-1)
    return out.astype(x.dtype)


def rope_2d(x, row, col):
    h = HEAD_DIM // 2
    return jnp.concatenate([rope_axis(x[..., :h], row), rope_axis(x[..., h:], col)], axis=-1)


def attend(q, k, v):
    b, sq, _, dh = q.shape
    g = N_HEADS // N_KV_HEADS
    nb = sq // Q_BLOCK
    scale = 1.0 / float(np.sqrt(dh))
    qb = q.reshape(b, nb, Q_BLOCK, N_KV_HEADS, g, dh).transpose(1, 0, 3, 4, 2, 5)
    kt = k.transpose(0, 2, 1, 3)
    vt = v.transpose(0, 2, 1, 3)

    def block(qi):
        s = jnp.einsum('bkgqd,bkld->bkgql', qi, kt).astype(jnp.float32) * scale
        p = jax.nn.softmax(s, axis=-1).astype(vt.dtype)
        return jnp.einsum('bkgql,bkld->bkgqd', p, vt)

    o = lax.map(block, qb)
    return o.transpose(1, 0, 4, 2, 3, 5).reshape(b, sq, N_HEADS * dh)


def fourier_mix(u):
    b, s, _ = u.shape
    ug = u.reshape(b, s, F_GROUPS, F_GROUP_DIM).astype(jnp.float32)
    y = jnp.fft.fft2(ug, axes=(1, 3), norm="ortho").real
    return y.reshape(b, s, F_DIM).astype(u.dtype)


def short_conv(u, w, bias):
    up = jnp.pad(u, ((0, 0), (1, 1), (0, 0)))
    return up[:, :-2] * w[0] + up[:, 1:-1] * w[1] + up[:, 2:] * w[2] + bias


def heads_qk(q, k, qn, kn):
    b, s, _ = q.shape
    q = rmsnorm(q.reshape(b, s, N_HEADS, HEAD_DIM), qn)
    k = rmsnorm(k.reshape(b, s, N_KV_HEADS, HEAD_DIM), kn)
    return q, k


def merge_branches(attn, ag, fx, fg, cx, cb, cc, cg, ml,
                   w_attn_o, w_f_mix, w_f_o, conv_w, conv_b, w_conv_o, w_out):
    silu = jax.nn.silu
    y_a = (attn * silu(ag)) @ w_attn_o
    y_f = ((fourier_mix(fx) @ w_f_mix) * silu(fg)) @ w_f_o
    y_c = (cb * short_conv(cc * cx, conv_w, conv_b) * silu(cg)) @ w_conv_o
    g = jax.nn.sigmoid(ml.astype(jnp.float32)).astype(ml.dtype)
    g = g.reshape(ml.shape[:-1] + (N_BRANCH, D_MODEL))
    m = g[..., 0, :] * y_a + g[..., 1, :] * y_f + g[..., 2, :] * y_c
    return m @ w_out


def setup_inputs(seed: int = 0) -> dict:
    key = jax.random.key(seed)
    ks = jax.random.split(key, 20)
    f32 = jnp.float32
    D = D_MODEL

    def nrm(k, shape, scale):
        return jax.random.normal(k, shape, f32) * scale

    return {
        "x": nrm(ks[0], (BATCH, SEQ, D), 1.0),
        "c": nrm(ks[1], (BATCH, D), 1.0),
        "ctx": nrm(ks[2], (BATCH, CTX_LEN, D), 1.0),
        "c_ctx": nrm(ks[3], (D,), 1.0),
        "w_mod": nrm(ks[4], (DEPTH, D, 3 * D), 0.5 * D ** -0.5),
        "b_mod": nrm(ks[5], (DEPTH, 3 * D), 0.01),
        "g_pre": 1.0 + nrm(ks[6], (DEPTH, D), 0.01),
        "g_post": 1.0 + nrm(ks[7], (DEPTH, D), 0.01),
        "w_in": nrm(ks[8], (DEPTH, D, IN_COLS), D ** -0.5),
        "q_norm": 1.0 + nrm(ks[9], (DEPTH, HEAD_DIM), 0.01),
        "k_norm": 1.0 + nrm(ks[10], (DEPTH, HEAD_DIM), 0.01),
        "w_attn_o": nrm(ks[11], (DEPTH, ATTN_DIM, D), ATTN_DIM ** -0.5),
        "w_f_mix": nrm(ks[12], (DEPTH, F_DIM, F_DIM), F_DIM ** -0.5),
        "w_f_o": nrm(ks[13], (DEPTH, F_DIM, D), F_DIM ** -0.5),
        "conv_w": nrm(ks[14], (DEPTH, CONV_WIDTH, CONV_DIM), CONV_WIDTH ** -0.5),
        "conv_b": nrm(ks[15], (DEPTH, CONV_DIM), 0.01),
        "w_conv_o": nrm(ks[16], (DEPTH, CONV_DIM, D), CONV_DIM ** -0.5),
        "w_out": nrm(ks[17], (DEPTH, D, D), D ** -0.5),
    }


def reference(x, c, ctx, c_ctx, w_mod, b_mod, g_pre, g_post, w_in, q_norm, k_norm,
              w_attn_o, w_f_mix, w_f_o, conv_w, conv_b, w_conv_o, w_out):
    S = x.shape[1]
    ROWS = S // GRID_W
    row = jnp.repeat(jnp.arange(ROWS, dtype=jnp.int32), GRID_W, total_repeat_length=S)
    col = jnp.tile(jnp.arange(GRID_W, dtype=jnp.int32), ROWS)

    sc_lat = jax.nn.silu(c)
    sc_ctx = jax.nn.silu(c_ctx)[None]
    h_ctx_stream = ctx

    for l in range(DEPTH):
        last = l == DEPTH - 1
        mod = sc_lat @ w_mod[l] + b_mod[l]
        shift, scale, gate = jnp.split(mod, 3, axis=-1)
        mod_c = sc_ctx @ w_mod[l] + b_mod[l]
        shift_c, scale_c, gate_c = jnp.split(mod_c, 3, axis=-1)

        h = rmsnorm(x, g_pre[l]) * (1.0 + scale[:, None, :]) + shift[:, None, :]
        hc = rmsnorm(h_ctx_stream, g_pre[l]) * (1.0 + scale_c[:, None, :]) + shift_c[:, None, :]

        q, k, v, ag, fx, fg, cx, cb, cc, cg, ml = jnp.split(h @ w_in[l], IN_OFFSETS, axis=-1)
        q, k = heads_qk(q, k, q_norm[l], k_norm[l])
        q = rope_2d(q, row, col)
        k = rope_2d(k, row, col)
        v = v.reshape(v.shape[0], S, N_KV_HEADS, HEAD_DIM)

        if last:
            kv_c = hc @ w_in[l][:, KV_START:KV_END]
            k_c, v_c = jnp.split(kv_c, 2, axis=-1)
            k_c = rmsnorm(k_c.reshape(k_c.shape[0], CTX_LEN, N_KV_HEADS, HEAD_DIM), k_norm[l])
        else:
            (q_c, k_c, v_c, ag_c, fx_c, fg_c, cx_c, cb_c, cc_c, cg_c, ml_c) = jnp.split(
                hc @ w_in[l], IN_OFFSETS, axis=-1)
            q_c, k_c = heads_qk(q_c, k_c, q_norm[l], k_norm[l])
        v_c = v_c.reshape(v_c.shape[0], CTX_LEN, N_KV_HEADS, HEAD_DIM)

        k_all = jnp.concatenate([jnp.broadcast_to(k_c, (k.shape[0],) + k_c.shape[1:]), k], axis=1)
        v_all = jnp.concatenate([jnp.broadcast_to(v_c, (v.shape[0],) + v_c.shape[1:]), v], axis=1)
        attn = attend(q, k_all, v_all)
        out = merge_branches(attn, ag, fx, fg, cx, cb, cc, cg, ml,
                             w_attn_o[l], w_f_mix[l], w_f_o[l], conv_w[l], conv_b[l],
                             w_conv_o[l], w_out[l])

        if not last:
            attn_c = attend(q_c, k_c, v_c)
            out_c = merge_branches(attn_c, ag_c, fx_c, fg_c, cx_c, cb_c, cc_c, cg_c, ml_c,
                                   w_attn_o[l], w_f_mix[l], w_f_o[l], conv_w[l], conv_b[l],
                                   w_conv_o[l], w_out[l])
            h_ctx_stream = h_ctx_stream + gate_c[:, None, :] * rmsnorm(out_c, g_post[l])

        x = x + gate[:, None, :] * rmsnorm(out, g_post[l])

    return x
```

```cpp
#include <hip/hip_runtime.h>
#include <hip/hip_cooperative_groups.h>
#include <cstdio>
#include <cstdint>
namespace cg = cooperative_groups;

#define LAS __attribute__((address_space(3)))
typedef unsigned short bf16_t;
typedef short bf16x8 __attribute__((ext_vector_type(8)));
typedef short s16x4 __attribute__((ext_vector_type(4)));
typedef float f32x4 __attribute__((ext_vector_type(4)));
typedef float f32x16 __attribute__((ext_vector_type(16)));
typedef unsigned u32x4 __attribute__((ext_vector_type(4)));
typedef unsigned u32x2 __attribute__((ext_vector_type(2)));

constexpr int DM = 2048, SEQ = 8192, CTX = 256, ROWS = SEQ + CTX, DEPTH = 4, INC = 17408;
constexpr int OQ = 0, OKK = 2048, OV = 2560, OAG = 3072, OFX = 5120, OFG = 6144, OCX = 7168, OCB = 8192, OCC = 9216, OCG = 10240, OML = 11264;
constexpr float EPS = 1e-6f;
constexpr size_t APL = (size_t)(SEQ + CTX) * 2048, WPL = (size_t)2048 * 2048;
constexpr int CLD = 2048;
constexpr int MLD = 2048 + 64;
constexpr int ZCH = 32768 + 256;
constexpr int LDS_STAGE = 131072, LDS_BYTES = LDS_STAGE + 64;
constexpr int NTHREADS = 512;

constexpr size_t SZ_WINT = (size_t)INC * DM * 2, SZ_WCAT = 3 * WPL * 2, SZ_WOUT = (size_t)DM * DM * 2, SZ_WMIXR = (size_t)1024 * 1024 * 2, SZ_WMIX = (size_t)1024 * 2048 * 2;
constexpr size_t WS_WINT = 0;
constexpr size_t WS_WCAT = WS_WINT + DEPTH * SZ_WINT;
constexpr size_t WS_WOUT = WS_WCAT + DEPTH * SZ_WCAT;
constexpr size_t WS_WMIXR = WS_WOUT + DEPTH * SZ_WOUT;
constexpr size_t WS_WMIX = WS_WMIXR + DEPTH * SZ_WMIXR;
constexpr size_t WS_TCH = WS_WMIX + DEPTH * SZ_WMIX;
constexpr size_t WS_ZT = WS_TCH + 512 * 256 * 2;
constexpr size_t WS_T1 = WS_ZT + (size_t)1024 * ZCH;
constexpr size_t WS_A2 = WS_T1 + 256 * 128 * 2;
constexpr size_t WS_ACTX = WS_A2 + 256 * 256 * 2;
constexpr size_t WS_ROPE = WS_ACTX + 512 * 256 * 2;
constexpr size_t WS_MOD = WS_ROPE + 128 * 32 * 8;
constexpr size_t WS_XS = WS_MOD + 4 * 2 * 6144 * 4;
constexpr size_t WS_H = WS_XS + (size_t)ROWS * DM * 4;
constexpr size_t WS_P = WS_H + (size_t)ROWS * DM * 2;
constexpr size_t WS_XT = WS_P + (size_t)ROWS * INC * 2;
constexpr size_t WS_PQ = WS_XT + (size_t)1024 * ROWS * 2;
constexpr size_t WS_ACAT = WS_PQ + (size_t)ROWS * DM * 2;
constexpr size_t WS_MBUF = WS_ACAT + 3 * APL * 2;
constexpr size_t WS_MB = WS_MBUF + (size_t)ROWS * MLD * 4;
constexpr size_t WS_OUTB = WS_MB + (size_t)ROWS * DM * 2;
constexpr size_t WS_KC = WS_OUTB + (size_t)ROWS * DM * 4;
constexpr size_t WS_VC = WS_KC + (size_t)4 * ROWS * 128 * 2;
constexpr size_t WS_MP = WS_VC + (size_t)4 * ROWS * 128 * 2;
constexpr size_t WS_OUTP = WS_MP + (size_t)8 * CTX * MLD * 4;
constexpr size_t WS_BAR = WS_OUTP + (size_t)4 * CTX * DM * 4;
constexpr size_t BAR_BYTES = 16384;
constexpr size_t WS_END = WS_BAR + BAR_BYTES;

struct Params { const float* in[18]; float* out; unsigned char* ws; };
enum { I_X = 0, I_C, I_CTX, I_CCTX, I_WMOD, I_BMOD, I_GPRE, I_GPOST, I_WIN, I_QN, I_KN, I_WAO, I_WFM, I_WFO, I_CW, I_CB, I_WCO, I_WOUT };

__device__ __forceinline__ unsigned cvtpk(float lo, float hi) { unsigned r; asm volatile("v_cvt_pk_bf16_f32 %0, %1, %2" : "=v"(r) : "v"(lo), "v"(hi)); return r; }
__device__ __forceinline__ float bf2f(unsigned short b) { return __uint_as_float(((unsigned)b) << 16); }
__device__ __forceinline__ float bflo(unsigned w) { return __uint_as_float(w << 16); }
__device__ __forceinline__ float bfhi(unsigned w) { return __uint_as_float(w & 0xffff0000u); }
__device__ __forceinline__ unsigned short f2bf(float f) { return (unsigned short)(cvtpk(f, f) & 0xffffu); }
__device__ __forceinline__ float sigmoidf_(float x) { return __builtin_amdgcn_rcpf(1.0f + __expf(-x)); }
__device__ __forceinline__ float siluf_(float x) { return x * sigmoidf_(x); }
__device__ __forceinline__ float wave_sum(float v) {
#pragma unroll
    for (int o = 32; o >= 1; o >>= 1) v += __shfl_xor(v, o);
    return v;
}

__device__ __forceinline__ void prep_phase(const Params& p, unsigned char* lds_g) {
    int tid_ = threadIdx.x; asm volatile("" : "+v"(tid_));
    const int tid = tid_, G = gridDim.x, bid = blockIdx.x;
    unsigned char* ws = p.ws;
    float* tile = (float*)lds_g;
    constexpr int T_IN = 32 * 272, T_AO = 32 * 32, T_FO = 16 * 32, T_CO = 16 * 32, T_OUT = 32 * 32, T_MIX = 16 * 16;
    constexpr int T_LAYER = T_IN + T_AO + T_FO + T_CO + T_OUT + T_MIX;
    for (int t = bid; t < DEPTH * T_LAYER; t += G) {
        const int l = t / T_LAYER; int r = t % T_LAYER;
        const float* src; int ldsrc; bf16_t* dst; int lddst; int ktiles;
        if (r < T_IN) { src = p.in[I_WIN] + (size_t)l * DM * INC; ldsrc = INC; dst = (bf16_t*)(ws + WS_WINT + l * SZ_WINT); lddst = DM; ktiles = 32; }
        else if ((r -= T_IN) < T_AO) { src = p.in[I_WAO] + (size_t)l * DM * DM; ldsrc = DM; dst = (bf16_t*)(ws + WS_WCAT + l * SZ_WCAT); lddst = CLD; ktiles = 32; }
        else if ((r -= T_AO) < T_FO) { src = p.in[I_WFO] + (size_t)l * 1024 * DM; ldsrc = DM; dst = (bf16_t*)(ws + WS_WCAT + l * SZ_WCAT) + WPL; lddst = CLD; ktiles = 16; }
        else if ((r -= T_FO) < T_CO) { src = p.in[I_WCO] + (size_t)l * 1024 * DM; ldsrc = DM; dst = (bf16_t*)(ws + WS_WCAT + l * SZ_WCAT) + 2 * WPL; lddst = CLD; ktiles = 16; }
        else if ((r -= T_CO) < T_OUT) { src = p.in[I_WOUT] + (size_t)l * DM * DM; ldsrc = DM; dst = (bf16_t*)(ws + WS_WOUT + l * SZ_WOUT); lddst = DM; ktiles = 32; }
        else { r -= T_OUT; src = p.in[I_WFM] + (size_t)l * 1024 * 1024; ldsrc = 1024; dst = (bf16_t*)(ws + WS_WMIXR + l * SZ_WMIXR); lddst = 1024; ktiles = 16; }
        const int k0 = (r % ktiles) * 64, n0 = (r / ktiles) * 64;
        { const int ty = tid >> 4, tx = tid & 15;
#pragma unroll
          for (int ps = 0; ps < 2; ++ps) { const int kk = ty + 32 * ps;
              const f32x4 v = *(const f32x4*)(src + (size_t)(k0 + kk) * ldsrc + n0 + tx * 4);
              tile[kk * 65 + tx * 4 + 0] = v[0]; tile[kk * 65 + tx * 4 + 1] = v[1]; tile[kk * 65 + tx * 4 + 2] = v[2]; tile[kk * 65 + tx * 4 + 3] = v[3]; } }
        __syncthreads();
        { const int n = tid >> 3, kc = (tid & 7) * 8; u32x4 w;
          w.x = cvtpk(tile[(kc + 0) * 65 + n], tile[(kc + 1) * 65 + n]); w.y = cvtpk(tile[(kc + 2) * 65 + n], tile[(kc + 3) * 65 + n]);
          w.z = cvtpk(tile[(kc + 4) * 65 + n], tile[(kc + 5) * 65 + n]); w.w = cvtpk(tile[(kc + 6) * 65 + n], tile[(kc + 7) * 65 + n]);
          *(u32x4*)(dst + (size_t)(n0 + n) * lddst + k0 + kc) = w; }
        __syncthreads();
    }
    {
        float* sc = (float*)lds_g;
        float* red = sc + 4096;
        for (int u = bid; u < 256; u += G) {
            for (int k = tid; k < 4096; k += NTHREADS) { const float cv = (k < 2048) ? p.in[I_C][k] : p.in[I_CCTX][k - 2048]; sc[k] = siluf_(cv); }
            __syncthreads();
            const int l = u >> 6, j0 = (u & 63) * 96;
            if (tid < 504) { const int kg = tid / 24, cq = tid % 24;
                f32x4 al = {0.f, 0.f, 0.f, 0.f}, ac = {0.f, 0.f, 0.f, 0.f};
                const float* wp = p.in[I_WMOD] + (size_t)l * DM * 6144 + j0 + cq * 4;
                for (int k = kg; k < 2048; k += 21) { const f32x4 w = *(const f32x4*)(wp + (size_t)k * 6144); al += sc[k] * w; ac += sc[2048 + k] * w; }
                float* rp = red + (kg * 24 + cq) * 8;
                rp[0] = al[0]; rp[1] = al[1]; rp[2] = al[2]; rp[3] = al[3]; rp[4] = ac[0]; rp[5] = ac[1]; rp[6] = ac[2]; rp[7] = ac[3]; }
            __syncthreads();
            if (tid < 192) { const int v = tid / 96, col = tid % 96, cq = col >> 2, e = col & 3; float s = 0.f;
                for (int kg = 0; kg < 21; ++kg) s += red[(kg * 24 + cq) * 8 + v * 4 + e];
                ((float*)(ws + WS_MOD))[(size_t)(l * 2 + v) * 6144 + j0 + col] = s + p.in[I_BMOD][(size_t)l * 6144 + j0 + col]; }
            __syncthreads();
        }
    }
    const long gt = (long)bid * NTHREADS + tid, gn = (long)G * NTHREADS;
    for (long it = gt; it < 256 * 16; it += gn) { const int r = (int)(it >> 4), s0 = (int)(it & 15) * 8, k1 = r >> 1, ri = r & 1;
        float v[8];
#pragma unroll
        for (int j = 0; j < 8; ++j) { const int ph = (k1 * (s0 + j)) & 127; const float x = (float)ph * (1.0f / 128.0f); v[j] = (ri ? -__builtin_amdgcn_sinf(x) : __builtin_amdgcn_cosf(x)) * 0.08838834764831845f; }
        u32x4 w; w.x = cvtpk(v[0], v[1]); w.y = cvtpk(v[2], v[3]); w.z = cvtpk(v[4], v[5]); w.w = cvtpk(v[6], v[7]);
        *(u32x4*)((bf16_t*)(ws + WS_T1) + (size_t)r * 128 + s0) = w; }
    for (long it = gt; it < 256 * 32; it += gn) { const int rr = (int)(it >> 5), c0 = (int)(it & 31) * 8, kb = rr >> 7, pq = (rr >> 6) & 1, k2 = rr & 63;
        float v[8];
#pragma unroll
        for (int j = 0; j < 8; ++j) { const int cc = c0 + j, kbc = cc >> 7, s2 = (cc >> 1) & 63, ri = cc & 1; const int ph = (k2 * s2) & 63; const float x = (float)ph * (1.0f / 64.0f);
            const float cs = __builtin_amdgcn_cosf(x), sn = __builtin_amdgcn_sinf(x);
            const float val = pq == 0 ? (ri == 0 ? cs : sn) : (ri == 0 ? sn : -cs);
            v[j] = (kb == kbc) ? val * 0.125f : 0.f; }
        u32x4 w; w.x = cvtpk(v[0], v[1]); w.y = cvtpk(v[2], v[3]); w.z = cvtpk(v[4], v[5]); w.w = cvtpk(v[6], v[7]);
        *(u32x4*)((bf16_t*)(ws + WS_A2) + (size_t)rr * 256 + c0) = w; }
    for (long it = gt; it < 2 * 512 * 32; it += gn) { const int which = (int)(it >> 14), rr = (int)(it & 16383), r = rr >> 5, s0 = (rr & 31) * 8, k = r & 255; const bool isin = r >= 256;
        bf16_t* A = (bf16_t*)(ws + (which ? WS_TCH : WS_ACTX)); const float sgn = (which && isin) ? -0.0625f : 0.0625f;
        float v[8];
#pragma unroll
        for (int j = 0; j < 8; ++j) { const int ph = (k * (s0 + j)) & 255; const float x = (float)ph * (1.0f / 256.0f); v[j] = (isin ? __builtin_amdgcn_sinf(x) : __builtin_amdgcn_cosf(x)) * sgn; }
        u32x4 w; w.x = cvtpk(v[0], v[1]); w.y = cvtpk(v[2], v[3]); w.z = cvtpk(v[4], v[5]); w.w = cvtpk(v[6], v[7]);
        *(u32x4*)(A + (size_t)r * 256 + s0) = w; }
    for (long it = gt; it < 128 * 32; it += gn) { const int pos = (int)(it >> 5), i = (int)(it & 31);
        const float freq = exp2f(-(float)i * (13.287712379549449f / 32.0f));
        const float ang = (float)pos * freq;
        double rev = (double)ang * 0.15915494309189535; rev -= floor(rev);
        const float xr = (float)rev;
        float2 cs; cs.x = __builtin_amdgcn_cosf(xr); cs.y = __builtin_amdgcn_sinf(xr);
        ((float2*)(ws + WS_ROPE))[it] = cs; }
    { f32x4* xs = (f32x4*)(ws + WS_XS); const f32x4* cx = (const f32x4*)p.in[I_CTX]; const f32x4* xx = (const f32x4*)p.in[I_X];
      const long nc = (long)CTX * DM / 4, nt = (long)ROWS * DM / 4;
      for (long it = gt; it < nt; it += gn) xs[it] = (it < nc) ? cx[it] : xx[it - nc]; }
}

__device__ __forceinline__ void rownorm_phase(const Params& p, int l) {
    int tid_ = threadIdx.x; asm volatile("" : "+v"(tid_));
    const int tid = tid_, lane = tid & 63, wid = tid >> 6;
    unsigned char* ws = p.ws;
    const int gw = blockIdx.x * 8 + wid, nw = gridDim.x * 8;
    const float* mod = (const float*)(ws + WS_MOD);
    for (int row = gw; row < ROWS; row += nw) {
        const int isctx = row < CTX ? 1 : 0;
        if (l == 4 && isctx) continue;
        float* xrow = (float*)(ws + WS_XS) + (size_t)row * DM;
        f32x4 xv[8];
#pragma unroll
        for (int i = 0; i < 8; ++i) xv[i] = *(const f32x4*)(xrow + lane * 4 + i * 256);
        if (l > 0) {
            const bf16_t* orow = (const bf16_t*)(ws + WS_OUTB) + (size_t)row * DM;
            f32x4 ov[8]; float ss = 0.f;
#pragma unroll
            for (int i = 0; i < 8; ++i) {
                if (isctx) { const float* pp = (const float*)(ws + WS_OUTP) + (size_t)row * DM + lane * 4 + i * 256;
                    ov[i] = (*(const f32x4*)pp + *(const f32x4*)(pp + (size_t)CTX * DM)) + (*(const f32x4*)(pp + (size_t)2 * CTX * DM) + *(const f32x4*)(pp + (size_t)3 * CTX * DM)); }
                else { const u32x2 w = *(const u32x2*)(orow + lane * 4 + i * 256); ov[i] = (f32x4){bflo(w.x), bfhi(w.x), bflo(w.y), bfhi(w.y)}; }
                ss += ov[i][0] * ov[i][0] + ov[i][1] * ov[i][1] + ov[i][2] * ov[i][2] + ov[i][3] * ov[i][3]; }
            ss = wave_sum(ss);
            const float rstd = rsqrtf(ss * (1.0f / DM) + EPS);
            const float* gate = mod + (size_t)((l - 1) * 2 + isctx) * 6144 + 4096;
            const float* gpost = p.in[I_GPOST] + (size_t)(l - 1) * DM;
#pragma unroll
            for (int i = 0; i < 8; ++i) { const f32x4 g = *(const f32x4*)(gate + lane * 4 + i * 256), gp = *(const f32x4*)(gpost + lane * 4 + i * 256);
                xv[i] = xv[i] + g * ((ov[i] * rstd) * gp); }
            if (l == 4) { float* orow2 = p.out + (size_t)(row - CTX) * DM;
#pragma unroll
                for (int i = 0; i < 8; ++i) *(f32x4*)(orow2 + lane * 4 + i * 256) = xv[i];
                continue; }
#pragma unroll
            for (int i = 0; i < 8; ++i) *(f32x4*)(xrow + lane * 4 + i * 256) = xv[i];
        }
        float ss = 0.f;
#pragma unroll
        for (int i = 0; i < 8; ++i) ss += xv[i][0] * xv[i][0] + xv[i][1] * xv[i][1] + xv[i][2] * xv[i][2] + xv[i][3] * xv[i][3];
        ss = wave_sum(ss);
        const float rstd = rsqrtf(ss * (1.0f / DM) + EPS);
        const float* ml = mod + (size_t)(l * 2 + isctx) * 6144;
        const float* gpre = p.in[I_GPRE] + (size_t)l * DM;
        bf16_t* hrow = (bf16_t*)(ws + WS_H) + (size_t)row * DM;
#pragma unroll
        for (int i = 0; i < 8; ++i) { const int c = lane * 4 + i * 256;
            const f32x4 sh = *(const f32x4*)(ml + c), scl = *(const f32x4*)(ml + 2048 + c), gp = *(const f32x4*)(gpre + c);
            const f32x4 hv = ((xv[i] * rstd) * gp) * (1.0f + scl) + sh;
            u32x2 w; w.x = cvtpk(hv[0], hv[1]); w.y = cvtpk(hv[2], hv[3]);
            *(u32x2*)(hrow + c) = w; }
    }
}

__device__ __forceinline__ void ew_phase(const Params& p, int l) {
    int tid_ = threadIdx.x; asm volatile("" : "+v"(tid_));
    const int tid = tid_;
    unsigned char* ws = p.ws;
    bf16_t* P = (bf16_t*)(ws + WS_P);
    {
        const int t = tid & 15; const long grp = ((long)blockIdx.x * NTHREADS + tid) >> 4, ngrp = (long)gridDim.x * NTHREADS / 16;
        const float2* rope = (const float2*)(ws + WS_ROPE);
        const int base = ((t & 8) ? 64 : 0) + 4 * (t & 7), fi = 4 * (t & 7);
        bf16_t* KC = (bf16_t*)(ws + WS_KC);
#pragma unroll 2
        for (long it = grp; it < (long)ROWS * 20; it += ngrp) { const int row = (int)(it / 20), head = (int)(it % 20);
            const bf16_t* src_ = P + (size_t)row * INC + (head < 16 ? OQ + head * 128 : OKK + (head - 16) * 128) + base;
            bf16_t* dst_ = (head < 16) ? (P + (size_t)row * INC + OQ + head * 128 + base) : (KC + ((size_t)(head - 16) * ROWS + row) * 128 + base);
            const float* gn = (head < 16 ? p.in[I_QN] : p.in[I_KN]) + (size_t)l * 128 + base;
            const u32x2 wa = *(const u32x2*)src_, wb = *(const u32x2*)(src_ + 32);
            const f32x4 ga = *(const f32x4*)gn, gb = *(const f32x4*)(gn + 32);
            float a[4] = {bflo(wa.x), bfhi(wa.x), bflo(wa.y), bfhi(wa.y)}, b[4] = {bflo(wb.x), bfhi(wb.x), bflo(wb.y), bfhi(wb.y)};
            float ss = 0.f;
#pragma unroll
            for (int q = 0; q < 4; ++q) ss += a[q] * a[q] + b[q] * b[q];
#pragma unroll
            for (int o = 8; o >= 1; o >>= 1) ss += __shfl_xor(ss, o);
            const float rstd = rsqrtf(ss * (1.0f / 128.0f) + EPS);
#pragma unroll
            for (int q = 0; q < 4; ++q) { a[q] = a[q] * rstd * ga[q]; b[q] = b[q] * rstd * gb[q]; }
            if (row >= CTX) { const int tk = row - CTX, pos = (t & 8) ? (tk & 63) : (tk >> 6);
                const f32x4 r01 = *(const f32x4*)(rope + pos * 32 + fi), r23 = *(const f32x4*)(rope + pos * 32 + fi + 2);
                const float cs[4] = {r01[0], r01[2], r23[0], r23[2]}, sn[4] = {r01[1], r01[3], r23[1], r23[3]};
#pragma unroll
                for (int q = 0; q < 4; ++q) { const float x0 = a[q], x1 = b[q]; a[q] = x0 * cs[q] - x1 * sn[q]; b[q] = x0 * sn[q] + x1 * cs[q]; } }
            u32x2 oa, ob; oa.x = cvtpk(a[0], a[1]); oa.y = cvtpk(a[2], a[3]); ob.x = cvtpk(b[0], b[1]); ob.y = cvtpk(b[2], b[3]);
            *(u32x2*)dst_ = oa; *(u32x2*)(dst_ + 32) = ob;
        }
    }
    {
        const long gt = (long)blockIdx.x * NTHREADS + tid, gn = (long)gridDim.x * NTHREADS;
        bf16_t* VC = (bf16_t*)(ws + WS_VC);
        for (long it = gt; it < (long)ROWS * 64; it += gn) { const int row = (int)(it >> 6), c = (int)(it & 63) * 8;
            const u32x4 v = *(const u32x4*)(P + (size_t)row * INC + OV + c);
            *(u32x4*)(VC + ((size_t)(c >> 7) * ROWS + row) * 128 + (c & 127)) = v; }
    }
    {
        const long gt = (long)blockIdx.x * NTHREADS + tid, gn = (long)gridDim.x * NTHREADS;
        bf16_t* Acat = (bf16_t*)(ws + WS_ACAT);
        const float* cw = p.in[I_CW] + (size_t)l * 3 * 1024; const float* cbias = p.in[I_CB] + (size_t)l * 1024;
        for (long it = gt; it < (long)(ROWS / 4) * 128; it += gn) { const int row0 = (int)(it >> 7) * 4, c0 = (int)(it & 127) * 8;
            const bf16_t* pr = P + (size_t)row0 * INC;
            const bool hp = (row0 != 0) && (row0 != CTX), hn = (row0 + 4 != CTX) && (row0 + 4 != ROWS);
            const u32x4 z = {0u, 0u, 0u, 0u};
            u32x4 xv[6], kv[6], bb[4], gg[4];
            xv[0] = hp ? *(const u32x4*)(pr - INC + OCX + c0) : z; kv[0] = hp ? *(const u32x4*)(pr - INC + OCC + c0) : z;
#pragma unroll
            for (int r = 0; r < 4; ++r) { xv[r + 1] = *(const u32x4*)(pr + (size_t)r * INC + OCX + c0); kv[r + 1] = *(const u32x4*)(pr + (size_t)r * INC + OCC + c0);
                bb[r] = *(const u32x4*)(pr + (size_t)r * INC + OCB + c0); gg[r] = *(const u32x4*)(pr + (size_t)r * INC + OCG + c0); }
            xv[5] = hn ? *(const u32x4*)(pr + (size_t)4 * INC + OCX + c0) : z; kv[5] = hn ? *(const u32x4*)(pr + (size_t)4 * INC + OCC + c0) : z;
            float w0[8], w1[8], w2[8], bs[8];
#pragma unroll
            for (int j = 0; j < 8; ++j) { w0[j] = cw[c0 + j]; w1[j] = cw[1024 + c0 + j]; w2[j] = cw[2048 + c0 + j]; bs[j] = cbias[c0 + j]; }
            float uu[6][8];
#pragma unroll
            for (int r = 0; r < 6; ++r)
#pragma unroll
                for (int q = 0; q < 4; ++q) { uu[r][2 * q] = bflo(xv[r][q]) * bflo(kv[r][q]); uu[r][2 * q + 1] = bfhi(xv[r][q]) * bfhi(kv[r][q]); }
#pragma unroll
            for (int r = 0; r < 4; ++r) { float res[8];
#pragma unroll
                for (int q = 0; q < 4; ++q) {
                    { const int j = 2 * q; const float cv = uu[r][j] * w0[j] + uu[r + 1][j] * w1[j] + uu[r + 2][j] * w2[j] + bs[j]; res[j] = bflo(bb[r][q]) * cv * siluf_(bflo(gg[r][q])); }
                    { const int j = 2 * q + 1; const float cv = uu[r][j] * w0[j] + uu[r + 1][j] * w1[j] + uu[r + 2][j] * w2[j] + bs[j]; res[j] = bfhi(bb[r][q]) * cv * siluf_(bfhi(gg[r][q])); } }
                u32x4 w; w.x = cvtpk(res[0], res[1]); w.y = cvtpk(res[2], res[3]); w.z = cvtpk(res[4], res[5]); w.w = cvtpk(res[6], res[7]);
                *(u32x4*)(Acat + 2 * APL + (size_t)(row0 + r) * CLD + c0) = w; }
        }
    }
}

constexpr int BM = 256, BK = 64, HALF = 128, HTB = HALF * BK * 2;
__device__ __forceinline__ int lds_byte(int r, int c) { const int st = (r >> 4) * 2 + (c >> 5), rr = r & 15, cc = c & 31, ob = rr * 64 + cc * 2; return st * 1024 + (ob ^ (((ob >> 9) & 1) << 5)); }
__device__ __forceinline__ void stage_rc(int b, int& R, int& C) { const int st = b / 1024, sb = b % 1024, swz = sb ^ (((sb >> 9) & 1) << 5); R = (st >> 1) * 16 + swz / 64; C = (st & 1) * 32 + (swz % 64) / 2; }
__device__ __forceinline__ int perm32(int rho) { const int n = rho >> 4, i = rho & 15; return 8 * (i >> 2) + 4 * n + (i & 3); }

enum { G_FOLD = 0, G_IN, G_XT, G_F1, G_F2, G_DFTC, G_MIX, G_MERGE, G_OUT, G_MERGEC };
enum { M_BF16 = 0, M_MIX, M_MERGE0, M_MERGE1, M_MERGE2, M_F32, M_F1, M_F2, M_MG0, M_MG1, M_MG2 };
struct Unit { const char* a; const char* b; char* o; const char* aux; char* m; int nt, mode, ldo; };

__device__ __forceinline__ void static_order(int w, int nM, int nN, int& pm, int& pn) {
    const int nwg = nM * nN, q = nwg / 8, r = nwg % 8, xcd = w % 8, off = w / 8;
    const int wg = (xcd < r ? xcd * (q + 1) : r * (q + 1) + (xcd - r) * q) + off;
    const int nig = 8 * nN, gid = wg / nig, fm = gid * 8, gsz = (nM - fm) < 8 ? (nM - fm) : 8;
    pm = fm + ((wg % nig) % gsz); pn = (wg % nig) / gsz;
}

__device__ __forceinline__ bool get_unit(int gid, int l, int i, unsigned char* ws, Unit& u) {
    const int G = gridDim.x, c = blockIdx.x;
    u.aux = nullptr; u.m = nullptr;
    switch (gid) {
    case G_FOLD: { const int L = i * G + c; if (L >= 128) return false;
        const int ll = L >> 5, g = (L >> 3) & 3, pm = (L >> 1) & 3, pnn = L & 1;
        u.a = (const char*)(ws + WS_WMIXR + ll * SZ_WMIXR) + ((size_t)pm * 256 * 1024 + g * 256) * 2;
        u.b = (const char*)(ws + WS_TCH) + (size_t)pnn * 256 * 256 * 2;
        u.o = (char*)(ws + WS_WMIX + ll * SZ_WMIX) + ((size_t)pm * 256 * 2048 + pnn * 1024 + g * 256) * 2;
        u.nt = 4; u.mode = M_BF16; u.ldo = 2048; return true; }
    case G_IN: { const int L = i * G + c; if (L >= 2116) return false;
        if (L < 2112) { int pm, pn; static_order(L, 33, 64, pm, pn); const int pnp = pn < 20 ? pn : pn + 4;
            u.a = (const char*)(ws + WS_H) + (size_t)pm * 256 * DM * 2;
            u.b = (const char*)(ws + WS_WINT + l * SZ_WINT) + (size_t)pnp * 256 * DM * 2;
            u.o = (char*)(ws + WS_P) + ((size_t)pm * 256 * INC + pnp * 256) * 2; u.ldo = INC; }
        else { const int pm = L - 2112;
            u.a = (const char*)(ws + WS_WINT + l * SZ_WINT) + (size_t)(OFX + pm * 256) * DM * 2;
            u.b = (const char*)(ws + WS_H);
            u.o = (char*)(ws + WS_XT) + (size_t)pm * 256 * ROWS * 2; u.ldo = ROWS; }
        u.nt = 32; u.mode = M_BF16; return true; }
    case G_XT: { const int L = i * G + ((c + G - 68) % G); if (L >= 128) return false; const int pm = L & 3, pn = 1 + (L >> 2);
        u.a = (const char*)(ws + WS_WINT + l * SZ_WINT) + (size_t)(OFX + pm * 256) * DM * 2;
        u.b = (const char*)(ws + WS_H) + (size_t)(CTX + 2 * (pn - 1)) * DM * 2;
        u.o = (char*)(ws + WS_XT) + ((size_t)pm * 256 * ROWS + pn * 256) * 2; u.ldo = ROWS;
        u.nt = 32; u.mode = M_BF16; return true; }
    case G_F1: { const int L = i * G + c; if (L >= 256) return false; const int s2 = L >> 2, ct = L & 3;
        u.a = (const char*)(ws + WS_XT) + ((size_t)ct * 256 * ROWS + CTX + s2 * 128) * 2;
        u.b = (const char*)(ws + WS_T1);
        u.o = (char*)(ws + WS_ZT) + (size_t)ct * 256 * ZCH + s2 * 4;
        u.nt = 2; u.mode = M_F1; u.ldo = s2; return true; }
    case G_F2: { const int L = i * G + c; if (L >= 256) return false; const int k1p = L >> 2, ct = L & 3;
        u.a = (const char*)(ws + WS_A2);
        u.b = (const char*)(ws + WS_ZT) + (size_t)ct * 256 * ZCH + k1p * 512;
        u.o = (char*)(ws + WS_PQ) + ((size_t)(CTX + 2 * k1p) * 2048 + ct * 256) * 2;
        u.nt = 4; u.mode = M_F2; u.ldo = 2048; return true; }
    case G_DFTC: { const int L = i * G + c; if (L >= 8) return false; const int pm = L >> 2, pn = L & 3;
        u.a = (const char*)(ws + WS_ACTX) + (size_t)pm * 256 * 256 * 2;
        u.b = (const char*)(ws + WS_XT) + (size_t)pn * 256 * ROWS * 2;
        u.o = (char*)(ws + WS_PQ) + ((size_t)pm * 1024 + pn * 256) * 2;
        u.nt = 4; u.mode = M_BF16; u.ldo = 2048; return true; }
    case G_MIX: { const int L = i * G + (G - 1 - c); if (L >= 132) return false; const int pm = L >> 2, pn = L & 3;
        u.a = (const char*)(ws + WS_PQ) + (size_t)pm * 256 * 2048 * 2;
        u.b = (const char*)(ws + WS_WMIX + l * SZ_WMIX) + (size_t)pn * 256 * 2048 * 2;
        u.aux = (const char*)(ws + WS_P) + ((size_t)pm * 256 * INC + OFG + pn * 256) * 2;
        u.o = (char*)(ws + WS_ACAT) + (APL + (size_t)pm * 256 * CLD + pn * 256) * 2;
        u.nt = 32; u.mode = M_MIX; u.ldo = CLD; return true; }
    case G_MERGE: {
        if (i < 3) { const int T = c, sub = i; if (T >= 256) return false;
            int pm, pn; static_order(T, 32, 8, pm, pn); pm += 1;
            u.a = (const char*)(ws + WS_ACAT) + ((size_t)sub * APL + (size_t)pm * 256 * CLD) * 2;
            u.b = (const char*)(ws + WS_WCAT + l * SZ_WCAT) + ((size_t)sub * WPL + (size_t)pn * 256 * CLD) * 2;
            u.aux = (const char*)(ws + WS_P) + ((size_t)pm * 256 * INC + OML + sub * 2048 + pn * 256) * 2;
            u.m = (char*)(ws + WS_MBUF) + ((size_t)pm * 256 * MLD + pn * 256) * 4;
            u.o = (char*)(ws + WS_MB) + ((size_t)pm * 256 * 2048 + pn * 256) * 2;
            u.nt = sub == 0 ? 32 : 16; u.mode = M_MG0 + sub; u.ldo = 2048; return true; }
        return false; }
    case G_MERGEC: {
        if (i == 0 && l < DEPTH - 1 && c >= G - 64) { const int pc = c - (G - 64), pn = pc >> 3, q = pc & 7;
            const int sub = q < 4 ? 0 : (q < 6 ? 1 : 2), kcol = q < 4 ? q * 512 : (q < 6 ? (q - 4) * 512 : (q - 6) * 512);
            u.a = (const char*)(ws + WS_ACAT) + ((size_t)sub * APL + kcol) * 2;
            u.b = (const char*)(ws + WS_WCAT + l * SZ_WCAT) + ((size_t)sub * WPL + (size_t)pn * 256 * CLD + kcol) * 2;
            u.aux = (const char*)(ws + WS_P) + ((size_t)OML + sub * 2048 + pn * 256) * 2;
            u.m = (char*)(ws + WS_MP) + ((size_t)q * CTX * MLD + pn * 256) * 4;
            u.o = nullptr; u.nt = 8; u.mode = M_MERGE0; u.ldo = 2048; return true; }
        return false; }
    case G_OUT: {
        const int piece = l >> 4; l &= 15;
        if (i != 0) return false;
        if (!piece) { if (c >= 256) return false; int pm, pn; static_order(c, 32, 8, pm, pn); pm += 1;
            u.a = (const char*)(ws + WS_MB) + (size_t)pm * 256 * 2048 * 2;
            u.b = (const char*)(ws + WS_WOUT + l * SZ_WOUT) + (size_t)pn * 256 * 2048 * 2;
            u.o = (char*)(ws + WS_OUTB) + ((size_t)pm * 256 * 2048 + pn * 256) * 2;
            u.nt = 32; u.mode = M_BF16; u.ldo = 2048; return true; }
        if (l < DEPTH - 1 && c >= G - 32) { const int pc = c - (G - 32), pn = pc >> 2, kp = pc & 3;
            u.a = (const char*)(ws + WS_MB) + (size_t)kp * 512 * 2;
            u.b = (const char*)(ws + WS_WOUT + l * SZ_WOUT) + ((size_t)pn * 256 * 2048 + kp * 512) * 2;
            u.o = (char*)(ws + WS_OUTP) + ((size_t)kp * CTX * 2048 + pn * 256) * 4;
            u.nt = 8; u.mode = M_F32; u.ldo = 2048; return true; }
        return false; }
    }
    return false;
}

__device__ __forceinline__ void epilogue(const f32x4 (&acc)[2][2][4][2], const Unit& u, int wr, int wc, int fr, int fq) {
    unsigned r0 = wr * 64 + fr, c0 = wc * 32 + 8 * fq;
    asm volatile("" : "+v"(r0), "+v"(c0));
    if (u.mode == M_BF16) {
        const unsigned base = (r0 * (unsigned)u.ldo + c0) * 2u;
#pragma unroll
        for (int ai = 0; ai < 2; ++ai)
#pragma unroll
            for (int m = 0; m < 4; ++m) { char* rowp = u.o + (size_t)(ai * HALF + m * 16) * u.ldo * 2;
#pragma unroll
                for (int bj = 0; bj < 2; ++bj) { const f32x4 v0 = acc[ai][bj][m][0], v1 = acc[ai][bj][m][1];
                    u32x4 w; w.x = cvtpk(v0[0], v0[1]); w.y = cvtpk(v0[2], v0[3]); w.z = cvtpk(v1[0], v1[1]); w.w = cvtpk(v1[2], v1[3]);
                    *(u32x4*)(rowp + base + bj * HALF * 2) = w; } }
    } else if (u.mode == M_MIX) {
        const unsigned base = (r0 * (unsigned)u.ldo + c0) * 2u, abase = (r0 * (unsigned)INC + c0) * 2u;
#pragma unroll
        for (int ai = 0; ai < 2; ++ai)
#pragma unroll
            for (int m = 0; m < 4; ++m) { char* rowp = u.o + (size_t)(ai * HALF + m * 16) * u.ldo * 2; const char* ap = u.aux + (size_t)(ai * HALF + m * 16) * INC * 2;
#pragma unroll
                for (int bj = 0; bj < 2; ++bj) { const f32x4 v0 = acc[ai][bj][m][0], v1 = acc[ai][bj][m][1]; const u32x4 g = *(const u32x4*)(ap + abase + bj * HALF * 2);
                    u32x4 w; w.x = cvtpk(v0[0] * siluf_(bflo(g.x)), v0[1] * siluf_(bfhi(g.x))); w.y = cvtpk(v0[2] * siluf_(bflo(g.y)), v0[3] * siluf_(bfhi(g.y)));
                    w.z = cvtpk(v1[0] * siluf_(bflo(g.z)), v1[1] * siluf_(bfhi(g.z))); w.w = cvtpk(v1[2] * siluf_(bflo(g.w)), v1[3] * siluf_(bfhi(g.w)));
                    *(u32x4*)(rowp + base + bj * HALF * 2) = w; }
                if (m & 1) __builtin_amdgcn_sched_barrier(0); }
    } else if (u.mode == M_F32) {
        const unsigned base = (r0 * (unsigned)u.ldo + c0) * 4u;
#pragma unroll
        for (int ai = 0; ai < 2; ++ai)
#pragma unroll
            for (int m = 0; m < 4; ++m) { char* rowp = u.o + (size_t)(ai * HALF + m * 16) * u.ldo * 4;
#pragma unroll
                for (int bj = 0; bj < 2; ++bj) { *(f32x4*)(rowp + base + bj * HALF * 4) = acc[ai][bj][m][0]; *(f32x4*)(rowp + base + bj * HALF * 4 + 16) = acc[ai][bj][m][1]; } }
    } else if (u.mode == M_MG0 || u.mode == M_MG1) {
    } else if (u.mode == M_MG2) {
        const unsigned abase = (r0 * (unsigned)INC + c0) * 2u, obase = (r0 * 2048u + c0) * 2u;
#pragma unroll
        for (int ai = 0; ai < 2; ++ai)
#pragma unroll
            for (int m = 0; m < 4; ++m) { const int rr = ai * HALF + m * 16; const char* ap = u.aux + (size_t)rr * INC * 2; char* rowp = u.o + (size_t)rr * 2048 * 2;
#pragma unroll
                for (int bj = 0; bj < 2; ++bj) { f32x4 v0 = acc[ai][bj][m][0], v1 = acc[ai][bj][m][1]; const u32x4 g = *(const u32x4*)(ap + abase + bj * HALF * 2);
                    v0[0] *= sigmoidf_(bflo(g.x)); v0[1] *= sigmoidf_(bfhi(g.x)); v0[2] *= sigmoidf_(bflo(g.y)); v0[3] *= sigmoidf_(bfhi(g.y));
                    v1[0] *= sigmoidf_(bflo(g.z)); v1[1] *= sigmoidf_(bfhi(g.z)); v1[2] *= sigmoidf_(bflo(g.w)); v1[3] *= sigmoidf_(bfhi(g.w));
                    u32x4 w; w.x = cvtpk(v0[0], v0[1]); w.y = cvtpk(v0[2], v0[3]); w.z = cvtpk(v1[0], v1[1]); w.w = cvtpk(v1[2], v1[3]); *(u32x4*)(rowp + obase + bj * HALF * 2) = w; }
                if (m == 3) __builtin_amdgcn_sched_barrier(0); }
    } else if (u.mode == M_F1) {
        const int s2 = u.ldo;
        const unsigned kb0 = (c0 >> 1);
        float tc[2][4], ts[2][4];
#pragma unroll
        for (int bj = 0; bj < 2; ++bj)
#pragma unroll
            for (int j = 0; j < 4; ++j) { const float x = (float)((bj * 64 + kb0 + j) * s2) * (1.0f / 8192.0f); tc[bj][j] = __builtin_amdgcn_cosf(x); ts[bj][j] = __builtin_amdgcn_sinf(x); }
        const unsigned base = r0 * (unsigned)ZCH + kb0 * 256u;
#pragma unroll
        for (int ai = 0; ai < 2; ++ai)
#pragma unroll
            for (int m = 0; m < 4; ++m) { char* rowp = u.o + (size_t)(ai * HALF + m * 16) * ZCH;
#pragma unroll
                for (int bj = 0; bj < 2; ++bj) { const f32x4 v0 = acc[ai][bj][m][0], v1 = acc[ai][bj][m][1];
                    const float zr[4] = {v0[0], v0[2], v1[0], v1[2]}, zi[4] = {v0[1], v0[3], v1[1], v1[3]};
#pragma unroll
                    for (int j = 0; j < 4; ++j) { const float pr = zr[j] * tc[bj][j] + zi[j] * ts[bj][j], pi = zi[j] * tc[bj][j] - zr[j] * ts[bj][j];
                        *(unsigned*)(rowp + base + (bj * 64 + j) * 256) = cvtpk(pr, pi); } } }
    } else if (u.mode == M_F2) {
        const unsigned fr_ = r0 & 15u, wr_ = r0 >> 6;
        const unsigned base = ((128u * fr_) * 2048u + wr_ * 1024u + c0) * 2u;
#pragma unroll
        for (int ai = 0; ai < 2; ++ai)
#pragma unroll
            for (int m = 0; m < 4; ++m) { char* rowp = u.o + (size_t)(ai + 2048 * m) * 2048 * 2;
#pragma unroll
                for (int bj = 0; bj < 2; ++bj) { const f32x4 v0 = acc[ai][bj][m][0], v1 = acc[ai][bj][m][1];
                    u32x4 w; w.x = cvtpk(v0[0], v0[1]); w.y = cvtpk(v0[2], v0[3]); w.z = cvtpk(v1[0], v1[1]); w.w = cvtpk(v1[2], v1[3]);
                    *(u32x4*)(rowp + base + bj * HALF * 2) = w; } }
    } else {
        const unsigned abase = (r0 * (unsigned)INC + c0) * 2u, mbase = (r0 * (unsigned)MLD + c0) * 4u;
#pragma unroll
        for (int ai = 0; ai < 2; ++ai)
#pragma unroll
            for (int m = 0; m < 4; ++m) { const int rr = ai * HALF + m * 16; const char* ap = u.aux + (size_t)rr * INC * 2; char* mp = u.m + (size_t)rr * MLD * 4;
#pragma unroll
                for (int bj = 0; bj < 2; ++bj) { f32x4 v0 = acc[ai][bj][m][0], v1 = acc[ai][bj][m][1]; const u32x4 g = *(const u32x4*)(ap + abase + bj * HALF * 2);
                    v0[0] *= sigmoidf_(bflo(g.x)); v0[1] *= sigmoidf_(bfhi(g.x)); v0[2] *= sigmoidf_(bflo(g.y)); v0[3] *= sigmoidf_(bfhi(g.y));
                    v1[0] *= sigmoidf_(bflo(g.z)); v1[1] *= sigmoidf_(bfhi(g.z)); v1[2] *= sigmoidf_(bflo(g.w)); v1[3] *= sigmoidf_(bfhi(g.w));
                    *(f32x4*)(mp + mbase + bj * HALF * 4) = v0; *(f32x4*)(mp + mbase + bj * HALF * 4 + 16) = v1; }
                if (m & 1) __builtin_amdgcn_sched_barrier(0); }
    }
}

__device__ __forceinline__ void rescale_or_reset(f32x4 (&acc)[2][2][4][2], const Unit& u, int wr, int wc, int fr, int fq) {
    const unsigned msk = (u.mode == M_MG0 || u.mode == M_MG1) ? 0xffffffffu : 0u;
    unsigned r0 = wr * 64 + fr, c0 = wc * 32 + 8 * fq;
    asm volatile("" : "+v"(r0), "+v"(c0));
    const unsigned abase = (r0 * (unsigned)INC + c0) * 2u;
#pragma unroll
    for (int ai = 0; ai < 2; ++ai)
#pragma unroll
        for (int m = 0; m < 4; ++m) { const char* ap = u.aux + (size_t)(ai * HALF + m * 16) * INC * 2;
#pragma unroll
            for (int bj = 0; bj < 2; ++bj) {
                const u32x4 ga = *(const u32x4*)(ap + abase + bj * HALF * 2), gb = *(const u32x4*)(ap + abase + bj * HALF * 2 + 4096);
                const unsigned wa[4] = {ga.x, ga.y, ga.z, ga.w}, wb[4] = {gb.x, gb.y, gb.z, gb.w};
                float f[8];
#pragma unroll
                for (int e = 0; e < 4; ++e) {
                    const float rl = (1.0f + __expf(-bflo(wb[e]))) * __builtin_amdgcn_rcpf(1.0f + __expf(-bflo(wa[e])));
                    const float rh = (1.0f + __expf(-bfhi(wb[e]))) * __builtin_amdgcn_rcpf(1.0f + __expf(-bfhi(wa[e])));
                    f[2 * e] = __uint_as_float(__float_as_uint(rl) & msk); f[2 * e + 1] = __uint_as_float(__float_as_uint(rh) & msk); }
                acc[ai][bj][m][0] *= (f32x4){f[0], f[1], f[2], f[3]}; acc[ai][bj][m][1] *= (f32x4){f[4], f[5], f[6], f[7]};
            }
            if (m & 1) __builtin_amdgcn_sched_barrier(0);
        }
}

__device__ __forceinline__ void gemm_phase(LAS unsigned char* lds, int gid, int l, unsigned char* ws) {
    int tid_ = threadIdx.x; asm volatile("" : "+v"(tid_));
    const int tid = tid_, wid = __builtin_amdgcn_readfirstlane(tid >> 6), lane = tid & 63, wr = wid >> 2, wc = wid & 3, fr = lane & 15, fq = lane >> 4;
    int lda, ldb;
    int ldbv = 0;
    switch (gid) { case G_FOLD: lda = 1024; ldb = 256; break; case G_IN: lda = 2048; ldb = 2048; break; case G_XT: lda = 2048; ldb = 2048; ldbv = 64 * 2048; break;
                   case G_F1: lda = ROWS; ldb = 128; break; case G_F2: lda = 256; ldb = ZCH / 2; break;
                   case G_DFTC: lda = 256; ldb = ROWS; break; case G_MIX: lda = 2048; ldb = 2048; break; case G_MERGE: case G_MERGEC: lda = CLD; ldb = CLD; break; default: lda = 2048; ldb = 2048; break; }
    if (ldbv == 0) ldbv = ldb;
    Unit cur, nxt; int ui = 0;
    if (!get_unit(gid, l, 0, ws, cur)) return;
    unsigned voffA[2], voffB[2];
#pragma unroll
    for (int i = 0; i < 2; ++i) { int R, C; stage_rc(tid * 16 + i * 8192, R, C); const int Rb = (R & ~31) + perm32(R & 31);
        voffA[i] = (unsigned)(R * lda + C) * 2u; voffB[i] = (unsigned)(Rb * ldbv + C) * 2u; }
    const size_t kstep = (size_t)(BK * 2);
    const size_t hstepA = (size_t)HALF * lda * 2, hstepB = (gid == G_XT) ? (size_t)ldb * 2 : (size_t)HALF * ldb * 2;
    const unsigned ldsw = (unsigned)wid * 1024u;
    const int aoff = lds_byte(wr * 64 + fr, fq * 8), boff = lds_byte(wc * 32 + fr, fq * 8);
#define PG8_SA(b, h) (((b) * 2 + (h)) * HTB)
#define PG8_SB(b, h) ((4 + (b) * 2 + (h)) * HTB)
#define PG8_STAGE(bufoff, gbase, voff) do { _Pragma("unroll") for (int _i = 0; _i < 2; ++_i) \
        __builtin_amdgcn_global_load_lds((const unsigned*)((const char*)(gbase) + (voff)[_i]), (LAS unsigned*)(lds + (bufoff) + ldsw + _i * 8192), 16, 0, 0); } while (0)
#define PG8_LDA(dst, b, h) do { _Pragma("unroll") for (int m = 0; m < 4; ++m) _Pragma("unroll") for (int k = 0; k < 2; ++k) dst[m][k] = *(const LAS bf16x8*)(lds + PG8_SA(b, h) + aoff + m * 2048 + k * 1024); } while (0)
#define PG8_LDB(dst, b, h) do { _Pragma("unroll") for (int n = 0; n < 2; ++n) _Pragma("unroll") for (int k = 0; k < 2; ++k) dst[n][k] = *(const LAS bf16x8*)(lds + PG8_SB(b, h) + boff + n * 2048 + k * 1024); } while (0)
#define PG8_MMA(ai, bj, At, Bt) do { __builtin_amdgcn_s_setprio(1); _Pragma("unroll") for (int m = 0; m < 4; ++m) _Pragma("unroll") for (int n = 0; n < 2; ++n) _Pragma("unroll") for (int k = 0; k < 2; ++k) \
        acc[ai][bj][m][n] = __builtin_amdgcn_mfma_f32_16x16x32_bf16(Bt[n][k], At[m][k], acc[ai][bj][m][n], 0, 0, 0); __builtin_amdgcn_s_setprio(0); } while (0)
#define PG8_WAIT_V(n) asm volatile("s_waitcnt vmcnt(" #n ")" ::: "memory")
#define PG8_WAIT_L(n) asm volatile("s_waitcnt lgkmcnt(" #n ")" ::: "memory")
#define PG8_BAR __builtin_amdgcn_s_barrier()
#define PG8_SCHED __builtin_amdgcn_sched_barrier(0)
    f32x4 acc[2][2][4][2];
#pragma unroll
    for (int a = 0; a < 2; ++a)
#pragma unroll
        for (int b = 0; b < 2; ++b)
#pragma unroll
            for (int m = 0; m < 4; ++m)
#pragma unroll
                for (int n = 0; n < 2; ++n) acc[a][b][m][n] = (f32x4){0.f, 0.f, 0.f, 0.f};
    bf16x8 At[4][2], B0[2][2], B1[2][2];
    const char* cA = cur.a; const char* cB = cur.b;
    PG8_STAGE(PG8_SB(0, 0), cB, voffB); PG8_STAGE(PG8_SA(0, 0), cA, voffA); PG8_STAGE(PG8_SB(0, 1), cB + hstepB, voffB); PG8_STAGE(PG8_SA(0, 1), cA + hstepA, voffA);
    if (wr == 1) PG8_BAR;
    PG8_WAIT_V(4); PG8_BAR;
    PG8_STAGE(PG8_SB(1, 0), cB + kstep, voffB); PG8_STAGE(PG8_SA(1, 0), cA + kstep, voffA); PG8_STAGE(PG8_SB(1, 1), cB + hstepB + kstep, voffB);
    PG8_WAIT_V(6); PG8_BAR;
    for (;;) {
        const bool has_next = get_unit(gid, l, ui + 1, ws, nxt);
        const char* nA = has_next ? nxt.a : cA; const char* nB = has_next ? nxt.b : cB;
        const int nt = cur.nt;
        for (int t = 0; t < nt; t += 2) {
            const bool last = (t == nt - 2);
            const char* a1 = cA + (size_t)(t + 1) * kstep;
            const char* a2 = last ? nA : cA + (size_t)(t + 2) * kstep; const char* b2 = last ? nB : cB + (size_t)(t + 2) * kstep;
            const char* a3 = a2 + kstep; const char* b3 = b2 + kstep;
            PG8_LDB(B0, 0, 0); PG8_SCHED; PG8_LDA(At, 0, 0); PG8_STAGE(PG8_SA(1, 1), a1 + hstepA, voffA);
            PG8_WAIT_L(8); PG8_BAR; PG8_WAIT_L(0); PG8_MMA(0, 0, At, B0); PG8_BAR; PG8_SCHED;
            PG8_LDB(B1, 0, 1); PG8_STAGE(PG8_SB(0, 0), b2, voffB);
            PG8_BAR; PG8_WAIT_L(0); PG8_MMA(0, 1, At, B1); PG8_BAR;
            PG8_LDA(At, 0, 1); PG8_STAGE(PG8_SA(0, 0), a2, voffA);
            PG8_BAR; PG8_WAIT_L(0); PG8_MMA(1, 0, At, B0); PG8_BAR; PG8_SCHED;
            PG8_STAGE(PG8_SB(0, 1), b2 + hstepB, voffB);
            PG8_WAIT_V(6); PG8_BAR; PG8_MMA(1, 1, At, B1); PG8_BAR;
            PG8_LDB(B0, 1, 0); PG8_SCHED; PG8_LDA(At, 1, 0); PG8_STAGE(PG8_SA(0, 1), a2 + hstepA, voffA);
            PG8_WAIT_L(8); PG8_BAR; PG8_WAIT_L(0); PG8_MMA(0, 0, At, B0); PG8_BAR; PG8_SCHED;
            PG8_LDB(B1, 1, 1); PG8_STAGE(PG8_SB(1, 0), b3, voffB);
            PG8_BAR; PG8_WAIT_L(0); PG8_MMA(0, 1, At, B1); PG8_BAR;
            PG8_LDA(At, 1, 1); PG8_STAGE(PG8_SA(1, 0), a3, voffA);
            PG8_BAR; PG8_WAIT_L(0); PG8_MMA(1, 0, At, B0); PG8_BAR; PG8_SCHED;
            PG8_STAGE(PG8_SB(1, 1), b3 + hstepB, voffB);
            PG8_WAIT_V(6); PG8_BAR; PG8_MMA(1, 1, At, B1); PG8_BAR;
        }
        epilogue(acc, cur, wr, wc, fr, fq);
        if (!has_next) break;
        if (gid == G_MERGE) rescale_or_reset(acc, cur, wr, wc, fr, fq);
        else {
#pragma unroll
            for (int a = 0; a < 2; ++a)
#pragma unroll
                for (int b = 0; b < 2; ++b)
#pragma unroll
                    for (int m = 0; m < 4; ++m)
#pragma unroll
                        for (int n = 0; n < 2; ++n) acc[a][b][m][n] = (f32x4){0.f, 0.f, 0.f, 0.f};
        }
        cur = nxt; cA = nA; cB = nB; ++ui;
    }
    PG8_WAIT_V(0);
    if (wr == 0) PG8_BAR;
    PG8_BAR;
#undef PG8_SA
#undef PG8_SB
#undef PG8_STAGE
#undef PG8_LDA
#undef PG8_LDB
#undef PG8_MMA
#undef PG8_WAIT_V
#undef PG8_WAIT_L
#undef PG8_BAR
#undef PG8_SCHED
}

namespace att {
constexpr int D = 128, NW = 8, QBLK = 32, KVBLK = 64;
constexpr float SCALE = 0.088388347648318440f;
constexpr float THR = 8.f;
constexpr int LDQ = INC, LDK = 128, LDO = CLD;
constexpr size_t SHM_V = KVBLK * D * 2, SHM_K = KVBLK * D * 2, SHM_ATTN = 2 * SHM_V + 2 * SHM_K + NW * 64 * 4;
#define KSWZ(row, colB) ((row) * 256 + ((colB) ^ (((row) & 7) << 4)))
#define SBAR() __builtin_amdgcn_sched_barrier(0)
__device__ __forceinline__ int crow(int r, int hi) { return (r & 3) + 8 * (r >> 2) + 4 * hi; }
__device__ __forceinline__ void partialSM(f32x16& p0, f32x16& p1, float& m_reg, float& mn, float& alpha) {
  constexpr float C = SCALE * 1.4426950408889634f;
  float pmax = p0[0];
#pragma unroll
  for (int r = 1; r < 16; ++r) pmax = fmaxf(pmax, p0[r]);
#pragma unroll
  for (int r = 0; r < 16; ++r) pmax = fmaxf(pmax, p1[r]);
  { auto rr = __builtin_amdgcn_permlane32_swap(__float_as_uint(pmax), __float_as_uint(pmax), false, false);
    pmax = fmaxf(__uint_as_float(rr[0]), __uint_as_float(rr[1])); }
  if (__builtin_expect(__all(pmax - m_reg <= THR / SCALE), 1)) { mn = m_reg; alpha = 1.f; }
  else { mn = fmaxf(m_reg, pmax); alpha = __builtin_amdgcn_exp2f((m_reg - mn) * C); m_reg = mn; }
  float mnC = -mn * C;
#pragma unroll
  for (int r = 0; r < 16; ++r) p0[r] = fmaf(p0[r], C, mnC);
#pragma unroll
  for (int r = 0; r < 16; ++r) p1[r] = fmaf(p1[r], C, mnC);
#pragma unroll
  for (int r = 0; r < 16; ++r) p0[r] = __builtin_amdgcn_exp2f(p0[r]);
}
__device__ __forceinline__ void finishSM(f32x16& p0, f32x16& p1, float alpha, float& l_reg, bf16x8& pa0, bf16x8& pa1, bf16x8& pa2, bf16x8& pa3) {
#pragma unroll
  for (int r = 0; r < 16; ++r) p1[r] = __builtin_amdgcn_exp2f(p1[r]);
  float ps = 0;
#pragma unroll
  for (int r = 0; r < 16; ++r) ps += p0[r];
#pragma unroll
  for (int r = 0; r < 16; ++r) ps += p1[r];
  { auto rr = __builtin_amdgcn_permlane32_swap(__float_as_uint(ps), __float_as_uint(ps), false, false);
    ps = __uint_as_float(rr[0]) + __uint_as_float(rr[1]); }
  l_reg = l_reg * alpha + ps;
#define PK4(P, BASE, OUT) do { unsigned a0 = cvtpk(P[BASE + 0], P[BASE + 1]), a1 = cvtpk(P[BASE + 2], P[BASE + 3]);   \
    unsigned b0 = cvtpk(P[BASE + 4], P[BASE + 5]), b1 = cvtpk(P[BASE + 6], P[BASE + 7]);                              \
    auto r0 = __builtin_amdgcn_permlane32_swap(a0, b0, false, false); auto r1 = __builtin_amdgcn_permlane32_swap(a1, b1, false, false); \
    u32x4 w = {r0[0], r1[0], r0[1], r1[1]}; OUT = *reinterpret_cast<bf16x8*>(&w); } while (0)
  PK4(p0, 0, pa0); PK4(p0, 8, pa1); PK4(p1, 0, pa2); PK4(p1, 8, pa3);
#undef PK4
}
__device__ __forceinline__ void qkt(f32x16& p0, f32x16& p1, const bf16_t* Ks, const bf16x8* qr, int r32, int hi) {
  p0 = f32x16{}; p1 = f32x16{};
#pragma unroll
  for (int d0 = 0; d0 < 8; ++d0) { int cb = (d0 * 16 + hi * 8) * 2;
    bf16x8 b0 = *reinterpret_cast<const bf16x8*>((const char*)Ks + KSWZ(r32, cb));
    bf16x8 b1 = *reinterpret_cast<const bf16x8*>((const char*)Ks + KSWZ(32 + r32, cb));
    p0 = __builtin_amdgcn_mfma_f32_32x32x16_bf16(b0, qr[d0], p0, 0, 0, 0);
    p1 = __builtin_amdgcn_mfma_f32_32x32x16_bf16(b1, qr[d0], p1, 0, 0, 0); }
}
__device__ __forceinline__ int v_st(int k, int c) { const int kk = (k & ~0xC) | ((k & 4) << 1) | ((k & 8) >> 1); return ((kk >> 3) * 4 + (c >> 5)) * 512 + ((kk & 7) * 32 + (c & 31)) * 2; }
__device__ __forceinline__ int v_rd_base(int lane) { return ((lane & 3) << 3) | (((lane >> 2) & 3) << 6) | (((lane >> 4) & 1) << 5) | (((lane >> 5) & 1) << 8); }
constexpr int v_rd_off(int d0, int ks, int half) { return d0 * 512 + ks * 4096 + half * 2048; }
template <int OFF> __device__ __forceinline__ s16x4 tr_read(int vb) {
  s16x4 r; asm volatile("ds_read_b64_tr_b16 %0, %1 offset:%2" : "=&v"(r) : "v"(vb), "i"(OFF) : "memory"); return r;
}
template <int D0> __device__ __forceinline__ void pv_one(f32x16& od, int vb, bf16x8 pa0, bf16x8 pa1, bf16x8 pa2, bf16x8 pa3) {
  const s16x4 l0 = tr_read<v_rd_off(D0, 0, 0)>(vb), h0 = tr_read<v_rd_off(D0, 0, 1)>(vb), l1 = tr_read<v_rd_off(D0, 1, 0)>(vb), h1 = tr_read<v_rd_off(D0, 1, 1)>(vb);
  const s16x4 l2 = tr_read<v_rd_off(D0, 2, 0)>(vb), h2 = tr_read<v_rd_off(D0, 2, 1)>(vb), l3 = tr_read<v_rd_off(D0, 3, 0)>(vb), h3 = tr_read<v_rd_off(D0, 3, 1)>(vb);
  asm volatile("s_waitcnt lgkmcnt(0)" ::: "memory"); SBAR();
#define PK(L, H) (bf16x8){L[0], L[1], L[2], L[3], H[0], H[1], H[2], H[3]}
  od = __builtin_amdgcn_mfma_f32_32x32x16_bf16(pa0, PK(l0, h0), od, 0, 0, 0);
  od = __builtin_amdgcn_mfma_f32_32x32x16_bf16(pa1, PK(l1, h1), od, 0, 0, 0);
  od = __builtin_amdgcn_mfma_f32_32x32x16_bf16(pa2, PK(l2, h2), od, 0, 0, 0);
  od = __builtin_amdgcn_mfma_f32_32x32x16_bf16(pa3, PK(l3, h3), od, 0, 0, 0);
#undef PK
}
__device__ __forceinline__ void pv_d0(f32x16* o, int vb, bf16x8 pa0, bf16x8 pa1, bf16x8 pa2, bf16x8 pa3) {
  pv_one<0>(o[0], vb, pa0, pa1, pa2, pa3); pv_one<1>(o[1], vb, pa0, pa1, pa2, pa3); pv_one<2>(o[2], vb, pa0, pa1, pa2, pa3); pv_one<3>(o[3], vb, pa0, pa1, pa2, pa3);
}
__device__ __forceinline__ void attn_body(const bf16_t* __restrict__ Qb, const bf16_t* __restrict__ Kh, const bf16_t* __restrict__ Vh,
                                          bf16_t* __restrict__ Ob, const bf16_t* __restrict__ AGb, int seq, char* lds) {
  int tid_ = threadIdx.x; asm volatile("" : "+v"(tid_));
  const int tid = tid_, wid = tid >> 6, lane = tid & 63, r32 = lane & 31, hi = lane >> 5;
  bf16_t* V_lds = (bf16_t*)lds; bf16_t* K_lds = (bf16_t*)(lds + 2 * SHM_V);
  float* wsl = (float*)(lds + 2 * SHM_V + 2 * SHM_K) + wid * 64; float* li_l = wsl; float* al_l = wsl + 32;
  float m_reg = -1e30f, l_reg = 0; f32x16 o[4] = {}; bf16x8 qr[8];
  const bf16_t* Qw = Qb + (long)(wid * QBLK + r32) * LDQ + hi * 8;
#pragma unroll
  for (int d0 = 0; d0 < 8; ++d0) qr[d0] = *reinterpret_cast<const bf16x8*>(Qw + d0 * 16);
  const int sr = tid >> 4, sc = (tid & 15) * 8, vst0 = v_st(sr, sc), vst1 = v_st(32 + sr, sc);
  const int vb0 = (int)(uintptr_t)V_lds + v_rd_base(lane);
  const unsigned goff0 = (unsigned)(sr * LDK + sc) * 2u, goff1 = (unsigned)((32 + sr) * LDK + sc) * 2u;
  struct { bf16x8 vs0, vs1, ks0, ks1; } sr_[2];
#define SLOAD(i, k0) do { const char* vt_ = (const char*)Vh + (size_t)(k0) * (LDK * 2); const char* kt_ = (const char*)Kh + (size_t)(k0) * (LDK * 2); \
    sr_[i].vs0 = *reinterpret_cast<const bf16x8*>(vt_ + goff0); sr_[i].vs1 = *reinterpret_cast<const bf16x8*>(vt_ + goff1); \
    sr_[i].ks0 = *reinterpret_cast<const bf16x8*>(kt_ + goff0); sr_[i].ks1 = *reinterpret_cast<const bf16x8*>(kt_ + goff1); } while (0)
#define SWRITE(b, i) do { *(bf16x8*)((char*)V_lds + (b) * SHM_V + vst0) = sr_[i].vs0;          \
    *(bf16x8*)((char*)V_lds + (b) * SHM_V + vst1) = sr_[i].vs1; int kc = sc * 2;               \
    *(bf16x8*)((char*)K_lds + (b) * SHM_K + KSWZ(sr, kc)) = sr_[i].ks0;                       \
    *(bf16x8*)((char*)K_lds + (b) * SHM_K + KSWZ(32 + sr, kc)) = sr_[i].ks1; } while (0)
#define SWAIT() asm volatile("s_waitcnt vmcnt(4)" ::: "memory")
#define RESC(a) do { if (__any((a) < 1.f)) { if (hi == 0) al_l[r32] = (a); asm volatile("s_waitcnt lgkmcnt(0)" ::: "memory"); \
    _Pragma("unroll") for (int d = 0; d < 4; ++d) _Pragma("unroll") for (int r = 0; r < 16; ++r) o[d][r] *= al_l[crow(r, hi)]; } } while (0)
  f32x16 pA0, pA1, pB0, pB1; float mnA, mnB, alA, alB; bf16x8 pa0, pa1, pa2, pa3; const int NT = seq / KVBLK;
  constexpr int SE = 0, SO = 1;
  SLOAD(SE, 0); asm volatile("s_waitcnt vmcnt(0)" ::: "memory"); SWRITE(0, SE); __syncthreads();
  qkt(pA0, pA1, K_lds, qr, r32, hi); partialSM(pA0, pA1, m_reg, mnA, alA);
  SLOAD(SO, KVBLK); if (2 < NT) SLOAD(SE, 2 * KVBLK);
  SWAIT(); SWRITE(1, SO); __syncthreads();
  for (int j = 1; j + 1 < NT; j += 2) {
    SBAR(); qkt(pB0, pB1, (bf16_t*)((char*)K_lds + SHM_K), qr, r32, hi);
    finishSM(pA0, pA1, alA, l_reg, pa0, pa1, pa2, pa3); SBAR();
    SLOAD(SO, (j + 2) * KVBLK); SBAR();
    pv_d0(o, vb0, pa0, pa1, pa2, pa3); partialSM(pB0, pB1, m_reg, mnB, alB);
    __syncthreads(); SWAIT(); SWRITE(0, SE);
    RESC(alB); __syncthreads();
    SBAR(); qkt(pA0, pA1, K_lds, qr, r32, hi);
    finishSM(pB0, pB1, alB, l_reg, pa0, pa1, pa2, pa3); SBAR();
    if (j + 3 < NT) SLOAD(SE, (j + 3) * KVBLK); SBAR();
    pv_d0(o, vb0 + (int)SHM_V, pa0, pa1, pa2, pa3); partialSM(pA0, pA1, m_reg, mnA, alA);
    __syncthreads(); SWAIT(); SWRITE(1, SO);
    RESC(alA); __syncthreads();
  }
  SBAR(); qkt(pB0, pB1, (bf16_t*)((char*)K_lds + SHM_K), qr, r32, hi);
  finishSM(pA0, pA1, alA, l_reg, pa0, pa1, pa2, pa3); SBAR();
  pv_d0(o, vb0, pa0, pa1, pa2, pa3); partialSM(pB0, pB1, m_reg, mnB, alB);
  __syncthreads(); RESC(alB);
  finishSM(pB0, pB1, alB, l_reg, pa0, pa1, pa2, pa3); SBAR();
  pv_d0(o, vb0 + (int)SHM_V, pa0, pa1, pa2, pa3);
  if (hi == 0) li_l[r32] = l_reg; asm volatile("s_waitcnt lgkmcnt(0)" ::: "memory");
  char* Ow = (char*)(Ob + (long)(wid * QBLK) * LDO); const char* Gw = (const char*)(AGb + (long)(wid * QBLK) * LDQ);
  unsigned hv = hi, cv = r32;
  asm volatile("" : "+v"(hv), "+v"(cv));
  const unsigned gbase = (hv * 4u * LDQ + cv) * 2u, obase = (hv * 4u * LDO + cv) * 2u;
#pragma unroll
  for (int r = 0; r < 16; ++r) { const int rc = (r & 3) + 8 * (r >> 2); const float rli = __builtin_amdgcn_rcpf(li_l[crow(r, hi)]);
    const unsigned go = gbase + (unsigned)(rc * LDQ * 2), oo = obase + (unsigned)(rc * LDO * 2);
    float g[4];
#pragma unroll
    for (int d0 = 0; d0 < 4; ++d0) g[d0] = bf2f(*(const bf16_t*)(Gw + go + d0 * 64));
#pragma unroll
    for (int d0 = 0; d0 < 4; ++d0) *(bf16_t*)(Ow + oo + d0 * 64) = f2bf(o[d0][r] * rli * siluf_(g[d0]));
    if ((r & 3) == 3) SBAR(); }
#undef SLOAD
#undef SWRITE
#undef SWAIT
#undef RESC
}
}

__device__ __forceinline__ void attn_phase(const Params& p, int l, char* lds) {
    unsigned char* ws = p.ws;
    const bf16_t* P = (const bf16_t*)(ws + WS_P); bf16_t* Acat = (bf16_t*)(ws + WS_ACAT);
    const int G = gridDim.x, nunits = 512 + (l < DEPTH - 1 ? 16 : 0);
    for (int U = blockIdx.x; U < nunits; U += G) {
        int h, qrow0, seq;
        if (U < 512) { int qb;
            if (G == 256) { const int xcd = U & 7, j = (U >> 3) & 31, r = U >> 8, kvh = xcd >> 1, idx = (xcd & 1) * 64 + r * 32 + j; h = kvh * 4 + (idx & 3); qb = idx >> 2; }
            else { h = U & 15; qb = U >> 4; }
            qrow0 = CTX + qb * 256; seq = ROWS; }
        else { h = U - 512; qrow0 = 0; seq = CTX; }
        const int kvh = h >> 2;
        att::attn_body(P + (size_t)qrow0 * INC + OQ + h * 128, (const bf16_t*)(ws + WS_KC) + (size_t)kvh * ROWS * 128, (const bf16_t*)(ws + WS_VC) + (size_t)kvh * ROWS * 128,
                       Acat + (size_t)qrow0 * CLD + h * 128, P + (size_t)qrow0 * INC + OAG + h * 128, seq, lds);
        __syncthreads();
    }
}

#define XB_TMO      128
#define XB_XCNT(j)  (256  + 64 * (j))
#define XB_XSUB(j)  (1280 + 64 * (j))
#define XB_XGEN(j)  (2304 + 64 * (j))
#define XB_TOP      3328
#define XB_TOPGEN   3392
#define XCD_BAR_WORDS 3456
#define XB_SPIN_CAP (1u << 18)

__device__ __forceinline__ unsigned xb_ld(unsigned* p)              { return __hip_atomic_load(p, __ATOMIC_RELAXED, __HIP_MEMORY_SCOPE_AGENT); }
__device__ __forceinline__ unsigned xb_add(unsigned* p, unsigned v) { return __hip_atomic_fetch_add(p, v, __ATOMIC_RELAXED, __HIP_MEMORY_SCOPE_AGENT); }
__device__ __forceinline__ unsigned xb_xcc_id() { return (unsigned)__builtin_amdgcn_s_getreg((3 << 11) | 20) & 0xFu; }
#define XB_SPIN(cond, bar) do { unsigned _sp = 0; while (cond) { __builtin_amdgcn_s_sleep(1); \
    if ((++_sp & 255u) == 0u) { if (xb_ld(&(bar)[XB_TMO])) break; if (_sp > XB_SPIN_CAP) { atomicAdd(&(bar)[XB_TMO], 1u); break; } } } } while (0)

struct XcdBarrier {
    unsigned* bar; unsigned x;
    volatile LAS unsigned* st;
};

__device__ __forceinline__ XcdBarrier xcd_barrier_post(unsigned* bar, volatile LAS unsigned* st) {
    XcdBarrier b; b.bar = bar; b.x = xb_xcc_id(); b.st = st;
    if (threadIdx.x == 0) (void)xb_add(&bar[XB_XCNT(b.x)], 1u);
    return b;
}
__device__ __forceinline__ void xcd_barrier_complete(unsigned* bar, unsigned x, unsigned& nloc, unsigned& nx) {
    const unsigned G = gridDim.x * gridDim.y * gridDim.z;
    unsigned sum, cnt, mine, sp = 0u;
    for (;;) {
        sum = 0u; cnt = 0u; mine = 0u;
#pragma unroll
        for (unsigned j = 0; j < 16; ++j) { const unsigned c = xb_ld(&bar[XB_XCNT(j)]); sum += c; cnt += (c > 0u) ? 1u : 0u; mine = (j == x) ? c : mine; }
        if (sum == G) break;
        __builtin_amdgcn_s_sleep(1);
        if ((++sp & 255u) == 0u) { if (xb_ld(&bar[XB_TMO])) break; if (sp > XB_SPIN_CAP) { atomicAdd(&bar[XB_TMO], 1u); break; } }
    }
    nloc = mine > 0u ? mine : 1u; nx = cnt > 0u ? cnt : 1u;
}

__device__ __forceinline__ void xcd_barrier(const XcdBarrier& b) {
    asm volatile("s_waitcnt vmcnt(0)" ::: "memory");
    __syncthreads();
    if (threadIdx.x == 0) {
        unsigned* bar = b.bar;
        __builtin_amdgcn_s_waitcnt(0);
        unsigned nloc = b.st[0], nx = b.st[1];
        if (nloc == 0u) { xcd_barrier_complete(bar, b.x, nloc, nx); b.st[0] = nloc; b.st[1] = nx; }
        const unsigned old = xb_add(&bar[XB_XSUB(b.x)], 1u);
        const unsigned gen = old / nloc;
        if (old + 1u == (gen + 1u) * nloc) {
            __builtin_amdgcn_fence(__ATOMIC_RELEASE, "agent");
            asm volatile("s_waitcnt vmcnt(0)" ::: "memory");
            const unsigned og = xb_add(&bar[XB_TOP], 1u);
            const unsigned tg = og / nx;
            if (og + 1u == (tg + 1u) * nx) xb_add(&bar[XB_TOPGEN], 1u);
            else XB_SPIN(xb_ld(&bar[XB_TOPGEN]) == tg, bar);
            __builtin_amdgcn_fence(__ATOMIC_ACQUIRE, "agent");
            xb_add(&bar[XB_XGEN(b.x)], 1u);
            asm volatile("s_waitcnt vmcnt(0)" ::: "memory");
        } else {
            XB_SPIN(xb_ld(&bar[XB_XGEN(b.x)]) == gen, bar);
            __builtin_amdgcn_fence(__ATOMIC_ACQUIRE, "agent");
            asm volatile("s_waitcnt vmcnt(0)" ::: "memory");
        }
    }
    __syncthreads();
}

__global__ void __launch_bounds__(NTHREADS, 2) mega_fwd(Params p0) {
    extern __shared__ __attribute__((aligned(16))) unsigned char lds[];
    cg::grid_group grid = cg::this_grid();
    volatile LAS unsigned* misc = (volatile LAS unsigned*)((LAS unsigned char*)lds + LDS_STAGE);
    if (threadIdx.x < 16) misc[threadIdx.x] = 0u;
    __syncthreads();
    (void)xcd_barrier_post((unsigned*)(p0.ws + WS_BAR), misc);
#ifndef PHASE_MASK
#define PHASE_MASK 0xFFFF
#endif
#define PH(b) if constexpr ((PHASE_MASK >> (b)) & 1)
#ifndef DBL_MASK
#define DBL_MASK 0
#endif
    PH(10) prep_phase(p0, lds);
    __syncthreads();
    if constexpr ((DBL_MASK >> 10) & 1) { prep_phase(p0, lds); __syncthreads(); }
    grid.sync();
#pragma unroll 1
    for (int l = 0; l < DEPTH; ++l) {
#pragma unroll 1
        for (int slot = 0; slot < 12; ++slot) {
            Params p = p0;
            { unsigned char* w = p.ws; asm volatile("" : "+s"(w)); p.ws = w; }
            bool sync = true;
            LAS unsigned char* L = (LAS unsigned char*)lds;
            const int reps = ((DBL_MASK >> slot) & 1) ? 2 : 1;
#pragma unroll 1
            for (int rep = 0; rep < reps; ++rep) {
            if (rep) __syncthreads();
            switch (slot) {
            case 0: rownorm_phase(p, l); sync = false; break;
            case 1: if (l == 0) gemm_phase(L, G_FOLD, l, p.ws); break;
            case 2: gemm_phase(L, G_IN, l, p.ws); sync = false; break;
            case 3: gemm_phase(L, G_XT, l, p.ws); break;
            case 4: gemm_phase(L, G_F1, l, p.ws); sync = false; break;
            case 5: gemm_phase(L, G_DFTC, l, p.ws); break;
            case 6: ew_phase(p, l); sync = false; break;
            case 7: gemm_phase(L, G_F2, l, p.ws); break;
            case 8: attn_phase(p, l, (char*)lds); sync = false; break;
            case 9: gemm_phase(L, G_MIX, l, p.ws); break;
            case 10: gemm_phase(L, G_MERGE, l, p.ws); __syncthreads(); gemm_phase(L, G_MERGEC, l, p.ws); break;
            default: {
                const bool hasctx = l < DEPTH - 1;
                unsigned* ccnt = (unsigned*)(p.ws + WS_BAR) + 3500;
                if (hasctx) {
                    int t0_ = threadIdx.x; asm volatile("" : "+v"(t0_));
                    const int idx = (int)blockIdx.x * NTHREADS + t0_, r = idx >> 9, cc = (idx & 511) * 4;
                    const float* mp = (const float*)(p.ws + WS_MP); bf16_t* mb = (bf16_t*)(p.ws + WS_MB);
                    f32x4 s = *(const f32x4*)(mp + (size_t)r * MLD + cc);
#pragma unroll
                    for (int q = 1; q < 8; ++q) s += *(const f32x4*)(mp + ((size_t)q * CTX + r) * MLD + cc);
                    u32x2 w; w.x = cvtpk(s[0], s[1]); w.y = cvtpk(s[2], s[3]); *(u32x2*)(mb + (size_t)r * DM + cc) = w;
                    asm volatile("s_waitcnt vmcnt(0)" ::: "memory"); __syncthreads();
                    if (threadIdx.x == 0) { __builtin_amdgcn_fence(__ATOMIC_RELEASE, "agent"); asm volatile("s_waitcnt vmcnt(0)" ::: "memory");
                        __hip_atomic_fetch_add(ccnt, 1u, __ATOMIC_RELAXED, __HIP_MEMORY_SCOPE_AGENT); }
                }
                const int nv = (hasctx && (int)blockIdx.x >= (int)gridDim.x - 32) ? 2 : 1;
#pragma unroll 1
                for (int v = 0; v < nv; ++v) {
                    if (v) {
                        __syncthreads();
                        if (threadIdx.x == 0) { const unsigned target = (unsigned)(l + 1) * gridDim.x; unsigned sp = 0;
                            while (__hip_atomic_load(ccnt, __ATOMIC_RELAXED, __HIP_MEMORY_SCOPE_AGENT) < target) { __builtin_amdgcn_s_sleep(1); if (++sp > (1u << 22)) break; }
                            __builtin_amdgcn_fence(__ATOMIC_ACQUIRE, "agent"); asm volatile("s_waitcnt vmcnt(0)" ::: "memory"); }
                        __syncthreads();
                    }
                    gemm_phase(L, G_OUT, l | (v << 4), p.ws);
                }
                break; }
            }
            }
            __syncthreads();
            if (sync) { XcdBarrier xb; xb.bar = (unsigned*)(p.ws + WS_BAR); xb.x = xb_xcc_id(); xb.st = (volatile LAS unsigned*)((LAS unsigned char*)lds + LDS_STAGE); xcd_barrier(xb); }
        }
    }
    PH(0) rownorm_phase(p0, DEPTH);
}

extern "C" void kernel_launch(void* const* d_in, const int* in_sizes, int n_in, void* d_out, int out_size, void* d_ws, size_t ws_size, hipStream_t stream) {
    static int grid_blocks = 0;
    if (grid_blocks == 0) {
        if (n_in != 18 || out_size != SEQ * DM || ws_size < WS_END) { fprintf(stderr, "kernel_launch: unexpected shapes: n_in %d out %d ws %zu (need %zu)\n", n_in, out_size, ws_size, (size_t)WS_END); grid_blocks = -1; return; }
        int dev = 0, cus = 0, per_cu = 0;
        hipGetDevice(&dev);
        hipDeviceGetAttribute(&cus, hipDeviceAttributeMultiprocessorCount, dev);
        if (hipFuncSetAttribute((const void*)mega_fwd, hipFuncAttributeMaxDynamicSharedMemorySize, LDS_BYTES) != hipSuccess) { fprintf(stderr, "kernel_launch: hipFuncSetAttribute failed\n"); grid_blocks = -1; return; }
        if (hipOccupancyMaxActiveBlocksPerMultiprocessor(&per_cu, (const void*)mega_fwd, NTHREADS, LDS_BYTES) != hipSuccess || per_cu < 1) { fprintf(stderr, "kernel_launch: occupancy query gave %d\n", per_cu); per_cu = 1; }
        (void)hipGetLastError();
        grid_blocks = cus * (per_cu > 1 ? 1 : per_cu);
        if (grid_blocks > 256) grid_blocks = 256;
        grid_blocks &= ~7;
        if (grid_blocks != 256) { fprintf(stderr, "kernel_launch: this kernel is laid out for 256 resident workgroups, got %d\n", grid_blocks); grid_blocks = -1; return; }
    }
    if (grid_blocks <= 0) return;
    Params p{};
    for (int i = 0; i < 18; ++i) p.in[i] = (const float*)d_in[i];
    p.out = (float*)d_out; p.ws = (unsigned char*)d_ws;
    if (hipMemsetAsync((char*)d_ws + WS_BAR, 0, BAR_BYTES, stream) != hipSuccess) { fprintf(stderr, "kernel_launch: memset of barrier words failed\n"); return; }
    void* args[] = {&p};
    hipError_t e = hipLaunchCooperativeKernel((const void*)mega_fwd, dim3(grid_blocks), dim3(NTHREADS), args, LDS_BYTES, stream);
    if (e != hipSuccess) fprintf(stderr, "cooperative launch failed: %s (grid %d)\n", hipGetErrorString(e), grid_blocks);
}
```

```cpp
#include <hip/hip_runtime.h>
#include <hip/hip_cooperative_groups.h>
#include <cstdio>
#include <cstdint>
namespace cg = cooperative_groups;

#define LAS __attribute__((address_space(3)))
typedef unsigned short bf16_t;
typedef short bf16x8 __attribute__((ext_vector_type(8)));
typedef short s16x4 __attribute__((ext_vector_type(4)));
typedef float f32x4 __attribute__((ext_vector_type(4)));
typedef float f32x16 __attribute__((ext_vector_type(16)));
typedef unsigned u32x4 __attribute__((ext_vector_type(4)));
typedef unsigned u32x2 __attribute__((ext_vector_type(2)));

constexpr int DM = 2048, SEQ = 8192, CTX = 256, ROWS = SEQ + CTX, DEPTH = 4, INC = 17408;
constexpr int OQ = 0, OKK = 2048, OV = 2560, OAG = 3072, OFX = 5120, OFG = 6144, OCX = 7168, OCB = 8192, OCC = 9216, OCG = 10240, OML = 11264;
constexpr float EPS = 1e-6f;
constexpr size_t APL = (size_t)(SEQ + CTX) * 2048, WPL = (size_t)2048 * 2048;
constexpr int CLD = 2048;
constexpr int MLD = 2048 + 64;
constexpr int ZCH = 32768 + 256;
constexpr int LDS_STAGE = 131072, LDS_BYTES = LDS_STAGE + 64;
constexpr int NTHREADS = 512;

constexpr size_t SZ_WINT = (size_t)INC * DM * 2, SZ_WCAT = 3 * WPL * 2, SZ_WOUT = (size_t)DM * DM * 2, SZ_WMIXR = (size_t)1024 * 1024 * 2, SZ_WMIX = (size_t)1024 * 2048 * 2;
constexpr size_t WS_WINT = 0;
constexpr size_t WS_WCAT = WS_WINT + DEPTH * SZ_WINT;
constexpr size_t WS_WOUT = WS_WCAT + DEPTH * SZ_WCAT;
constexpr size_t WS_WMIXR = WS_WOUT + DEPTH * SZ_WOUT;
constexpr size_t WS_WMIX = WS_WMIXR + DEPTH * SZ_WMIXR;
constexpr size_t WS_TCH = WS_WMIX + DEPTH * SZ_WMIX;
constexpr size_t WS_ZT = WS_TCH + 512 * 256 * 2;
constexpr size_t WS_T1 = WS_ZT + (size_t)1024 * ZCH;
constexpr size_t WS_A2 = WS_T1 + 256 * 128 * 2;
constexpr size_t WS_ACTX = WS_A2 + 256 * 256 * 2;
constexpr size_t WS_ROPE = WS_ACTX + 512 * 256 * 2;
constexpr size_t WS_MOD = WS_ROPE + 128 * 32 * 8;
constexpr size_t WS_XS = WS_MOD + 4 * 2 * 6144 * 4;
constexpr size_t WS_H = WS_XS + (size_t)ROWS * DM * 4;
constexpr size_t WS_P = WS_H + (size_t)ROWS * DM * 2;
constexpr size_t WS_XT = WS_P + (size_t)ROWS * INC * 2;
constexpr size_t WS_PQ = WS_XT + (size_t)1024 * ROWS * 2;
constexpr size_t WS_ACAT = WS_PQ + (size_t)ROWS * DM * 2;
constexpr size_t WS_MBUF = WS_ACAT + 3 * APL * 2;
constexpr size_t WS_MB = WS_MBUF + (size_t)ROWS * MLD * 4;
constexpr size_t WS_OUTB = WS_MB + (size_t)ROWS * DM * 2;
constexpr size_t WS_KC = WS_OUTB + (size_t)ROWS * DM * 4;
constexpr size_t WS_VC = WS_KC + (size_t)4 * ROWS * 128 * 2;
constexpr size_t WS_MP = WS_VC + (size_t)4 * ROWS * 128 * 2;
constexpr size_t WS_OUTP = WS_MP + (size_t)8 * CTX * MLD * 4;
constexpr size_t WS_BAR = WS_OUTP + (size_t)4 * CTX * DM * 4;
constexpr size_t BAR_BYTES = 16384;
constexpr size_t WS_END = WS_BAR + BAR_BYTES;

struct Params { const float* in[18]; float* out; unsigned char* ws; };
enum { I_X = 0, I_C, I_CTX, I_CCTX, I_WMOD, I_BMOD, I_GPRE, I_GPOST, I_WIN, I_QN, I_KN, I_WAO, I_WFM, I_WFO, I_CW, I_CB, I_WCO, I_WOUT };

__device__ __forceinline__ unsigned cvtpk(float lo, float hi) { unsigned r; asm volatile("v_cvt_pk_bf16_f32 %0, %1, %2" : "=v"(r) : "v"(lo), "v"(hi)); return r; }
__device__ __forceinline__ float bf2f(unsigned short b) { return __uint_as_float(((unsigned)b) << 16); }
__device__ __forceinline__ float bflo(unsigned w) { return __uint_as_float(w << 16); }
__device__ __forceinline__ float bfhi(unsigned w) { return __uint_as_float(w & 0xffff0000u); }
__device__ __forceinline__ unsigned short f2bf(float f) { return (unsigned short)(cvtpk(f, f) & 0xffffu); }
__device__ __forceinline__ float sigmoidf_(float x) { return __builtin_amdgcn_rcpf(1.0f + __expf(-x)); }
__device__ __forceinline__ float siluf_(float x) { return x * sigmoidf_(x); }
__device__ __forceinline__ float wave_sum(float v) {
#pragma unroll
    for (int o = 32; o >= 1; o >>= 1) v += __shfl_xor(v, o);
    return v;
}

__device__ __forceinline__ void prep_phase(const Params& p, unsigned char* lds_g) {
    int tid_ = threadIdx.x; asm volatile("" : "+v"(tid_));
    const int tid = tid_, G = gridDim.x, bid = blockIdx.x;
    unsigned char* ws = p.ws;
    float* tile = (float*)lds_g;
    constexpr int T_IN = 32 * 272, T_AO = 32 * 32, T_FO = 16 * 32, T_CO = 16 * 32, T_OUT = 32 * 32, T_MIX = 16 * 16;
    constexpr int T_LAYER = T_IN + T_AO + T_FO + T_CO + T_OUT + T_MIX;
    for (int t = bid; t < DEPTH * T_LAYER; t += G) {
        const int l = t / T_LAYER; int r = t % T_LAYER;
        const float* src; int ldsrc; bf16_t* dst; int lddst; int ktiles;
        if (r < T_IN) { src = p.in[I_WIN] + (size_t)l * DM * INC; ldsrc = INC; dst = (bf16_t*)(ws + WS_WINT + l * SZ_WINT); lddst = DM; ktiles = 32; }
        else if ((r -= T_IN) < T_AO) { src = p.in[I_WAO] + (size_t)l * DM * DM; ldsrc = DM; dst = (bf16_t*)(ws + WS_WCAT + l * SZ_WCAT); lddst = CLD; ktiles = 32; }
        else if ((r -= T_AO) < T_FO) { src = p.in[I_WFO] + (size_t)l * 1024 * DM; ldsrc = DM; dst = (bf16_t*)(ws + WS_WCAT + l * SZ_WCAT) + WPL; lddst = CLD; ktiles = 16; }
        else if ((r -= T_FO) < T_CO) { src = p.in[I_WCO] + (size_t)l * 1024 * DM; ldsrc = DM; dst = (bf16_t*)(ws + WS_WCAT + l * SZ_WCAT) + 2 * WPL; lddst = CLD; ktiles = 16; }
        else if ((r -= T_CO) < T_OUT) { src = p.in[I_WOUT] + (size_t)l * DM * DM; ldsrc = DM; dst = (bf16_t*)(ws + WS_WOUT + l * SZ_WOUT); lddst = DM; ktiles = 32; }
        else { r -= T_OUT; src = p.in[I_WFM] + (size_t)l * 1024 * 1024; ldsrc = 1024; dst = (bf16_t*)(ws + WS_WMIXR + l * SZ_WMIXR); lddst = 1024; ktiles = 16; }
        const int k0 = (r % ktiles) * 64, n0 = (r / ktiles) * 64;
        { const int ty = tid >> 4, tx = tid & 15;
#pragma unroll
          for (int ps = 0; ps < 2; ++ps) { const int kk = ty + 32 * ps;
              const f32x4 v = *(const f32x4*)(src + (size_t)(k0 + kk) * ldsrc + n0 + tx * 4);
              tile[kk * 65 + tx * 4 + 0] = v[0]; tile[kk * 65 + tx * 4 + 1] = v[1]; tile[kk * 65 + tx * 4 + 2] = v[2]; tile[kk * 65 + tx * 4 + 3] = v[3]; } }
        __syncthreads();
        { const int n = tid >> 3, kc = (tid & 7) * 8; u32x4 w;
          w.x = cvtpk(tile[(kc + 0) * 65 + n], tile[(kc + 1) * 65 + n]); w.y = cvtpk(tile[(kc + 2) * 65 + n], tile[(kc + 3) * 65 + n]);
          w.z = cvtpk(tile[(kc + 4) * 65 + n], tile[(kc + 5) * 65 + n]); w.w = cvtpk(tile[(kc + 6) * 65 + n], tile[(kc + 7) * 65 + n]);
          *(u32x4*)(dst + (size_t)(n0 + n) * lddst + k0 + kc) = w; }
        __syncthreads();
    }
    {
        float* sc = (float*)lds_g;
        float* red = sc + 4096;
        for (int u = bid; u < 256; u += G) {
            for (int k = tid; k < 4096; k += NTHREADS) { const float cv = (k < 2048) ? p.in[I_C][k] : p.in[I_CCTX][k - 2048]; sc[k] = siluf_(cv); }
            __syncthreads();
            const int l = u >> 6, j0 = (u & 63) * 96;
            if (tid < 504) { const int kg = tid / 24, cq = tid % 24;
                f32x4 al = {0.f, 0.f, 0.f, 0.f}, ac = {0.f, 0.f, 0.f, 0.f};
                const float* wp = p.in[I_WMOD] + (size_t)l * DM * 6144 + j0 + cq * 4;
                for (int k = kg; k < 2048; k += 21) { const f32x4 w = *(const f32x4*)(wp + (size_t)k * 6144); al += sc[k] * w; ac += sc[2048 + k] * w; }
                float* rp = red + (kg * 24 + cq) * 8;
                rp[0] = al[0]; rp[1] = al[1]; rp[2] = al[2]; rp[3] = al[3]; rp[4] = ac[0]; rp[5] = ac[1]; rp[6] = ac[2]; rp[7] = ac[3]; }
            __syncthreads();
            if (tid < 192) { const int v = tid / 96, col = tid % 96, cq = col >> 2, e = col & 3; float s = 0.f;
                for (int kg = 0; kg < 21; ++kg) s += red[(kg * 24 + cq) * 8 + v * 4 + e];
                ((float*)(ws + WS_MOD))[(size_t)(l * 2 + v) * 6144 + j0 + col] = s + p.in[I_BMOD][(size_t)l * 6144 + j0 + col]; }
            __syncthreads();
        }
    }
    const long gt = (long)bid * NTHREADS + tid, gn = (long)G * NTHREADS;
    for (long it = gt; it < 256 * 16; it += gn) { const int r = (int)(it >> 4), s0 = (int)(it & 15) * 8, k1 = r >> 1, ri = r & 1;
        float v[8];
#pragma unroll
        for (int j = 0; j < 8; ++j) { const int ph = (k1 * (s0 + j)) & 127; const float x = (float)ph * (1.0f / 128.0f); v[j] = (ri ? -__builtin_amdgcn_sinf(x) : __builtin_amdgcn_cosf(x)) * 0.08838834764831845f; }
        u32x4 w; w.x = cvtpk(v[0], v[1]); w.y = cvtpk(v[2], v[3]); w.z = cvtpk(v[4], v[5]); w.w = cvtpk(v[6], v[7]);
        *(u32x4*)((bf16_t*)(ws + WS_T1) + (size_t)r * 128 + s0) = w; }
    for (long it = gt; it < 256 * 32; it += gn) { const int rr = (int)(it >> 5), c0 = (int)(it & 31) * 8, kb = rr >> 7, pq = (rr >> 6) & 1, k2 = rr & 63;
        float v[8];
#pragma unroll
        for (int j = 0; j < 8; ++j) { const int cc = c0 + j, kbc = cc >> 7, s2 = (cc >> 1) & 63, ri = cc & 1; const int ph = (k2 * s2) & 63; const float x = (float)ph * (1.0f / 64.0f);
            const float cs = __builtin_amdgcn_cosf(x), sn = __builtin_amdgcn_sinf(x);
            const float val = pq == 0 ? (ri == 0 ? cs : sn) : (ri == 0 ? sn : -cs);
            v[j] = (kb == kbc) ? val * 0.125f : 0.f; }
        u32x4 w; w.x = cvtpk(v[0], v[1]); w.y = cvtpk(v[2], v[3]); w.z = cvtpk(v[4], v[5]); w.w = cvtpk(v[6], v[7]);
        *(u32x4*)((bf16_t*)(ws + WS_A2) + (size_t)rr * 256 + c0) = w; }
    for (long it = gt; it < 2 * 512 * 32; it += gn) { const int which = (int)(it >> 14), rr = (int)(it & 16383), r = rr >> 5, s0 = (rr & 31) * 8, k = r & 255; const bool isin = r >= 256;
        bf16_t* A = (bf16_t*)(ws + (which ? WS_TCH : WS_ACTX)); const float sgn = (which && isin) ? -0.0625f : 0.0625f;
        float v[8];
#pragma unroll
        for (int j = 0; j < 8; ++j) { const int ph = (k * (s0 + j)) & 255; const float x = (float)ph * (1.0f / 256.0f); v[j] = (isin ? __builtin_amdgcn_sinf(x) : __builtin_amdgcn_cosf(x)) * sgn; }
        u32x4 w; w.x = cvtpk(v[0], v[1]); w.y = cvtpk(v[2], v[3]); w.z = cvtpk(v[4], v[5]); w.w = cvtpk(v[6], v[7]);
        *(u32x4*)(A + (size_t)r * 256 + s0) = w; }
    for (long it = gt; it < 128 * 32; it += gn) { const int pos = (int)(it >> 5), i = (int)(it & 31);
        const float freq = exp2f(-(float)i * (13.287712379549449f / 32.0f));
        const float ang = (float)pos * freq;
        double rev = (double)ang * 0.15915494309189535; rev -= floor(rev);
        const float xr = (float)rev;
        float2 cs; cs.x = __builtin_amdgcn_cosf(xr); cs.y = __builtin_amdgcn_sinf(xr);
        ((float2*)(ws + WS_ROPE))[it] = cs; }
    { f32x4* xs = (f32x4*)(ws + WS_XS); const f32x4* cx = (const f32x4*)p.in[I_CTX]; const f32x4* xx = (const f32x4*)p.in[I_X];
      const long nc = (long)CTX * DM / 4, nt = (long)ROWS * DM / 4;
      for (long it = gt; it < nt; it += gn) xs[it] = (it < nc) ? cx[it] : xx[it - nc]; }
}

__device__ __forceinline__ void rownorm_phase(const Params& p, int l) {
    int tid_ = threadIdx.x; asm volatile("" : "+v"(tid_));
    const int tid = tid_, lane = tid & 63, wid = tid >> 6;
    unsigned char* ws = p.ws;
    const int gw = blockIdx.x * 8 + wid, nw = gridDim.x * 8;
    const float* mod = (const float*)(ws + WS_MOD);
    for (int row = gw; row < ROWS; row += nw) {
        const int isctx = row < CTX ? 1 : 0;
        if (l == 4 && isctx) continue;
        float* xrow = (float*)(ws + WS_XS) + (size_t)row * DM;
        f32x4 xv[8];
#pragma unroll
        for (int i = 0; i < 8; ++i) xv[i] = *(const f32x4*)(xrow + lane * 4 + i * 256);
        if (l > 0) {
            const float* orow = (const float*)(ws + WS_OUTB) + (size_t)row * DM;
            f32x4 ov[8]; float ss = 0.f;
#pragma unroll
            for (int i = 0; i < 8; ++i) {
                if (isctx) { const float* pp = (const float*)(ws + WS_OUTP) + (size_t)row * DM + lane * 4 + i * 256;
                    ov[i] = (*(const f32x4*)pp + *(const f32x4*)(pp + (size_t)CTX * DM)) + (*(const f32x4*)(pp + (size_t)2 * CTX * DM) + *(const f32x4*)(pp + (size_t)3 * CTX * DM)); }
                else ov[i] = *(const f32x4*)(orow + lane * 4 + i * 256);
                ss += ov[i][0] * ov[i][0] + ov[i][1] * ov[i][1] + ov[i][2] * ov[i][2] + ov[i][3] * ov[i][3]; }
            ss = wave_sum(ss);
            const float rstd = rsqrtf(ss * (1.0f / DM) + EPS);
            const float* gate = mod + (size_t)((l - 1) * 2 + isctx) * 6144 + 4096;
            const float* gpost = p.in[I_GPOST] + (size_t)(l - 1) * DM;
#pragma unroll
            for (int i = 0; i < 8; ++i) { const f32x4 g = *(const f32x4*)(gate + lane * 4 + i * 256), gp = *(const f32x4*)(gpost + lane * 4 + i * 256);
                xv[i] = xv[i] + g * ((ov[i] * rstd) * gp); }
            if (l == 4) { float* orow2 = p.out + (size_t)(row - CTX) * DM;
#pragma unroll
                for (int i = 0; i < 8; ++i) *(f32x4*)(orow2 + lane * 4 + i * 256) = xv[i];
                continue; }
#pragma unroll
            for (int i = 0; i < 8; ++i) *(f32x4*)(xrow + lane * 4 + i * 256) = xv[i];
        }
        float ss = 0.f;
#pragma unroll
        for (int i = 0; i < 8; ++i) ss += xv[i][0] * xv[i][0] + xv[i][1] * xv[i][1] + xv[i][2] * xv[i][2] + xv[i][3] * xv[i][3];
        ss = wave_sum(ss);
        const float rstd = rsqrtf(ss * (1.0f / DM) + EPS);
        const float* ml = mod + (size_t)(l * 2 + isctx) * 6144;
        const float* gpre = p.in[I_GPRE] + (size_t)l * DM;
        bf16_t* hrow = (bf16_t*)(ws + WS_H) + (size_t)row * DM;
#pragma unroll
        for (int i = 0; i < 8; ++i) { const int c = lane * 4 + i * 256;
            const f32x4 sh = *(const f32x4*)(ml + c), scl = *(const f32x4*)(ml + 2048 + c), gp = *(const f32x4*)(gpre + c);
            const f32x4 hv = ((xv[i] * rstd) * gp) * (1.0f + scl) + sh;
            u32x2 w; w.x = cvtpk(hv[0], hv[1]); w.y = cvtpk(hv[2], hv[3]);
            *(u32x2*)(hrow + c) = w; }
    }
}

__device__ __forceinline__ void ew_phase(const Params& p, int l) {
    int tid_ = threadIdx.x; asm volatile("" : "+v"(tid_));
    const int tid = tid_;
    unsigned char* ws = p.ws;
    bf16_t* P = (bf16_t*)(ws + WS_P);
    {
        const int t = tid & 15; const long grp = ((long)blockIdx.x * NTHREADS + tid) >> 4, ngrp = (long)gridDim.x * NTHREADS / 16;
        const float2* rope = (const float2*)(ws + WS_ROPE);
        const int base = ((t & 8) ? 64 : 0) + 4 * (t & 7), fi = 4 * (t & 7);
        bf16_t* KC = (bf16_t*)(ws + WS_KC);
#pragma unroll 2
        for (long it = grp; it < (long)ROWS * 20; it += ngrp) { const int row = (int)(it / 20), head = (int)(it % 20);
            const bf16_t* src_ = P + (size_t)row * INC + (head < 16 ? OQ + head * 128 : OKK + (head - 16) * 128) + base;
            bf16_t* dst_ = (head < 16) ? (P + (size_t)row * INC + OQ + head * 128 + base) : (KC + ((size_t)(head - 16) * ROWS + row) * 128 + base);
            const float* gn = (head < 16 ? p.in[I_QN] : p.in[I_KN]) + (size_t)l * 128 + base;
            const u32x2 wa = *(const u32x2*)src_, wb = *(const u32x2*)(src_ + 32);
            const f32x4 ga = *(const f32x4*)gn, gb = *(const f32x4*)(gn + 32);
            float a[4] = {bflo(wa.x), bfhi(wa.x), bflo(wa.y), bfhi(wa.y)}, b[4] = {bflo(wb.x), bfhi(wb.x), bflo(wb.y), bfhi(wb.y)};
            float ss = 0.f;
#pragma unroll
            for (int q = 0; q < 4; ++q) ss += a[q] * a[q] + b[q] * b[q];
#pragma unroll
            for (int o = 8; o >= 1; o >>= 1) ss += __shfl_xor(ss, o);
            const float rstd = rsqrtf(ss * (1.0f / 128.0f) + EPS);
#pragma unroll
            for (int q = 0; q < 4; ++q) { a[q] = a[q] * rstd * ga[q]; b[q] = b[q] * rstd * gb[q]; }
            if (row >= CTX) { const int tk = row - CTX, pos = (t & 8) ? (tk & 63) : (tk >> 6);
                const f32x4 r01 = *(const f32x4*)(rope + pos * 32 + fi), r23 = *(const f32x4*)(rope + pos * 32 + fi + 2);
                const float cs[4] = {r01[0], r01[2], r23[0], r23[2]}, sn[4] = {r01[1], r01[3], r23[1], r23[3]};
#pragma unroll
                for (int q = 0; q < 4; ++q) { const float x0 = a[q], x1 = b[q]; a[q] = x0 * cs[q] - x1 * sn[q]; b[q] = x0 * sn[q] + x1 * cs[q]; } }
            u32x2 oa, ob; oa.x = cvtpk(a[0], a[1]); oa.y = cvtpk(a[2], a[3]); ob.x = cvtpk(b[0], b[1]); ob.y = cvtpk(b[2], b[3]);
            *(u32x2*)dst_ = oa; *(u32x2*)(dst_ + 32) = ob;
        }
    }
    {
        const long gt = (long)blockIdx.x * NTHREADS + tid, gn = (long)gridDim.x * NTHREADS;
        bf16_t* VC = (bf16_t*)(ws + WS_VC);
        for (long it = gt; it < (long)ROWS * 64; it += gn) { const int row = (int)(it >> 6), c = (int)(it & 63) * 8;
            const u32x4 v = *(const u32x4*)(P + (size_t)row * INC + OV + c);
            *(u32x4*)(VC + ((size_t)(c >> 7) * ROWS + row) * 128 + (c & 127)) = v; }
    }
    {
        const long gt = (long)blockIdx.x * NTHREADS + tid, gn = (long)gridDim.x * NTHREADS;
        bf16_t* Acat = (bf16_t*)(ws + WS_ACAT);
        const float* cw = p.in[I_CW] + (size_t)l * 3 * 1024; const float* cbias = p.in[I_CB] + (size_t)l * 1024;
        for (long it = gt; it < (long)(ROWS / 4) * 128; it += gn) { const int row0 = (int)(it >> 7) * 4, c0 = (int)(it & 127) * 8;
            const bf16_t* pr = P + (size_t)row0 * INC;
            const bool hp = (row0 != 0) && (row0 != CTX), hn = (row0 + 4 != CTX) && (row0 + 4 != ROWS);
            const u32x4 z = {0u, 0u, 0u, 0u};
            u32x4 xv[6], kv[6], bb[4], gg[4];
            xv[0] = hp ? *(const u32x4*)(pr - INC + OCX + c0) : z; kv[0] = hp ? *(const u32x4*)(pr - INC + OCC + c0) : z;
#pragma unroll
            for (int r = 0; r < 4; ++r) { xv[r + 1] = *(const u32x4*)(pr + (size_t)r * INC + OCX + c0); kv[r + 1] = *(const u32x4*)(pr + (size_t)r * INC + OCC + c0);
                bb[r] = *(const u32x4*)(pr + (size_t)r * INC + OCB + c0); gg[r] = *(const u32x4*)(pr + (size_t)r * INC + OCG + c0); }
            xv[5] = hn ? *(const u32x4*)(pr + (size_t)4 * INC + OCX + c0) : z; kv[5] = hn ? *(const u32x4*)(pr + (size_t)4 * INC + OCC + c0) : z;
            float w0[8], w1[8], w2[8], bs[8];
#pragma unroll
            for (int j = 0; j < 8; ++j) { w0[j] = cw[c0 + j]; w1[j] = cw[1024 + c0 + j]; w2[j] = cw[2048 + c0 + j]; bs[j] = cbias[c0 + j]; }
            float uu[6][8];
#pragma unroll
            for (int r = 0; r < 6; ++r)
#pragma unroll
                for (int q = 0; q < 4; ++q) { uu[r][2 * q] = bflo(xv[r][q]) * bflo(kv[r][q]); uu[r][2 * q + 1] = bfhi(xv[r][q]) * bfhi(kv[r][q]); }
#pragma unroll
            for (int r = 0; r < 4; ++r) { float res[8];
#pragma unroll
                for (int q = 0; q < 4; ++q) {
                    { const int j = 2 * q; const float cv = uu[r][j] * w0[j] + uu[r + 1][j] * w1[j] + uu[r + 2][j] * w2[j] + bs[j]; res[j] = bflo(bb[r][q]) * cv * siluf_(bflo(gg[r][q])); }
                    { const int j = 2 * q + 1; const float cv = uu[r][j] * w0[j] + uu[r + 1][j] * w1[j] + uu[r + 2][j] * w2[j] + bs[j]; res[j] = bfhi(bb[r][q]) * cv * siluf_(bfhi(gg[r][q])); } }
                u32x4 w; w.x = cvtpk(res[0], res[1]); w.y = cvtpk(res[2], res[3]); w.z = cvtpk(res[4], res[5]); w.w = cvtpk(res[6], res[7]);
                *(u32x4*)(Acat + 2 * APL + (size_t)(row0 + r) * CLD + c0) = w; }
        }
    }
}

constexpr int BM = 256, BK = 64, HALF = 128, HTB = HALF * BK * 2;
constexpr int BJC = 32;
__device__ __forceinline__ int lds_byte(int r, int c) { const int st = (r >> 4) * 2 + (c >> 5), rr = r & 15, cc = c & 31, ob = rr * 64 + cc * 2; return st * 1024 + (ob ^ (((ob >> 9) & 1) << 5)); }
__device__ __forceinline__ void stage_rc(int b, int& R, int& C) { const int st = b / 1024, sb = b % 1024, swz = sb ^ (((sb >> 9) & 1) << 5); R = (st >> 1) * 16 + swz / 64; C = (st & 1) * 32 + (swz % 64) / 2; }
__device__ __forceinline__ int perm32(int rho) { const int n = rho >> 4, i = rho & 15; return 8 * (i >> 2) + 4 * n + (i & 3); }

enum { G_FOLD = 0, G_IN, G_XT, G_F1, G_F2, G_DFTC, G_MIX, G_MERGE, G_OUT, G_MERGEC };
enum { M_BF16 = 0, M_MIX, M_MERGE0, M_MERGE1, M_MERGE2, M_F32, M_F1, M_F2, M_MG0, M_MG1, M_MG2 };
struct Unit { const char* a; const char* b; char* o; const char* aux; char* m; int nt, mode, ldo; };

__device__ __forceinline__ void static_order(int w, int nM, int nN, int& pm, int& pn) {
    const int nwg = nM * nN, q = nwg / 8, r = nwg % 8, xcd = w % 8, off = w / 8;
    const int wg = (xcd < r ? xcd * (q + 1) : r * (q + 1) + (xcd - r) * q) + off;
    const int nig = 8 * nN, gid = wg / nig, fm = gid * 8, gsz = (nM - fm) < 8 ? (nM - fm) : 8;
    pm = fm + ((wg % nig) % gsz); pn = (wg % nig) / gsz;
}

__device__ __forceinline__ bool get_unit(int gid, int l, int i, unsigned char* ws, Unit& u) {
    const int G = gridDim.x, c = blockIdx.x;
    u.aux = nullptr; u.m = nullptr;
    switch (gid) {
    case G_FOLD: { const int L = i * G + c; if (L >= 128) return false;
        const int ll = L >> 5, g = (L >> 3) & 3, pm = (L >> 1) & 3, pnn = L & 1;
        u.a = (const char*)(ws + WS_WMIXR + ll * SZ_WMIXR) + ((size_t)pm * 256 * 1024 + g * 256) * 2;
        u.b = (const char*)(ws + WS_TCH) + (size_t)pnn * 256 * 256 * 2;
        u.o = (char*)(ws + WS_WMIX + ll * SZ_WMIX) + ((size_t)pm * 256 * 2048 + pnn * 1024 + g * 256) * 2;
        u.nt = 4; u.mode = M_BF16; u.ldo = 2048; return true; }
    case G_IN: { const int L = i * G + c; if (L >= 2116) return false;
        if (L < 2112) { int pm, pn; static_order(L, 33, 64, pm, pn); const int pnp = pn < 20 ? pn : pn + 4;
            u.a = (const char*)(ws + WS_H) + (size_t)pm * 256 * DM * 2;
            u.b = (const char*)(ws + WS_WINT + l * SZ_WINT) + (size_t)pnp * 256 * DM * 2;
            u.o = (char*)(ws + WS_P) + ((size_t)pm * 256 * INC + pnp * 256) * 2; u.ldo = INC; }
        else { const int pm = L - 2112;
            u.a = (const char*)(ws + WS_WINT + l * SZ_WINT) + (size_t)(OFX + pm * 256) * DM * 2;
            u.b = (const char*)(ws + WS_H);
            u.o = (char*)(ws + WS_XT) + (size_t)pm * 256 * ROWS * 2; u.ldo = ROWS; }
        u.nt = 32; u.mode = M_BF16; return true; }
    case G_XT: { const int L = i * G + ((c + G - 68) % G); if (L >= 128) return false; const int pm = L & 3, pn = 1 + (L >> 2);
        u.a = (const char*)(ws + WS_WINT + l * SZ_WINT) + (size_t)(OFX + pm * 256) * DM * 2;
        u.b = (const char*)(ws + WS_H) + (size_t)(CTX + 2 * (pn - 1)) * DM * 2;
        u.o = (char*)(ws + WS_XT) + ((size_t)pm * 256 * ROWS + pn * 256) * 2; u.ldo = ROWS;
        u.nt = 32; u.mode = M_BF16; return true; }
    case G_F1: { const int L = i * G + c; if (L >= 256) return false; const int s2 = L >> 2, ct = L & 3;
        u.a = (const char*)(ws + WS_XT) + ((size_t)ct * 256 * ROWS + CTX + s2 * 128) * 2;
        u.b = (const char*)(ws + WS_T1);
        u.o = (char*)(ws + WS_ZT) + (size_t)ct * 256 * ZCH + s2 * 4;
        u.nt = 2; u.mode = M_F1; u.ldo = s2; return true; }
    case G_F2: { const int L = i * G + c; if (L >= 256) return false; const int k1p = L >> 2, ct = L & 3;
        u.a = (const char*)(ws + WS_A2);
        u.b = (const char*)(ws + WS_ZT) + (size_t)ct * 256 * ZCH + k1p * 512;
        u.o = (char*)(ws + WS_PQ) + ((size_t)(CTX + 2 * k1p) * 2048 + ct * 256) * 2;
        u.nt = 4; u.mode = M_F2; u.ldo = 2048; return true; }
    case G_DFTC: { const int L = i * G + c; if (L >= 8) return false; const int pm = L >> 2, pn = L & 3;
        u.a = (const char*)(ws + WS_ACTX) + (size_t)pm * 256 * 256 * 2;
        u.b = (const char*)(ws + WS_XT) + (size_t)pn * 256 * ROWS * 2;
        u.o = (char*)(ws + WS_PQ) + ((size_t)pm * 1024 + pn * 256) * 2;
        u.nt = 4; u.mode = M_BF16; u.ldo = 2048; return true; }
    case G_MIX: { const int L = i * G + (G - 1 - c); if (L >= 132) return false; const int pm = L >> 2, pn = L & 3;
        u.a = (const char*)(ws + WS_PQ) + (size_t)pm * 256 * 2048 * 2;
        u.b = (const char*)(ws + WS_WMIX + l * SZ_WMIX) + (size_t)pn * 256 * 2048 * 2;
        u.aux = (const char*)(ws + WS_P) + ((size_t)pm * 256 * INC + OFG + pn * 256) * 2;
        u.o = (char*)(ws + WS_ACAT) + (APL + (size_t)pm * 256 * CLD + pn * 256) * 2;
        u.nt = 32; u.mode = M_MIX; u.ldo = CLD; return true; }
    case G_MERGE: {
        if (i < 3) { const int T = c, sub = i; if (T >= 256) return false;
            int pm, pn; static_order(T, 32, 8, pm, pn); pm += 1;
            u.a = (const char*)(ws + WS_ACAT) + ((size_t)sub * APL + (size_t)pm * 256 * CLD) * 2;
            u.b = (const char*)(ws + WS_WCAT + l * SZ_WCAT) + ((size_t)sub * WPL + (size_t)pn * 256 * CLD) * 2;
            u.aux = (const char*)(ws + WS_P) + ((size_t)pm * 256 * INC + OML + sub * 2048 + pn * 256) * 2;
            u.m = (char*)(ws + WS_MBUF) + ((size_t)pm * 256 * MLD + pn * 256) * 4;
            u.o = (char*)(ws + WS_MB) + ((size_t)pm * 256 * 2048 + pn * 256) * 2;
            u.nt = sub == 0 ? 32 : 16; u.mode = M_MG0 + sub; u.ldo = 2048; return true; }
        return false; }
    case G_MERGEC: {
        if (i == 0 && l < DEPTH - 1 && c >= G - 64) { const int pc = c - (G - 64), pn = pc >> 3, q = pc & 7;
            const int sub = q < 4 ? 0 : (q < 6 ? 1 : 2), kcol = q < 4 ? q * 512 : (q < 6 ? (q - 4) * 512 : (q - 6) * 512);
            u.a = (const char*)(ws + WS_ACAT) + ((size_t)sub * APL + kcol) * 2;
            u.b = (const char*)(ws + WS_WCAT + l * SZ_WCAT) + ((size_t)sub * WPL + (size_t)pn * 256 * CLD + kcol) * 2;
            u.aux = (const char*)(ws + WS_P) + ((size_t)OML + sub * 2048 + pn * 256) * 2;
            u.m = (char*)(ws + WS_MP) + ((size_t)q * CTX * MLD + pn * 256) * 4;
            u.o = nullptr; u.nt = 8; u.mode = M_MERGE0; u.ldo = 2048; return true; }
        return false; }
    case G_OUT: {
        const int piece = l >> 4; l &= 15;
        if (i != 0) return false;
        if (!piece) { if (c >= 256) return false; int pm, pn; static_order(c, 32, 8, pm, pn); pm += 1;
            u.a = (const char*)(ws + WS_MB) + (size_t)pm * 256 * 2048 * 2;
            u.b = (const char*)(ws + WS_WOUT + l * SZ_WOUT) + (size_t)pn * 256 * 2048 * 2;
            u.o = (char*)(ws + WS_OUTB) + ((size_t)pm * 256 * 2048 + pn * 256) * 4;
            u.nt = 32; u.mode = M_F32; u.ldo = 2048; return true; }
        if (l < DEPTH - 1 && c >= G - 32) { const int pc = c - (G - 32), pn = pc >> 2, kp = pc & 3;
            u.a = (const char*)(ws + WS_MB) + (size_t)kp * 512 * 2;
            u.b = (const char*)(ws + WS_WOUT + l * SZ_WOUT) + ((size_t)pn * 256 * 2048 + kp * 512) * 2;
            u.o = (char*)(ws + WS_OUTP) + ((size_t)kp * CTX * 2048 + pn * 256) * 4;
            u.nt = 8; u.mode = M_F32; u.ldo = 2048; return true; }
        return false; }
    }
    return false;
}

__device__ __forceinline__ void epilogue(const f32x4 (&acc)[2][2][4][2], const Unit& u, int wr, int wc, int fr, int fq) {
    unsigned r0 = wr * 64 + fr, c0 = wc * 64 + 8 * fq;
    asm volatile("" : "+v"(r0), "+v"(c0));
    if (u.mode == M_BF16) {
        const unsigned base = (r0 * (unsigned)u.ldo + c0) * 2u;
#pragma unroll
        for (int ai = 0; ai < 2; ++ai)
#pragma unroll
            for (int m = 0; m < 4; ++m) { char* rowp = u.o + (size_t)(ai * HALF + m * 16) * u.ldo * 2;
#pragma unroll
                for (int bj = 0; bj < 2; ++bj) { const f32x4 v0 = acc[ai][bj][m][0], v1 = acc[ai][bj][m][1];
                    u32x4 w; w.x = cvtpk(v0[0], v0[1]); w.y = cvtpk(v0[2], v0[3]); w.z = cvtpk(v1[0], v1[1]); w.w = cvtpk(v1[2], v1[3]);
                    *(u32x4*)(rowp + base + bj * BJC * 2) = w; } }
    } else if (u.mode == M_MIX) {
        const unsigned base = (r0 * (unsigned)u.ldo + c0) * 2u, abase = (r0 * (unsigned)INC + c0) * 2u;
#pragma unroll
        for (int ai = 0; ai < 2; ++ai) {
            u32x4 g[4][2];
#pragma unroll
            for (int m = 0; m < 4; ++m)
#pragma unroll
                for (int bj = 0; bj < 2; ++bj) g[m][bj] = *(const u32x4*)(u.aux + (size_t)(ai * HALF + m * 16) * INC * 2 + abase + bj * BJC * 2);
            __builtin_amdgcn_sched_barrier(0);
#pragma unroll
            for (int m = 0; m < 4; ++m) { char* rowp = u.o + (size_t)(ai * HALF + m * 16) * u.ldo * 2;
#pragma unroll
                for (int bj = 0; bj < 2; ++bj) { const f32x4 v0 = acc[ai][bj][m][0], v1 = acc[ai][bj][m][1]; const u32x4 gg = g[m][bj];
                    u32x4 w; w.x = cvtpk(v0[0] * siluf_(bflo(gg.x)), v0[1] * siluf_(bfhi(gg.x))); w.y = cvtpk(v0[2] * siluf_(bflo(gg.y)), v0[3] * siluf_(bfhi(gg.y)));
                    w.z = cvtpk(v1[0] * siluf_(bflo(gg.z)), v1[1] * siluf_(bfhi(gg.z))); w.w = cvtpk(v1[2] * siluf_(bflo(gg.w)), v1[3] * siluf_(bfhi(gg.w)));
                    *(u32x4*)(rowp + base + bj * BJC * 2) = w; } }
            __builtin_amdgcn_sched_barrier(0);
        }
    } else if (u.mode == M_F32) {
        const unsigned base = (r0 * (unsigned)u.ldo + c0) * 4u;
#pragma unroll
        for (int ai = 0; ai < 2; ++ai)
#pragma unroll
            for (int m = 0; m < 4; ++m) { char* rowp = u.o + (size_t)(ai * HALF + m * 16) * u.ldo * 4;
#pragma unroll
                for (int bj = 0; bj < 2; ++bj) { *(f32x4*)(rowp + base + bj * BJC * 4) = acc[ai][bj][m][0]; *(f32x4*)(rowp + base + bj * BJC * 4 + 16) = acc[ai][bj][m][1]; } }
    } else if (u.mode == M_MG0 || u.mode == M_MG1) {
    } else if (u.mode == M_MG2) {
        const unsigned abase = (r0 * (unsigned)INC + c0) * 2u, obase = (r0 * 2048u + c0) * 2u;
#pragma unroll
        for (int ai = 0; ai < 2; ++ai) {
            u32x4 g[4][2];
#pragma unroll
            for (int m = 0; m < 4; ++m)
#pragma unroll
                for (int bj = 0; bj < 2; ++bj) g[m][bj] = *(const u32x4*)(u.aux + (size_t)(ai * HALF + m * 16) * INC * 2 + abase + bj * BJC * 2);
            __builtin_amdgcn_sched_barrier(0);
#pragma unroll
            for (int m = 0; m < 4; ++m) { char* rowp = u.o + (size_t)(ai * HALF + m * 16) * 2048 * 2;
#pragma unroll
                for (int bj = 0; bj < 2; ++bj) { f32x4 v0 = acc[ai][bj][m][0], v1 = acc[ai][bj][m][1]; const u32x4 gg = g[m][bj];
                    v0[0] *= sigmoidf_(bflo(gg.x)); v0[1] *= sigmoidf_(bfhi(gg.x)); v0[2] *= sigmoidf_(bflo(gg.y)); v0[3] *= sigmoidf_(bfhi(gg.y));
                    v1[0] *= sigmoidf_(bflo(gg.z)); v1[1] *= sigmoidf_(bfhi(gg.z)); v1[2] *= sigmoidf_(bflo(gg.w)); v1[3] *= sigmoidf_(bfhi(gg.w));
                    u32x4 w; w.x = cvtpk(v0[0], v0[1]); w.y = cvtpk(v0[2], v0[3]); w.z = cvtpk(v1[0], v1[1]); w.w = cvtpk(v1[2], v1[3]); *(u32x4*)(rowp + obase + bj * BJC * 2) = w; } }
            __builtin_amdgcn_sched_barrier(0);
        }
    } else if (u.mode == M_F1) {
        const int s2 = u.ldo;
        const unsigned kb0 = (c0 >> 1);
        float tc[2][4], ts[2][4];
#pragma unroll
        for (int bj = 0; bj < 2; ++bj)
#pragma unroll
            for (int j = 0; j < 4; ++j) { const float x = (float)((bj * 16 + kb0 + j) * s2) * (1.0f / 8192.0f); tc[bj][j] = __builtin_amdgcn_cosf(x); ts[bj][j] = __builtin_amdgcn_sinf(x); }
        const unsigned base = r0 * (unsigned)ZCH + kb0 * 256u;
#pragma unroll
        for (int ai = 0; ai < 2; ++ai)
#pragma unroll
            for (int m = 0; m < 4; ++m) { char* rowp = u.o + (size_t)(ai * HALF + m * 16) * ZCH;
#pragma unroll
                for (int bj = 0; bj < 2; ++bj) { const f32x4 v0 = acc[ai][bj][m][0], v1 = acc[ai][bj][m][1];
                    const float zr[4] = {v0[0], v0[2], v1[0], v1[2]}, zi[4] = {v0[1], v0[3], v1[1], v1[3]};
#pragma unroll
                    for (int j = 0; j < 4; ++j) { const float pr = zr[j] * tc[bj][j] + zi[j] * ts[bj][j], pi = zi[j] * tc[bj][j] - zr[j] * ts[bj][j];
                        *(unsigned*)(rowp + base + (bj * 16 + j) * 256) = cvtpk(pr, pi); } } }
    } else if (u.mode == M_F2) {
        const unsigned fr_ = r0 & 15u, wr_ = r0 >> 6;
        const unsigned base = ((128u * fr_) * 2048u + wr_ * 1024u + c0) * 2u;
#pragma unroll
        for (int ai = 0; ai < 2; ++ai)
#pragma unroll
            for (int m = 0; m < 4; ++m) { char* rowp = u.o + (size_t)(ai + 2048 * m) * 2048 * 2;
#pragma unroll
                for (int bj = 0; bj < 2; ++bj) { const f32x4 v0 = acc[ai][bj][m][0], v1 = acc[ai][bj][m][1];
                    u32x4 w; w.x = cvtpk(v0[0], v0[1]); w.y = cvtpk(v0[2], v0[3]); w.z = cvtpk(v1[0], v1[1]); w.w = cvtpk(v1[2], v1[3]);
                    *(u32x4*)(rowp + base + bj * BJC * 2) = w; } }
    } else {
        const unsigned abase = (r0 * (unsigned)INC + c0) * 2u, mbase = (r0 * (unsigned)MLD + c0) * 4u;
#pragma unroll
        for (int ai = 0; ai < 2; ++ai)
#pragma unroll
            for (int m = 0; m < 4; ++m) { const int rr = ai * HALF + m * 16; const char* ap = u.aux + (size_t)rr * INC * 2; char* mp = u.m + (size_t)rr * MLD * 4;
#pragma unroll
                for (int bj = 0; bj < 2; ++bj) { f32x4 v0 = acc[ai][bj][m][0], v1 = acc[ai][bj][m][1]; const u32x4 g = *(const u32x4*)(ap + abase + bj * BJC * 2);
                    v0[0] *= sigmoidf_(bflo(g.x)); v0[1] *= sigmoidf_(bfhi(g.x)); v0[2] *= sigmoidf_(bflo(g.y)); v0[3] *= sigmoidf_(bfhi(g.y));
                    v1[0] *= sigmoidf_(bflo(g.z)); v1[1] *= sigmoidf_(bfhi(g.z)); v1[2] *= sigmoidf_(bflo(g.w)); v1[3] *= sigmoidf_(bfhi(g.w));
                    *(f32x4*)(mp + mbase + bj * BJC * 4) = v0; *(f32x4*)(mp + mbase + bj * BJC * 4 + 16) = v1; }
                if (m & 1) __builtin_amdgcn_sched_barrier(0); }
    }
}

__device__ __forceinline__ void rescale_or_reset(f32x4 (&acc)[2][2][4][2], const Unit& u, int wr, int wc, int fr, int fq) {
    const unsigned msk = (u.mode == M_MG0 || u.mode == M_MG1) ? 0xffffffffu : 0u;
    unsigned r0 = wr * 64 + fr, c0 = wc * 64 + 8 * fq;
    asm volatile("" : "+v"(r0), "+v"(c0));
    const unsigned abase = (r0 * (unsigned)INC + c0) * 2u;
#pragma unroll
    for (int ai = 0; ai < 2; ++ai)
#pragma unroll
        for (int m = 0; m < 4; ++m) { const char* ap = u.aux + (size_t)(ai * HALF + m * 16) * INC * 2;
#pragma unroll
            for (int bj = 0; bj < 2; ++bj) {
                const u32x4 ga = *(const u32x4*)(ap + abase + bj * BJC * 2), gb = *(const u32x4*)(ap + abase + bj * BJC * 2 + 4096);
                const unsigned wa[4] = {ga.x, ga.y, ga.z, ga.w}, wb[4] = {gb.x, gb.y, gb.z, gb.w};
                float f[8];
#pragma unroll
                for (int e = 0; e < 4; ++e) {
                    const float rl = (1.0f + __expf(-bflo(wb[e]))) * __builtin_amdgcn_rcpf(1.0f + __expf(-bflo(wa[e])));
                    const float rh = (1.0f + __expf(-bfhi(wb[e]))) * __builtin_amdgcn_rcpf(1.0f + __expf(-bfhi(wa[e])));
                    f[2 * e] = __uint_as_float(__float_as_uint(rl) & msk); f[2 * e + 1] = __uint_as_float(__float_as_uint(rh) & msk); }
                acc[ai][bj][m][0] *= (f32x4){f[0], f[1], f[2], f[3]}; acc[ai][bj][m][1] *= (f32x4){f[4], f[5], f[6], f[7]};
            }
            if (m & 1) __builtin_amdgcn_sched_barrier(0);
        }
}

__device__ __forceinline__ void gemm_phase(LAS unsigned char* lds, int gid, int l, unsigned char* ws) {
    int tid_ = threadIdx.x; asm volatile("" : "+v"(tid_));
    const int tid = tid_, wid = __builtin_amdgcn_readfirstlane(tid >> 6), lane = tid & 63, wr = wid >> 2, wc = wid & 3, fr = lane & 15, fq = lane >> 4;
    int lda, ldb;
    int ldbv = 0;
    switch (gid) { case G_FOLD: lda = 1024; ldb = 256; break; case G_IN: lda = 2048; ldb = 2048; break; case G_XT: lda = 2048; ldb = 2048; ldbv = 64 * 2048; break;
                   case G_F1: lda = ROWS; ldb = 128; break; case G_F2: lda = 256; ldb = ZCH / 2; break;
                   case G_DFTC: lda = 256; ldb = ROWS; break; case G_MIX: lda = 2048; ldb = 2048; break; case G_MERGE: case G_MERGEC: lda = CLD; ldb = CLD; break; default: lda = 2048; ldb = 2048; break; }
    if (ldbv == 0) ldbv = ldb;
    Unit cur, nxt; int ui = 0;
    if (!get_unit(gid, l, 0, ws, cur)) return;
    unsigned voffA[2], voffB[2];
#pragma unroll
    for (int i = 0; i < 2; ++i) { int R, C; stage_rc(tid * 16 + i * 8192, R, C); const int w_ = R >> 5, ip = perm32(R & 31);
        const int Rb = (gid == G_XT) ? (4096 * (w_ & 1) + 64 * ip + (w_ >> 1)) : (64 * w_ + ip);
        voffA[i] = (unsigned)(R * lda + C) * 2u; voffB[i] = (unsigned)(Rb * ldb + C) * 2u; }
    const size_t kstep = (size_t)(BK * 2);
    const size_t hstepA = (size_t)HALF * lda * 2, hstepB = (gid == G_XT) ? (size_t)2048 * ldb * 2 : (size_t)32 * ldb * 2;
    const unsigned ldsw = (unsigned)wid * 1024u;
    const int aoff = lds_byte(wr * 64 + fr, fq * 8), boff = lds_byte(wc * 32 + fr, fq * 8);
#define PG8_SA(b, h) (((b) * 2 + (h)) * HTB)
#define PG8_SB(b, h) ((4 + (b) * 2 + (h)) * HTB)
#define PG8_STAGE(bufoff, gbase, voff) do { _Pragma("unroll") for (int _i = 0; _i < 2; ++_i) \
        __builtin_amdgcn_global_load_lds((const unsigned*)((const char*)(gbase) + (voff)[_i]), (LAS unsigned*)(lds + (bufoff) + ldsw + _i * 8192), 16, 0, 0); } while (0)
#define PG8_LDA(dst, b, h) do { _Pragma("unroll") for (int m = 0; m < 4; ++m) _Pragma("unroll") for (int k = 0; k < 2; ++k) dst[m][k] = *(const LAS bf16x8*)(lds + PG8_SA(b, h) + aoff + m * 2048 + k * 1024); } while (0)
#define PG8_LDB(dst, b, h) do { _Pragma("unroll") for (int n = 0; n < 2; ++n) _Pragma("unroll") for (int k = 0; k < 2; ++k) dst[n][k] = *(const LAS bf16x8*)(lds + PG8_SB(b, h) + boff + n * 2048 + k * 1024); } while (0)
#define PG8_MMA(ai, bj, At, Bt) do { __builtin_amdgcn_s_setprio(1); _Pragma("unroll") for (int m = 0; m < 4; ++m) _Pragma("unroll") for (int n = 0; n < 2; ++n) _Pragma("unroll") for (int k = 0; k < 2; ++k) \
        acc[ai][bj][m][n] = __builtin_amdgcn_mfma_f32_16x16x32_bf16(Bt[n][k], At[m][k], acc[ai][bj][m][n], 0, 0, 0); __builtin_amdgcn_s_setprio(0); } while (0)
#define PG8_WAIT_V(n) asm volatile("s_waitcnt vmcnt(" #n ")" ::: "memory")
#define PG8_WAIT_L(n) asm volatile("s_waitcnt lgkmcnt(" #n ")" ::: "memory")
#define PG8_BAR __builtin_amdgcn_s_barrier()
#define PG8_SCHED __builtin_amdgcn_sched_barrier(0)
    f32x4 acc[2][2][4][2];
#pragma unroll
    for (int a = 0; a < 2; ++a)
#pragma unroll
        for (int b = 0; b < 2; ++b)
#pragma unroll
            for (int m = 0; m < 4; ++m)
#pragma unroll
                for (int n = 0; n < 2; ++n) acc[a][b][m][n] = (f32x4){0.f, 0.f, 0.f, 0.f};
    bf16x8 At[4][2], B0[2][2], B1[2][2];
    const char* cA = cur.a; const char* cB = cur.b;
    PG8_STAGE(PG8_SB(0, 0), cB, voffB); PG8_STAGE(PG8_SA(0, 0), cA, voffA); PG8_STAGE(PG8_SB(0, 1), cB + hstepB, voffB); PG8_STAGE(PG8_SA(0, 1), cA + hstepA, voffA);
    if (wr == 1) PG8_BAR;
    PG8_WAIT_V(4); PG8_BAR;
    PG8_STAGE(PG8_SB(1, 0), cB + kstep, voffB); PG8_STAGE(PG8_SA(1, 0), cA + kstep, voffA); PG8_STAGE(PG8_SB(1, 1), cB + hstepB + kstep, voffB);
    PG8_WAIT_V(6); PG8_BAR;
    for (;;) {
        const bool has_next = get_unit(gid, l, ui + 1, ws, nxt);
        const char* nA = has_next ? nxt.a : cA; const char* nB = has_next ? nxt.b : cB;
        const int nt = cur.nt;
        for (int t = 0; t < nt; t += 2) {
            const bool last = (t == nt - 2);
            const char* a1 = cA + (size_t)(t + 1) * kstep;
            const char* a2 = last ? nA : cA + (size_t)(t + 2) * kstep; const char* b2 = last ? nB : cB + (size_t)(t + 2) * kstep;
            const char* a3 = a2 + kstep; const char* b3 = b2 + kstep;
            PG8_LDB(B0, 0, 0); PG8_SCHED; PG8_LDA(At, 0, 0); PG8_STAGE(PG8_SA(1, 1), a1 + hstepA, voffA);
            PG8_WAIT_L(8); PG8_BAR; PG8_WAIT_L(0); PG8_MMA(0, 0, At, B0); PG8_BAR; PG8_SCHED;
            PG8_LDB(B1, 0, 1); PG8_STAGE(PG8_SB(0, 0), b2, voffB);
            PG8_BAR; PG8_WAIT_L(0); PG8_MMA(0, 1, At, B1); PG8_BAR;
            PG8_LDA(At, 0, 1); PG8_STAGE(PG8_SA(0, 0), a2, voffA);
            PG8_BAR; PG8_WAIT_L(0); PG8_MMA(1, 0, At, B0); PG8_BAR; PG8_SCHED;
            PG8_STAGE(PG8_SB(0, 1), b2 + hstepB, voffB);
            PG8_WAIT_V(6); PG8_BAR; PG8_MMA(1, 1, At, B1); PG8_BAR;
            PG8_LDB(B0, 1, 0); PG8_SCHED; PG8_LDA(At, 1, 0); PG8_STAGE(PG8_SA(0, 1), a2 + hstepA, voffA);
            PG8_WAIT_L(8); PG8_BAR; PG8_WAIT_L(0); PG8_MMA(0, 0, At, B0); PG8_BAR; PG8_SCHED;
            PG8_LDB(B1, 1, 1); PG8_STAGE(PG8_SB(1, 0), b3, voffB);
            PG8_BAR; PG8_WAIT_L(0); PG8_MMA(0, 1, At, B1); PG8_BAR;
            PG8_LDA(At, 1, 1); PG8_STAGE(PG8_SA(1, 0), a3, voffA);
            PG8_BAR; PG8_WAIT_L(0); PG8_MMA(1, 0, At, B0); PG8_BAR; PG8_SCHED;
            PG8_STAGE(PG8_SB(1, 1), b3 + hstepB, voffB);
            PG8_WAIT_V(6); PG8_BAR; PG8_MMA(1, 1, At, B1); PG8_BAR;
        }
        epilogue(acc, cur, wr, wc, fr, fq);
        if (!has_next) break;
        if (gid == G_MERGE) rescale_or_reset(acc, cur, wr, wc, fr, fq);
        else {
#pragma unroll
            for (int a = 0; a < 2; ++a)
#pragma unroll
                for (int b = 0; b < 2; ++b)
#pragma unroll
                    for (int m = 0; m < 4; ++m)
#pragma unroll
                        for (int n = 0; n < 2; ++n) acc[a][b][m][n] = (f32x4){0.f, 0.f, 0.f, 0.f};
        }
        cur = nxt; cA = nA; cB = nB; ++ui;
    }
    PG8_WAIT_V(0);
    if (wr == 0) PG8_BAR;
    PG8_BAR;
#undef PG8_SA
#undef PG8_SB
#undef PG8_STAGE
#undef PG8_LDA
#undef PG8_LDB
#undef PG8_MMA
#undef PG8_WAIT_V
#undef PG8_WAIT_L
#undef PG8_BAR
#undef PG8_SCHED
}

namespace att {
constexpr int D = 128, NW = 8, QBLK = 32, KVBLK = 64;
constexpr float SCALE = 0.088388347648318440f;
constexpr float THR = 8.f;
constexpr int LDQ = INC, LDK = 128, LDO = CLD;
constexpr size_t SHM_V = KVBLK * D * 2, SHM_K = KVBLK * D * 2, SHM_ATTN = 2 * SHM_V + 2 * SHM_K + NW * 64 * 4;
#define KSWZ(row, colB) ((row) * 256 + ((colB) ^ (((row) & 7) << 4)))
#define SBAR() __builtin_amdgcn_sched_barrier(0)
__device__ __forceinline__ int crow(int r, int hi) { return (r & 3) + 8 * (r >> 2) + 4 * hi; }
__device__ __forceinline__ void partialSM(f32x16& p0, f32x16& p1, float& m_reg, float& mn, float& alpha) {
  constexpr float C = SCALE * 1.4426950408889634f;
  float pmax = p0[0];
#pragma unroll
  for (int r = 1; r < 16; ++r) pmax = fmaxf(pmax, p0[r]);
#pragma unroll
  for (int r = 0; r < 16; ++r) pmax = fmaxf(pmax, p1[r]);
  { auto rr = __builtin_amdgcn_permlane32_swap(__float_as_uint(pmax), __float_as_uint(pmax), false, false);
    pmax = fmaxf(__uint_as_float(rr[0]), __uint_as_float(rr[1])); }
  if (__builtin_expect(__all(pmax - m_reg <= THR / SCALE), 1)) { mn = m_reg; alpha = 1.f; }
  else { mn = fmaxf(m_reg, pmax); alpha = __builtin_amdgcn_exp2f((m_reg - mn) * C); m_reg = mn; }
  float mnC = -mn * C;
#pragma unroll
  for (int r = 0; r < 16; ++r) p0[r] = fmaf(p0[r], C, mnC);
#pragma unroll
  for (int r = 0; r < 16; ++r) p1[r] = fmaf(p1[r], C, mnC);
#pragma unroll
  for (int r = 0; r < 16; ++r) p0[r] = __builtin_amdgcn_exp2f(p0[r]);
}
__device__ __forceinline__ void finishSM(f32x16& p0, f32x16& p1, float alpha, float& l_reg, bf16x8& pa0, bf16x8& pa1, bf16x8& pa2, bf16x8& pa3) {
#pragma unroll
  for (int r = 0; r < 16; ++r) p1[r] = __builtin_amdgcn_exp2f(p1[r]);
  float ps = 0;
#pragma unroll
  for (int r = 0; r < 16; ++r) ps += p0[r];
#pragma unroll
  for (int r = 0; r < 16; ++r) ps += p1[r];
  { auto rr = __builtin_amdgcn_permlane32_swap(__float_as_uint(ps), __float_as_uint(ps), false, false);
    ps = __uint_as_float(rr[0]) + __uint_as_float(rr[1]); }
  l_reg = l_reg * alpha + ps;
#define PK4(P, BASE, OUT) do { unsigned a0 = cvtpk(P[BASE + 0], P[BASE + 1]), a1 = cvtpk(P[BASE + 2], P[BASE + 3]);   \
    unsigned b0 = cvtpk(P[BASE + 4], P[BASE + 5]), b1 = cvtpk(P[BASE + 6], P[BASE + 7]);                              \
    auto r0 = __builtin_amdgcn_permlane32_swap(a0, b0, false, false); auto r1 = __builtin_amdgcn_permlane32_swap(a1, b1, false, false); \
    u32x4 w = {r0[0], r1[0], r0[1], r1[1]}; OUT = *reinterpret_cast<bf16x8*>(&w); } while (0)
  PK4(p0, 0, pa0); PK4(p0, 8, pa1); PK4(p1, 0, pa2); PK4(p1, 8, pa3);
#undef PK4
}
__device__ __forceinline__ void qkt(f32x16& p0, f32x16& p1, const bf16_t* Ks, const bf16x8* qr, int r32, int hi) {
  p0 = f32x16{}; p1 = f32x16{};
#pragma unroll
  for (int d0 = 0; d0 < 8; ++d0) { int cb = (d0 * 16 + hi * 8) * 2;
    bf16x8 b0 = *reinterpret_cast<const bf16x8*>((const char*)Ks + KSWZ(r32, cb));
    bf16x8 b1 = *reinterpret_cast<const bf16x8*>((const char*)Ks + KSWZ(32 + r32, cb));
    p0 = __builtin_amdgcn_mfma_f32_32x32x16_bf16(b0, qr[d0], p0, 0, 0, 0);
    p1 = __builtin_amdgcn_mfma_f32_32x32x16_bf16(b1, qr[d0], p1, 0, 0, 0); }
}
__device__ __forceinline__ int v_st(int k, int c) { const int kk = (k & ~0xC) | ((k & 4) << 1) | ((k & 8) >> 1); return ((kk >> 3) * 4 + (c >> 5)) * 512 + ((kk & 7) * 32 + (c & 31)) * 2; }
__device__ __forceinline__ int v_rd_base(int lane) { return ((lane & 3) << 3) | (((lane >> 2) & 3) << 6) | (((lane >> 4) & 1) << 5) | (((lane >> 5) & 1) << 8); }
constexpr int v_rd_off(int d0, int ks, int half) { return d0 * 512 + ks * 4096 + half * 2048; }
template <int OFF> __device__ __forceinline__ s16x4 tr_read(int vb) {
  s16x4 r; asm volatile("ds_read_b64_tr_b16 %0, %1 offset:%2" : "=&v"(r) : "v"(vb), "i"(OFF) : "memory"); return r;
}
template <int D0> __device__ __forceinline__ void pv_one(f32x16& od, int vb, bf16x8 pa0, bf16x8 pa1, bf16x8 pa2, bf16x8 pa3) {
  const s16x4 l0 = tr_read<v_rd_off(D0, 0, 0)>(vb), h0 = tr_read<v_rd_off(D0, 0, 1)>(vb), l1 = tr_read<v_rd_off(D0, 1, 0)>(vb), h1 = tr_read<v_rd_off(D0, 1, 1)>(vb);
  const s16x4 l2 = tr_read<v_rd_off(D0, 2, 0)>(vb), h2 = tr_read<v_rd_off(D0, 2, 1)>(vb), l3 = tr_read<v_rd_off(D0, 3, 0)>(vb), h3 = tr_read<v_rd_off(D0, 3, 1)>(vb);
  asm volatile("s_waitcnt lgkmcnt(0)" ::: "memory"); SBAR();
#define PK(L, H) (bf16x8){L[0], L[1], L[2], L[3], H[0], H[1], H[2], H[3]}
  od = __builtin_amdgcn_mfma_f32_32x32x16_bf16(pa0, PK(l0, h0), od, 0, 0, 0);
  od = __builtin_amdgcn_mfma_f32_32x32x16_bf16(pa1, PK(l1, h1), od, 0, 0, 0);
  od = __builtin_amdgcn_mfma_f32_32x32x16_bf16(pa2, PK(l2, h2), od, 0, 0, 0);
  od = __builtin_amdgcn_mfma_f32_32x32x16_bf16(pa3, PK(l3, h3), od, 0, 0, 0);
#undef PK
}
__device__ __forceinline__ void pv_d0(f32x16* o, int vb, bf16x8 pa0, bf16x8 pa1, bf16x8 pa2, bf16x8 pa3) {
  pv_one<0>(o[0], vb, pa0, pa1, pa2, pa3); pv_one<1>(o[1], vb, pa0, pa1, pa2, pa3); pv_one<2>(o[2], vb, pa0, pa1, pa2, pa3); pv_one<3>(o[3], vb, pa0, pa1, pa2, pa3);
}
__device__ __forceinline__ void attn_body(const bf16_t* __restrict__ Qb, const bf16_t* __restrict__ Kh, const bf16_t* __restrict__ Vh,
                                          bf16_t* __restrict__ Ob, const bf16_t* __restrict__ AGb, int seq, char* lds) {
  int tid_ = threadIdx.x; asm volatile("" : "+v"(tid_));
  const int tid = tid_, wid = tid >> 6, lane = tid & 63, r32 = lane & 31, hi = lane >> 5;
  bf16_t* V_lds = (bf16_t*)lds; bf16_t* K_lds = (bf16_t*)(lds + 2 * SHM_V);
  float* wsl = (float*)(lds + 2 * SHM_V + 2 * SHM_K) + wid * 64; float* li_l = wsl; float* al_l = wsl + 32;
  float m_reg = -1e30f, l_reg = 0; f32x16 o[4] = {}; bf16x8 qr[8];
  const bf16_t* Qw = Qb + (long)(wid * QBLK + r32) * LDQ + hi * 8;
#pragma unroll
  for (int d0 = 0; d0 < 8; ++d0) qr[d0] = *reinterpret_cast<const bf16x8*>(Qw + d0 * 16);
  const int sr = tid >> 4, sc = (tid & 15) * 8, vst0 = v_st(sr, sc), vst1 = v_st(32 + sr, sc);
  const int vb0 = (int)(uintptr_t)V_lds + v_rd_base(lane);
  const unsigned goff0 = (unsigned)(sr * LDK + sc) * 2u, goff1 = (unsigned)((32 + sr) * LDK + sc) * 2u;
  struct { bf16x8 vs0, vs1, ks0, ks1; } sr_[2];
#define SLOAD(i, k0) do { const char* vt_ = (const char*)Vh + (size_t)(k0) * (LDK * 2); const char* kt_ = (const char*)Kh + (size_t)(k0) * (LDK * 2); \
    sr_[i].vs0 = *reinterpret_cast<const bf16x8*>(vt_ + goff0); sr_[i].vs1 = *reinterpret_cast<const bf16x8*>(vt_ + goff1); \
    sr_[i].ks0 = *reinterpret_cast<const bf16x8*>(kt_ + goff0); sr_[i].ks1 = *reinterpret_cast<const bf16x8*>(kt_ + goff1); } while (0)
#define SWRITE(b, i) do { *(bf16x8*)((char*)V_lds + (b) * SHM_V + vst0) = sr_[i].vs0;          \
    *(bf16x8*)((char*)V_lds + (b) * SHM_V + vst1) = sr_[i].vs1; int kc = sc * 2;               \
    *(bf16x8*)((char*)K_lds + (b) * SHM_K + KSWZ(sr, kc)) = sr_[i].ks0;                       \
    *(bf16x8*)((char*)K_lds + (b) * SHM_K + KSWZ(32 + sr, kc)) = sr_[i].ks1; } while (0)
#define SWAIT() asm volatile("s_waitcnt vmcnt(4)" ::: "memory")
#define RESC(a) do { if (__any((a) < 1.f)) { if (hi == 0) al_l[r32] = (a); asm volatile("s_waitcnt lgkmcnt(0)" ::: "memory"); \
    _Pragma("unroll") for (int d = 0; d < 4; ++d) _Pragma("unroll") for (int r = 0; r < 16; ++r) o[d][r] *= al_l[crow(r, hi)]; } } while (0)
  f32x16 pA0, pA1, pB0, pB1; float mnA, mnB, alA, alB; bf16x8 pa0, pa1, pa2, pa3; const int NT = seq / KVBLK;
  constexpr int SE = 0, SO = 1;
  SLOAD(SE, 0); asm volatile("s_waitcnt vmcnt(0)" ::: "memory"); SWRITE(0, SE); __syncthreads();
  qkt(pA0, pA1, K_lds, qr, r32, hi); partialSM(pA0, pA1, m_reg, mnA, alA);
  SLOAD(SO, KVBLK); if (2 < NT) SLOAD(SE, 2 * KVBLK);
  SWAIT(); SWRITE(1, SO); __syncthreads();
  for (int j = 1; j + 1 < NT; j += 2) {
    SBAR(); qkt(pB0, pB1, (bf16_t*)((char*)K_lds + SHM_K), qr, r32, hi);
    finishSM(pA0, pA1, alA, l_reg, pa0, pa1, pa2, pa3); SBAR();
    SLOAD(SO, (j + 2) * KVBLK); SBAR();
    pv_d0(o, vb0, pa0, pa1, pa2, pa3); partialSM(pB0, pB1, m_reg, mnB, alB);
    __syncthreads(); SWAIT(); SWRITE(0, SE);
    RESC(alB); __syncthreads();
    SBAR(); qkt(pA0, pA1, K_lds, qr, r32, hi);
    finishSM(pB0, pB1, alB, l_reg, pa0, pa1, pa2, pa3); SBAR();
    if (j + 3 < NT) SLOAD(SE, (j + 3) * KVBLK); SBAR();
    pv_d0(o, vb0 + (int)SHM_V, pa0, pa1, pa2, pa3); partialSM(pA0, pA1, m_reg, mnA, alA);
    __syncthreads(); SWAIT(); SWRITE(1, SO);
    RESC(alA); __syncthreads();
  }
  SBAR(); qkt(pB0, pB1, (bf16_t*)((char*)K_lds + SHM_K), qr, r32, hi);
  finishSM(pA0, pA1, alA, l_reg, pa0, pa1, pa2, pa3); SBAR();
  pv_d0(o, vb0, pa0, pa1, pa2, pa3); partialSM(pB0, pB1, m_reg, mnB, alB);
  __syncthreads(); RESC(alB);
  finishSM(pB0, pB1, alB, l_reg, pa0, pa1, pa2, pa3); SBAR();
  pv_d0(o, vb0 + (int)SHM_V, pa0, pa1, pa2, pa3);
  if (hi == 0) li_l[r32] = l_reg; asm volatile("s_waitcnt lgkmcnt(0)" ::: "memory");
  char* Ow = (char*)(Ob + (long)(wid * QBLK) * LDO); const char* Gw = (const char*)(AGb + (long)(wid * QBLK) * LDQ);
  unsigned hv = hi, cv = r32;
  asm volatile("" : "+v"(hv), "+v"(cv));
  const unsigned gbase = (hv * 4u * LDQ + cv) * 2u, obase = (hv * 4u * LDO + cv) * 2u;
#pragma unroll
  for (int r = 0; r < 16; ++r) { const int rc = (r & 3) + 8 * (r >> 2); const float rli = __builtin_amdgcn_rcpf(li_l[crow(r, hi)]);
    const unsigned go = gbase + (unsigned)(rc * LDQ * 2), oo = obase + (unsigned)(rc * LDO * 2);
    float g[4];
#pragma unroll
    for (int d0 = 0; d0 < 4; ++d0) g[d0] = bf2f(*(const bf16_t*)(Gw + go + d0 * 64));
#pragma unroll
    for (int d0 = 0; d0 < 4; ++d0) *(bf16_t*)(Ow + oo + d0 * 64) = f2bf(o[d0][r] * rli * siluf_(g[d0]));
    if ((r & 3) == 3) SBAR(); }
#undef SLOAD
#undef SWRITE
#undef SWAIT
#undef RESC
}
}

__device__ __forceinline__ void attn_phase(const Params& p, int l, char* lds) {
    unsigned char* ws = p.ws;
    const bf16_t* P = (const bf16_t*)(ws + WS_P); bf16_t* Acat = (bf16_t*)(ws + WS_ACAT);
    const int G = gridDim.x, nunits = 512 + (l < DEPTH - 1 ? 16 : 0);
    for (int U = blockIdx.x; U < nunits; U += G) {
        int h, qrow0, seq;
        if (U < 512) { int qb;
            if (G == 256) { const int xcd = U & 7, j = (U >> 3) & 31, r = U >> 8, kvh = xcd >> 1, idx = (xcd & 1) * 64 + r * 32 + j; h = kvh * 4 + (idx & 3); qb = idx >> 2; }
            else { h = U & 15; qb = U >> 4; }
            qrow0 = CTX + qb * 256; seq = ROWS; }
        else { h = U - 512; qrow0 = 0; seq = CTX; }
        const int kvh = h >> 2;
        att::attn_body(P + (size_t)qrow0 * INC + OQ + h * 128, (const bf16_t*)(ws + WS_KC) + (size_t)kvh * ROWS * 128, (const bf16_t*)(ws + WS_VC) + (size_t)kvh * ROWS * 128,
                       Acat + (size_t)qrow0 * CLD + h * 128, P + (size_t)qrow0 * INC + OAG + h * 128, seq, lds);
        __syncthreads();
    }
}

#define XB_TMO      128
#define XB_XCNT(j)  (256  + 64 * (j))
#define XB_XSUB(j)  (1280 + 64 * (j))
#define XB_XGEN(j)  (2304 + 64 * (j))
#define XB_TOP      3328
#define XB_TOPGEN   3392
#define XCD_BAR_WORDS 3456
#define XB_SPIN_CAP (1u << 18)

__device__ __forceinline__ unsigned xb_ld(unsigned* p)              { return __hip_atomic_load(p, __ATOMIC_RELAXED, __HIP_MEMORY_SCOPE_AGENT); }
__device__ __forceinline__ unsigned xb_add(unsigned* p, unsigned v) { return __hip_atomic_fetch_add(p, v, __ATOMIC_RELAXED, __HIP_MEMORY_SCOPE_AGENT); }
__device__ __forceinline__ unsigned xb_xcc_id() { return (unsigned)__builtin_amdgcn_s_getreg((3 << 11) | 20) & 0xFu; }
#define XB_SPIN(cond, bar) do { unsigned _sp = 0; while (cond) { __builtin_amdgcn_s_sleep(1); \
    if ((++_sp & 255u) == 0u) { if (xb_ld(&(bar)[XB_TMO])) break; if (_sp > XB_SPIN_CAP) { atomicAdd(&(bar)[XB_TMO], 1u); break; } } } } while (0)

struct XcdBarrier {
    unsigned* bar; unsigned x;
    volatile LAS unsigned* st;
};

__device__ __forceinline__ XcdBarrier xcd_barrier_post(unsigned* bar, volatile LAS unsigned* st) {
    XcdBarrier b; b.bar = bar; b.x = xb_xcc_id(); b.st = st;
    if (threadIdx.x == 0) (void)xb_add(&bar[XB_XCNT(b.x)], 1u);
    return b;
}
__device__ __forceinline__ void xcd_barrier_complete(unsigned* bar, unsigned x, unsigned& nloc, unsigned& nx) {
    const unsigned G = gridDim.x * gridDim.y * gridDim.z;
    unsigned sum, cnt, mine, sp = 0u;
    for (;;) {
        sum = 0u; cnt = 0u; mine = 0u;
#pragma unroll
        for (unsigned j = 0; j < 16; ++j) { const unsigned c = xb_ld(&bar[XB_XCNT(j)]); sum += c; cnt += (c > 0u) ? 1u : 0u; mine = (j == x) ? c : mine; }
        if (sum == G) break;
        __builtin_amdgcn_s_sleep(1);
        if ((++sp & 255u) == 0u) { if (xb_ld(&bar[XB_TMO])) break; if (sp > XB_SPIN_CAP) { atomicAdd(&bar[XB_TMO], 1u); break; } }
    }
    nloc = mine > 0u ? mine : 1u; nx = cnt > 0u ? cnt : 1u;
}

__device__ __forceinline__ void xcd_barrier(const XcdBarrier& b) {
    asm volatile("s_waitcnt vmcnt(0)" ::: "memory");
    __syncthreads();
    if (threadIdx.x == 0) {
        unsigned* bar = b.bar;
        __builtin_amdgcn_s_waitcnt(0);
        unsigned nloc = b.st[0], nx = b.st[1];
        if (nloc == 0u) { xcd_barrier_complete(bar, b.x, nloc, nx); b.st[0] = nloc; b.st[1] = nx; }
        const unsigned old = xb_add(&bar[XB_XSUB(b.x)], 1u);
        const unsigned gen = old / nloc;
        if (old + 1u == (gen + 1u) * nloc) {
            __builtin_amdgcn_fence(__ATOMIC_RELEASE, "agent");
            asm volatile("s_waitcnt vmcnt(0)" ::: "memory");
            const unsigned og = xb_add(&bar[XB_TOP], 1u);
            const unsigned tg = og / nx;
            if (og + 1u == (tg + 1u) * nx) xb_add(&bar[XB_TOPGEN], 1u);
            else XB_SPIN(xb_ld(&bar[XB_TOPGEN]) == tg, bar);
            __builtin_amdgcn_fence(__ATOMIC_ACQUIRE, "agent");
            xb_add(&bar[XB_XGEN(b.x)], 1u);
            asm volatile("s_waitcnt vmcnt(0)" ::: "memory");
        } else {
            XB_SPIN(xb_ld(&bar[XB_XGEN(b.x)]) == gen, bar);
            __builtin_amdgcn_fence(__ATOMIC_ACQUIRE, "agent");
            asm volatile("s_waitcnt vmcnt(0)" ::: "memory");
        }
    }
    __syncthreads();
}

__global__ void __launch_bounds__(NTHREADS, 2) mega_fwd(Params p0) {
    extern __shared__ __attribute__((aligned(16))) unsigned char lds[];
    cg::grid_group grid = cg::this_grid();
    volatile LAS unsigned* misc = (volatile LAS unsigned*)((LAS unsigned char*)lds + LDS_STAGE);
    if (threadIdx.x < 16) misc[threadIdx.x] = 0u;
    __syncthreads();
    (void)xcd_barrier_post((unsigned*)(p0.ws + WS_BAR), misc);
#ifndef PHASE_MASK
#define PHASE_MASK 0xFFFF
#endif
#define PH(b) if constexpr ((PHASE_MASK >> (b)) & 1)
#ifndef DBL_MASK
#define DBL_MASK 0
#endif
    PH(10) prep_phase(p0, lds);
    __syncthreads();
    if constexpr ((DBL_MASK >> 10) & 1) { prep_phase(p0, lds); __syncthreads(); }
    grid.sync();
#pragma unroll 1
    for (int l = 0; l < DEPTH; ++l) {
#pragma unroll 1
        for (int slot = 0; slot < 12; ++slot) {
            Params p = p0;
            { unsigned char* w = p.ws; asm volatile("" : "+s"(w)); p.ws = w; }
            bool sync = true;
            LAS unsigned char* L = (LAS unsigned char*)lds;
            const int reps = ((DBL_MASK >> slot) & 1) ? 2 : 1;
#pragma unroll 1
            for (int rep = 0; rep < reps; ++rep) {
            if (rep) __syncthreads();
            switch (slot) {
            case 0: rownorm_phase(p, l); sync = false; break;
            case 1: if (l == 0) gemm_phase(L, G_FOLD, l, p.ws); break;
            case 2: gemm_phase(L, G_IN, l, p.ws); sync = false; break;
            case 3: gemm_phase(L, G_XT, l, p.ws); break;
            case 4: gemm_phase(L, G_F1, l, p.ws); sync = false; break;
            case 5: gemm_phase(L, G_DFTC, l, p.ws); break;
            case 6: ew_phase(p, l); sync = false; break;
            case 7: gemm_phase(L, G_F2, l, p.ws); break;
            case 8: attn_phase(p, l, (char*)lds); sync = false; break;
            case 9: gemm_phase(L, G_MIX, l, p.ws); break;
            case 10: gemm_phase(L, G_MERGE, l, p.ws); __syncthreads(); gemm_phase(L, G_MERGEC, l, p.ws); break;
            default: {
                const bool hasctx = l < DEPTH - 1;
                unsigned* ccnt = (unsigned*)(p.ws + WS_BAR) + 3500;
                if (hasctx) {
                    int t0_ = threadIdx.x; asm volatile("" : "+v"(t0_));
                    const int idx = (int)blockIdx.x * NTHREADS + t0_, r = idx >> 9, cc = (idx & 511) * 4;
                    const float* mp = (const float*)(p.ws + WS_MP); bf16_t* mb = (bf16_t*)(p.ws + WS_MB);
                    f32x4 s = *(const f32x4*)(mp + (size_t)r * MLD + cc);
#pragma unroll
                    for (int q = 1; q < 8; ++q) s += *(const f32x4*)(mp + ((size_t)q * CTX + r) * MLD + cc);
                    u32x2 w; w.x = cvtpk(s[0], s[1]); w.y = cvtpk(s[2], s[3]); *(u32x2*)(mb + (size_t)r * DM + cc) = w;
                    asm volatile("s_waitcnt vmcnt(0)" ::: "memory"); __syncthreads();
                    if (threadIdx.x == 0) { __builtin_amdgcn_fence(__ATOMIC_RELEASE, "agent"); asm volatile("s_waitcnt vmcnt(0)" ::: "memory");
                        __hip_atomic_fetch_add(ccnt, 1u, __ATOMIC_RELAXED, __HIP_MEMORY_SCOPE_AGENT); }
                }
                const int nv = (hasctx && (int)blockIdx.x >= (int)gridDim.x - 32) ? 2 : 1;
#pragma unroll 1
                for (int v = 0; v < nv; ++v) {
                    if (v) {
                        __syncthreads();
                        if (threadIdx.x == 0) { const unsigned target = (unsigned)(l + 1) * gridDim.x; unsigned sp = 0;
                            while (__hip_atomic_load(ccnt, __ATOMIC_RELAXED, __HIP_MEMORY_SCOPE_AGENT) < target) { __builtin_amdgcn_s_sleep(1); if (++sp > (1u << 22)) break; }
                            __builtin_amdgcn_fence(__ATOMIC_ACQUIRE, "agent"); asm volatile("s_waitcnt vmcnt(0)" ::: "memory"); }
                        __syncthreads();
                    }
                    gemm_phase(L, G_OUT, l | (v << 4), p.ws);
                }
                break; }
            }
            }
            __syncthreads();
            if (sync) { XcdBarrier xb; xb.bar = (unsigned*)(p.ws + WS_BAR); xb.x = xb_xcc_id(); xb.st = (volatile LAS unsigned*)((LAS unsigned char*)lds + LDS_STAGE); xcd_barrier(xb); }
        }
    }
    PH(0) rownorm_phase(p0, DEPTH);
}

extern "C" void kernel_launch(void* const* d_in, const int* in_sizes, int n_in, void* d_out, int out_size, void* d_ws, size_t ws_size, hipStream_t stream) {
    static int grid_blocks = 0;
    if (grid_blocks == 0) {
        if (n_in != 18 || out_size != SEQ * DM || ws_size < WS_END) { fprintf(stderr, "kernel_launch: unexpected shapes: n_in %d out %d ws %zu (need %zu)\n", n_in, out_size, ws_size, (size_t)WS_END); grid_blocks = -1; return; }
        int dev = 0, cus = 0, per_cu = 0;
        hipGetDevice(&dev);
        hipDeviceGetAttribute(&cus, hipDeviceAttributeMultiprocessorCount, dev);
        if (hipFuncSetAttribute((const void*)mega_fwd, hipFuncAttributeMaxDynamicSharedMemorySize, LDS_BYTES) != hipSuccess) { fprintf(stderr, "kernel_launch: hipFuncSetAttribute failed\n"); grid_blocks = -1; return; }
        if (hipOccupancyMaxActiveBlocksPerMultiprocessor(&per_cu, (const void*)mega_fwd, NTHREADS, LDS_BYTES) != hipSuccess || per_cu < 1) { fprintf(stderr, "kernel_launch: occupancy query gave %d\n", per_cu); per_cu = 1; }
        (void)hipGetLastError();
        grid_blocks = cus * (per_cu > 1 ? 1 : per_cu);
        if (grid_blocks > 256) grid_blocks = 256;
        grid_blocks &= ~7;
        if (grid_blocks != 256) { fprintf(stderr, "kernel_launch: this kernel is laid out for 256 resident workgroups, got %d\n", grid_blocks); grid_blocks = -1; return; }
    }
    if (grid_blocks <= 0) return;
    Params p{};
    for (int i = 0; i < 18; ++i) p.in[i] = (const float*)d_in[i];
    p.out = (float*)d_out; p.ws = (unsigned char*)d_ws;
    if (hipMemsetAsync((char*)d_ws + WS_BAR, 0, BAR_BYTES, stream) != hipSuccess) { fprintf(stderr, "kernel_launch: memset of barrier words failed\n"); return; }
    void* args[] = {&p};
    hipError_t e = hipLaunchCooperativeKernel((const void*)mega_fwd, dim3(grid_blocks), dim3(NTHREADS), args, LDS_BYTES, stream);
    if (e != hipSuccess) fprintf(stderr, "cooperative launch failed: %s (grid %d)\n", hipGetErrorString(e), grid_blocks);
}
```

```cpp
#include <hip/hip_runtime.h>
#include <hip/hip_cooperative_groups.h>
#include <cstdio>
#include <cstdint>
namespace cg = cooperative_groups;

#define LAS __attribute__((address_space(3)))
typedef unsigned short bf16_t;
typedef short bf16x8 __attribute__((ext_vector_type(8)));
typedef short s16x4 __attribute__((ext_vector_type(4)));
typedef float f32x4 __attribute__((ext_vector_type(4)));
typedef float f32x16 __attribute__((ext_vector_type(16)));
typedef unsigned u32x4 __attribute__((ext_vector_type(4)));
typedef unsigned u32x2 __attribute__((ext_vector_type(2)));

constexpr int DM = 2048, SEQ = 8192, CTX = 256, ROWS = SEQ + CTX, DEPTH = 4, INC = 17408;
constexpr int OQ = 0, OKK = 2048, OV = 2560, OAG = 3072, OFX = 5120, OFG = 6144, OCX = 7168, OCB = 8192, OCC = 9216, OCG = 10240, OML = 11264;
constexpr float EPS = 1e-6f;
constexpr size_t APL = (size_t)(SEQ + CTX) * 2048, WPL = (size_t)2048 * 2048;
constexpr int CLD = 2048;
constexpr int MLD = 2048 + 64;
constexpr int ZCH = 32768 + 256;
constexpr int LDS_STAGE = 131072, LDS_BYTES = LDS_STAGE + 64;
constexpr int NTHREADS = 512;

constexpr size_t SZ_WINT = (size_t)INC * DM * 2, SZ_WCAT = 3 * WPL * 2, SZ_WOUT = (size_t)DM * DM * 2, SZ_WMIXR = (size_t)1024 * 1024 * 2, SZ_WMIX = (size_t)1024 * 2048 * 2;
constexpr size_t WS_WINT = 0;
constexpr size_t WS_WCAT = WS_WINT + DEPTH * SZ_WINT;
constexpr size_t WS_WOUT = WS_WCAT + DEPTH * SZ_WCAT;
constexpr size_t WS_WMIXR = WS_WOUT + DEPTH * SZ_WOUT;
constexpr size_t WS_WMIX = WS_WMIXR + DEPTH * SZ_WMIXR;
constexpr size_t WS_TCH = WS_WMIX + DEPTH * SZ_WMIX;
constexpr size_t WS_ZT = WS_TCH + 512 * 256 * 2;
constexpr size_t WS_T1 = WS_ZT + (size_t)1024 * ZCH;
constexpr size_t WS_A2 = WS_T1 + 256 * 128 * 2;
constexpr size_t WS_ACTX = WS_A2 + 256 * 256 * 2;
constexpr size_t WS_ROPE = WS_ACTX + 512 * 256 * 2;
constexpr size_t WS_MOD = WS_ROPE + 128 * 32 * 8;
constexpr size_t WS_XS = WS_MOD + 4 * 2 * 6144 * 4;
constexpr size_t WS_H = WS_XS + (size_t)ROWS * DM * 4;
constexpr size_t WS_P = WS_H + (size_t)ROWS * DM * 2;
constexpr size_t WS_XT = WS_P + (size_t)ROWS * INC * 2;
constexpr size_t WS_PQ = WS_XT + (size_t)1024 * ROWS * 2;
constexpr size_t WS_ACAT = WS_PQ + (size_t)ROWS * DM * 2;
constexpr size_t WS_MBUF = WS_ACAT + 3 * APL * 2;
constexpr size_t WS_MB = WS_MBUF + (size_t)ROWS * MLD * 4;
constexpr size_t WS_OUTB = WS_MB + (size_t)ROWS * DM * 2;
constexpr size_t WS_KC = WS_OUTB + (size_t)ROWS * DM * 4;
constexpr size_t WS_VC = WS_KC + (size_t)4 * ROWS * 128 * 2;
constexpr size_t WS_MP = WS_VC + (size_t)4 * ROWS * 128 * 2;
constexpr size_t WS_OUTP = WS_MP + (size_t)8 * CTX * MLD * 4;
constexpr size_t WS_BAR = WS_OUTP + (size_t)4 * CTX * DM * 4;
constexpr size_t BAR_BYTES = 16384;
constexpr size_t WS_END = WS_BAR + BAR_BYTES;

struct Params { const float* in[18]; float* out; unsigned char* ws; };
enum { I_X = 0, I_C, I_CTX, I_CCTX, I_WMOD, I_BMOD, I_GPRE, I_GPOST, I_WIN, I_QN, I_KN, I_WAO, I_WFM, I_WFO, I_CW, I_CB, I_WCO, I_WOUT };

__device__ __forceinline__ unsigned cvtpk(float lo, float hi) { unsigned r; asm volatile("v_cvt_pk_bf16_f32 %0, %1, %2" : "=v"(r) : "v"(lo), "v"(hi)); return r; }
__device__ __forceinline__ float bf2f(unsigned short b) { return __uint_as_float(((unsigned)b) << 16); }
__device__ __forceinline__ float bflo(unsigned w) { return __uint_as_float(w << 16); }
__device__ __forceinline__ float bfhi(unsigned w) { return __uint_as_float(w & 0xffff0000u); }
__device__ __forceinline__ unsigned short f2bf(float f) { return (unsigned short)(cvtpk(f, f) & 0xffffu); }
__device__ __forceinline__ float sigmoidf_(float x) { return __builtin_amdgcn_rcpf(1.0f + __expf(-x)); }
__device__ __forceinline__ float siluf_(float x) { return x * sigmoidf_(x); }
__device__ __forceinline__ float wave_sum(float v) {
#pragma unroll
    for (int o = 32; o >= 1; o >>= 1) v += __shfl_xor(v, o);
    return v;
}

__device__ __forceinline__ void prep_phase(const Params& p, unsigned char* lds_g) {
    int tid_ = threadIdx.x; asm volatile("" : "+v"(tid_));
    const int tid = tid_, G = gridDim.x, bid = blockIdx.x;
    unsigned char* ws = p.ws;
    float* tile = (float*)lds_g;
    constexpr int T_IN = 32 * 272, T_AO = 32 * 32, T_FO = 16 * 32, T_CO = 16 * 32, T_OUT = 32 * 32, T_MIX = 16 * 16;
    constexpr int T_LAYER = T_IN + T_AO + T_FO + T_CO + T_OUT + T_MIX;
    for (int t = bid; t < DEPTH * T_LAYER; t += G) {
        const int l = t / T_LAYER; int r = t % T_LAYER;
        const float* src; int ldsrc; bf16_t* dst; int lddst; int ktiles;
        if (r < T_IN) { src = p.in[I_WIN] + (size_t)l * DM * INC; ldsrc = INC; dst = (bf16_t*)(ws + WS_WINT + l * SZ_WINT); lddst = DM; ktiles = 32; }
        else if ((r -= T_IN) < T_AO) { src = p.in[I_WAO] + (size_t)l * DM * DM; ldsrc = DM; dst = (bf16_t*)(ws + WS_WCAT + l * SZ_WCAT); lddst = CLD; ktiles = 32; }
        else if ((r -= T_AO) < T_FO) { src = p.in[I_WFO] + (size_t)l * 1024 * DM; ldsrc = DM; dst = (bf16_t*)(ws + WS_WCAT + l * SZ_WCAT) + WPL; lddst = CLD; ktiles = 16; }
        else if ((r -= T_FO) < T_CO) { src = p.in[I_WCO] + (size_t)l * 1024 * DM; ldsrc = DM; dst = (bf16_t*)(ws + WS_WCAT + l * SZ_WCAT) + 2 * WPL; lddst = CLD; ktiles = 16; }
        else if ((r -= T_CO) < T_OUT) { src = p.in[I_WOUT] + (size_t)l * DM * DM; ldsrc = DM; dst = (bf16_t*)(ws + WS_WOUT + l * SZ_WOUT); lddst = DM; ktiles = 32; }
        else { r -= T_OUT; src = p.in[I_WFM] + (size_t)l * 1024 * 1024; ldsrc = 1024; dst = (bf16_t*)(ws + WS_WMIXR + l * SZ_WMIXR); lddst = 1024; ktiles = 16; }
        const int k0 = (r % ktiles) * 64, n0 = (r / ktiles) * 64;
        { const int ty = tid >> 4, tx = tid & 15;
#pragma unroll
          for (int ps = 0; ps < 2; ++ps) { const int kk = ty + 32 * ps;
              const f32x4 v = *(const f32x4*)(src + (size_t)(k0 + kk) * ldsrc + n0 + tx * 4);
              tile[kk * 65 + tx * 4 + 0] = v[0]; tile[kk * 65 + tx * 4 + 1] = v[1]; tile[kk * 65 + tx * 4 + 2] = v[2]; tile[kk * 65 + tx * 4 + 3] = v[3]; } }
        __syncthreads();
        { const int n = tid >> 3, kc = (tid & 7) * 8; u32x4 w;
          w.x = cvtpk(tile[(kc + 0) * 65 + n], tile[(kc + 1) * 65 + n]); w.y = cvtpk(tile[(kc + 2) * 65 + n], tile[(kc + 3) * 65 + n]);
          w.z = cvtpk(tile[(kc + 4) * 65 + n], tile[(kc + 5) * 65 + n]); w.w = cvtpk(tile[(kc + 6) * 65 + n], tile[(kc + 7) * 65 + n]);
          *(u32x4*)(dst + (size_t)(n0 + n) * lddst + k0 + kc) = w; }
        __syncthreads();
    }
    {
        float* sc = (float*)lds_g;
        float* red = sc + 4096;
        for (int u = bid; u < 256; u += G) {
            for (int k = tid; k < 4096; k += NTHREADS) { const float cv = (k < 2048) ? p.in[I_C][k] : p.in[I_CCTX][k - 2048]; sc[k] = siluf_(cv); }
            __syncthreads();
            const int l = u >> 6, j0 = (u & 63) * 96;
            if (tid < 504) { const int kg = tid / 24, cq = tid % 24;
                f32x4 al = {0.f, 0.f, 0.f, 0.f}, ac = {0.f, 0.f, 0.f, 0.f};
                const float* wp = p.in[I_WMOD] + (size_t)l * DM * 6144 + j0 + cq * 4;
                for (int k = kg; k < 2048; k += 21) { const f32x4 w = *(const f32x4*)(wp + (size_t)k * 6144); al += sc[k] * w; ac += sc[2048 + k] * w; }
                float* rp = red + (kg * 24 + cq) * 8;
                rp[0] = al[0]; rp[1] = al[1]; rp[2] = al[2]; rp[3] = al[3]; rp[4] = ac[0]; rp[5] = ac[1]; rp[6] = ac[2]; rp[7] = ac[3]; }
            __syncthreads();
            if (tid < 192) { const int v = tid / 96, col = tid % 96, cq = col >> 2, e = col & 3; float s = 0.f;
                for (int kg = 0; kg < 21; ++kg) s += red[(kg * 24 + cq) * 8 + v * 4 + e];
                ((float*)(ws + WS_MOD))[(size_t)(l * 2 + v) * 6144 + j0 + col] = s + p.in[I_BMOD][(size_t)l * 6144 + j0 + col]; }
            __syncthreads();
        }
    }
    const long gt = (long)bid * NTHREADS + tid, gn = (long)G * NTHREADS;
    for (long it = gt; it < 256 * 16; it += gn) { const int r = (int)(it >> 4), s0 = (int)(it & 15) * 8, k1 = r >> 1, ri = r & 1;
        float v[8];
#pragma unroll
        for (int j = 0; j < 8; ++j) { const int ph = (k1 * (s0 + j)) & 127; const float x = (float)ph * (1.0f / 128.0f); v[j] = (ri ? -__builtin_amdgcn_sinf(x) : __builtin_amdgcn_cosf(x)) * 0.08838834764831845f; }
        u32x4 w; w.x = cvtpk(v[0], v[1]); w.y = cvtpk(v[2], v[3]); w.z = cvtpk(v[4], v[5]); w.w = cvtpk(v[6], v[7]);
        *(u32x4*)((bf16_t*)(ws + WS_T1) + (size_t)r * 128 + s0) = w; }
    for (long it = gt; it < 256 * 32; it += gn) { const int rr = (int)(it >> 5), c0 = (int)(it & 31) * 8, kb = rr >> 7, pq = (rr >> 6) & 1, k2 = rr & 63;
        float v[8];
#pragma unroll
        for (int j = 0; j < 8; ++j) { const int cc = c0 + j, kbc = cc >> 7, s2 = (cc >> 1) & 63, ri = cc & 1; const int ph = (k2 * s2) & 63; const float x = (float)ph * (1.0f / 64.0f);
            const float cs = __builtin_amdgcn_cosf(x), sn = __builtin_amdgcn_sinf(x);
            const float val = pq == 0 ? (ri == 0 ? cs : sn) : (ri == 0 ? sn : -cs);
            v[j] = (kb == kbc) ? val * 0.125f : 0.f; }
        u32x4 w; w.x = cvtpk(v[0], v[1]); w.y = cvtpk(v[2], v[3]); w.z = cvtpk(v[4], v[5]); w.w = cvtpk(v[6], v[7]);
        *(u32x4*)((bf16_t*)(ws + WS_A2) + (size_t)rr * 256 + c0) = w; }
    for (long it = gt; it < 2 * 512 * 32; it += gn) { const int which = (int)(it >> 14), rr = (int)(it & 16383), r = rr >> 5, s0 = (rr & 31) * 8, k = r & 255; const bool isin = r >= 256;
        bf16_t* A = (bf16_t*)(ws + (which ? WS_TCH : WS_ACTX)); const float sgn = (which && isin) ? -0.0625f : 0.0625f;
        float v[8];
#pragma unroll
        for (int j = 0; j < 8; ++j) { const int ph = (k * (s0 + j)) & 255; const float x = (float)ph * (1.0f / 256.0f); v[j] = (isin ? __builtin_amdgcn_sinf(x) : __builtin_amdgcn_cosf(x)) * sgn; }
        u32x4 w; w.x = cvtpk(v[0], v[1]); w.y = cvtpk(v[2], v[3]); w.z = cvtpk(v[4], v[5]); w.w = cvtpk(v[6], v[7]);
        *(u32x4*)(A + (size_t)r * 256 + s0) = w; }
    for (long it = gt; it < 128 * 32; it += gn) { const int pos = (int)(it >> 5), i = (int)(it & 31);
        const float freq = exp2f(-(float)i * (13.287712379549449f / 32.0f));
        const float ang = (float)pos * freq;
        double rev = (double)ang * 0.15915494309189535; rev -= floor(rev);
        const float xr = (float)rev;
        float2 cs; cs.x = __builtin_amdgcn_cosf(xr); cs.y = __builtin_amdgcn_sinf(xr);
        ((float2*)(ws + WS_ROPE))[it] = cs; }
    { f32x4* xs = (f32x4*)(ws + WS_XS); const f32x4* cx = (const f32x4*)p.in[I_CTX]; const f32x4* xx = (const f32x4*)p.in[I_X];
      const long nc = (long)CTX * DM / 4, nt = (long)ROWS * DM / 4;
      for (long it = gt; it < nt; it += gn) xs[it] = (it < nc) ? cx[it] : xx[it - nc]; }
}

__device__ __forceinline__ void rownorm_phase(const Params& p, int l) {
    int tid_ = threadIdx.x; asm volatile("" : "+v"(tid_));
    const int tid = tid_, lane = tid & 63, wid = tid >> 6;
    unsigned char* ws = p.ws;
    const int gw = blockIdx.x * 8 + wid, nw = gridDim.x * 8;
    const float* mod = (const float*)(ws + WS_MOD);
    for (int row = gw; row < ROWS; row += nw) {
        const int isctx = row < CTX ? 1 : 0;
        if (l == 4 && isctx) continue;
        float* xrow = (float*)(ws + WS_XS) + (size_t)row * DM;
        f32x4 xv[8];
#pragma unroll
        for (int i = 0; i < 8; ++i) xv[i] = *(const f32x4*)(xrow + lane * 4 + i * 256);
        if (l > 0) {
            const float* orow = (const float*)(ws + WS_OUTB) + (size_t)row * DM;
            f32x4 ov[8]; float ss = 0.f;
#pragma unroll
            for (int i = 0; i < 8; ++i) {
                if (isctx) { const float* pp = (const float*)(ws + WS_OUTP) + (size_t)row * DM + lane * 4 + i * 256;
                    ov[i] = (*(const f32x4*)pp + *(const f32x4*)(pp + (size_t)CTX * DM)) + (*(const f32x4*)(pp + (size_t)2 * CTX * DM) + *(const f32x4*)(pp + (size_t)3 * CTX * DM)); }
                else ov[i] = *(const f32x4*)(orow + lane * 4 + i * 256);
                ss += ov[i][0] * ov[i][0] + ov[i][1] * ov[i][1] + ov[i][2] * ov[i][2] + ov[i][3] * ov[i][3]; }
            ss = wave_sum(ss);
            const float rstd = rsqrtf(ss * (1.0f / DM) + EPS);
            const float* gate = mod + (size_t)((l - 1) * 2 + isctx) * 6144 + 4096;
            const float* gpost = p.in[I_GPOST] + (size_t)(l - 1) * DM;
#pragma unroll
            for (int i = 0; i < 8; ++i) { const f32x4 g = *(const f32x4*)(gate + lane * 4 + i * 256), gp = *(const f32x4*)(gpost + lane * 4 + i * 256);
                xv[i] = xv[i] + g * ((ov[i] * rstd) * gp); }
            if (l == 4) { float* orow2 = p.out + (size_t)(row - CTX) * DM;
#pragma unroll
                for (int i = 0; i < 8; ++i) *(f32x4*)(orow2 + lane * 4 + i * 256) = xv[i];
                continue; }
#pragma unroll
            for (int i = 0; i < 8; ++i) *(f32x4*)(xrow + lane * 4 + i * 256) = xv[i];
        }
        float ss = 0.f;
#pragma unroll
        for (int i = 0; i < 8; ++i) ss += xv[i][0] * xv[i][0] + xv[i][1] * xv[i][1] + xv[i][2] * xv[i][2] + xv[i][3] * xv[i][3];
        ss = wave_sum(ss);
        const float rstd = rsqrtf(ss * (1.0f / DM) + EPS);
        const float* ml = mod + (size_t)(l * 2 + isctx) * 6144;
        const float* gpre = p.in[I_GPRE] + (size_t)l * DM;
        bf16_t* hrow = (bf16_t*)(ws + WS_H) + (size_t)row * DM;
#pragma unroll
        for (int i = 0; i < 8; ++i) { const int c = lane * 4 + i * 256;
            const f32x4 sh = *(const f32x4*)(ml + c), scl = *(const f32x4*)(ml + 2048 + c), gp = *(const f32x4*)(gpre + c);
            const f32x4 hv = ((xv[i] * rstd) * gp) * (1.0f + scl) + sh;
            u32x2 w; w.x = cvtpk(hv[0], hv[1]); w.y = cvtpk(hv[2], hv[3]);
            *(u32x2*)(hrow + c) = w; }
    }
}

__device__ __forceinline__ void ew_phase(const Params& p, int l) {
    int tid_ = threadIdx.x; asm volatile("" : "+v"(tid_));
    const int tid = tid_;
    unsigned char* ws = p.ws;
    bf16_t* P = (bf16_t*)(ws + WS_P);
    {
        const int t = tid & 15; const long grp = ((long)blockIdx.x * NTHREADS + tid) >> 4, ngrp = (long)gridDim.x * NTHREADS / 16;
        const float2* rope = (const float2*)(ws + WS_ROPE);
        const int base = ((t & 8) ? 64 : 0) + 4 * (t & 7), fi = 4 * (t & 7);
        bf16_t* KC = (bf16_t*)(ws + WS_KC);
#pragma unroll 2
        for (long it = grp; it < (long)ROWS * 20; it += ngrp) { const int row = (int)(it / 20), head = (int)(it % 20);
            const bf16_t* src_ = P + (size_t)row * INC + (head < 16 ? OQ + head * 128 : OKK + (head - 16) * 128) + base;
            bf16_t* dst_ = (head < 16) ? (P + (size_t)row * INC + OQ + head * 128 + base) : (KC + ((size_t)(head - 16) * ROWS + row) * 128 + base);
            const float* gn = (head < 16 ? p.in[I_QN] : p.in[I_KN]) + (size_t)l * 128 + base;
            const u32x2 wa = *(const u32x2*)src_, wb = *(const u32x2*)(src_ + 32);
            const f32x4 ga = *(const f32x4*)gn, gb = *(const f32x4*)(gn + 32);
            float a[4] = {bflo(wa.x), bfhi(wa.x), bflo(wa.y), bfhi(wa.y)}, b[4] = {bflo(wb.x), bfhi(wb.x), bflo(wb.y), bfhi(wb.y)};
            float ss = 0.f;
#pragma unroll
            for (int q = 0; q < 4; ++q) ss += a[q] * a[q] + b[q] * b[q];
#pragma unroll
            for (int o = 8; o >= 1; o >>= 1) ss += __shfl_xor(ss, o);
            const float rstd = rsqrtf(ss * (1.0f / 128.0f) + EPS);
#pragma unroll
            for (int q = 0; q < 4; ++q) { a[q] = a[q] * rstd * ga[q]; b[q] = b[q] * rstd * gb[q]; }
            if (row >= CTX) { const int tk = row - CTX, pos = (t & 8) ? (tk & 63) : (tk >> 6);
                const f32x4 r01 = *(const f32x4*)(rope + pos * 32 + fi), r23 = *(const f32x4*)(rope + pos * 32 + fi + 2);
                const float cs[4] = {r01[0], r01[2], r23[0], r23[2]}, sn[4] = {r01[1], r01[3], r23[1], r23[3]};
#pragma unroll
                for (int q = 0; q < 4; ++q) { const float x0 = a[q], x1 = b[q]; a[q] = x0 * cs[q] - x1 * sn[q]; b[q] = x0 * sn[q] + x1 * cs[q]; } }
            u32x2 oa, ob; oa.x = cvtpk(a[0], a[1]); oa.y = cvtpk(a[2], a[3]); ob.x = cvtpk(b[0], b[1]); ob.y = cvtpk(b[2], b[3]);
            *(u32x2*)dst_ = oa; *(u32x2*)(dst_ + 32) = ob;
        }
    }
    {
        const long gt = (long)blockIdx.x * NTHREADS + tid, gn = (long)gridDim.x * NTHREADS;
        bf16_t* VC = (bf16_t*)(ws + WS_VC);
        for (long it = gt; it < (long)ROWS * 64; it += gn) { const int row = (int)(it >> 6), c = (int)(it & 63) * 8;
            const u32x4 v = *(const u32x4*)(P + (size_t)row * INC + OV + c);
            *(u32x4*)(VC + ((size_t)(c >> 7) * ROWS + row) * 128 + (c & 127)) = v; }
    }
    {
        const long gt = (long)blockIdx.x * NTHREADS + tid, gn = (long)gridDim.x * NTHREADS;
        bf16_t* Acat = (bf16_t*)(ws + WS_ACAT);
        const float* cw = p.in[I_CW] + (size_t)l * 3 * 1024; const float* cbias = p.in[I_CB] + (size_t)l * 1024;
        for (long it = gt; it < (long)(ROWS / 4) * 128; it += gn) { const int row0 = (int)(it >> 7) * 4, c0 = (int)(it & 127) * 8;
            const bf16_t* pr = P + (size_t)row0 * INC;
            const bool hp = (row0 != 0) && (row0 != CTX), hn = (row0 + 4 != CTX) && (row0 + 4 != ROWS);
            const u32x4 z = {0u, 0u, 0u, 0u};
            u32x4 xv[6], kv[6], bb[4], gg[4];
            xv[0] = hp ? *(const u32x4*)(pr - INC + OCX + c0) : z; kv[0] = hp ? *(const u32x4*)(pr - INC + OCC + c0) : z;
#pragma unroll
            for (int r = 0; r < 4; ++r) { xv[r + 1] = *(const u32x4*)(pr + (size_t)r * INC + OCX + c0); kv[r + 1] = *(const u32x4*)(pr + (size_t)r * INC + OCC + c0);
                bb[r] = *(const u32x4*)(pr + (size_t)r * INC + OCB + c0); gg[r] = *(const u32x4*)(pr + (size_t)r * INC + OCG + c0); }
            xv[5] = hn ? *(const u32x4*)(pr + (size_t)4 * INC + OCX + c0) : z; kv[5] = hn ? *(const u32x4*)(pr + (size_t)4 * INC + OCC + c0) : z;
            float w0[8], w1[8], w2[8], bs[8];
#pragma unroll
            for (int j = 0; j < 8; ++j) { w0[j] = cw[c0 + j]; w1[j] = cw[1024 + c0 + j]; w2[j] = cw[2048 + c0 + j]; bs[j] = cbias[c0 + j]; }
            float uu[6][8];
#pragma unroll
            for (int r = 0; r < 6; ++r)
#pragma unroll
                for (int q = 0; q < 4; ++q) { uu[r][2 * q] = bflo(xv[r][q]) * bflo(kv[r][q]); uu[r][2 * q + 1] = bfhi(xv[r][q]) * bfhi(kv[r][q]); }
#pragma unroll
            for (int r = 0; r < 4; ++r) { float res[8];
#pragma unroll
                for (int q = 0; q < 4; ++q) {
                    { const int j = 2 * q; const float cv = uu[r][j] * w0[j] + uu[r + 1][j] * w1[j] + uu[r + 2][j] * w2[j] + bs[j]; res[j] = bflo(bb[r][q]) * cv * siluf_(bflo(gg[r][q])); }
                    { const int j = 2 * q + 1; const float cv = uu[r][j] * w0[j] + uu[r + 1][j] * w1[j] + uu[r + 2][j] * w2[j] + bs[j]; res[j] = bfhi(bb[r][q]) * cv * siluf_(bfhi(gg[r][q])); } }
                u32x4 w; w.x = cvtpk(res[0], res[1]); w.y = cvtpk(res[2], res[3]); w.z = cvtpk(res[4], res[5]); w.w = cvtpk(res[6], res[7]);
                *(u32x4*)(Acat + 2 * APL + (size_t)(row0 + r) * CLD + c0) = w; }
        }
    }
}

constexpr int BM = 256, BK = 64, HALF = 128, HTB = HALF * BK * 2;
constexpr int BJC = 32;
__device__ __forceinline__ int lds_byte(int r, int c) { const int st = (r >> 4) * 2 + (c >> 5), rr = r & 15, cc = c & 31, ob = rr * 64 + cc * 2; return st * 1024 + (ob ^ (((ob >> 9) & 1) << 5)); }
__device__ __forceinline__ void stage_rc(int b, int& R, int& C) { const int st = b / 1024, sb = b % 1024, swz = sb ^ (((sb >> 9) & 1) << 5); R = (st >> 1) * 16 + swz / 64; C = (st & 1) * 32 + (swz % 64) / 2; }
__device__ __forceinline__ int perm32(int rho) { const int n = rho >> 4, i = rho & 15; return 8 * (i >> 2) + 4 * n + (i & 3); }

enum { G_FOLD = 0, G_IN, G_XT, G_F1, G_F2, G_DFTC, G_MIX, G_MERGE, G_OUT, G_MERGEC };
enum { M_BF16 = 0, M_MIX, M_MERGE0, M_MERGE1, M_MERGE2, M_F32, M_F1, M_F2, M_MG0, M_MG1, M_MG2 };
struct Unit { const char* a; const char* b; char* o; const char* aux; char* m; int nt, mode, ldo; };

__device__ __forceinline__ void static_order(int w, int nM, int nN, int& pm, int& pn) {
    const int nwg = nM * nN, q = nwg / 8, r = nwg % 8, xcd = w % 8, off = w / 8;
    const int wg = (xcd < r ? xcd * (q + 1) : r * (q + 1) + (xcd - r) * q) + off;
    const int nig = 8 * nN, gid = wg / nig, fm = gid * 8, gsz = (nM - fm) < 8 ? (nM - fm) : 8;
    pm = fm + ((wg % nig) % gsz); pn = (wg % nig) / gsz;
}

__device__ __forceinline__ bool get_unit(int gid, int l, int i, unsigned char* ws, Unit& u) {
    const int G = gridDim.x, c = blockIdx.x;
    u.aux = nullptr; u.m = nullptr;
    switch (gid) {
    case G_FOLD: { const int L = i * G + c; if (L >= 128) return false;
        const int ll = L >> 5, g = (L >> 3) & 3, pm = (L >> 1) & 3, pnn = L & 1;
        u.a = (const char*)(ws + WS_WMIXR + ll * SZ_WMIXR) + ((size_t)pm * 256 * 1024 + g * 256) * 2;
        u.b = (const char*)(ws + WS_TCH) + (size_t)pnn * 256 * 256 * 2;
        u.o = (char*)(ws + WS_WMIX + ll * SZ_WMIX) + ((size_t)pm * 256 * 2048 + pnn * 1024 + g * 256) * 2;
        u.nt = 4; u.mode = M_BF16; u.ldo = 2048; return true; }
    case G_IN: { const int L = i * G + c; if (L >= 2116) return false;
        if (L < 2112) { int pm, pn; static_order(L, 33, 64, pm, pn); const int pnp = pn < 20 ? pn : pn + 4;
            u.a = (const char*)(ws + WS_H) + (size_t)pm * 256 * DM * 2;
            u.b = (const char*)(ws + WS_WINT + l * SZ_WINT) + (size_t)pnp * 256 * DM * 2;
            u.o = (char*)(ws + WS_P) + ((size_t)pm * 256 * INC + pnp * 256) * 2; u.ldo = INC; }
        else { const int pm = L - 2112;
            u.a = (const char*)(ws + WS_WINT + l * SZ_WINT) + (size_t)(OFX + pm * 256) * DM * 2;
            u.b = (const char*)(ws + WS_H);
            u.o = (char*)(ws + WS_XT) + (size_t)pm * 256 * ROWS * 2; u.ldo = ROWS; }
        u.nt = 32; u.mode = M_BF16; return true; }
    case G_XT: { const int L = i * G + ((c + G - 68) % G); if (L >= 128) return false; const int pm = L & 3, pn = 1 + (L >> 2);
        u.a = (const char*)(ws + WS_WINT + l * SZ_WINT) + (size_t)(OFX + pm * 256) * DM * 2;
        u.b = (const char*)(ws + WS_H) + (size_t)(CTX + 2 * (pn - 1)) * DM * 2;
        u.o = (char*)(ws + WS_XT) + ((size_t)pm * 256 * ROWS + pn * 256) * 2; u.ldo = ROWS;
        u.nt = 32; u.mode = M_BF16; return true; }
    case G_F1: { const int L = i * G + c; if (L >= 256) return false; const int s2 = L >> 2, ct = L & 3;
        u.a = (const char*)(ws + WS_XT) + ((size_t)ct * 256 * ROWS + CTX + s2 * 128) * 2;
        u.b = (const char*)(ws + WS_T1);
        u.o = (char*)(ws + WS_ZT) + (size_t)ct * 256 * ZCH + s2 * 4;
        u.nt = 2; u.mode = M_F1; u.ldo = s2; return true; }
    case G_F2: { if (c < 16 || c >= G - 132) return false; const int L = i * (G - 148) + (c - 16); if (L >= 256) return false; const int k1p = L >> 2, ct = L & 3;
        u.a = (const char*)(ws + WS_A2);
        u.b = (const char*)(ws + WS_ZT) + (size_t)ct * 256 * ZCH + k1p * 512;
        u.o = (char*)(ws + WS_PQ) + ((size_t)(CTX + 2 * k1p) * 2048 + ct * 256) * 2;
        u.nt = 4; u.mode = M_F2; u.ldo = 2048; return true; }
    case G_DFTC: { const int L = i * G + c; if (L >= 8) return false; const int pm = L >> 2, pn = L & 3;
        u.a = (const char*)(ws + WS_ACTX) + (size_t)pm * 256 * 256 * 2;
        u.b = (const char*)(ws + WS_XT) + (size_t)pn * 256 * ROWS * 2;
        u.o = (char*)(ws + WS_PQ) + ((size_t)pm * 1024 + pn * 256) * 2;
        u.nt = 4; u.mode = M_BF16; u.ldo = 2048; return true; }
    case G_MIX: { const int L = i * G + (G - 1 - c); if (L >= 132) return false; const int pm = L >> 2, pn = L & 3;
        u.a = (const char*)(ws + WS_PQ) + (size_t)pm * 256 * 2048 * 2;
        u.b = (const char*)(ws + WS_WMIX + l * SZ_WMIX) + (size_t)pn * 256 * 2048 * 2;
        u.aux = (const char*)(ws + WS_P) + ((size_t)pm * 256 * INC + OFG + pn * 256) * 2;
        u.o = (char*)(ws + WS_ACAT) + (APL + (size_t)pm * 256 * CLD + pn * 256) * 2;
        u.nt = 32; u.mode = M_MIX; u.ldo = CLD; return true; }
    case G_MERGE: {
        if (i < 3) { const int T = c, sub = i; if (T >= 256) return false;
            int pm, pn; static_order(T, 32, 8, pm, pn); pm += 1;
            u.a = (const char*)(ws + WS_ACAT) + ((size_t)sub * APL + (size_t)pm * 256 * CLD) * 2;
            u.b = (const char*)(ws + WS_WCAT + l * SZ_WCAT) + ((size_t)sub * WPL + (size_t)pn * 256 * CLD) * 2;
            u.aux = (const char*)(ws + WS_P) + ((size_t)pm * 256 * INC + OML + sub * 2048 + pn * 256) * 2;
            u.m = (char*)(ws + WS_MBUF) + ((size_t)pm * 256 * MLD + pn * 256) * 4;
            u.o = (char*)(ws + WS_MB) + ((size_t)pm * 256 * 2048 + pn * 256) * 2;
            u.nt = sub == 0 ? 32 : 16; u.mode = M_MG0 + sub; u.ldo = 2048; return true; }
        return false; }
    case G_MERGEC: {
        if (i == 0 && l < DEPTH - 1 && c >= G - 64) { const int pc = c - (G - 64), pn = pc >> 3, q = pc & 7;
            const int sub = q < 4 ? 0 : (q < 6 ? 1 : 2), kcol = q < 4 ? q * 512 : (q < 6 ? (q - 4) * 512 : (q - 6) * 512);
            u.a = (const char*)(ws + WS_ACAT) + ((size_t)sub * APL + kcol) * 2;
            u.b = (const char*)(ws + WS_WCAT + l * SZ_WCAT) + ((size_t)sub * WPL + (size_t)pn * 256 * CLD + kcol) * 2;
            u.aux = (const char*)(ws + WS_P) + ((size_t)OML + sub * 2048 + pn * 256) * 2;
            u.m = (char*)(ws + WS_MP) + ((size_t)q * CTX * MLD + pn * 256) * 4;
            u.o = nullptr; u.nt = 8; u.mode = M_MERGE0; u.ldo = 2048; return true; }
        return false; }
    case G_OUT: {
        const int piece = l >> 4; l &= 15;
        if (i != 0) return false;
        if (!piece) { if (c >= 256) return false; int pm, pn; static_order(c, 32, 8, pm, pn); pm += 1;
            u.a = (const char*)(ws + WS_MB) + (size_t)pm * 256 * 2048 * 2;
            u.b = (const char*)(ws + WS_WOUT + l * SZ_WOUT) + (size_t)pn * 256 * 2048 * 2;
            u.o = (char*)(ws + WS_OUTB) + ((size_t)pm * 256 * 2048 + pn * 256) * 4;
            u.nt = 32; u.mode = M_F32; u.ldo = 2048; return true; }
        if (l < DEPTH - 1 && c >= G - 32) { const int pc = c - (G - 32), pn = pc >> 2, kp = pc & 3;
            u.a = (const char*)(ws + WS_MB) + (size_t)kp * 512 * 2;
            u.b = (const char*)(ws + WS_WOUT + l * SZ_WOUT) + ((size_t)pn * 256 * 2048 + kp * 512) * 2;
            u.o = (char*)(ws + WS_OUTP) + ((size_t)kp * CTX * 2048 + pn * 256) * 4;
            u.nt = 8; u.mode = M_F32; u.ldo = 2048; return true; }
        return false; }
    }
    return false;
}

__device__ __forceinline__ void epilogue(const f32x4 (&acc)[2][2][4][2], const Unit& u, int wr, int wc, int fr, int fq) {
    unsigned r0 = wr * 64 + fr, c0 = wc * 64 + 8 * fq;
    asm volatile("" : "+v"(r0), "+v"(c0));
    if (u.mode == M_BF16) {
        const unsigned base = (r0 * (unsigned)u.ldo + c0) * 2u;
#pragma unroll
        for (int ai = 0; ai < 2; ++ai)
#pragma unroll
            for (int m = 0; m < 4; ++m) { char* rowp = u.o + (size_t)(ai * HALF + m * 16) * u.ldo * 2;
#pragma unroll
                for (int bj = 0; bj < 2; ++bj) { const f32x4 v0 = acc[ai][bj][m][0], v1 = acc[ai][bj][m][1];
                    u32x4 w; w.x = cvtpk(v0[0], v0[1]); w.y = cvtpk(v0[2], v0[3]); w.z = cvtpk(v1[0], v1[1]); w.w = cvtpk(v1[2], v1[3]);
                    *(u32x4*)(rowp + base + bj * BJC * 2) = w; } }
    } else if (u.mode == M_MIX) {
        const unsigned base = (r0 * (unsigned)u.ldo + c0) * 2u, abase = (r0 * (unsigned)INC + c0) * 2u;
#pragma unroll
        for (int ai = 0; ai < 2; ++ai) {
            u32x4 g[4][2];
#pragma unroll
            for (int m = 0; m < 4; ++m)
#pragma unroll
                for (int bj = 0; bj < 2; ++bj) g[m][bj] = *(const u32x4*)(u.aux + (size_t)(ai * HALF + m * 16) * INC * 2 + abase + bj * BJC * 2);
            __builtin_amdgcn_sched_barrier(0);
#pragma unroll
            for (int m = 0; m < 4; ++m) { char* rowp = u.o + (size_t)(ai * HALF + m * 16) * u.ldo * 2;
#pragma unroll
                for (int bj = 0; bj < 2; ++bj) { const f32x4 v0 = acc[ai][bj][m][0], v1 = acc[ai][bj][m][1]; const u32x4 gg = g[m][bj];
                    u32x4 w; w.x = cvtpk(v0[0] * siluf_(bflo(gg.x)), v0[1] * siluf_(bfhi(gg.x))); w.y = cvtpk(v0[2] * siluf_(bflo(gg.y)), v0[3] * siluf_(bfhi(gg.y)));
                    w.z = cvtpk(v1[0] * siluf_(bflo(gg.z)), v1[1] * siluf_(bfhi(gg.z))); w.w = cvtpk(v1[2] * siluf_(bflo(gg.w)), v1[3] * siluf_(bfhi(gg.w)));
                    *(u32x4*)(rowp + base + bj * BJC * 2) = w; } }
            __builtin_amdgcn_sched_barrier(0);
        }
    } else if (u.mode == M_F32) {
        const unsigned base = (r0 * (unsigned)u.ldo + c0) * 4u;
#pragma unroll
        for (int ai = 0; ai < 2; ++ai)
#pragma unroll
            for (int m = 0; m < 4; ++m) { char* rowp = u.o + (size_t)(ai * HALF + m * 16) * u.ldo * 4;
#pragma unroll
                for (int bj = 0; bj < 2; ++bj) { *(f32x4*)(rowp + base + bj * BJC * 4) = acc[ai][bj][m][0]; *(f32x4*)(rowp + base + bj * BJC * 4 + 16) = acc[ai][bj][m][1]; } }
    } else if (u.mode == M_MG0 || u.mode == M_MG1) {
    } else if (u.mode == M_MG2) {
        const unsigned abase = (r0 * (unsigned)INC + c0) * 2u, obase = (r0 * 2048u + c0) * 2u;
#pragma unroll
        for (int ai = 0; ai < 2; ++ai) {
            u32x4 g[4][2];
#pragma unroll
            for (int m = 0; m < 4; ++m)
#pragma unroll
                for (int bj = 0; bj < 2; ++bj) g[m][bj] = *(const u32x4*)(u.aux + (size_t)(ai * HALF + m * 16) * INC * 2 + abase + bj * BJC * 2);
            __builtin_amdgcn_sched_barrier(0);
#pragma unroll
            for (int m = 0; m < 4; ++m) { char* rowp = u.o + (size_t)(ai * HALF + m * 16) * 2048 * 2;
#pragma unroll
                for (int bj = 0; bj < 2; ++bj) { f32x4 v0 = acc[ai][bj][m][0], v1 = acc[ai][bj][m][1]; const u32x4 gg = g[m][bj];
                    v0[0] *= sigmoidf_(bflo(gg.x)); v0[1] *= sigmoidf_(bfhi(gg.x)); v0[2] *= sigmoidf_(bflo(gg.y)); v0[3] *= sigmoidf_(bfhi(gg.y));
                    v1[0] *= sigmoidf_(bflo(gg.z)); v1[1] *= sigmoidf_(bfhi(gg.z)); v1[2] *= sigmoidf_(bflo(gg.w)); v1[3] *= sigmoidf_(bfhi(gg.w));
                    u32x4 w; w.x = cvtpk(v0[0], v0[1]); w.y = cvtpk(v0[2], v0[3]); w.z = cvtpk(v1[0], v1[1]); w.w = cvtpk(v1[2], v1[3]); *(u32x4*)(rowp + obase + bj * BJC * 2) = w; } }
            __builtin_amdgcn_sched_barrier(0);
        }
    } else if (u.mode == M_F1) {
        const int s2 = u.ldo;
        const unsigned kb0 = (c0 >> 1);
        float tc[2][4], ts[2][4];
#pragma unroll
        for (int bj = 0; bj < 2; ++bj)
#pragma unroll
            for (int j = 0; j < 4; ++j) { const float x = (float)((bj * 16 + kb0 + j) * s2) * (1.0f / 8192.0f); tc[bj][j] = __builtin_amdgcn_cosf(x); ts[bj][j] = __builtin_amdgcn_sinf(x); }
        const unsigned base = r0 * (unsigned)ZCH + kb0 * 256u;
#pragma unroll
        for (int ai = 0; ai < 2; ++ai)
#pragma unroll
            for (int m = 0; m < 4; ++m) { char* rowp = u.o + (size_t)(ai * HALF + m * 16) * ZCH;
#pragma unroll
                for (int bj = 0; bj < 2; ++bj) { const f32x4 v0 = acc[ai][bj][m][0], v1 = acc[ai][bj][m][1];
                    const float zr[4] = {v0[0], v0[2], v1[0], v1[2]}, zi[4] = {v0[1], v0[3], v1[1], v1[3]};
#pragma unroll
                    for (int j = 0; j < 4; ++j) { const float pr = zr[j] * tc[bj][j] + zi[j] * ts[bj][j], pi = zi[j] * tc[bj][j] - zr[j] * ts[bj][j];
                        *(unsigned*)(rowp + base + (bj * 16 + j) * 256) = cvtpk(pr, pi); } } }
    } else if (u.mode == M_F2) {
        const unsigned fr_ = r0 & 15u, wr_ = r0 >> 6;
        const unsigned base = ((128u * fr_) * 2048u + wr_ * 1024u + c0) * 2u;
#pragma unroll
        for (int ai = 0; ai < 2; ++ai)
#pragma unroll
            for (int m = 0; m < 4; ++m) { char* rowp = u.o + (size_t)(ai + 2048 * m) * 2048 * 2;
#pragma unroll
                for (int bj = 0; bj < 2; ++bj) { const f32x4 v0 = acc[ai][bj][m][0], v1 = acc[ai][bj][m][1];
                    u32x4 w; w.x = cvtpk(v0[0], v0[1]); w.y = cvtpk(v0[2], v0[3]); w.z = cvtpk(v1[0], v1[1]); w.w = cvtpk(v1[2], v1[3]);
                    *(u32x4*)(rowp + base + bj * BJC * 2) = w; } }
    } else {
        const unsigned abase = (r0 * (unsigned)INC + c0) * 2u, mbase = (r0 * (unsigned)MLD + c0) * 4u;
#pragma unroll
        for (int ai = 0; ai < 2; ++ai)
#pragma unroll
            for (int m = 0; m < 4; ++m) { const int rr = ai * HALF + m * 16; const char* ap = u.aux + (size_t)rr * INC * 2; char* mp = u.m + (size_t)rr * MLD * 4;
#pragma unroll
                for (int bj = 0; bj < 2; ++bj) { f32x4 v0 = acc[ai][bj][m][0], v1 = acc[ai][bj][m][1]; const u32x4 g = *(const u32x4*)(ap + abase + bj * BJC * 2);
                    v0[0] *= sigmoidf_(bflo(g.x)); v0[1] *= sigmoidf_(bfhi(g.x)); v0[2] *= sigmoidf_(bflo(g.y)); v0[3] *= sigmoidf_(bfhi(g.y));
                    v1[0] *= sigmoidf_(bflo(g.z)); v1[1] *= sigmoidf_(bfhi(g.z)); v1[2] *= sigmoidf_(bflo(g.w)); v1[3] *= sigmoidf_(bfhi(g.w));
                    *(f32x4*)(mp + mbase + bj * BJC * 4) = v0; *(f32x4*)(mp + mbase + bj * BJC * 4 + 16) = v1; }
                if (m & 1) __builtin_amdgcn_sched_barrier(0); }
    }
}

__device__ __forceinline__ void rescale_or_reset(f32x4 (&acc)[2][2][4][2], const Unit& u, int wr, int wc, int fr, int fq) {
    const unsigned msk = (u.mode == M_MG0 || u.mode == M_MG1) ? 0xffffffffu : 0u;
    unsigned r0 = wr * 64 + fr, c0 = wc * 64 + 8 * fq;
    asm volatile("" : "+v"(r0), "+v"(c0));
    const unsigned abase = (r0 * (unsigned)INC + c0) * 2u;
#pragma unroll
    for (int ai = 0; ai < 2; ++ai)
#pragma unroll
        for (int m = 0; m < 4; ++m) { const char* ap = u.aux + (size_t)(ai * HALF + m * 16) * INC * 2;
#pragma unroll
            for (int bj = 0; bj < 2; ++bj) {
                const u32x4 ga = *(const u32x4*)(ap + abase + bj * BJC * 2), gb = *(const u32x4*)(ap + abase + bj * BJC * 2 + 4096);
                const unsigned wa[4] = {ga.x, ga.y, ga.z, ga.w}, wb[4] = {gb.x, gb.y, gb.z, gb.w};
                float f[8];
#pragma unroll
                for (int e = 0; e < 4; ++e) {
                    const float rl = (1.0f + __expf(-bflo(wb[e]))) * __builtin_amdgcn_rcpf(1.0f + __expf(-bflo(wa[e])));
                    const float rh = (1.0f + __expf(-bfhi(wb[e]))) * __builtin_amdgcn_rcpf(1.0f + __expf(-bfhi(wa[e])));
                    f[2 * e] = __uint_as_float(__float_as_uint(rl) & msk); f[2 * e + 1] = __uint_as_float(__float_as_uint(rh) & msk); }
                acc[ai][bj][m][0] *= (f32x4){f[0], f[1], f[2], f[3]}; acc[ai][bj][m][1] *= (f32x4){f[4], f[5], f[6], f[7]};
            }
            if (m & 1) __builtin_amdgcn_sched_barrier(0);
        }
}

__device__ __forceinline__ void gemm_phase(LAS unsigned char* lds, int gid, int l, unsigned char* ws) {
    int tid_ = threadIdx.x; asm volatile("" : "+v"(tid_));
    const int tid = tid_, wid = __builtin_amdgcn_readfirstlane(tid >> 6), lane = tid & 63, wr = wid >> 2, wc = wid & 3, fr = lane & 15, fq = lane >> 4;
    int lda, ldb;
    int ldbv = 0;
    switch (gid) { case G_FOLD: lda = 1024; ldb = 256; break; case G_IN: lda = 2048; ldb = 2048; break; case G_XT: lda = 2048; ldb = 2048; ldbv = 64 * 2048; break;
                   case G_F1: lda = ROWS; ldb = 128; break; case G_F2: lda = 256; ldb = ZCH / 2; break;
                   case G_DFTC: lda = 256; ldb = ROWS; break; case G_MIX: lda = 2048; ldb = 2048; break; case G_MERGE: case G_MERGEC: lda = CLD; ldb = CLD; break; default: lda = 2048; ldb = 2048; break; }
    if (ldbv == 0) ldbv = ldb;
    Unit cur, nxt; int ui = 0;
    if (!get_unit(gid, l, 0, ws, cur)) return;
    unsigned voffA[2], voffB[2];
#pragma unroll
    for (int i = 0; i < 2; ++i) { int R, C; stage_rc(tid * 16 + i * 8192, R, C); const int w_ = R >> 5, ip = perm32(R & 31);
        const int Rb = (gid == G_XT) ? (4096 * (w_ & 1) + 64 * ip + (w_ >> 1)) : (64 * w_ + ip);
        voffA[i] = (unsigned)(R * lda + C) * 2u; voffB[i] = (unsigned)(Rb * ldb + C) * 2u; }
    const size_t kstep = (size_t)(BK * 2);
    const size_t hstepA = (size_t)HALF * lda * 2, hstepB = (gid == G_XT) ? (size_t)2048 * ldb * 2 : (size_t)32 * ldb * 2;
    const unsigned ldsw = (unsigned)wid * 1024u;
    const int aoff = lds_byte(wr * 64 + fr, fq * 8), boff = lds_byte(wc * 32 + fr, fq * 8);
#define PG8_SA(b, h) (((b) * 2 + (h)) * HTB)
#define PG8_SB(b, h) ((4 + (b) * 2 + (h)) * HTB)
#define PG8_STAGE(bufoff, gbase, voff) do { _Pragma("unroll") for (int _i = 0; _i < 2; ++_i) \
        __builtin_amdgcn_global_load_lds((const unsigned*)((const char*)(gbase) + (voff)[_i]), (LAS unsigned*)(lds + (bufoff) + ldsw + _i * 8192), 16, 0, 0); } while (0)
#define PG8_LDA(dst, b, h) do { _Pragma("unroll") for (int m = 0; m < 4; ++m) _Pragma("unroll") for (int k = 0; k < 2; ++k) dst[m][k] = *(const LAS bf16x8*)(lds + PG8_SA(b, h) + aoff + m * 2048 + k * 1024); } while (0)
#define PG8_LDB(dst, b, h) do { _Pragma("unroll") for (int n = 0; n < 2; ++n) _Pragma("unroll") for (int k = 0; k < 2; ++k) dst[n][k] = *(const LAS bf16x8*)(lds + PG8_SB(b, h) + boff + n * 2048 + k * 1024); } while (0)
#define PG8_MMA(ai, bj, At, Bt) do { __builtin_amdgcn_s_setprio(1); _Pragma("unroll") for (int m = 0; m < 4; ++m) _Pragma("unroll") for (int n = 0; n < 2; ++n) _Pragma("unroll") for (int k = 0; k < 2; ++k) \
        acc[ai][bj][m][n] = __builtin_amdgcn_mfma_f32_16x16x32_bf16(Bt[n][k], At[m][k], acc[ai][bj][m][n], 0, 0, 0); __builtin_amdgcn_s_setprio(0); } while (0)
#define PG8_WAIT_V(n) asm volatile("s_waitcnt vmcnt(" #n ")" ::: "memory")
#define PG8_WAIT_L(n) asm volatile("s_waitcnt lgkmcnt(" #n ")" ::: "memory")
#define PG8_BAR __builtin_amdgcn_s_barrier()
#define PG8_SCHED __builtin_amdgcn_sched_barrier(0)
    f32x4 acc[2][2][4][2];
#pragma unroll
    for (int a = 0; a < 2; ++a)
#pragma unroll
        for (int b = 0; b < 2; ++b)
#pragma unroll
            for (int m = 0; m < 4; ++m)
#pragma unroll
                for (int n = 0; n < 2; ++n) acc[a][b][m][n] = (f32x4){0.f, 0.f, 0.f, 0.f};
    bf16x8 At[4][2], B0[2][2], B1[2][2];
    const char* cA = cur.a; const char* cB = cur.b;
    PG8_STAGE(PG8_SB(0, 0), cB, voffB); PG8_STAGE(PG8_SA(0, 0), cA, voffA); PG8_STAGE(PG8_SB(0, 1), cB + hstepB, voffB); PG8_STAGE(PG8_SA(0, 1), cA + hstepA, voffA);
    if (wr == 1) PG8_BAR;
    PG8_WAIT_V(4); PG8_BAR;
    PG8_STAGE(PG8_SB(1, 0), cB + kstep, voffB); PG8_STAGE(PG8_SA(1, 0), cA + kstep, voffA); PG8_STAGE(PG8_SB(1, 1), cB + hstepB + kstep, voffB);
    PG8_WAIT_V(6); PG8_BAR;
    for (;;) {
        const bool has_next = get_unit(gid, l, ui + 1, ws, nxt);
        const char* nA = has_next ? nxt.a : cA; const char* nB = has_next ? nxt.b : cB;
        const int nt = cur.nt;
        for (int t = 0; t < nt; t += 2) {
            const bool last = (t == nt - 2);
            const char* a1 = cA + (size_t)(t + 1) * kstep;
            const char* a2 = last ? nA : cA + (size_t)(t + 2) * kstep; const char* b2 = last ? nB : cB + (size_t)(t + 2) * kstep;
            const char* a3 = a2 + kstep; const char* b3 = b2 + kstep;
            PG8_LDB(B0, 0, 0); PG8_SCHED; PG8_LDA(At, 0, 0); PG8_STAGE(PG8_SA(1, 1), a1 + hstepA, voffA);
            PG8_WAIT_L(8); PG8_BAR; PG8_WAIT_L(0); PG8_MMA(0, 0, At, B0); PG8_BAR; PG8_SCHED;
            PG8_LDB(B1, 0, 1); PG8_STAGE(PG8_SB(0, 0), b2, voffB);
            PG8_BAR; PG8_WAIT_L(0); PG8_MMA(0, 1, At, B1); PG8_BAR;
            PG8_LDA(At, 0, 1); PG8_STAGE(PG8_SA(0, 0), a2, voffA);
            PG8_BAR; PG8_WAIT_L(0); PG8_MMA(1, 0, At, B0); PG8_BAR; PG8_SCHED;
            PG8_STAGE(PG8_SB(0, 1), b2 + hstepB, voffB);
            PG8_WAIT_V(6); PG8_BAR; PG8_MMA(1, 1, At, B1); PG8_BAR;
            PG8_LDB(B0, 1, 0); PG8_SCHED; PG8_LDA(At, 1, 0); PG8_STAGE(PG8_SA(0, 1), a2 + hstepA, voffA);
            PG8_WAIT_L(8); PG8_BAR; PG8_WAIT_L(0); PG8_MMA(0, 0, At, B0); PG8_BAR; PG8_SCHED;
            PG8_LDB(B1, 1, 1); PG8_STAGE(PG8_SB(1, 0), b3, voffB);
            PG8_BAR; PG8_WAIT_L(0); PG8_MMA(0, 1, At, B1); PG8_BAR;
            PG8_LDA(At, 1, 1); PG8_STAGE(PG8_SA(1, 0), a3, voffA);
            PG8_BAR; PG8_WAIT_L(0); PG8_MMA(1, 0, At, B0); PG8_BAR; PG8_SCHED;
            PG8_STAGE(PG8_SB(1, 1), b3 + hstepB, voffB);
            PG8_WAIT_V(6); PG8_BAR; PG8_MMA(1, 1, At, B1); PG8_BAR;
        }
        epilogue(acc, cur, wr, wc, fr, fq);
        if (!has_next) break;
        if (gid == G_MERGE) rescale_or_reset(acc, cur, wr, wc, fr, fq);
        else {
#pragma unroll
            for (int a = 0; a < 2; ++a)
#pragma unroll
                for (int b = 0; b < 2; ++b)
#pragma unroll
                    for (int m = 0; m < 4; ++m)
#pragma unroll
                        for (int n = 0; n < 2; ++n) acc[a][b][m][n] = (f32x4){0.f, 0.f, 0.f, 0.f};
        }
        cur = nxt; cA = nA; cB = nB; ++ui;
    }
    PG8_WAIT_V(0);
    if (wr == 0) PG8_BAR;
    PG8_BAR;
#undef PG8_SA
#undef PG8_SB
#undef PG8_STAGE
#undef PG8_LDA
#undef PG8_LDB
#undef PG8_MMA
#undef PG8_WAIT_V
#undef PG8_WAIT_L
#undef PG8_BAR
#undef PG8_SCHED
}

namespace att {
constexpr int D = 128, NW = 8, QBLK = 32, KVBLK = 64;
constexpr float SCALE = 0.088388347648318440f;
constexpr float THR = 8.f;
constexpr int LDQ = INC, LDK = 128, LDO = CLD;
constexpr size_t SHM_V = KVBLK * D * 2, SHM_K = KVBLK * D * 2, SHM_ATTN = 2 * SHM_V + 2 * SHM_K + NW * 64 * 4;
#define KSWZ(row, colB) ((row) * 256 + ((colB) ^ (((row) & 7) << 4)))
#define SBAR() __builtin_amdgcn_sched_barrier(0)
__device__ __forceinline__ int crow(int r, int hi) { return (r & 3) + 8 * (r >> 2) + 4 * hi; }
__device__ __forceinline__ void partialSM(f32x16& p0, f32x16& p1, float& m_reg, float& mn, float& alpha) {
  constexpr float C = SCALE * 1.4426950408889634f;
  float pmax = p0[0];
#pragma unroll
  for (int r = 1; r < 16; ++r) pmax = fmaxf(pmax, p0[r]);
#pragma unroll
  for (int r = 0; r < 16; ++r) pmax = fmaxf(pmax, p1[r]);
  { auto rr = __builtin_amdgcn_permlane32_swap(__float_as_uint(pmax), __float_as_uint(pmax), false, false);
    pmax = fmaxf(__uint_as_float(rr[0]), __uint_as_float(rr[1])); }
  if (__builtin_expect(__all(pmax - m_reg <= THR / SCALE), 1)) { mn = m_reg; alpha = 1.f; }
  else { mn = fmaxf(m_reg, pmax); alpha = __builtin_amdgcn_exp2f((m_reg - mn) * C); m_reg = mn; }
  float mnC = -mn * C;
#pragma unroll
  for (int r = 0; r < 16; ++r) p0[r] = fmaf(p0[r], C, mnC);
#pragma unroll
  for (int r = 0; r < 16; ++r) p1[r] = fmaf(p1[r], C, mnC);
#pragma unroll
  for (int r = 0; r < 16; ++r) p0[r] = __builtin_amdgcn_exp2f(p0[r]);
}
__device__ __forceinline__ void finishSM(f32x16& p0, f32x16& p1, float alpha, float& l_reg, bf16x8& pa0, bf16x8& pa1, bf16x8& pa2, bf16x8& pa3) {
#pragma unroll
  for (int r = 0; r < 16; ++r) p1[r] = __builtin_amdgcn_exp2f(p1[r]);
  float ps = 0;
#pragma unroll
  for (int r = 0; r < 16; ++r) ps += p0[r];
#pragma unroll
  for (int r = 0; r < 16; ++r) ps += p1[r];
  { auto rr = __builtin_amdgcn_permlane32_swap(__float_as_uint(ps), __float_as_uint(ps), false, false);
    ps = __uint_as_float(rr[0]) + __uint_as_float(rr[1]); }
  l_reg = l_reg * alpha + ps;
#define PK4(P, BASE, OUT) do { unsigned a0 = cvtpk(P[BASE + 0], P[BASE + 1]), a1 = cvtpk(P[BASE + 2], P[BASE + 3]);   \
    unsigned b0 = cvtpk(P[BASE + 4], P[BASE + 5]), b1 = cvtpk(P[BASE + 6], P[BASE + 7]);                              \
    auto r0 = __builtin_amdgcn_permlane32_swap(a0, b0, false, false); auto r1 = __builtin_amdgcn_permlane32_swap(a1, b1, false, false); \
    u32x4 w = {r0[0], r1[0], r0[1], r1[1]}; OUT = *reinterpret_cast<bf16x8*>(&w); } while (0)
  PK4(p0, 0, pa0); PK4(p0, 8, pa1); PK4(p1, 0, pa2); PK4(p1, 8, pa3);
#undef PK4
}
__device__ __forceinline__ void qkt(f32x16& p0, f32x16& p1, const bf16_t* Ks, const bf16x8* qr, int r32, int hi) {
  p0 = f32x16{}; p1 = f32x16{};
#pragma unroll
  for (int d0 = 0; d0 < 8; ++d0) { int cb = (d0 * 16 + hi * 8) * 2;
    bf16x8 b0 = *reinterpret_cast<const bf16x8*>((const char*)Ks + KSWZ(r32, cb));
    bf16x8 b1 = *reinterpret_cast<const bf16x8*>((const char*)Ks + KSWZ(32 + r32, cb));
    p0 = __builtin_amdgcn_mfma_f32_32x32x16_bf16(b0, qr[d0], p0, 0, 0, 0);
    p1 = __builtin_amdgcn_mfma_f32_32x32x16_bf16(b1, qr[d0], p1, 0, 0, 0); }
}
__device__ __forceinline__ int v_st(int k, int c) { const int kk = (k & ~0xC) | ((k & 4) << 1) | ((k & 8) >> 1); return ((kk >> 3) * 4 + (c >> 5)) * 512 + ((kk & 7) * 32 + (c & 31)) * 2; }
__device__ __forceinline__ int v_rd_base(int lane) { return ((lane & 3) << 3) | (((lane >> 2) & 3) << 6) | (((lane >> 4) & 1) << 5) | (((lane >> 5) & 1) << 8); }
constexpr int v_rd_off(int d0, int ks, int half) { return d0 * 512 + ks * 4096 + half * 2048; }
template <int OFF> __device__ __forceinline__ s16x4 tr_read(int vb) {
  s16x4 r; asm volatile("ds_read_b64_tr_b16 %0, %1 offset:%2" : "=&v"(r) : "v"(vb), "i"(OFF) : "memory"); return r;
}
template <int D0> __device__ __forceinline__ void pv_one(f32x16& od, int vb, bf16x8 pa0, bf16x8 pa1, bf16x8 pa2, bf16x8 pa3) {
  const s16x4 l0 = tr_read<v_rd_off(D0, 0, 0)>(vb), h0 = tr_read<v_rd_off(D0, 0, 1)>(vb), l1 = tr_read<v_rd_off(D0, 1, 0)>(vb), h1 = tr_read<v_rd_off(D0, 1, 1)>(vb);
  const s16x4 l2 = tr_read<v_rd_off(D0, 2, 0)>(vb), h2 = tr_read<v_rd_off(D0, 2, 1)>(vb), l3 = tr_read<v_rd_off(D0, 3, 0)>(vb), h3 = tr_read<v_rd_off(D0, 3, 1)>(vb);
  asm volatile("s_waitcnt lgkmcnt(0)" ::: "memory"); SBAR();
#define PK(L, H) (bf16x8){L[0], L[1], L[2], L[3], H[0], H[1], H[2], H[3]}
  od = __builtin_amdgcn_mfma_f32_32x32x16_bf16(pa0, PK(l0, h0), od, 0, 0, 0);
  od = __builtin_amdgcn_mfma_f32_32x32x16_bf16(pa1, PK(l1, h1), od, 0, 0, 0);
  od = __builtin_amdgcn_mfma_f32_32x32x16_bf16(pa2, PK(l2, h2), od, 0, 0, 0);
  od = __builtin_amdgcn_mfma_f32_32x32x16_bf16(pa3, PK(l3, h3), od, 0, 0, 0);
#undef PK
}
__device__ __forceinline__ void pv_d0(f32x16* o, int vb, bf16x8 pa0, bf16x8 pa1, bf16x8 pa2, bf16x8 pa3) {
  pv_one<0>(o[0], vb, pa0, pa1, pa2, pa3); pv_one<1>(o[1], vb, pa0, pa1, pa2, pa3); pv_one<2>(o[2], vb, pa0, pa1, pa2, pa3); pv_one<3>(o[3], vb, pa0, pa1, pa2, pa3);
}
__device__ __forceinline__ void attn_body(const bf16_t* __restrict__ Qb, const bf16_t* __restrict__ Kh, const bf16_t* __restrict__ Vh,
                                          bf16_t* __restrict__ Ob, const bf16_t* __restrict__ AGb, int seq, char* lds) {
  int tid_ = threadIdx.x; asm volatile("" : "+v"(tid_));
  const int tid = tid_, wid = tid >> 6, lane = tid & 63, r32 = lane & 31, hi = lane >> 5;
  bf16_t* V_lds = (bf16_t*)lds; bf16_t* K_lds = (bf16_t*)(lds + 2 * SHM_V);
  float* wsl = (float*)(lds + 2 * SHM_V + 2 * SHM_K) + wid * 64; float* li_l = wsl; float* al_l = wsl + 32;
  float m_reg = -1e30f, l_reg = 0; f32x16 o[4] = {}; bf16x8 qr[8];
  const bf16_t* Qw = Qb + (long)(wid * QBLK + r32) * LDQ + hi * 8;
#pragma unroll
  for (int d0 = 0; d0 < 8; ++d0) qr[d0] = *reinterpret_cast<const bf16x8*>(Qw + d0 * 16);
  const int sr = tid >> 4, sc = (tid & 15) * 8, vst0 = v_st(sr, sc), vst1 = v_st(32 + sr, sc);
  const int vb0 = (int)(uintptr_t)V_lds + v_rd_base(lane);
  const unsigned goff0 = (unsigned)(sr * LDK + sc) * 2u, goff1 = (unsigned)((32 + sr) * LDK + sc) * 2u;
  struct { bf16x8 vs0, vs1, ks0, ks1; } sr_[2];
#define SLOAD(i, k0) do { const char* vt_ = (const char*)Vh + (size_t)(k0) * (LDK * 2); const char* kt_ = (const char*)Kh + (size_t)(k0) * (LDK * 2); \
    sr_[i].vs0 = *reinterpret_cast<const bf16x8*>(vt_ + goff0); sr_[i].vs1 = *reinterpret_cast<const bf16x8*>(vt_ + goff1); \
    sr_[i].ks0 = *reinterpret_cast<const bf16x8*>(kt_ + goff0); sr_[i].ks1 = *reinterpret_cast<const bf16x8*>(kt_ + goff1); } while (0)
#define SWRITE(b, i) do { *(bf16x8*)((char*)V_lds + (b) * SHM_V + vst0) = sr_[i].vs0;          \
    *(bf16x8*)((char*)V_lds + (b) * SHM_V + vst1) = sr_[i].vs1; int kc = sc * 2;               \
    *(bf16x8*)((char*)K_lds + (b) * SHM_K + KSWZ(sr, kc)) = sr_[i].ks0;                       \
    *(bf16x8*)((char*)K_lds + (b) * SHM_K + KSWZ(32 + sr, kc)) = sr_[i].ks1; } while (0)
#define SWAIT() asm volatile("s_waitcnt vmcnt(4)" ::: "memory")
#define RESC(a) do { if (__any((a) < 1.f)) { if (hi == 0) al_l[r32] = (a); asm volatile("s_waitcnt lgkmcnt(0)" ::: "memory"); \
    _Pragma("unroll") for (int d = 0; d < 4; ++d) _Pragma("unroll") for (int r = 0; r < 16; ++r) o[d][r] *= al_l[crow(r, hi)]; } } while (0)
  f32x16 pA0, pA1, pB0, pB1; float mnA, mnB, alA, alB; bf16x8 pa0, pa1, pa2, pa3; const int NT = seq / KVBLK;
  constexpr int SE = 0, SO = 1;
  SLOAD(SE, 0); asm volatile("s_waitcnt vmcnt(0)" ::: "memory"); SWRITE(0, SE); __syncthreads();
  qkt(pA0, pA1, K_lds, qr, r32, hi); partialSM(pA0, pA1, m_reg, mnA, alA);
  SLOAD(SO, KVBLK); if (2 < NT) SLOAD(SE, 2 * KVBLK);
  SWAIT(); SWRITE(1, SO); __syncthreads();
  for (int j = 1; j + 1 < NT; j += 2) {
    SBAR(); qkt(pB0, pB1, (bf16_t*)((char*)K_lds + SHM_K), qr, r32, hi);
    finishSM(pA0, pA1, alA, l_reg, pa0, pa1, pa2, pa3); SBAR();
    SLOAD(SO, (j + 2) * KVBLK); SBAR();
    pv_d0(o, vb0, pa0, pa1, pa2, pa3); partialSM(pB0, pB1, m_reg, mnB, alB);
    __syncthreads(); SWAIT(); SWRITE(0, SE);
    RESC(alB); __syncthreads();
    SBAR(); qkt(pA0, pA1, K_lds, qr, r32, hi);
    finishSM(pB0, pB1, alB, l_reg, pa0, pa1, pa2, pa3); SBAR();
    if (j + 3 < NT) SLOAD(SE, (j + 3) * KVBLK); SBAR();
    pv_d0(o, vb0 + (int)SHM_V, pa0, pa1, pa2, pa3); partialSM(pA0, pA1, m_reg, mnA, alA);
    __syncthreads(); SWAIT(); SWRITE(1, SO);
    RESC(alA); __syncthreads();
  }
  SBAR(); qkt(pB0, pB1, (bf16_t*)((char*)K_lds + SHM_K), qr, r32, hi);
  finishSM(pA0, pA1, alA, l_reg, pa0, pa1, pa2, pa3); SBAR();
  pv_d0(o, vb0, pa0, pa1, pa2, pa3); partialSM(pB0, pB1, m_reg, mnB, alB);
  __syncthreads(); RESC(alB);
  finishSM(pB0, pB1, alB, l_reg, pa0, pa1, pa2, pa3); SBAR();
  pv_d0(o, vb0 + (int)SHM_V, pa0, pa1, pa2, pa3);
  if (hi == 0) li_l[r32] = l_reg; asm volatile("s_waitcnt lgkmcnt(0)" ::: "memory");
  char* Ow = (char*)(Ob + (long)(wid * QBLK) * LDO); const char* Gw = (const char*)(AGb + (long)(wid * QBLK) * LDQ);
  unsigned hv = hi, cv = r32;
  asm volatile("" : "+v"(hv), "+v"(cv));
  const unsigned gbase = (hv * 4u * LDQ + cv) * 2u, obase = (hv * 4u * LDO + cv) * 2u;
#pragma unroll
  for (int r = 0; r < 16; ++r) { const int rc = (r & 3) + 8 * (r >> 2); const float rli = __builtin_amdgcn_rcpf(li_l[crow(r, hi)]);
    const unsigned go = gbase + (unsigned)(rc * LDQ * 2), oo = obase + (unsigned)(rc * LDO * 2);
    float g[4];
#pragma unroll
    for (int d0 = 0; d0 < 4; ++d0) g[d0] = bf2f(*(const bf16_t*)(Gw + go + d0 * 64));
#pragma unroll
    for (int d0 = 0; d0 < 4; ++d0) *(bf16_t*)(Ow + oo + d0 * 64) = f2bf(o[d0][r] * rli * siluf_(g[d0]));
    if ((r & 3) == 3) SBAR(); }
#undef SLOAD
#undef SWRITE
#undef SWAIT
#undef RESC
}
}

__device__ __forceinline__ void attn_phase(const Params& p, int l, char* lds) {
    unsigned char* ws = p.ws;
    const bf16_t* P = (const bf16_t*)(ws + WS_P); bf16_t* Acat = (bf16_t*)(ws + WS_ACAT);
    const int G = gridDim.x, nunits = 512 + (l < DEPTH - 1 ? 16 : 0);
    for (int U = blockIdx.x; U < nunits; U += G) {
        int h, qrow0, seq;
        if (U < 512) { int qb;
            if (G == 256) { const int xcd = U & 7, j = (U >> 3) & 31, r = U >> 8, kvh = xcd >> 1, idx = (xcd & 1) * 64 + r * 32 + j; h = kvh * 4 + (idx & 3); qb = idx >> 2; }
            else { h = U & 15; qb = U >> 4; }
            qrow0 = CTX + qb * 256; seq = ROWS; }
        else { h = U - 512; qrow0 = 0; seq = CTX; }
        const int kvh = h >> 2;
        att::attn_body(P + (size_t)qrow0 * INC + OQ + h * 128, (const bf16_t*)(ws + WS_KC) + (size_t)kvh * ROWS * 128, (const bf16_t*)(ws + WS_VC) + (size_t)kvh * ROWS * 128,
                       Acat + (size_t)qrow0 * CLD + h * 128, P + (size_t)qrow0 * INC + OAG + h * 128, seq, lds);
        __syncthreads();
    }
}

#define XB_TMO      128
#define XB_XCNT(j)  (256  + 64 * (j))
#define XB_XSUB(j)  (1280 + 64 * (j))
#define XB_XGEN(j)  (2304 + 64 * (j))
#define XB_TOP      3328
#define XB_TOPGEN   3392
#define XCD_BAR_WORDS 3456
#define XB_SPIN_CAP (1u << 18)

__device__ __forceinline__ unsigned xb_ld(unsigned* p)              { return __hip_atomic_load(p, __ATOMIC_RELAXED, __HIP_MEMORY_SCOPE_AGENT); }
__device__ __forceinline__ unsigned xb_add(unsigned* p, unsigned v) { return __hip_atomic_fetch_add(p, v, __ATOMIC_RELAXED, __HIP_MEMORY_SCOPE_AGENT); }
__device__ __forceinline__ unsigned xb_xcc_id() { return (unsigned)__builtin_amdgcn_s_getreg((3 << 11) | 20) & 0xFu; }
#define XB_SPIN(cond, bar) do { unsigned _sp = 0; while (cond) { __builtin_amdgcn_s_sleep(1); \
    if ((++_sp & 255u) == 0u) { if (xb_ld(&(bar)[XB_TMO])) break; if (_sp > XB_SPIN_CAP) { atomicAdd(&(bar)[XB_TMO], 1u); break; } } } } while (0)

struct XcdBarrier {
    unsigned* bar; unsigned x;
    volatile LAS unsigned* st;
};

__device__ __forceinline__ XcdBarrier xcd_barrier_post(unsigned* bar, volatile LAS unsigned* st) {
    XcdBarrier b; b.bar = bar; b.x = xb_xcc_id(); b.st = st;
    if (threadIdx.x == 0) (void)xb_add(&bar[XB_XCNT(b.x)], 1u);
    return b;
}
__device__ __forceinline__ void xcd_barrier_complete(unsigned* bar, unsigned x, unsigned& nloc, unsigned& nx) {
    const unsigned G = gridDim.x * gridDim.y * gridDim.z;
    unsigned sum, cnt, mine, sp = 0u;
    for (;;) {
        sum = 0u; cnt = 0u; mine = 0u;
#pragma unroll
        for (unsigned j = 0; j < 16; ++j) { const unsigned c = xb_ld(&bar[XB_XCNT(j)]); sum += c; cnt += (c > 0u) ? 1u : 0u; mine = (j == x) ? c : mine; }
        if (sum == G) break;
        __builtin_amdgcn_s_sleep(1);
        if ((++sp & 255u) == 0u) { if (xb_ld(&bar[XB_TMO])) break; if (sp > XB_SPIN_CAP) { atomicAdd(&bar[XB_TMO], 1u); break; } }
    }
    nloc = mine > 0u ? mine : 1u; nx = cnt > 0u ? cnt : 1u;
}

__device__ __forceinline__ void xcd_barrier(const XcdBarrier& b) {
    asm volatile("s_waitcnt vmcnt(0)" ::: "memory");
    __syncthreads();
    if (threadIdx.x == 0) {
        unsigned* bar = b.bar;
        __builtin_amdgcn_s_waitcnt(0);
        unsigned nloc = b.st[0], nx = b.st[1];
        if (nloc == 0u) { xcd_barrier_complete(bar, b.x, nloc, nx); b.st[0] = nloc; b.st[1] = nx; }
        const unsigned old = xb_add(&bar[XB_XSUB(b.x)], 1u);
        const unsigned gen = old / nloc;
        if (old + 1u == (gen + 1u) * nloc) {
            __builtin_amdgcn_fence(__ATOMIC_RELEASE, "agent");
            asm volatile("s_waitcnt vmcnt(0)" ::: "memory");
            const unsigned og = xb_add(&bar[XB_TOP], 1u);
            const unsigned tg = og / nx;
            if (og + 1u == (tg + 1u) * nx) xb_add(&bar[XB_TOPGEN], 1u);
            else XB_SPIN(xb_ld(&bar[XB_TOPGEN]) == tg, bar);
            __builtin_amdgcn_fence(__ATOMIC_ACQUIRE, "agent");
            xb_add(&bar[XB_XGEN(b.x)], 1u);
            asm volatile("s_waitcnt vmcnt(0)" ::: "memory");
        } else {
            XB_SPIN(xb_ld(&bar[XB_XGEN(b.x)]) == gen, bar);
            __builtin_amdgcn_fence(__ATOMIC_ACQUIRE, "agent");
            asm volatile("s_waitcnt vmcnt(0)" ::: "memory");
        }
    }
    __syncthreads();
}

__global__ void __launch_bounds__(NTHREADS, 2) mega_fwd(Params p0) {
    extern __shared__ __attribute__((aligned(16))) unsigned char lds[];
    cg::grid_group grid = cg::this_grid();
    volatile LAS unsigned* misc = (volatile LAS unsigned*)((LAS unsigned char*)lds + LDS_STAGE);
    if (threadIdx.x < 16) misc[threadIdx.x] = 0u;
    __syncthreads();
    (void)xcd_barrier_post((unsigned*)(p0.ws + WS_BAR), misc);
#ifndef PHASE_MASK
#define PHASE_MASK 0xFFFF
#endif
#define PH(b) if constexpr ((PHASE_MASK >> (b)) & 1)
#ifndef DBL_MASK
#define DBL_MASK 0
#endif
    PH(10) prep_phase(p0, lds);
    __syncthreads();
    if constexpr ((DBL_MASK >> 10) & 1) { prep_phase(p0, lds); __syncthreads(); }
    grid.sync();
#pragma unroll 1
    for (int l = 0; l < DEPTH; ++l) {
#pragma unroll 1
        for (int slot = 0; slot < 12; ++slot) {
            Params p = p0;
            { unsigned char* w = p.ws; asm volatile("" : "+s"(w)); p.ws = w; }
            bool sync = true;
            LAS unsigned char* L = (LAS unsigned char*)lds;
            const int reps = ((DBL_MASK >> slot) & 1) ? 2 : 1;
#pragma unroll 1
            for (int rep = 0; rep < reps; ++rep) {
            if (rep) __syncthreads();
            switch (slot) {
            case 0: rownorm_phase(p, l); sync = false; break;
            case 1: if (l == 0) gemm_phase(L, G_FOLD, l, p.ws); break;
            case 2: gemm_phase(L, G_IN, l, p.ws); sync = false; break;
            case 3: gemm_phase(L, G_XT, l, p.ws); break;
            case 4: gemm_phase(L, G_F1, l, p.ws); sync = false; break;
            case 5: gemm_phase(L, G_DFTC, l, p.ws); break;
            case 6: ew_phase(p, l); break;
            case 7: case 8: sync = false; break;
            case 9: {
                const int cb = (int)blockIdx.x, Gn = (int)gridDim.x;
                unsigned* c2 = (unsigned*)(p.ws + WS_BAR) + 3540;
                const unsigned target = (unsigned)(Gn - 148) * (unsigned)(l + 1);
                if (cb >= 16 && cb < Gn - 132) {
                    gemm_phase(L, G_F2, l, p.ws);
                    __syncthreads();
                    if (threadIdx.x == 0) { __builtin_amdgcn_fence(__ATOMIC_RELEASE, "agent"); asm volatile("s_waitcnt vmcnt(0)" ::: "memory");
                        __hip_atomic_fetch_add(c2, 1u, __ATOMIC_RELAXED, __HIP_MEMORY_SCOPE_AGENT); }
                    __syncthreads();
                }
                attn_phase(p, l, (char*)lds);
                __syncthreads();
                if (cb >= Gn - 132) {
                    if (threadIdx.x == 0) { unsigned sp = 0;
                        while (__hip_atomic_load(c2, __ATOMIC_RELAXED, __HIP_MEMORY_SCOPE_AGENT) < target) { __builtin_amdgcn_s_sleep(1); if (++sp > (1u << 22)) break; }
                        __builtin_amdgcn_fence(__ATOMIC_ACQUIRE, "agent"); asm volatile("s_waitcnt vmcnt(0)" ::: "memory"); }
                    __syncthreads();
                    gemm_phase(L, G_MIX, l, p.ws);
                }
                break; }
            case 10: gemm_phase(L, G_MERGE, l, p.ws); __syncthreads(); gemm_phase(L, G_MERGEC, l, p.ws); break;
            default: {
                const bool hasctx = l < DEPTH - 1;
                unsigned* ccnt = (unsigned*)(p.ws + WS_BAR) + 3500;
                if (hasctx) {
                    int t0_ = threadIdx.x; asm volatile("" : "+v"(t0_));
                    const int idx = (int)blockIdx.x * NTHREADS + t0_, r = idx >> 9, cc = (idx & 511) * 4;
                    const float* mp = (const float*)(p.ws + WS_MP); bf16_t* mb = (bf16_t*)(p.ws + WS_MB);
                    f32x4 s = *(const f32x4*)(mp + (size_t)r * MLD + cc);
#pragma unroll
                    for (int q = 1; q < 8; ++q) s += *(const f32x4*)(mp + ((size_t)q * CTX + r) * MLD + cc);
                    u32x2 w; w.x = cvtpk(s[0], s[1]); w.y = cvtpk(s[2], s[3]); *(u32x2*)(mb + (size_t)r * DM + cc) = w;
                    asm volatile("s_waitcnt vmcnt(0)" ::: "memory"); __syncthreads();
                    if (threadIdx.x == 0) { __builtin_amdgcn_fence(__ATOMIC_RELEASE, "agent"); asm volatile("s_waitcnt vmcnt(0)" ::: "memory");
                        __hip_atomic_fetch_add(ccnt, 1u, __ATOMIC_RELAXED, __HIP_MEMORY_SCOPE_AGENT); }
                }
                const int nv = (hasctx && (int)blockIdx.x >= (int)gridDim.x - 32) ? 2 : 1;
#pragma unroll 1
                for (int v = 0; v < nv; ++v) {
                    if (v) {
                        __syncthreads();
                        if (threadIdx.x == 0) { const unsigned target = (unsigned)(l + 1) * gridDim.x; unsigned sp = 0;
                            while (__hip_atomic_load(ccnt, __ATOMIC_RELAXED, __HIP_MEMORY_SCOPE_AGENT) < target) { __builtin_amdgcn_s_sleep(1); if (++sp > (1u << 22)) break; }
                            __builtin_amdgcn_fence(__ATOMIC_ACQUIRE, "agent"); asm volatile("s_waitcnt vmcnt(0)" ::: "memory"); }
                        __syncthreads();
                    }
                    gemm_phase(L, G_OUT, l | (v << 4), p.ws);
                }
                break; }
            }
            }
            __syncthreads();
            if (sync) { XcdBarrier xb; xb.bar = (unsigned*)(p.ws + WS_BAR); xb.x = xb_xcc_id(); xb.st = (volatile LAS unsigned*)((LAS unsigned char*)lds + LDS_STAGE); xcd_barrier(xb); }
        }
    }
    PH(0) rownorm_phase(p0, DEPTH);
}

extern "C" void kernel_launch(void* const* d_in, const int* in_sizes, int n_in, void* d_out, int out_size, void* d_ws, size_t ws_size, hipStream_t stream) {
    static int grid_blocks = 0;
    if (grid_blocks == 0) {
        if (n_in != 18 || out_size != SEQ * DM || ws_size < WS_END) { fprintf(stderr, "kernel_launch: unexpected shapes: n_in %d out %d ws %zu (need %zu)\n", n_in, out_size, ws_size, (size_t)WS_END); grid_blocks = -1; return; }
        int dev = 0, cus = 0, per_cu = 0;
        hipGetDevice(&dev);
        hipDeviceGetAttribute(&cus, hipDeviceAttributeMultiprocessorCount, dev);
        if (hipFuncSetAttribute((const void*)mega_fwd, hipFuncAttributeMaxDynamicSharedMemorySize, LDS_BYTES) != hipSuccess) { fprintf(stderr, "kernel_launch: hipFuncSetAttribute failed\n"); grid_blocks = -1; return; }
        if (hipOccupancyMaxActiveBlocksPerMultiprocessor(&per_cu, (const void*)mega_fwd, NTHREADS, LDS_BYTES) != hipSuccess || per_cu < 1) { fprintf(stderr, "kernel_launch: occupancy query gave %d\n", per_cu); per_cu = 1; }
        (void)hipGetLastError();
        grid_blocks = cus * (per_cu > 1 ? 1 : per_cu);
        if (grid_blocks > 256) grid_blocks = 256;
        grid_blocks &= ~7;
        if (grid_blocks != 256) { fprintf(stderr, "kernel_launch: this kernel is laid out for 256 resident workgroups, got %d\n", grid_blocks); grid_blocks = -1; return; }
    }
    if (grid_blocks <= 0) return;
    Params p{};
    for (int i = 0; i < 18; ++i) p.in[i] = (const float*)d_in[i];
    p.out = (float*)d_out; p.ws = (unsigned char*)d_ws;
    if (hipMemsetAsync((char*)d_ws + WS_BAR, 0, BAR_BYTES, stream) != hipSuccess) { fprintf(stderr, "kernel_launch: memset of barrier words failed\n"); return; }
    void* args[] = {&p};
    hipError_t e = hipLaunchCooperativeKernel((const void*)mega_fwd, dim3(grid_blocks), dim3(NTHREADS), args, LDS_BYTES, stream);
    if (e != hipSuccess) fprintf(stderr, "cooperative launch failed: %s (grid %d)\n", hipGetErrorString(e), grid_blocks);
}
```

```cpp
#include <hip/hip_runtime.h>
#include <hip/hip_cooperative_groups.h>
#include <cstdio>
#include <cstdint>
namespace cg = cooperative_groups;

#define LAS __attribute__((address_space(3)))
typedef unsigned short bf16_t;
typedef short bf16x8 __attribute__((ext_vector_type(8)));
typedef short s16x4 __attribute__((ext_vector_type(4)));
typedef float f32x4 __attribute__((ext_vector_type(4)));
typedef float f32x16 __attribute__((ext_vector_type(16)));
typedef unsigned u32x4 __attribute__((ext_vector_type(4)));
typedef unsigned u32x2 __attribute__((ext_vector_type(2)));

constexpr int DM = 2048, SEQ = 8192, CTX = 256, ROWS = SEQ + CTX, DEPTH = 4, INC = 17408;
constexpr int OQ = 0, OKK = 2048, OV = 2560, OAG = 3072, OFX = 5120, OFG = 6144, OCX = 7168, OCB = 8192, OCC = 9216, OCG = 10240, OML = 11264;
constexpr float EPS = 1e-6f;
constexpr size_t APL = (size_t)(SEQ + CTX) * 2048, WPL = (size_t)2048 * 2048;
constexpr int CLD = 2048;
constexpr int MLD = 2048 + 64;
constexpr int ZCH = 32768 + 256;
constexpr int LDS_STAGE = 131072, LDS_BYTES = LDS_STAGE + 64;
constexpr int NTHREADS = 512;

constexpr size_t SZ_WINT = (size_t)INC * DM * 2, SZ_WCAT = 3 * WPL * 2, SZ_WOUT = (size_t)DM * DM * 2, SZ_WMIXR = (size_t)1024 * 1024 * 2, SZ_WMIX = (size_t)1024 * 2048 * 2;
constexpr size_t WS_WINT = 0;
constexpr size_t WS_WCAT = WS_WINT + DEPTH * SZ_WINT;
constexpr size_t WS_WOUT = WS_WCAT + DEPTH * SZ_WCAT;
constexpr size_t WS_WMIXR = WS_WOUT + DEPTH * SZ_WOUT;
constexpr size_t WS_WMIX = WS_WMIXR + DEPTH * SZ_WMIXR;
constexpr size_t WS_TCH = WS_WMIX + DEPTH * SZ_WMIX;
constexpr size_t WS_ZT = WS_TCH + 512 * 256 * 2;
constexpr size_t WS_T1 = WS_ZT + (size_t)1024 * ZCH;
constexpr size_t WS_A2 = WS_T1 + 256 * 128 * 2;
constexpr size_t WS_ACTX = WS_A2 + 256 * 256 * 2;
constexpr size_t WS_ROPE = WS_ACTX + 512 * 256 * 2;
constexpr size_t WS_MOD = WS_ROPE + 128 * 32 * 8;
constexpr size_t WS_XS = WS_MOD + 4 * 2 * 6144 * 4;
constexpr size_t WS_H = WS_XS + (size_t)ROWS * DM * 4;
constexpr size_t WS_P = WS_H + (size_t)ROWS * DM * 2;
constexpr size_t WS_XT = WS_P + (size_t)ROWS * INC * 2;
constexpr size_t WS_PQ = WS_XT + (size_t)1024 * ROWS * 2;
constexpr size_t WS_ACAT = WS_PQ + (size_t)ROWS * DM * 2;
constexpr size_t WS_MBUF = WS_ACAT + 3 * APL * 2;
constexpr size_t WS_MB = WS_MBUF + (size_t)ROWS * MLD * 4;
constexpr size_t WS_OUTB = WS_MB + (size_t)ROWS * DM * 2;
constexpr size_t WS_KC = WS_OUTB + (size_t)ROWS * DM * 4;
constexpr size_t WS_VC = WS_KC + (size_t)4 * ROWS * 128 * 2;
constexpr size_t WS_MP = WS_VC + (size_t)4 * ROWS * 128 * 2;
constexpr size_t WS_OUTP = WS_MP + (size_t)8 * CTX * MLD * 4;
constexpr size_t WS_BAR = WS_OUTP + (size_t)4 * CTX * DM * 4;
constexpr size_t BAR_BYTES = 16384;
constexpr size_t WS_END = WS_BAR + BAR_BYTES;

struct Params { const float* in[18]; float* out; unsigned char* ws; };
enum { I_X = 0, I_C, I_CTX, I_CCTX, I_WMOD, I_BMOD, I_GPRE, I_GPOST, I_WIN, I_QN, I_KN, I_WAO, I_WFM, I_WFO, I_CW, I_CB, I_WCO, I_WOUT };

__device__ __forceinline__ unsigned cvtpk(float lo, float hi) { unsigned r; asm volatile("v_cvt_pk_bf16_f32 %0, %1, %2" : "=v"(r) : "v"(lo), "v"(hi)); return r; }
__device__ __forceinline__ float bf2f(unsigned short b) { return __uint_as_float(((unsigned)b) << 16); }
__device__ __forceinline__ float bflo(unsigned w) { return __uint_as_float(w << 16); }
__device__ __forceinline__ float bfhi(unsigned w) { return __uint_as_float(w & 0xffff0000u); }
__device__ __forceinline__ unsigned short f2bf(float f) { return (unsigned short)(cvtpk(f, f) & 0xffffu); }
__device__ __forceinline__ float sigmoidf_(float x) { return __builtin_amdgcn_rcpf(1.0f + __expf(-x)); }
__device__ __forceinline__ float siluf_(float x) { return x * sigmoidf_(x); }
__device__ __forceinline__ float wave_sum(float v) {
#pragma unroll
    for (int o = 32; o >= 1; o >>= 1) v += __shfl_xor(v, o);
    return v;
}

__device__ __forceinline__ void prep_phase(const Params& p, unsigned char* lds_g) {
    int tid_ = threadIdx.x; asm volatile("" : "+v"(tid_));
    const int tid = tid_, G = gridDim.x, bid = blockIdx.x;
    unsigned char* ws = p.ws;
    float* tile = (float*)lds_g;
    constexpr int T_IN = 32 * 272, T_AO = 32 * 32, T_FO = 16 * 32, T_CO = 16 * 32, T_OUT = 32 * 32, T_MIX = 16 * 16;
    constexpr int T_LAYER = T_IN + T_AO + T_FO + T_CO + T_OUT + T_MIX;
    for (int t = bid; t < DEPTH * T_LAYER; t += G) {
        const int l = t / T_LAYER; int r = t % T_LAYER;
        const float* src; int ldsrc; bf16_t* dst; int lddst; int ktiles;
        if (r < T_IN) { src = p.in[I_WIN] + (size_t)l * DM * INC; ldsrc = INC; dst = (bf16_t*)(ws + WS_WINT + l * SZ_WINT); lddst = DM; ktiles = 32; }
        else if ((r -= T_IN) < T_AO) { src = p.in[I_WAO] + (size_t)l * DM * DM; ldsrc = DM; dst = (bf16_t*)(ws + WS_WCAT + l * SZ_WCAT); lddst = CLD; ktiles = 32; }
        else if ((r -= T_AO) < T_FO) { src = p.in[I_WFO] + (size_t)l * 1024 * DM; ldsrc = DM; dst = (bf16_t*)(ws + WS_WCAT + l * SZ_WCAT) + WPL; lddst = CLD; ktiles = 16; }
        else if ((r -= T_FO) < T_CO) { src = p.in[I_WCO] + (size_t)l * 1024 * DM; ldsrc = DM; dst = (bf16_t*)(ws + WS_WCAT + l * SZ_WCAT) + 2 * WPL; lddst = CLD; ktiles = 16; }
        else if ((r -= T_CO) < T_OUT) { src = p.in[I_WOUT] + (size_t)l * DM * DM; ldsrc = DM; dst = (bf16_t*)(ws + WS_WOUT + l * SZ_WOUT); lddst = DM; ktiles = 32; }
        else { r -= T_OUT; src = p.in[I_WFM] + (size_t)l * 1024 * 1024; ldsrc = 1024; dst = (bf16_t*)(ws + WS_WMIXR + l * SZ_WMIXR); lddst = 1024; ktiles = 16; }
        const int k0 = (r % ktiles) * 64, n0 = (r / ktiles) * 64;
        { const int ty = tid >> 4, tx = tid & 15;
#pragma unroll
          for (int ps = 0; ps < 2; ++ps) { const int kk = ty + 32 * ps;
              const f32x4 v = *(const f32x4*)(src + (size_t)(k0 + kk) * ldsrc + n0 + tx * 4);
              tile[kk * 65 + tx * 4 + 0] = v[0]; tile[kk * 65 + tx * 4 + 1] = v[1]; tile[kk * 65 + tx * 4 + 2] = v[2]; tile[kk * 65 + tx * 4 + 3] = v[3]; } }
        __syncthreads();
        { const int n = tid >> 3, kc = (tid & 7) * 8; u32x4 w;
          w.x = cvtpk(tile[(kc + 0) * 65 + n], tile[(kc + 1) * 65 + n]); w.y = cvtpk(tile[(kc + 2) * 65 + n], tile[(kc + 3) * 65 + n]);
          w.z = cvtpk(tile[(kc + 4) * 65 + n], tile[(kc + 5) * 65 + n]); w.w = cvtpk(tile[(kc + 6) * 65 + n], tile[(kc + 7) * 65 + n]);
          *(u32x4*)(dst + (size_t)(n0 + n) * lddst + k0 + kc) = w; }
        __syncthreads();
    }
    {
        float* sc = (float*)lds_g;
        float* red = sc + 4096;
        for (int u = bid; u < 256; u += G) {
            for (int k = tid; k < 4096; k += NTHREADS) { const float cv = (k < 2048) ? p.in[I_C][k] : p.in[I_CCTX][k - 2048]; sc[k] = siluf_(cv); }
            __syncthreads();
            const int l = u >> 6, j0 = (u & 63) * 96;
            if (tid < 504) { const int kg = tid / 24, cq = tid % 24;
                f32x4 al = {0.f, 0.f, 0.f, 0.f}, ac = {0.f, 0.f, 0.f, 0.f};
                const float* wp = p.in[I_WMOD] + (size_t)l * DM * 6144 + j0 + cq * 4;
                for (int k = kg; k < 2048; k += 21) { const f32x4 w = *(const f32x4*)(wp + (size_t)k * 6144); al += sc[k] * w; ac += sc[2048 + k] * w; }
                float* rp = red + (kg * 24 + cq) * 8;
                rp[0] = al[0]; rp[1] = al[1]; rp[2] = al[2]; rp[3] = al[3]; rp[4] = ac[0]; rp[5] = ac[1]; rp[6] = ac[2]; rp[7] = ac[3]; }
            __syncthreads();
            if (tid < 192) { const int v = tid / 96, col = tid % 96, cq = col >> 2, e = col & 3; float s = 0.f;
                for (int kg = 0; kg < 21; ++kg) s += red[(kg * 24 + cq) * 8 + v * 4 + e];
                ((float*)(ws + WS_MOD))[(size_t)(l * 2 + v) * 6144 + j0 + col] = s + p.in[I_BMOD][(size_t)l * 6144 + j0 + col]; }
            __syncthreads();
        }
    }
    const long gt = (long)bid * NTHREADS + tid, gn = (long)G * NTHREADS;
    for (long it = gt; it < 256 * 16; it += gn) { const int r = (int)(it >> 4), s0 = (int)(it & 15) * 8, k1 = r >> 1, ri = r & 1;
        float v[8];
#pragma unroll
        for (int j = 0; j < 8; ++j) { const int ph = (k1 * (s0 + j)) & 127; const float x = (float)ph * (1.0f / 128.0f); v[j] = (ri ? -__builtin_amdgcn_sinf(x) : __builtin_amdgcn_cosf(x)) * 0.08838834764831845f; }
        u32x4 w; w.x = cvtpk(v[0], v[1]); w.y = cvtpk(v[2], v[3]); w.z = cvtpk(v[4], v[5]); w.w = cvtpk(v[6], v[7]);
        *(u32x4*)((bf16_t*)(ws + WS_T1) + (size_t)r * 128 + s0) = w; }
    for (long it = gt; it < 256 * 32; it += gn) { const int rr = (int)(it >> 5), c0 = (int)(it & 31) * 8, kb = rr >> 7, pq = (rr >> 6) & 1, k2 = rr & 63;
        float v[8];
#pragma unroll
        for (int j = 0; j < 8; ++j) { const int cc = c0 + j, s2 = cc >> 2, kbc = (cc >> 1) & 1, ri = cc & 1;     const int ph = (k2 * s2) & 63; const float x = (float)ph * (1.0f / 64.0f);
            const float cs = __builtin_amdgcn_cosf(x), sn = __builtin_amdgcn_sinf(x);
            const float val = pq == 0 ? (ri == 0 ? cs : sn) : (ri == 0 ? sn : -cs);
            v[j] = (kb == kbc) ? val * 0.125f : 0.f; }
        u32x4 w; w.x = cvtpk(v[0], v[1]); w.y = cvtpk(v[2], v[3]); w.z = cvtpk(v[4], v[5]); w.w = cvtpk(v[6], v[7]);
        *(u32x4*)((bf16_t*)(ws + WS_A2) + (size_t)rr * 256 + c0) = w; }
    for (long it = gt; it < 2 * 512 * 32; it += gn) { const int which = (int)(it >> 14), rr = (int)(it & 16383), r = rr >> 5, s0 = (rr & 31) * 8, k = r & 255; const bool isin = r >= 256;
        bf16_t* A = (bf16_t*)(ws + (which ? WS_TCH : WS_ACTX)); const float sgn = (which && isin) ? -0.0625f : 0.0625f;
        float v[8];
#pragma unroll
        for (int j = 0; j < 8; ++j) { const int ph = (k * (s0 + j)) & 255; const float x = (float)ph * (1.0f / 256.0f); v[j] = (isin ? __builtin_amdgcn_sinf(x) : __builtin_amdgcn_cosf(x)) * sgn; }
        u32x4 w; w.x = cvtpk(v[0], v[1]); w.y = cvtpk(v[2], v[3]); w.z = cvtpk(v[4], v[5]); w.w = cvtpk(v[6], v[7]);
        *(u32x4*)(A + (size_t)r * 256 + s0) = w; }
    for (long it = gt; it < 128 * 32; it += gn) { const int pos = (int)(it >> 5), i = (int)(it & 31);
        const float freq = exp2f(-(float)i * (13.287712379549449f / 32.0f));
        const float ang = (float)pos * freq;
        double rev = (double)ang * 0.15915494309189535; rev -= floor(rev);
        const float xr = (float)rev;
        float2 cs; cs.x = __builtin_amdgcn_cosf(xr); cs.y = __builtin_amdgcn_sinf(xr);
        ((float2*)(ws + WS_ROPE))[it] = cs; }
    { f32x4* xs = (f32x4*)(ws + WS_XS); const f32x4* cx = (const f32x4*)p.in[I_CTX]; const f32x4* xx = (const f32x4*)p.in[I_X];
      const long nc = (long)CTX * DM / 4, nt = (long)ROWS * DM / 4;
      for (long it = gt; it < nt; it += gn) xs[it] = (it < nc) ? cx[it] : xx[it - nc]; }
}

__device__ __forceinline__ void rownorm_phase(const Params& p, int l) {
    int tid_ = threadIdx.x; asm volatile("" : "+v"(tid_));
    const int tid = tid_, lane = tid & 63, wid = tid >> 6;
    unsigned char* ws = p.ws;
    const int gw = blockIdx.x * 8 + wid, nw = gridDim.x * 8;
    const float* mod = (const float*)(ws + WS_MOD);
    for (int row = gw; row < ROWS; row += nw) {
        const int isctx = row < CTX ? 1 : 0;
        if (l == 4 && isctx) continue;
        float* xrow = (float*)(ws + WS_XS) + (size_t)row * DM;
        f32x4 xv[8];
#pragma unroll
        for (int i = 0; i < 8; ++i) xv[i] = *(const f32x4*)(xrow + lane * 4 + i * 256);
        if (l > 0) {
            const float* orow = (const float*)(ws + WS_OUTB) + (size_t)row * DM;
            f32x4 ov[8]; float ss = 0.f;
#pragma unroll
            for (int i = 0; i < 8; ++i) {
                if (isctx) { const float* pp = (const float*)(ws + WS_OUTP) + (size_t)row * DM + lane * 4 + i * 256;
                    ov[i] = (*(const f32x4*)pp + *(const f32x4*)(pp + (size_t)CTX * DM)) + (*(const f32x4*)(pp + (size_t)2 * CTX * DM) + *(const f32x4*)(pp + (size_t)3 * CTX * DM)); }
                else ov[i] = *(const f32x4*)(orow + lane * 4 + i * 256);
                ss += ov[i][0] * ov[i][0] + ov[i][1] * ov[i][1] + ov[i][2] * ov[i][2] + ov[i][3] * ov[i][3]; }
            ss = wave_sum(ss);
            const float rstd = rsqrtf(ss * (1.0f / DM) + EPS);
            const float* gate = mod + (size_t)((l - 1) * 2 + isctx) * 6144 + 4096;
            const float* gpost = p.in[I_GPOST] + (size_t)(l - 1) * DM;
#pragma unroll
            for (int i = 0; i < 8; ++i) { const f32x4 g = *(const f32x4*)(gate + lane * 4 + i * 256), gp = *(const f32x4*)(gpost + lane * 4 + i * 256);
                xv[i] = xv[i] + g * ((ov[i] * rstd) * gp); }
            if (l == 4) { float* orow2 = p.out + (size_t)(row - CTX) * DM;
#pragma unroll
                for (int i = 0; i < 8; ++i) *(f32x4*)(orow2 + lane * 4 + i * 256) = xv[i];
                continue; }
#pragma unroll
            for (int i = 0; i < 8; ++i) *(f32x4*)(xrow + lane * 4 + i * 256) = xv[i];
        }
        float ss = 0.f;
#pragma unroll
        for (int i = 0; i < 8; ++i) ss += xv[i][0] * xv[i][0] + xv[i][1] * xv[i][1] + xv[i][2] * xv[i][2] + xv[i][3] * xv[i][3];
        ss = wave_sum(ss);
        const float rstd = rsqrtf(ss * (1.0f / DM) + EPS);
        const float* ml = mod + (size_t)(l * 2 + isctx) * 6144;
        const float* gpre = p.in[I_GPRE] + (size_t)l * DM;
        bf16_t* hrow = (bf16_t*)(ws + WS_H) + (size_t)row * DM;
#pragma unroll
        for (int i = 0; i < 8; ++i) { const int c = lane * 4 + i * 256;
            const f32x4 sh = *(const f32x4*)(ml + c), scl = *(const f32x4*)(ml + 2048 + c), gp = *(const f32x4*)(gpre + c);
            const f32x4 hv = ((xv[i] * rstd) * gp) * (1.0f + scl) + sh;
            u32x2 w; w.x = cvtpk(hv[0], hv[1]); w.y = cvtpk(hv[2], hv[3]);
            *(u32x2*)(hrow + c) = w; }
    }
}

__device__ __forceinline__ void ew_phase(const Params& p, int l) {
    int tid_ = threadIdx.x; asm volatile("" : "+v"(tid_));
    const int tid = tid_;
    unsigned char* ws = p.ws;
    bf16_t* P = (bf16_t*)(ws + WS_P);
    {
        const int t = tid & 15; const long grp = ((long)blockIdx.x * NTHREADS + tid) >> 4, ngrp = (long)gridDim.x * NTHREADS / 16;
        const float2* rope = (const float2*)(ws + WS_ROPE);
        const int base = ((t & 8) ? 64 : 0) + 4 * (t & 7), fi = 4 * (t & 7);
        bf16_t* KC = (bf16_t*)(ws + WS_KC);
#pragma unroll 2
        for (long it = grp; it < (long)ROWS * 20; it += ngrp) { const int row = (int)(it / 20), head = (int)(it % 20);
            const bf16_t* src_ = P + (size_t)row * INC + (head < 16 ? OQ + head * 128 : OKK + (head - 16) * 128) + base;
            bf16_t* dst_ = (head < 16) ? (P + (size_t)row * INC + OQ + head * 128 + base) : (KC + ((size_t)(head - 16) * ROWS + row) * 128 + base);
            const float* gn = (head < 16 ? p.in[I_QN] : p.in[I_KN]) + (size_t)l * 128 + base;
            const u32x2 wa = *(const u32x2*)src_, wb = *(const u32x2*)(src_ + 32);
            const f32x4 ga = *(const f32x4*)gn, gb = *(const f32x4*)(gn + 32);
            float a[4] = {bflo(wa.x), bfhi(wa.x), bflo(wa.y), bfhi(wa.y)}, b[4] = {bflo(wb.x), bfhi(wb.x), bflo(wb.y), bfhi(wb.y)};
            float ss = 0.f;
#pragma unroll
            for (int q = 0; q < 4; ++q) ss += a[q] * a[q] + b[q] * b[q];
#pragma unroll
            for (int o = 8; o >= 1; o >>= 1) ss += __shfl_xor(ss, o);
            const float rstd = rsqrtf(ss * (1.0f / 128.0f) + EPS);
#pragma unroll
            for (int q = 0; q < 4; ++q) { a[q] = a[q] * rstd * ga[q]; b[q] = b[q] * rstd * gb[q]; }
            if (row >= CTX) { const int tk = row - CTX, pos = (t & 8) ? (tk & 63) : (tk >> 6);
                const f32x4 r01 = *(const f32x4*)(rope + pos * 32 + fi), r23 = *(const f32x4*)(rope + pos * 32 + fi + 2);
                const float cs[4] = {r01[0], r01[2], r23[0], r23[2]}, sn[4] = {r01[1], r01[3], r23[1], r23[3]};
#pragma unroll
                for (int q = 0; q < 4; ++q) { const float x0 = a[q], x1 = b[q]; a[q] = x0 * cs[q] - x1 * sn[q]; b[q] = x0 * sn[q] + x1 * cs[q]; } }
            u32x2 oa, ob; oa.x = cvtpk(a[0], a[1]); oa.y = cvtpk(a[2], a[3]); ob.x = cvtpk(b[0], b[1]); ob.y = cvtpk(b[2], b[3]);
            *(u32x2*)dst_ = oa; *(u32x2*)(dst_ + 32) = ob;
        }
    }
    {
        const long gt = (long)blockIdx.x * NTHREADS + tid, gn = (long)gridDim.x * NTHREADS;
        bf16_t* VC = (bf16_t*)(ws + WS_VC);
        for (long it = gt; it < (long)ROWS * 64; it += gn) { const int row = (int)(it >> 6), c = (int)(it & 63) * 8;
            const u32x4 v = *(const u32x4*)(P + (size_t)row * INC + OV + c);
            *(u32x4*)(VC + ((size_t)(c >> 7) * ROWS + row) * 128 + (c & 127)) = v; }
    }
    {
        const long gt = (long)blockIdx.x * NTHREADS + tid, gn = (long)gridDim.x * NTHREADS;
        bf16_t* Acat = (bf16_t*)(ws + WS_ACAT);
        const float* cw = p.in[I_CW] + (size_t)l * 3 * 1024; const float* cbias = p.in[I_CB] + (size_t)l * 1024;
        for (long it = gt; it < (long)(ROWS / 4) * 128; it += gn) { const int row0 = (int)(it >> 7) * 4, c0 = (int)(it & 127) * 8;
            const bf16_t* pr = P + (size_t)row0 * INC;
            const bool hp = (row0 != 0) && (row0 != CTX), hn = (row0 + 4 != CTX) && (row0 + 4 != ROWS);
            const u32x4 z = {0u, 0u, 0u, 0u};
            u32x4 xv[6], kv[6], bb[4], gg[4];
            xv[0] = hp ? *(const u32x4*)(pr - INC + OCX + c0) : z; kv[0] = hp ? *(const u32x4*)(pr - INC + OCC + c0) : z;
#pragma unroll
            for (int r = 0; r < 4; ++r) { xv[r + 1] = *(const u32x4*)(pr + (size_t)r * INC + OCX + c0); kv[r + 1] = *(const u32x4*)(pr + (size_t)r * INC + OCC + c0);
                bb[r] = *(const u32x4*)(pr + (size_t)r * INC + OCB + c0); gg[r] = *(const u32x4*)(pr + (size_t)r * INC + OCG + c0); }
            xv[5] = hn ? *(const u32x4*)(pr + (size_t)4 * INC + OCX + c0) : z; kv[5] = hn ? *(const u32x4*)(pr + (size_t)4 * INC + OCC + c0) : z;
            float w0[8], w1[8], w2[8], bs[8];
#pragma unroll
            for (int j = 0; j < 8; ++j) { w0[j] = cw[c0 + j]; w1[j] = cw[1024 + c0 + j]; w2[j] = cw[2048 + c0 + j]; bs[j] = cbias[c0 + j]; }
            float uu[6][8];
#pragma unroll
            for (int r = 0; r < 6; ++r)
#pragma unroll
                for (int q = 0; q < 4; ++q) { uu[r][2 * q] = bflo(xv[r][q]) * bflo(kv[r][q]); uu[r][2 * q + 1] = bfhi(xv[r][q]) * bfhi(kv[r][q]); }
#pragma unroll
            for (int r = 0; r < 4; ++r) { float res[8];
#pragma unroll
                for (int q = 0; q < 4; ++q) {
                    { const int j = 2 * q; const float cv = uu[r][j] * w0[j] + uu[r + 1][j] * w1[j] + uu[r + 2][j] * w2[j] + bs[j]; res[j] = bflo(bb[r][q]) * cv * siluf_(bflo(gg[r][q])); }
                    { const int j = 2 * q + 1; const float cv = uu[r][j] * w0[j] + uu[r + 1][j] * w1[j] + uu[r + 2][j] * w2[j] + bs[j]; res[j] = bfhi(bb[r][q]) * cv * siluf_(bfhi(gg[r][q])); } }
                u32x4 w; w.x = cvtpk(res[0], res[1]); w.y = cvtpk(res[2], res[3]); w.z = cvtpk(res[4], res[5]); w.w = cvtpk(res[6], res[7]);
                *(u32x4*)(Acat + 2 * APL + (size_t)(row0 + r) * CLD + c0) = w; }
        }
    }
}

constexpr int BM = 256, BK = 64, HALF = 128, HTB = HALF * BK * 2;
constexpr int BJC = 32;
__device__ __forceinline__ int lds_byte(int r, int c) { const int st = (r >> 4) * 2 + (c >> 5), rr = r & 15, cc = c & 31, ob = rr * 64 + cc * 2; return st * 1024 + (ob ^ (((ob >> 9) & 1) << 5)); }
__device__ __forceinline__ void stage_rc(int b, int& R, int& C) { const int st = b / 1024, sb = b % 1024, swz = sb ^ (((sb >> 9) & 1) << 5); R = (st >> 1) * 16 + swz / 64; C = (st & 1) * 32 + (swz % 64) / 2; }
__device__ __forceinline__ int perm32(int rho) { const int n = rho >> 4, i = rho & 15; return 8 * (i >> 2) + 4 * n + (i & 3); }

enum { G_FOLD = 0, G_IN, G_XT, G_F1, G_F2, G_DFTC, G_MIX, G_MERGE, G_OUT, G_MERGEC };
enum { M_BF16 = 0, M_MIX, M_MERGE0, M_MERGE1, M_MERGE2, M_F32, M_F1, M_F2, M_MG0, M_MG1, M_MG2 };
struct Unit { const char* a; const char* b; char* o; const char* aux; char* m; int nt, mode, ldo; };

__device__ __forceinline__ void static_order(int w, int nM, int nN, int& pm, int& pn) {
    const int nwg = nM * nN, q = nwg / 8, r = nwg % 8, xcd = w % 8, off = w / 8;
    const int wg = (xcd < r ? xcd * (q + 1) : r * (q + 1) + (xcd - r) * q) + off;
    const int nig = 8 * nN, gid = wg / nig, fm = gid * 8, gsz = (nM - fm) < 8 ? (nM - fm) : 8;
    pm = fm + ((wg % nig) % gsz); pn = (wg % nig) / gsz;
}

__device__ __forceinline__ bool get_unit(int gid, int l, int i, unsigned char* ws, Unit& u) {
    const int G = gridDim.x, c = blockIdx.x;
    u.aux = nullptr; u.m = nullptr;
    switch (gid) {
    case G_FOLD: { const int L = i * G + c; if (L >= 128) return false;
        const int ll = L >> 5, g = (L >> 3) & 3, pm = (L >> 1) & 3, pnn = L & 1;
        u.a = (const char*)(ws + WS_WMIXR + ll * SZ_WMIXR) + ((size_t)pm * 256 * 1024 + g * 256) * 2;
        u.b = (const char*)(ws + WS_TCH) + (size_t)pnn * 256 * 256 * 2;
        u.o = (char*)(ws + WS_WMIX + ll * SZ_WMIX) + ((size_t)pm * 256 * 2048 + pnn * 1024 + g * 256) * 2;
        u.nt = 4; u.mode = M_BF16; u.ldo = 2048; return true; }
    case G_IN: { const int L = i * G + c; if (L >= 2116) return false;
        if (L < 2112) { int pm, pn; static_order(L, 33, 64, pm, pn); const int pnp = pn < 20 ? pn : pn + 4;
            u.a = (const char*)(ws + WS_H) + (size_t)pm * 256 * DM * 2;
            u.b = (const char*)(ws + WS_WINT + l * SZ_WINT) + (size_t)pnp * 256 * DM * 2;
            u.o = (char*)(ws + WS_P) + ((size_t)pm * 256 * INC + pnp * 256) * 2; u.ldo = INC; }
        else { const int pm = L - 2112;
            u.a = (const char*)(ws + WS_WINT + l * SZ_WINT) + (size_t)(OFX + pm * 256) * DM * 2;
            u.b = (const char*)(ws + WS_H);
            u.o = (char*)(ws + WS_XT) + (size_t)pm * 256 * ROWS * 2; u.ldo = ROWS; }
        u.nt = 32; u.mode = M_BF16; return true; }
    case G_XT: { const int L = i * G + ((c + G - 68) % G); if (L >= 128) return false; const int pm = L & 3, pn = 1 + (L >> 2);
        u.a = (const char*)(ws + WS_WINT + l * SZ_WINT) + (size_t)(OFX + pm * 256) * DM * 2;
        u.b = (const char*)(ws + WS_H) + (size_t)(CTX + 2 * (pn - 1)) * DM * 2;
        u.o = (char*)(ws + WS_XT) + ((size_t)pm * 256 * ROWS + pn * 256) * 2; u.ldo = ROWS;
        u.nt = 32; u.mode = M_BF16; return true; }
    case G_F1: { const int L = i * G + c; if (L >= 256) return false; const int s2 = L >> 2, ct = L & 3;
        u.a = (const char*)(ws + WS_XT) + ((size_t)ct * 256 * ROWS + CTX + s2 * 128) * 2;
        u.b = (const char*)(ws + WS_T1);
        u.o = (char*)(ws + WS_ZT) + (size_t)ct * 256 * ZCH + s2 * 8;
        u.nt = 2; u.mode = M_F1; u.ldo = s2; return true; }
    case G_F2: { if (c < 16 || c >= G - 132) return false; const int L = i * (G - 148) + (c - 16); if (L >= 256) return false; const int k1p = L >> 2, ct = L & 3;
        u.a = (const char*)(ws + WS_A2);
        u.b = (const char*)(ws + WS_ZT) + (size_t)ct * 256 * ZCH + k1p * 512;
        u.o = (char*)(ws + WS_PQ) + ((size_t)(CTX + 2 * k1p) * 2048 + ct * 256) * 2;
        u.nt = 4; u.mode = M_F2; u.ldo = 2048; return true; }
    case G_DFTC: { const int L = i * G + c; if (L >= 8) return false; const int pm = L >> 2, pn = L & 3;
        u.a = (const char*)(ws + WS_ACTX) + (size_t)pm * 256 * 256 * 2;
        u.b = (const char*)(ws + WS_XT) + (size_t)pn * 256 * ROWS * 2;
        u.o = (char*)(ws + WS_PQ) + ((size_t)pm * 1024 + pn * 256) * 2;
        u.nt = 4; u.mode = M_BF16; u.ldo = 2048; return true; }
    case G_MIX: { const int L = i * G + (G - 1 - c); if (L >= 132) return false; const int pm = L >> 2, pn = L & 3;
        u.a = (const char*)(ws + WS_PQ) + (size_t)pm * 256 * 2048 * 2;
        u.b = (const char*)(ws + WS_WMIX + l * SZ_WMIX) + (size_t)pn * 256 * 2048 * 2;
        u.aux = (const char*)(ws + WS_P) + ((size_t)pm * 256 * INC + OFG + pn * 256) * 2;
        u.o = (char*)(ws + WS_ACAT) + (APL + (size_t)pm * 256 * CLD + pn * 256) * 2;
        u.nt = 32; u.mode = M_MIX; u.ldo = CLD; return true; }
    case G_MERGE: {
        if (i < 3) { const int T = c, sub = i; if (T >= 256) return false;
            int pm, pn; static_order(T, 32, 8, pm, pn); pm += 1;
            u.a = (const char*)(ws + WS_ACAT) + ((size_t)sub * APL + (size_t)pm * 256 * CLD) * 2;
            u.b = (const char*)(ws + WS_WCAT + l * SZ_WCAT) + ((size_t)sub * WPL + (size_t)pn * 256 * CLD) * 2;
            u.aux = (const char*)(ws + WS_P) + ((size_t)pm * 256 * INC + OML + sub * 2048 + pn * 256) * 2;
            u.m = (char*)(ws + WS_MBUF) + ((size_t)pm * 256 * MLD + pn * 256) * 4;
            u.o = (char*)(ws + WS_MB) + ((size_t)pm * 256 * 2048 + pn * 256) * 2;
            u.nt = sub == 0 ? 32 : 16; u.mode = M_MG0 + sub; u.ldo = 2048; return true; }
        return false; }
    case G_MERGEC: {
        if (i == 0 && l < DEPTH - 1 && c >= G - 64) { const int pc = c - (G - 64), pn = pc >> 3, q = pc & 7;
            const int sub = q < 4 ? 0 : (q < 6 ? 1 : 2), kcol = q < 4 ? q * 512 : (q < 6 ? (q - 4) * 512 : (q - 6) * 512);
            u.a = (const char*)(ws + WS_ACAT) + ((size_t)sub * APL + kcol) * 2;
            u.b = (const char*)(ws + WS_WCAT + l * SZ_WCAT) + ((size_t)sub * WPL + (size_t)pn * 256 * CLD + kcol) * 2;
            u.aux = (const char*)(ws + WS_P) + ((size_t)OML + sub * 2048 + pn * 256) * 2;
            u.m = (char*)(ws + WS_MP) + ((size_t)q * CTX * MLD + pn * 256) * 4;
            u.o = nullptr; u.nt = 8; u.mode = M_MERGE0; u.ldo = 2048; return true; }
        return false; }
    case G_OUT: {
        const int piece = l >> 4; l &= 15;
        if (i != 0) return false;
        if (!piece) { if (c >= 256) return false; int pm, pn; static_order(c, 32, 8, pm, pn); pm += 1;
            u.a = (const char*)(ws + WS_MB) + (size_t)pm * 256 * 2048 * 2;
            u.b = (const char*)(ws + WS_WOUT + l * SZ_WOUT) + (size_t)pn * 256 * 2048 * 2;
            u.o = (char*)(ws + WS_OUTB) + ((size_t)pm * 256 * 2048 + pn * 256) * 4;
            u.nt = 32; u.mode = M_F32; u.ldo = 2048; return true; }
        if (l < DEPTH - 1 && c >= G - 32) { const int pc = c - (G - 32), pn = pc >> 2, kp = pc & 3;
            u.a = (const char*)(ws + WS_MB) + (size_t)kp * 512 * 2;
            u.b = (const char*)(ws + WS_WOUT + l * SZ_WOUT) + ((size_t)pn * 256 * 2048 + kp * 512) * 2;
            u.o = (char*)(ws + WS_OUTP) + ((size_t)kp * CTX * 2048 + pn * 256) * 4;
            u.nt = 8; u.mode = M_F32; u.ldo = 2048; return true; }
        return false; }
    }
    return false;
}

__device__ __forceinline__ void epilogue(const f32x4 (&acc)[2][2][4][2], const Unit& u, int wr, int wc, int fr, int fq) {
    unsigned r0 = wr * 64 + fr, c0 = wc * 64 + 8 * fq;
    asm volatile("" : "+v"(r0), "+v"(c0));
    if (u.mode == M_BF16) {
        const unsigned base = (r0 * (unsigned)u.ldo + c0) * 2u;
#pragma unroll
        for (int ai = 0; ai < 2; ++ai)
#pragma unroll
            for (int m = 0; m < 4; ++m) { char* rowp = u.o + (size_t)(ai * HALF + m * 16) * u.ldo * 2;
#pragma unroll
                for (int bj = 0; bj < 2; ++bj) { const f32x4 v0 = acc[ai][bj][m][0], v1 = acc[ai][bj][m][1];
                    u32x4 w; w.x = cvtpk(v0[0], v0[1]); w.y = cvtpk(v0[2], v0[3]); w.z = cvtpk(v1[0], v1[1]); w.w = cvtpk(v1[2], v1[3]);
                    *(u32x4*)(rowp + base + bj * BJC * 2) = w; } }
    } else if (u.mode == M_MIX) {
        const unsigned base = (r0 * (unsigned)u.ldo + c0) * 2u, abase = (r0 * (unsigned)INC + c0) * 2u;
#pragma unroll
        for (int ai = 0; ai < 2; ++ai) {
            u32x4 g[4][2];
#pragma unroll
            for (int m = 0; m < 4; ++m)
#pragma unroll
                for (int bj = 0; bj < 2; ++bj) g[m][bj] = *(const u32x4*)(u.aux + (size_t)(ai * HALF + m * 16) * INC * 2 + abase + bj * BJC * 2);
            __builtin_amdgcn_sched_barrier(0);
#pragma unroll
            for (int m = 0; m < 4; ++m) { char* rowp = u.o + (size_t)(ai * HALF + m * 16) * u.ldo * 2;
#pragma unroll
                for (int bj = 0; bj < 2; ++bj) { const f32x4 v0 = acc[ai][bj][m][0], v1 = acc[ai][bj][m][1]; const u32x4 gg = g[m][bj];
                    u32x4 w; w.x = cvtpk(v0[0] * siluf_(bflo(gg.x)), v0[1] * siluf_(bfhi(gg.x))); w.y = cvtpk(v0[2] * siluf_(bflo(gg.y)), v0[3] * siluf_(bfhi(gg.y)));
                    w.z = cvtpk(v1[0] * siluf_(bflo(gg.z)), v1[1] * siluf_(bfhi(gg.z))); w.w = cvtpk(v1[2] * siluf_(bflo(gg.w)), v1[3] * siluf_(bfhi(gg.w)));
                    *(u32x4*)(rowp + base + bj * BJC * 2) = w; } }
            __builtin_amdgcn_sched_barrier(0);
        }
    } else if (u.mode == M_F32) {
        const unsigned base = (r0 * (unsigned)u.ldo + c0) * 4u;
#pragma unroll
        for (int ai = 0; ai < 2; ++ai)
#pragma unroll
            for (int m = 0; m < 4; ++m) { char* rowp = u.o + (size_t)(ai * HALF + m * 16) * u.ldo * 4;
#pragma unroll
                for (int bj = 0; bj < 2; ++bj) { *(f32x4*)(rowp + base + bj * BJC * 4) = acc[ai][bj][m][0]; *(f32x4*)(rowp + base + bj * BJC * 4 + 16) = acc[ai][bj][m][1]; } }
    } else if (u.mode == M_MG0 || u.mode == M_MG1) {
    } else if (u.mode == M_MG2) {
        const unsigned abase = (r0 * (unsigned)INC + c0) * 2u, obase = (r0 * 2048u + c0) * 2u;
#pragma unroll
        for (int ai = 0; ai < 2; ++ai) {
            u32x4 g[4][2];
#pragma unroll
            for (int m = 0; m < 4; ++m)
#pragma unroll
                for (int bj = 0; bj < 2; ++bj) g[m][bj] = *(const u32x4*)(u.aux + (size_t)(ai * HALF + m * 16) * INC * 2 + abase + bj * BJC * 2);
            __builtin_amdgcn_sched_barrier(0);
#pragma unroll
            for (int m = 0; m < 4; ++m) { char* rowp = u.o + (size_t)(ai * HALF + m * 16) * 2048 * 2;
#pragma unroll
                for (int bj = 0; bj < 2; ++bj) { f32x4 v0 = acc[ai][bj][m][0], v1 = acc[ai][bj][m][1]; const u32x4 gg = g[m][bj];
                    v0[0] *= sigmoidf_(bflo(gg.x)); v0[1] *= sigmoidf_(bfhi(gg.x)); v0[2] *= sigmoidf_(bflo(gg.y)); v0[3] *= sigmoidf_(bfhi(gg.y));
                    v1[0] *= sigmoidf_(bflo(gg.z)); v1[1] *= sigmoidf_(bfhi(gg.z)); v1[2] *= sigmoidf_(bflo(gg.w)); v1[3] *= sigmoidf_(bfhi(gg.w));
                    u32x4 w; w.x = cvtpk(v0[0], v0[1]); w.y = cvtpk(v0[2], v0[3]); w.z = cvtpk(v1[0], v1[1]); w.w = cvtpk(v1[2], v1[3]); *(u32x4*)(rowp + obase + bj * BJC * 2) = w; } }
            __builtin_amdgcn_sched_barrier(0);
        }
    } else if (u.mode == M_F1) {
        const int s2 = u.ldo;
        const unsigned kb0 = (c0 >> 1);
        float tc[2][4], ts[2][4];
#pragma unroll
        for (int bj = 0; bj < 2; ++bj)
#pragma unroll
            for (int j = 0; j < 4; ++j) { const float x = (float)((bj * 16 + kb0 + j) * s2) * (1.0f / 8192.0f); tc[bj][j] = __builtin_amdgcn_cosf(x); ts[bj][j] = __builtin_amdgcn_sinf(x); }
        const unsigned base = r0 * (unsigned)ZCH + kb0 * 256u;
#pragma unroll
        for (int ai = 0; ai < 2; ++ai)
#pragma unroll
            for (int m = 0; m < 4; ++m) { char* rowp = u.o + (size_t)(ai * HALF + m * 16) * ZCH;
#pragma unroll
                for (int bj = 0; bj < 2; ++bj) { const f32x4 v0 = acc[ai][bj][m][0], v1 = acc[ai][bj][m][1];
                    const float zr[4] = {v0[0], v0[2], v1[0], v1[2]}, zi[4] = {v0[1], v0[3], v1[1], v1[3]};
#pragma unroll
                    for (int jp = 0; jp < 2; ++jp) { u32x2 w;
                        { const int j = 2 * jp; w.x = cvtpk(zr[j] * tc[bj][j] + zi[j] * ts[bj][j], zi[j] * tc[bj][j] - zr[j] * ts[bj][j]); }
                        { const int j = 2 * jp + 1; w.y = cvtpk(zr[j] * tc[bj][j] + zi[j] * ts[bj][j], zi[j] * tc[bj][j] - zr[j] * ts[bj][j]); }
                        *(u32x2*)(rowp + base + (bj * 8 + jp) * 512) = w; } } }
    } else if (u.mode == M_F2) {
        const unsigned fr_ = r0 & 15u, wr_ = r0 >> 6;
        const unsigned base = ((128u * fr_) * 2048u + wr_ * 1024u + c0) * 2u;
#pragma unroll
        for (int ai = 0; ai < 2; ++ai)
#pragma unroll
            for (int m = 0; m < 4; ++m) { char* rowp = u.o + (size_t)(ai + 2048 * m) * 2048 * 2;
#pragma unroll
                for (int bj = 0; bj < 2; ++bj) { const f32x4 v0 = acc[ai][bj][m][0], v1 = acc[ai][bj][m][1];
                    u32x4 w; w.x = cvtpk(v0[0], v0[1]); w.y = cvtpk(v0[2], v0[3]); w.z = cvtpk(v1[0], v1[1]); w.w = cvtpk(v1[2], v1[3]);
                    *(u32x4*)(rowp + base + bj * BJC * 2) = w; } }
    } else {
        const unsigned abase = (r0 * (unsigned)INC + c0) * 2u, mbase = (r0 * (unsigned)MLD + c0) * 4u;
#pragma unroll
        for (int ai = 0; ai < 2; ++ai)
#pragma unroll
            for (int m = 0; m < 4; ++m) { const int rr = ai * HALF + m * 16; const char* ap = u.aux + (size_t)rr * INC * 2; char* mp = u.m + (size_t)rr * MLD * 4;
#pragma unroll
                for (int bj = 0; bj < 2; ++bj) { f32x4 v0 = acc[ai][bj][m][0], v1 = acc[ai][bj][m][1]; const u32x4 g = *(const u32x4*)(ap + abase + bj * BJC * 2);
                    v0[0] *= sigmoidf_(bflo(g.x)); v0[1] *= sigmoidf_(bfhi(g.x)); v0[2] *= sigmoidf_(bflo(g.y)); v0[3] *= sigmoidf_(bfhi(g.y));
                    v1[0] *= sigmoidf_(bflo(g.z)); v1[1] *= sigmoidf_(bfhi(g.z)); v1[2] *= sigmoidf_(bflo(g.w)); v1[3] *= sigmoidf_(bfhi(g.w));
                    *(f32x4*)(mp + mbase + bj * BJC * 4) = v0; *(f32x4*)(mp + mbase + bj * BJC * 4 + 16) = v1; }
                if (m & 1) __builtin_amdgcn_sched_barrier(0); }
    }
}

__device__ __forceinline__ void rescale_or_reset(f32x4 (&acc)[2][2][4][2], const Unit& u, int wr, int wc, int fr, int fq) {
    const unsigned msk = (u.mode == M_MG0 || u.mode == M_MG1) ? 0xffffffffu : 0u;
    unsigned r0 = wr * 64 + fr, c0 = wc * 64 + 8 * fq;
    asm volatile("" : "+v"(r0), "+v"(c0));
    const unsigned abase = (r0 * (unsigned)INC + c0) * 2u;
#pragma unroll
    for (int ai = 0; ai < 2; ++ai)
#pragma unroll
        for (int m = 0; m < 4; ++m) { const char* ap = u.aux + (size_t)(ai * HALF + m * 16) * INC * 2;
#pragma unroll
            for (int bj = 0; bj < 2; ++bj) {
                const u32x4 ga = *(const u32x4*)(ap + abase + bj * BJC * 2), gb = *(const u32x4*)(ap + abase + bj * BJC * 2 + 4096);
                const unsigned wa[4] = {ga.x, ga.y, ga.z, ga.w}, wb[4] = {gb.x, gb.y, gb.z, gb.w};
                float f[8];
#pragma unroll
                for (int e = 0; e < 4; ++e) {
                    const float rl = (1.0f + __expf(-bflo(wb[e]))) * __builtin_amdgcn_rcpf(1.0f + __expf(-bflo(wa[e])));
                    const float rh = (1.0f + __expf(-bfhi(wb[e]))) * __builtin_amdgcn_rcpf(1.0f + __expf(-bfhi(wa[e])));
                    f[2 * e] = __uint_as_float(__float_as_uint(rl) & msk); f[2 * e + 1] = __uint_as_float(__float_as_uint(rh) & msk); }
                acc[ai][bj][m][0] *= (f32x4){f[0], f[1], f[2], f[3]}; acc[ai][bj][m][1] *= (f32x4){f[4], f[5], f[6], f[7]};
            }
            if (m & 1) __builtin_amdgcn_sched_barrier(0);
        }
}

__device__ __forceinline__ void gemm_phase(LAS unsigned char* lds, int gid, int l, unsigned char* ws) {
    int tid_ = threadIdx.x; asm volatile("" : "+v"(tid_));
    const int tid = tid_, wid = __builtin_amdgcn_readfirstlane(tid >> 6), lane = tid & 63, wr = wid >> 2, wc = wid & 3, fr = lane & 15, fq = lane >> 4;
    int lda, ldb;
    int ldbv = 0;
    switch (gid) { case G_FOLD: lda = 1024; ldb = 256; break; case G_IN: lda = 2048; ldb = 2048; break; case G_XT: lda = 2048; ldb = 2048; ldbv = 64 * 2048; break;
                   case G_F1: lda = ROWS; ldb = 128; break; case G_F2: lda = 256; ldb = ZCH / 2; break;
                   case G_DFTC: lda = 256; ldb = ROWS; break; case G_MIX: lda = 2048; ldb = 2048; break; case G_MERGE: case G_MERGEC: lda = CLD; ldb = CLD; break; default: lda = 2048; ldb = 2048; break; }
    if (ldbv == 0) ldbv = ldb;
    Unit cur, nxt; int ui = 0;
    if (!get_unit(gid, l, 0, ws, cur)) return;
    unsigned voffA[2], voffB[2];
#pragma unroll
    for (int i = 0; i < 2; ++i) { int R, C; stage_rc(tid * 16 + i * 8192, R, C); const int w_ = R >> 5, ip = perm32(R & 31);
        const int Rb = (gid == G_XT) ? (4096 * (w_ & 1) + 64 * ip + (w_ >> 1)) : (64 * w_ + ip);
        voffA[i] = (unsigned)(R * lda + C) * 2u; voffB[i] = (unsigned)(Rb * ldb + C) * 2u; }
    const size_t kstep = (size_t)(BK * 2);
    const size_t hstepA = (size_t)HALF * lda * 2, hstepB = (gid == G_XT) ? (size_t)2048 * ldb * 2 : (size_t)32 * ldb * 2;
    const unsigned ldsw = (unsigned)wid * 1024u;
    const int aoff = lds_byte(wr * 64 + fr, fq * 8), boff = lds_byte(wc * 32 + fr, fq * 8);
#define PG8_SA(b, h) (((b) * 2 + (h)) * HTB)
#define PG8_SB(b, h) ((4 + (b) * 2 + (h)) * HTB)
#define PG8_STAGE(bufoff, gbase, voff) do { _Pragma("unroll") for (int _i = 0; _i < 2; ++_i) \
        __builtin_amdgcn_global_load_lds((const unsigned*)((const char*)(gbase) + (voff)[_i]), (LAS unsigned*)(lds + (bufoff) + ldsw + _i * 8192), 16, 0, 0); } while (0)
#define PG8_LDA(dst, b, h) do { _Pragma("unroll") for (int m = 0; m < 4; ++m) _Pragma("unroll") for (int k = 0; k < 2; ++k) dst[m][k] = *(const LAS bf16x8*)(lds + PG8_SA(b, h) + aoff + m * 2048 + k * 1024); } while (0)
#define PG8_LDB(dst, b, h) do { _Pragma("unroll") for (int n = 0; n < 2; ++n) _Pragma("unroll") for (int k = 0; k < 2; ++k) dst[n][k] = *(const LAS bf16x8*)(lds + PG8_SB(b, h) + boff + n * 2048 + k * 1024); } while (0)
#define PG8_MMA(ai, bj, At, Bt) do { __builtin_amdgcn_s_setprio(1); _Pragma("unroll") for (int m = 0; m < 4; ++m) _Pragma("unroll") for (int n = 0; n < 2; ++n) _Pragma("unroll") for (int k = 0; k < 2; ++k) \
        acc[ai][bj][m][n] = __builtin_amdgcn_mfma_f32_16x16x32_bf16(Bt[n][k], At[m][k], acc[ai][bj][m][n], 0, 0, 0); __builtin_amdgcn_s_setprio(0); } while (0)
#define PG8_WAIT_V(n) asm volatile("s_waitcnt vmcnt(" #n ")" ::: "memory")
#define PG8_WAIT_L(n) asm volatile("s_waitcnt lgkmcnt(" #n ")" ::: "memory")
#define PG8_BAR __builtin_amdgcn_s_barrier()
#define PG8_SCHED __builtin_amdgcn_sched_barrier(0)
    f32x4 acc[2][2][4][2];
#pragma unroll
    for (int a = 0; a < 2; ++a)
#pragma unroll
        for (int b = 0; b < 2; ++b)
#pragma unroll
            for (int m = 0; m < 4; ++m)
#pragma unroll
                for (int n = 0; n < 2; ++n) acc[a][b][m][n] = (f32x4){0.f, 0.f, 0.f, 0.f};
    bf16x8 At[4][2], B0[2][2], B1[2][2];
    const char* cA = cur.a; const char* cB = cur.b;
    PG8_STAGE(PG8_SB(0, 0), cB, voffB); PG8_STAGE(PG8_SA(0, 0), cA, voffA); PG8_STAGE(PG8_SB(0, 1), cB + hstepB, voffB); PG8_STAGE(PG8_SA(0, 1), cA + hstepA, voffA);
    if (wr == 1) PG8_BAR;
    PG8_WAIT_V(4); PG8_BAR;
    PG8_STAGE(PG8_SB(1, 0), cB + kstep, voffB); PG8_STAGE(PG8_SA(1, 0), cA + kstep, voffA); PG8_STAGE(PG8_SB(1, 1), cB + hstepB + kstep, voffB);
    PG8_WAIT_V(6); PG8_BAR;
    for (;;) {
        const bool has_next = get_unit(gid, l, ui + 1, ws, nxt);
        const char* nA = has_next ? nxt.a : cA; const char* nB = has_next ? nxt.b : cB;
        const int nt = cur.nt;
        for (int t = 0; t < nt; t += 2) {
            const bool last = (t == nt - 2);
            const char* a1 = cA + (size_t)(t + 1) * kstep;
            const char* a2 = last ? nA : cA + (size_t)(t + 2) * kstep; const char* b2 = last ? nB : cB + (size_t)(t + 2) * kstep;
            const char* a3 = a2 + kstep; const char* b3 = b2 + kstep;
            PG8_LDB(B0, 0, 0); PG8_SCHED; PG8_LDA(At, 0, 0); PG8_STAGE(PG8_SA(1, 1), a1 + hstepA, voffA);
            PG8_WAIT_L(8); PG8_BAR; PG8_WAIT_L(0); PG8_MMA(0, 0, At, B0); PG8_BAR; PG8_SCHED;
            PG8_LDB(B1, 0, 1); PG8_STAGE(PG8_SB(0, 0), b2, voffB);
            PG8_BAR; PG8_WAIT_L(0); PG8_MMA(0, 1, At, B1); PG8_BAR;
            PG8_LDA(At, 0, 1); PG8_STAGE(PG8_SA(0, 0), a2, voffA);
            PG8_BAR; PG8_WAIT_L(0); PG8_MMA(1, 0, At, B0); PG8_BAR; PG8_SCHED;
            PG8_STAGE(PG8_SB(0, 1), b2 + hstepB, voffB);
            PG8_WAIT_V(6); PG8_BAR; PG8_MMA(1, 1, At, B1); PG8_BAR;
            PG8_LDB(B0, 1, 0); PG8_SCHED; PG8_LDA(At, 1, 0); PG8_STAGE(PG8_SA(0, 1), a2 + hstepA, voffA);
            PG8_WAIT_L(8); PG8_BAR; PG8_WAIT_L(0); PG8_MMA(0, 0, At, B0); PG8_BAR; PG8_SCHED;
            PG8_LDB(B1, 1, 1); PG8_STAGE(PG8_SB(1, 0), b3, voffB);
            PG8_BAR; PG8_WAIT_L(0); PG8_MMA(0, 1, At, B1); PG8_BAR;
            PG8_LDA(At, 1, 1); PG8_STAGE(PG8_SA(1, 0), a3, voffA);
            PG8_BAR; PG8_WAIT_L(0); PG8_MMA(1, 0, At, B0); PG8_BAR; PG8_SCHED;
            PG8_STAGE(PG8_SB(1, 1), b3 + hstepB, voffB);
            PG8_WAIT_V(6); PG8_BAR; PG8_MMA(1, 1, At, B1); PG8_BAR;
        }
        epilogue(acc, cur, wr, wc, fr, fq);
        if (!has_next) break;
        if (gid == G_MERGE) rescale_or_reset(acc, cur, wr, wc, fr, fq);
        else {
#pragma unroll
            for (int a = 0; a < 2; ++a)
#pragma unroll
                for (int b = 0; b < 2; ++b)
#pragma unroll
                    for (int m = 0; m < 4; ++m)
#pragma unroll
                        for (int n = 0; n < 2; ++n) acc[a][b][m][n] = (f32x4){0.f, 0.f, 0.f, 0.f};
        }
        cur = nxt; cA = nA; cB = nB; ++ui;
    }
    PG8_WAIT_V(0);
    if (wr == 0) PG8_BAR;
    PG8_BAR;
#undef PG8_SA
#undef PG8_SB
#undef PG8_STAGE
#undef PG8_LDA
#undef PG8_LDB
#undef PG8_MMA
#undef PG8_WAIT_V
#undef PG8_WAIT_L
#undef PG8_BAR
#undef PG8_SCHED
}

namespace att {
constexpr int D = 128, NW = 8, QBLK = 32, KVBLK = 64;
constexpr float SCALE = 0.088388347648318440f;
constexpr float THR = 8.f;
constexpr int LDQ = INC, LDK = 128, LDO = CLD;
constexpr size_t SHM_V = KVBLK * D * 2, SHM_K = KVBLK * D * 2, SHM_ATTN = 2 * SHM_V + 2 * SHM_K + NW * 64 * 4;
#define KSWZ(row, colB) ((row) * 256 + ((colB) ^ (((row) & 7) << 4)))
#define SBAR() __builtin_amdgcn_sched_barrier(0)
__device__ __forceinline__ int crow(int r, int hi) { return (r & 3) + 8 * (r >> 2) + 4 * hi; }
__device__ __forceinline__ void partialSM(f32x16& p0, f32x16& p1, float& m_reg, float& mn, float& alpha) {
  constexpr float C = SCALE * 1.4426950408889634f;
  float pmax = p0[0];
#pragma unroll
  for (int r = 1; r < 16; ++r) pmax = fmaxf(pmax, p0[r]);
#pragma unroll
  for (int r = 0; r < 16; ++r) pmax = fmaxf(pmax, p1[r]);
  { auto rr = __builtin_amdgcn_permlane32_swap(__float_as_uint(pmax), __float_as_uint(pmax), false, false);
    pmax = fmaxf(__uint_as_float(rr[0]), __uint_as_float(rr[1])); }
  if (__builtin_expect(__all(pmax - m_reg <= THR / SCALE), 1)) { mn = m_reg; alpha = 1.f; }
  else { mn = fmaxf(m_reg, pmax); alpha = __builtin_amdgcn_exp2f((m_reg - mn) * C); m_reg = mn; }
  float mnC = -mn * C;
#pragma unroll
  for (int r = 0; r < 16; ++r) p0[r] = fmaf(p0[r], C, mnC);
#pragma unroll
  for (int r = 0; r < 16; ++r) p1[r] = fmaf(p1[r], C, mnC);
#pragma unroll
  for (int r = 0; r < 16; ++r) p0[r] = __builtin_amdgcn_exp2f(p0[r]);
}
__device__ __forceinline__ void finishSM(f32x16& p0, f32x16& p1, float alpha, float& l_reg, bf16x8& pa0, bf16x8& pa1, bf16x8& pa2, bf16x8& pa3) {
#pragma unroll
  for (int r = 0; r < 16; ++r) p1[r] = __builtin_amdgcn_exp2f(p1[r]);
  float ps = 0;
#pragma unroll
  for (int r = 0; r < 16; ++r) ps += p0[r];
#pragma unroll
  for (int r = 0; r < 16; ++r) ps += p1[r];
  { auto rr = __builtin_amdgcn_permlane32_swap(__float_as_uint(ps), __float_as_uint(ps), false, false);
    ps = __uint_as_float(rr[0]) + __uint_as_float(rr[1]); }
  l_reg = l_reg * alpha + ps;
#define PK4(P, BASE, OUT) do { unsigned a0 = cvtpk(P[BASE + 0], P[BASE + 1]), a1 = cvtpk(P[BASE + 2], P[BASE + 3]);   \
    unsigned b0 = cvtpk(P[BASE + 4], P[BASE + 5]), b1 = cvtpk(P[BASE + 6], P[BASE + 7]);                              \
    auto r0 = __builtin_amdgcn_permlane32_swap(a0, b0, false, false); auto r1 = __builtin_amdgcn_permlane32_swap(a1, b1, false, false); \
    u32x4 w = {r0[0], r1[0], r0[1], r1[1]}; OUT = *reinterpret_cast<bf16x8*>(&w); } while (0)
  PK4(p0, 0, pa0); PK4(p0, 8, pa1); PK4(p1, 0, pa2); PK4(p1, 8, pa3);
#undef PK4
}
__device__ __forceinline__ void qkt(f32x16& p0, f32x16& p1, const bf16_t* Ks, const bf16x8* qr, int r32, int hi) {
  p0 = f32x16{}; p1 = f32x16{};
#pragma unroll
  for (int d0 = 0; d0 < 8; ++d0) { int cb = (d0 * 16 + hi * 8) * 2;
    bf16x8 b0 = *reinterpret_cast<const bf16x8*>((const char*)Ks + KSWZ(r32, cb));
    bf16x8 b1 = *reinterpret_cast<const bf16x8*>((const char*)Ks + KSWZ(32 + r32, cb));
    p0 = __builtin_amdgcn_mfma_f32_32x32x16_bf16(b0, qr[d0], p0, 0, 0, 0);
    p1 = __builtin_amdgcn_mfma_f32_32x32x16_bf16(b1, qr[d0], p1, 0, 0, 0); }
}
__device__ __forceinline__ int v_st(int k, int c) { const int kk = (k & ~0xC) | ((k & 4) << 1) | ((k & 8) >> 1); return ((kk >> 3) * 4 + (c >> 5)) * 512 + ((kk & 7) * 32 + (c & 31)) * 2; }
__device__ __forceinline__ int v_rd_base(int lane) { return ((lane & 3) << 3) | (((lane >> 2) & 3) << 6) | (((lane >> 4) & 1) << 5) | (((lane >> 5) & 1) << 8); }
constexpr int v_rd_off(int d0, int ks, int half) { return d0 * 512 + ks * 4096 + half * 2048; }
template <int OFF> __device__ __forceinline__ s16x4 tr_read(int vb) {
  s16x4 r; asm volatile("ds_read_b64_tr_b16 %0, %1 offset:%2" : "=&v"(r) : "v"(vb), "i"(OFF) : "memory"); return r;
}
template <int D0> __device__ __forceinline__ void pv_one(f32x16& od, int vb, bf16x8 pa0, bf16x8 pa1, bf16x8 pa2, bf16x8 pa3) {
  const s16x4 l0 = tr_read<v_rd_off(D0, 0, 0)>(vb), h0 = tr_read<v_rd_off(D0, 0, 1)>(vb), l1 = tr_read<v_rd_off(D0, 1, 0)>(vb), h1 = tr_read<v_rd_off(D0, 1, 1)>(vb);
  const s16x4 l2 = tr_read<v_rd_off(D0, 2, 0)>(vb), h2 = tr_read<v_rd_off(D0, 2, 1)>(vb), l3 = tr_read<v_rd_off(D0, 3, 0)>(vb), h3 = tr_read<v_rd_off(D0, 3, 1)>(vb);
  asm volatile("s_waitcnt lgkmcnt(0)" ::: "memory"); SBAR();
#define PK(L, H) (bf16x8){L[0], L[1], L[2], L[3], H[0], H[1], H[2], H[3]}
  od = __builtin_amdgcn_mfma_f32_32x32x16_bf16(pa0, PK(l0, h0), od, 0, 0, 0);
  od = __builtin_amdgcn_mfma_f32_32x32x16_bf16(pa1, PK(l1, h1), od, 0, 0, 0);
  od = __builtin_amdgcn_mfma_f32_32x32x16_bf16(pa2, PK(l2, h2), od, 0, 0, 0);
  od = __builtin_amdgcn_mfma_f32_32x32x16_bf16(pa3, PK(l3, h3), od, 0, 0, 0);
#undef PK
}
__device__ __forceinline__ void pv_d0(f32x16* o, int vb, bf16x8 pa0, bf16x8 pa1, bf16x8 pa2, bf16x8 pa3) {
  pv_one<0>(o[0], vb, pa0, pa1, pa2, pa3); pv_one<1>(o[1], vb, pa0, pa1, pa2, pa3); pv_one<2>(o[2], vb, pa0, pa1, pa2, pa3); pv_one<3>(o[3], vb, pa0, pa1, pa2, pa3);
}
__device__ __forceinline__ void attn_body(const bf16_t* __restrict__ Qb, const bf16_t* __restrict__ Kh, const bf16_t* __restrict__ Vh,
                                          bf16_t* __restrict__ Ob, const bf16_t* __restrict__ AGb, int seq, char* lds) {
  int tid_ = threadIdx.x; asm volatile("" : "+v"(tid_));
  const int tid = tid_, wid = tid >> 6, lane = tid & 63, r32 = lane & 31, hi = lane >> 5;
  bf16_t* V_lds = (bf16_t*)lds; bf16_t* K_lds = (bf16_t*)(lds + 2 * SHM_V);
  float* wsl = (float*)(lds + 2 * SHM_V + 2 * SHM_K) + wid * 64; float* li_l = wsl; float* al_l = wsl + 32;
  float m_reg = -1e30f, l_reg = 0; f32x16 o[4] = {}; bf16x8 qr[8];
  const bf16_t* Qw = Qb + (long)(wid * QBLK + r32) * LDQ + hi * 8;
#pragma unroll
  for (int d0 = 0; d0 < 8; ++d0) qr[d0] = *reinterpret_cast<const bf16x8*>(Qw + d0 * 16);
  const int sr = tid >> 4, sc = (tid & 15) * 8, vst0 = v_st(sr, sc), vst1 = v_st(32 + sr, sc);
  const int vb0 = (int)(uintptr_t)V_lds + v_rd_base(lane);
  const unsigned goff0 = (unsigned)(sr * LDK + sc) * 2u, goff1 = (unsigned)((32 + sr) * LDK + sc) * 2u;
  struct { bf16x8 vs0, vs1, ks0, ks1; } sr_[2];
#define SLOAD(i, k0) do { const char* vt_ = (const char*)Vh + (size_t)(k0) * (LDK * 2); const char* kt_ = (const char*)Kh + (size_t)(k0) * (LDK * 2); \
    sr_[i].vs0 = *reinterpret_cast<const bf16x8*>(vt_ + goff0); sr_[i].vs1 = *reinterpret_cast<const bf16x8*>(vt_ + goff1); \
    sr_[i].ks0 = *reinterpret_cast<const bf16x8*>(kt_ + goff0); sr_[i].ks1 = *reinterpret_cast<const bf16x8*>(kt_ + goff1); } while (0)
#define SWRITE(b, i) do { *(bf16x8*)((char*)V_lds + (b) * SHM_V + vst0) = sr_[i].vs0;          \
    *(bf16x8*)((char*)V_lds + (b) * SHM_V + vst1) = sr_[i].vs1; int kc = sc * 2;               \
    *(bf16x8*)((char*)K_lds + (b) * SHM_K + KSWZ(sr, kc)) = sr_[i].ks0;                       \
    *(bf16x8*)((char*)K_lds + (b) * SHM_K + KSWZ(32 + sr, kc)) = sr_[i].ks1; } while (0)
#define SWAIT() asm volatile("s_waitcnt vmcnt(4)" ::: "memory")
#define RESC(a) do { if (__any((a) < 1.f)) { if (hi == 0) al_l[r32] = (a); asm volatile("s_waitcnt lgkmcnt(0)" ::: "memory"); \
    _Pragma("unroll") for (int d = 0; d < 4; ++d) _Pragma("unroll") for (int r = 0; r < 16; ++r) o[d][r] *= al_l[crow(r, hi)]; } } while (0)
  f32x16 pA0, pA1, pB0, pB1; float mnA, mnB, alA, alB; bf16x8 pa0, pa1, pa2, pa3; const int NT = seq / KVBLK;
  constexpr int SE = 0, SO = 1;
  SLOAD(SE, 0); asm volatile("s_waitcnt vmcnt(0)" ::: "memory"); SWRITE(0, SE); __syncthreads();
  qkt(pA0, pA1, K_lds, qr, r32, hi); partialSM(pA0, pA1, m_reg, mnA, alA);
  SLOAD(SO, KVBLK); if (2 < NT) SLOAD(SE, 2 * KVBLK);
  SWAIT(); SWRITE(1, SO); __syncthreads();
  for (int j = 1; j + 1 < NT; j += 2) {
    SBAR(); qkt(pB0, pB1, (bf16_t*)((char*)K_lds + SHM_K), qr, r32, hi);
    finishSM(pA0, pA1, alA, l_reg, pa0, pa1, pa2, pa3); SBAR();
    SLOAD(SO, (j + 2) * KVBLK); SBAR();
    pv_d0(o, vb0, pa0, pa1, pa2, pa3); partialSM(pB0, pB1, m_reg, mnB, alB);
    __syncthreads(); SWAIT(); SWRITE(0, SE);
    RESC(alB); __syncthreads();
    SBAR(); qkt(pA0, pA1, K_lds, qr, r32, hi);
    finishSM(pB0, pB1, alB, l_reg, pa0, pa1, pa2, pa3); SBAR();
    if (j + 3 < NT) SLOAD(SE, (j + 3) * KVBLK); SBAR();
    pv_d0(o, vb0 + (int)SHM_V, pa0, pa1, pa2, pa3); partialSM(pA0, pA1, m_reg, mnA, alA);
    __syncthreads(); SWAIT(); SWRITE(1, SO);
    RESC(alA); __syncthreads();
  }
  SBAR(); qkt(pB0, pB1, (bf16_t*)((char*)K_lds + SHM_K), qr, r32, hi);
  finishSM(pA0, pA1, alA, l_reg, pa0, pa1, pa2, pa3); SBAR();
  pv_d0(o, vb0, pa0, pa1, pa2, pa3); partialSM(pB0, pB1, m_reg, mnB, alB);
  __syncthreads(); RESC(alB);
  finishSM(pB0, pB1, alB, l_reg, pa0, pa1, pa2, pa3); SBAR();
  pv_d0(o, vb0 + (int)SHM_V, pa0, pa1, pa2, pa3);
  if (hi == 0) li_l[r32] = l_reg; asm volatile("s_waitcnt lgkmcnt(0)" ::: "memory");
  char* Ow = (char*)(Ob + (long)(wid * QBLK) * LDO); const char* Gw = (const char*)(AGb + (long)(wid * QBLK) * LDQ);
  unsigned hv = hi, cv = r32;
  asm volatile("" : "+v"(hv), "+v"(cv));
  const unsigned gbase = (hv * 4u * LDQ + cv) * 2u, obase = (hv * 4u * LDO + cv) * 2u;
#pragma unroll
  for (int r = 0; r < 16; ++r) { const int rc = (r & 3) + 8 * (r >> 2); const float rli = __builtin_amdgcn_rcpf(li_l[crow(r, hi)]);
    const unsigned go = gbase + (unsigned)(rc * LDQ * 2), oo = obase + (unsigned)(rc * LDO * 2);
    float g[4];
#pragma unroll
    for (int d0 = 0; d0 < 4; ++d0) g[d0] = bf2f(*(const bf16_t*)(Gw + go + d0 * 64));
#pragma unroll
    for (int d0 = 0; d0 < 4; ++d0) *(bf16_t*)(Ow + oo + d0 * 64) = f2bf(o[d0][r] * rli * siluf_(g[d0]));
    if ((r & 3) == 3) SBAR(); }
#undef SLOAD
#undef SWRITE
#undef SWAIT
#undef RESC
}
}

__device__ __forceinline__ void attn_phase(const Params& p, int l, char* lds) {
    unsigned char* ws = p.ws;
    const bf16_t* P = (const bf16_t*)(ws + WS_P); bf16_t* Acat = (bf16_t*)(ws + WS_ACAT);
    const int G = gridDim.x, nunits = 512 + (l < DEPTH - 1 ? 16 : 0);
    for (int U = blockIdx.x; U < nunits; U += G) {
        int h, qrow0, seq;
        if (U < 512) { int qb;
            if (G == 256) { const int xcd = U & 7, j = (U >> 3) & 31, r = U >> 8, kvh = xcd >> 1, idx = (xcd & 1) * 64 + r * 32 + j; h = kvh * 4 + (idx & 3); qb = idx >> 2; }
            else { h = U & 15; qb = U >> 4; }
            qrow0 = CTX + qb * 256; seq = ROWS; }
        else { h = U - 512; qrow0 = 0; seq = CTX; }
        const int kvh = h >> 2;
        att::attn_body(P + (size_t)qrow0 * INC + OQ + h * 128, (const bf16_t*)(ws + WS_KC) + (size_t)kvh * ROWS * 128, (const bf16_t*)(ws + WS_VC) + (size_t)kvh * ROWS * 128,
                       Acat + (size_t)qrow0 * CLD + h * 128, P + (size_t)qrow0 * INC + OAG + h * 128, seq, lds);
        __syncthreads();
    }
}

#define XB_TMO      128
#define XB_XCNT(j)  (256  + 64 * (j))
#define XB_XSUB(j)  (1280 + 64 * (j))
#define XB_XGEN(j)  (2304 + 64 * (j))
#define XB_TOP      3328
#define XB_TOPGEN   3392
#define XCD_BAR_WORDS 3456
#define XB_SPIN_CAP (1u << 18)

__device__ __forceinline__ unsigned xb_ld(unsigned* p)              { return __hip_atomic_load(p, __ATOMIC_RELAXED, __HIP_MEMORY_SCOPE_AGENT); }
__device__ __forceinline__ unsigned xb_add(unsigned* p, unsigned v) { return __hip_atomic_fetch_add(p, v, __ATOMIC_RELAXED, __HIP_MEMORY_SCOPE_AGENT); }
__device__ __forceinline__ unsigned xb_xcc_id() { return (unsigned)__builtin_amdgcn_s_getreg((3 << 11) | 20) & 0xFu; }
#define XB_SPIN(cond, bar) do { unsigned _sp = 0; while (cond) { __builtin_amdgcn_s_sleep(1); \
    if ((++_sp & 255u) == 0u) { if (xb_ld(&(bar)[XB_TMO])) break; if (_sp > XB_SPIN_CAP) { atomicAdd(&(bar)[XB_TMO], 1u); break; } } } } while (0)

struct XcdBarrier {
    unsigned* bar; unsigned x;
    volatile LAS unsigned* st;
};

__device__ __forceinline__ XcdBarrier xcd_barrier_post(unsigned* bar, volatile LAS unsigned* st) {
    XcdBarrier b; b.bar = bar; b.x = xb_xcc_id(); b.st = st;
    if (threadIdx.x == 0) (void)xb_add(&bar[XB_XCNT(b.x)], 1u);
    return b;
}
__device__ __forceinline__ void xcd_barrier_complete(unsigned* bar, unsigned x, unsigned& nloc, unsigned& nx) {
    const unsigned G = gridDim.x * gridDim.y * gridDim.z;
    unsigned sum, cnt, mine, sp = 0u;
    for (;;) {
        sum = 0u; cnt = 0u; mine = 0u;
#pragma unroll
        for (unsigned j = 0; j < 16; ++j) { const unsigned c = xb_ld(&bar[XB_XCNT(j)]); sum += c; cnt += (c > 0u) ? 1u : 0u; mine = (j == x) ? c : mine; }
        if (sum == G) break;
        __builtin_amdgcn_s_sleep(1);
        if ((++sp & 255u) == 0u) { if (xb_ld(&bar[XB_TMO])) break; if (sp > XB_SPIN_CAP) { atomicAdd(&bar[XB_TMO], 1u); break; } }
    }
    nloc = mine > 0u ? mine : 1u; nx = cnt > 0u ? cnt : 1u;
}

__device__ __forceinline__ void xcd_barrier(const XcdBarrier& b) {
    asm volatile("s_waitcnt vmcnt(0)" ::: "memory");
    __syncthreads();
    if (threadIdx.x == 0) {
        unsigned* bar = b.bar;
        __builtin_amdgcn_s_waitcnt(0);
        unsigned nloc = b.st[0], nx = b.st[1];
        if (nloc == 0u) { xcd_barrier_complete(bar, b.x, nloc, nx); b.st[0] = nloc; b.st[1] = nx; }
        const unsigned old = xb_add(&bar[XB_XSUB(b.x)], 1u);
        const unsigned gen = old / nloc;
        if (old + 1u == (gen + 1u) * nloc) {
            __builtin_amdgcn_fence(__ATOMIC_RELEASE, "agent");
            asm volatile("s_waitcnt vmcnt(0)" ::: "memory");
            const unsigned og = xb_add(&bar[XB_TOP], 1u);
            const unsigned tg = og / nx;
            if (og + 1u == (tg + 1u) * nx) xb_add(&bar[XB_TOPGEN], 1u);
            else XB_SPIN(xb_ld(&bar[XB_TOPGEN]) == tg, bar);
            __builtin_amdgcn_fence(__ATOMIC_ACQUIRE, "agent");
            xb_add(&bar[XB_XGEN(b.x)], 1u);
            asm volatile("s_waitcnt vmcnt(0)" ::: "memory");
        } else {
            XB_SPIN(xb_ld(&bar[XB_XGEN(b.x)]) == gen, bar);
            __builtin_amdgcn_fence(__ATOMIC_ACQUIRE, "agent");
            asm volatile("s_waitcnt vmcnt(0)" ::: "memory");
        }
    }
    __syncthreads();
}

__global__ void __launch_bounds__(NTHREADS, 2) mega_fwd(Params p0) {
    extern __shared__ __attribute__((aligned(16))) unsigned char lds[];
    cg::grid_group grid = cg::this_grid();
    volatile LAS unsigned* misc = (volatile LAS unsigned*)((LAS unsigned char*)lds + LDS_STAGE);
    if (threadIdx.x < 16) misc[threadIdx.x] = 0u;
    __syncthreads();
    (void)xcd_barrier_post((unsigned*)(p0.ws + WS_BAR), misc);
#ifndef PHASE_MASK
#define PHASE_MASK 0xFFFF
#endif
#define PH(b) if constexpr ((PHASE_MASK >> (b)) & 1)
#ifndef DBL_MASK
#define DBL_MASK 0
#endif
    PH(10) prep_phase(p0, lds);
    __syncthreads();
    if constexpr ((DBL_MASK >> 10) & 1) { prep_phase(p0, lds); __syncthreads(); }
    grid.sync();
#pragma unroll 1
    for (int l = 0; l < DEPTH; ++l) {
#pragma unroll 1
        for (int slot = 0; slot < 12; ++slot) {
            Params p = p0;
            { unsigned char* w = p.ws; asm volatile("" : "+s"(w)); p.ws = w; }
            bool sync = true;
            LAS unsigned char* L = (LAS unsigned char*)lds;
            const int reps = ((DBL_MASK >> slot) & 1) ? 2 : 1;
#pragma unroll 1
            for (int rep = 0; rep < reps; ++rep) {
            if (rep) __syncthreads();
            switch (slot) {
            case 0: rownorm_phase(p, l); sync = false; break;
            case 1: if (l == 0) gemm_phase(L, G_FOLD, l, p.ws); break;
            case 2: gemm_phase(L, G_IN, l, p.ws); sync = false; break;
            case 3: gemm_phase(L, G_XT, l, p.ws); break;
            case 4: gemm_phase(L, G_F1, l, p.ws); sync = false; break;
            case 5: gemm_phase(L, G_DFTC, l, p.ws); break;
            case 6: ew_phase(p, l); break;
            case 7: case 8: sync = false; break;
            case 9: {
                const int cb = (int)blockIdx.x, Gn = (int)gridDim.x;
                unsigned* c2 = (unsigned*)(p.ws + WS_BAR) + 3540;
                const unsigned target = (unsigned)(Gn - 148) * (unsigned)(l + 1);
                if (cb >= 16 && cb < Gn - 132) {
                    gemm_phase(L, G_F2, l, p.ws);
                    __syncthreads();
                    if (threadIdx.x == 0) { __builtin_amdgcn_fence(__ATOMIC_RELEASE, "agent"); asm volatile("s_waitcnt vmcnt(0)" ::: "memory");
                        __hip_atomic_fetch_add(c2, 1u, __ATOMIC_RELAXED, __HIP_MEMORY_SCOPE_AGENT); }
                    __syncthreads();
                }
                attn_phase(p, l, (char*)lds);
                __syncthreads();
                if (cb >= Gn - 132) {
                    if (threadIdx.x == 0) { unsigned sp = 0;
                        while (__hip_atomic_load(c2, __ATOMIC_RELAXED, __HIP_MEMORY_SCOPE_AGENT) < target) { __builtin_amdgcn_s_sleep(1); if (++sp > (1u << 22)) break; }
                        __builtin_amdgcn_fence(__ATOMIC_ACQUIRE, "agent"); asm volatile("s_waitcnt vmcnt(0)" ::: "memory"); }
                    __syncthreads();
                    gemm_phase(L, G_MIX, l, p.ws);
                }
                break; }
            case 10: gemm_phase(L, G_MERGE, l, p.ws); __syncthreads(); gemm_phase(L, G_MERGEC, l, p.ws); break;
            default: {
                const bool hasctx = l < DEPTH - 1;
                unsigned* ccnt = (unsigned*)(p.ws + WS_BAR) + 3500;
                if (hasctx) {
                    int t0_ = threadIdx.x; asm volatile("" : "+v"(t0_));
                    const int idx = (int)blockIdx.x * NTHREADS + t0_, r = idx >> 9, cc = (idx & 511) * 4;
                    const float* mp = (const float*)(p.ws + WS_MP); bf16_t* mb = (bf16_t*)(p.ws + WS_MB);
                    f32x4 s = *(const f32x4*)(mp + (size_t)r * MLD + cc);
#pragma unroll
                    for (int q = 1; q < 8; ++q) s += *(const f32x4*)(mp + ((size_t)q * CTX + r) * MLD + cc);
                    u32x2 w; w.x = cvtpk(s[0], s[1]); w.y = cvtpk(s[2], s[3]); *(u32x2*)(mb + (size_t)r * DM + cc) = w;
                    asm volatile("s_waitcnt vmcnt(0)" ::: "memory"); __syncthreads();
                    if (threadIdx.x == 0) { __builtin_amdgcn_fence(__ATOMIC_RELEASE, "agent"); asm volatile("s_waitcnt vmcnt(0)" ::: "memory");
                        __hip_atomic_fetch_add(ccnt, 1u, __ATOMIC_RELAXED, __HIP_MEMORY_SCOPE_AGENT); }
                }
                const int nv = (hasctx && (int)blockIdx.x >= (int)gridDim.x - 32) ? 2 : 1;
#pragma unroll 1
                for (int v = 0; v < nv; ++v) {
                    if (v) {
                        __syncthreads();
                        if (threadIdx.x == 0) { const unsigned target = (unsigned)(l + 1) * gridDim.x; unsigned sp = 0;
                            while (__hip_atomic_load(ccnt, __ATOMIC_RELAXED, __HIP_MEMORY_SCOPE_AGENT) < target) { __builtin_amdgcn_s_sleep(1); if (++sp > (1u << 22)) break; }
                            __builtin_amdgcn_fence(__ATOMIC_ACQUIRE, "agent"); asm volatile("s_waitcnt vmcnt(0)" ::: "memory"); }
                        __syncthreads();
                    }
                    gemm_phase(L, G_OUT, l | (v << 4), p.ws);
                }
                break; }
            }
            }
            __syncthreads();
            if (sync) { XcdBarrier xb; xb.bar = (unsigned*)(p.ws + WS_BAR); xb.x = xb_xcc_id(); xb.st = (volatile LAS unsigned*)((LAS unsigned char*)lds + LDS_STAGE); xcd_barrier(xb); }
        }
    }
    PH(0) rownorm_phase(p0, DEPTH);
}

extern "C" void kernel_launch(void* const* d_in, const int* in_sizes, int n_in, void* d_out, int out_size, void* d_ws, size_t ws_size, hipStream_t stream) {
    static int grid_blocks = 0;
    if (grid_blocks == 0) {
        if (n_in != 18 || out_size != SEQ * DM || ws_size < WS_END) { fprintf(stderr, "kernel_launch: unexpected shapes: n_in %d out %d ws %zu (need %zu)\n", n_in, out_size, ws_size, (size_t)WS_END); grid_blocks = -1; return; }
        int dev = 0, cus = 0, per_cu = 0;
        hipGetDevice(&dev);
        hipDeviceGetAttribute(&cus, hipDeviceAttributeMultiprocessorCount, dev);
        if (hipFuncSetAttribute((const void*)mega_fwd, hipFuncAttributeMaxDynamicSharedMemorySize, LDS_BYTES) != hipSuccess) { fprintf(stderr, "kernel_launch: hipFuncSetAttribute failed\n"); grid_blocks = -1; return; }
        if (hipOccupancyMaxActiveBlocksPerMultiprocessor(&per_cu, (const void*)mega_fwd, NTHREADS, LDS_BYTES) != hipSuccess || per_cu < 1) { fprintf(stderr, "kernel_launch: occupancy query gave %d\n", per_cu); per_cu = 1; }
        (void)hipGetLastError();
        grid_blocks = cus * (per_cu > 1 ? 1 : per_cu);
        if (grid_blocks > 256) grid_blocks = 256;
        grid_blocks &= ~7;
        if (grid_blocks != 256) { fprintf(stderr, "kernel_launch: this kernel is laid out for 256 resident workgroups, got %d\n", grid_blocks); grid_blocks = -1; return; }
    }
    if (grid_blocks <= 0) return;
    Params p{};
    for (int i = 0; i < 18; ++i) p.in[i] = (const float*)d_in[i];
    p.out = (float*)d_out; p.ws = (unsigned char*)d_ws;
    if (hipMemsetAsync((char*)d_ws + WS_BAR, 0, BAR_BYTES, stream) != hipSuccess) { fprintf(stderr, "kernel_launch: memset of barrier words failed\n"); return; }
    void* args[] = {&p};
    hipError_t e = hipLaunchCooperativeKernel((const void*)mega_fwd, dim3(grid_blocks), dim3(NTHREADS), args, LDS_BYTES, stream);
    if (e != hipSuccess) fprintf(stderr, "cooperative launch failed: %s (grid %d)\n", hipGetErrorString(e), grid_blocks);
}
```

```cpp
#include <hip/hip_runtime.h>
#include <hip/hip_cooperative_groups.h>
#include <cstdio>
#include <cstdint>
namespace cg = cooperative_groups;

#define LAS __attribute__((address_space(3)))
typedef unsigned short bf16_t;
typedef short bf16x8 __attribute__((ext_vector_type(8)));
typedef short s16x4 __attribute__((ext_vector_type(4)));
typedef float f32x4 __attribute__((ext_vector_type(4)));
typedef float f32x16 __attribute__((ext_vector_type(16)));
typedef unsigned u32x4 __attribute__((ext_vector_type(4)));
typedef unsigned u32x2 __attribute__((ext_vector_type(2)));

constexpr int DM = 2048, SEQ = 8192, CTX = 256, ROWS = SEQ + CTX, DEPTH = 4, INC = 17408;
constexpr int OQ = 0, OKK = 2048, OV = 2560, OAG = 3072, OFX = 5120, OFG = 6144, OCX = 7168, OCB = 8192, OCC = 9216, OCG = 10240, OML = 11264;
constexpr float EPS = 1e-6f;
constexpr size_t APL = (size_t)(SEQ + CTX) * 2048, WPL = (size_t)2048 * 2048;
constexpr int CLD = 2048;
constexpr int MLD = 2048 + 64;
constexpr int ZCH = 32768 + 256;
constexpr int LDS_STAGE = 131072, LDS_BYTES = LDS_STAGE + 64;
constexpr int NTHREADS = 512;

constexpr size_t SZ_WINT = (size_t)INC * DM * 2, SZ_WCAT = 3 * WPL * 2, SZ_WOUT = (size_t)DM * DM * 2, SZ_WMIXR = (size_t)1024 * 1024 * 2, SZ_WMIX = (size_t)1024 * 2048 * 2;
constexpr size_t WS_WINT = 0;
constexpr size_t WS_WCAT = WS_WINT + DEPTH * SZ_WINT;
constexpr size_t WS_WOUT = WS_WCAT + DEPTH * SZ_WCAT;
constexpr size_t WS_WMIXR = WS_WOUT + DEPTH * SZ_WOUT;
constexpr size_t WS_WMIX = WS_WMIXR + DEPTH * SZ_WMIXR;
constexpr size_t WS_TCH = WS_WMIX + DEPTH * SZ_WMIX;
constexpr size_t WS_ZT = WS_TCH + 512 * 256 * 2;
constexpr size_t WS_T1 = WS_ZT + (size_t)1024 * ZCH;
constexpr size_t WS_A2 = WS_T1 + 256 * 128 * 2;
constexpr size_t WS_ACTX = WS_A2 + 256 * 256 * 2;
constexpr size_t WS_ROPE = WS_ACTX + 512 * 256 * 2;
constexpr size_t WS_MOD = WS_ROPE + 128 * 32 * 8;
constexpr size_t WS_XS = WS_MOD + 4 * 2 * 6144 * 4;
constexpr size_t WS_H = WS_XS + (size_t)ROWS * DM * 4;
constexpr size_t WS_P = WS_H + (size_t)ROWS * DM * 2;
constexpr size_t WS_XT = WS_P + (size_t)ROWS * INC * 2;
constexpr size_t WS_PQ = WS_XT + (size_t)1024 * ROWS * 2;
constexpr size_t WS_ACAT = WS_PQ + (size_t)ROWS * DM * 2;
constexpr size_t WS_MBUF = WS_ACAT + 3 * APL * 2;
constexpr size_t WS_MB = WS_MBUF + (size_t)ROWS * MLD * 4;
constexpr size_t WS_OUTB = WS_MB + (size_t)ROWS * DM * 2;
constexpr size_t WS_KC = WS_OUTB + (size_t)ROWS * DM * 4;
constexpr size_t WS_VC = WS_KC + (size_t)4 * ROWS * 128 * 2;
constexpr size_t WS_MP = WS_VC + (size_t)4 * ROWS * 128 * 2;
constexpr size_t WS_OUTP = WS_MP + (size_t)8 * CTX * MLD * 4;
constexpr size_t WS_BAR = WS_OUTP + (size_t)4 * CTX * DM * 4;
constexpr size_t BAR_BYTES = 16384;
constexpr size_t WS_END = WS_BAR + BAR_BYTES;

struct Params { const float* in[18]; float* out; unsigned char* ws; };
enum { I_X = 0, I_C, I_CTX, I_CCTX, I_WMOD, I_BMOD, I_GPRE, I_GPOST, I_WIN, I_QN, I_KN, I_WAO, I_WFM, I_WFO, I_CW, I_CB, I_WCO, I_WOUT };

__device__ __forceinline__ unsigned cvtpk(float lo, float hi) { unsigned r; asm volatile("v_cvt_pk_bf16_f32 %0, %1, %2" : "=v"(r) : "v"(lo), "v"(hi)); return r; }
__device__ __forceinline__ float bf2f(unsigned short b) { return __uint_as_float(((unsigned)b) << 16); }
__device__ __forceinline__ float bflo(unsigned w) { return __uint_as_float(w << 16); }
__device__ __forceinline__ float bfhi(unsigned w) { return __uint_as_float(w & 0xffff0000u); }
__device__ __forceinline__ unsigned short f2bf(float f) { return (unsigned short)(cvtpk(f, f) & 0xffffu); }
__device__ __forceinline__ float sigmoidf_(float x) { return __builtin_amdgcn_rcpf(1.0f + __expf(-x)); }
__device__ __forceinline__ float siluf_(float x) { return x * sigmoidf_(x); }
__device__ __forceinline__ float wave_sum(float v) {
#pragma unroll
    for (int o = 32; o >= 1; o >>= 1) v += __shfl_xor(v, o);
    return v;
}

__device__ __forceinline__ void prep_phase(const Params& p, unsigned char* lds_g) {
    int tid_ = threadIdx.x; asm volatile("" : "+v"(tid_));
    const int tid = tid_, G = gridDim.x, bid = blockIdx.x;
    unsigned char* ws = p.ws;
    float* tile = (float*)lds_g;
    constexpr int T_IN = 32 * 272, T_AO = 32 * 32, T_FO = 16 * 32, T_CO = 16 * 32, T_OUT = 32 * 32, T_MIX = 16 * 16;
    constexpr int T_LAYER = T_IN + T_AO + T_FO + T_CO + T_OUT + T_MIX;
    for (int t = bid; t < DEPTH * T_LAYER; t += G) {
        const int l = t / T_LAYER; int r = t % T_LAYER;
        const float* src; int ldsrc; bf16_t* dst; int lddst; int ktiles;
        if (r < T_IN) { src = p.in[I_WIN] + (size_t)l * DM * INC; ldsrc = INC; dst = (bf16_t*)(ws + WS_WINT + l * SZ_WINT); lddst = DM; ktiles = 32; }
        else if ((r -= T_IN) < T_AO) { src = p.in[I_WAO] + (size_t)l * DM * DM; ldsrc = DM; dst = (bf16_t*)(ws + WS_WCAT + l * SZ_WCAT); lddst = CLD; ktiles = 32; }
        else if ((r -= T_AO) < T_FO) { src = p.in[I_WFO] + (size_t)l * 1024 * DM; ldsrc = DM; dst = (bf16_t*)(ws + WS_WCAT + l * SZ_WCAT) + WPL; lddst = CLD; ktiles = 16; }
        else if ((r -= T_FO) < T_CO) { src = p.in[I_WCO] + (size_t)l * 1024 * DM; ldsrc = DM; dst = (bf16_t*)(ws + WS_WCAT + l * SZ_WCAT) + 2 * WPL; lddst = CLD; ktiles = 16; }
        else if ((r -= T_CO) < T_OUT) { src = p.in[I_WOUT] + (size_t)l * DM * DM; ldsrc = DM; dst = (bf16_t*)(ws + WS_WOUT + l * SZ_WOUT); lddst = DM; ktiles = 32; }
        else { r -= T_OUT; src = p.in[I_WFM] + (size_t)l * 1024 * 1024; ldsrc = 1024; dst = (bf16_t*)(ws + WS_WMIXR + l * SZ_WMIXR); lddst = 1024; ktiles = 16; }
        const int k0 = (r % ktiles) * 64, n0 = (r / ktiles) * 64;
        { const int ty = tid >> 4, tx = tid & 15;
#pragma unroll
          for (int ps = 0; ps < 2; ++ps) { const int kk = ty + 32 * ps;
              const f32x4 v = *(const f32x4*)(src + (size_t)(k0 + kk) * ldsrc + n0 + tx * 4);
              tile[kk * 65 + tx * 4 + 0] = v[0]; tile[kk * 65 + tx * 4 + 1] = v[1]; tile[kk * 65 + tx * 4 + 2] = v[2]; tile[kk * 65 + tx * 4 + 3] = v[3]; } }
        __syncthreads();
        { const int n = tid >> 3, kc = (tid & 7) * 8; u32x4 w;
          w.x = cvtpk(tile[(kc + 0) * 65 + n], tile[(kc + 1) * 65 + n]); w.y = cvtpk(tile[(kc + 2) * 65 + n], tile[(kc + 3) * 65 + n]);
          w.z = cvtpk(tile[(kc + 4) * 65 + n], tile[(kc + 5) * 65 + n]); w.w = cvtpk(tile[(kc + 6) * 65 + n], tile[(kc + 7) * 65 + n]);
          *(u32x4*)(dst + (size_t)(n0 + n) * lddst + k0 + kc) = w; }
        __syncthreads();
    }
    {
        float* sc = (float*)lds_g;
        float* red = sc + 4096;
        for (int u = bid; u < 256; u += G) {
            for (int k = tid; k < 4096; k += NTHREADS) { const float cv = (k < 2048) ? p.in[I_C][k] : p.in[I_CCTX][k - 2048]; sc[k] = siluf_(cv); }
            __syncthreads();
            const int l = u >> 6, j0 = (u & 63) * 96;
            if (tid < 504) { const int kg = tid / 24, cq = tid % 24;
                f32x4 al = {0.f, 0.f, 0.f, 0.f}, ac = {0.f, 0.f, 0.f, 0.f};
                const float* wp = p.in[I_WMOD] + (size_t)l * DM * 6144 + j0 + cq * 4;
                for (int k = kg; k < 2048; k += 21) { const f32x4 w = *(const f32x4*)(wp + (size_t)k * 6144); al += sc[k] * w; ac += sc[2048 + k] * w; }
                float* rp = red + (kg * 24 + cq) * 8;
                rp[0] = al[0]; rp[1] = al[1]; rp[2] = al[2]; rp[3] = al[3]; rp[4] = ac[0]; rp[5] = ac[1]; rp[6] = ac[2]; rp[7] = ac[3]; }
            __syncthreads();
            if (tid < 192) { const int v = tid / 96, col = tid % 96, cq = col >> 2, e = col & 3; float s = 0.f;
                for (int kg = 0; kg < 21; ++kg) s += red[(kg * 24 + cq) * 8 + v * 4 + e];
                ((float*)(ws + WS_MOD))[(size_t)(l * 2 + v) * 6144 + j0 + col] = s + p.in[I_BMOD][(size_t)l * 6144 + j0 + col]; }
            __syncthreads();
        }
    }
    const long gt = (long)bid * NTHREADS + tid, gn = (long)G * NTHREADS;
    for (long it = gt; it < 256 * 16; it += gn) { const int r = (int)(it >> 4), s0 = (int)(it & 15) * 8, k1 = r >> 1, ri = r & 1;
        float v[8];
#pragma unroll
        for (int j = 0; j < 8; ++j) { const int ph = (k1 * (s0 + j)) & 127; const float x = (float)ph * (1.0f / 128.0f); v[j] = (ri ? -__builtin_amdgcn_sinf(x) : __builtin_amdgcn_cosf(x)) * 0.08838834764831845f; }
        u32x4 w; w.x = cvtpk(v[0], v[1]); w.y = cvtpk(v[2], v[3]); w.z = cvtpk(v[4], v[5]); w.w = cvtpk(v[6], v[7]);
        *(u32x4*)((bf16_t*)(ws + WS_T1) + (size_t)r * 128 + s0) = w; }
    for (long it = gt; it < 256 * 32; it += gn) { const int rr = (int)(it >> 5), c0 = (int)(it & 31) * 8, kb = rr >> 7, pq = (rr >> 6) & 1, k2 = rr & 63;
        float v[8];
#pragma unroll
        for (int j = 0; j < 8; ++j) { const int cc = c0 + j, s2 = cc >> 2, kbc = (cc >> 1) & 1, ri = cc & 1;     const int ph = (k2 * s2) & 63; const float x = (float)ph * (1.0f / 64.0f);
            const float cs = __builtin_amdgcn_cosf(x), sn = __builtin_amdgcn_sinf(x);
            const float val = pq == 0 ? (ri == 0 ? cs : sn) : (ri == 0 ? sn : -cs);
            v[j] = (kb == kbc) ? val * 0.125f : 0.f; }
        u32x4 w; w.x = cvtpk(v[0], v[1]); w.y = cvtpk(v[2], v[3]); w.z = cvtpk(v[4], v[5]); w.w = cvtpk(v[6], v[7]);
        *(u32x4*)((bf16_t*)(ws + WS_A2) + (size_t)rr * 256 + c0) = w; }
    for (long it = gt; it < 2 * 512 * 32; it += gn) { const int which = (int)(it >> 14), rr = (int)(it & 16383), r = rr >> 5, s0 = (rr & 31) * 8, k = r & 255; const bool isin = r >= 256;
        bf16_t* A = (bf16_t*)(ws + (which ? WS_TCH : WS_ACTX)); const float sgn = (which && isin) ? -0.0625f : 0.0625f;
        float v[8];
#pragma unroll
        for (int j = 0; j < 8; ++j) { const int ph = (k * (s0 + j)) & 255; const float x = (float)ph * (1.0f / 256.0f); v[j] = (isin ? __builtin_amdgcn_sinf(x) : __builtin_amdgcn_cosf(x)) * sgn; }
        u32x4 w; w.x = cvtpk(v[0], v[1]); w.y = cvtpk(v[2], v[3]); w.z = cvtpk(v[4], v[5]); w.w = cvtpk(v[6], v[7]);
        *(u32x4*)(A + (size_t)r * 256 + s0) = w; }
    for (long it = gt; it < 128 * 32; it += gn) { const int pos = (int)(it >> 5), i = (int)(it & 31);
        const float freq = exp2f(-(float)i * (13.287712379549449f / 32.0f));
        const float ang = (float)pos * freq;
        double rev = (double)ang * 0.15915494309189535; rev -= floor(rev);
        const float xr = (float)rev;
        float2 cs; cs.x = __builtin_amdgcn_cosf(xr); cs.y = __builtin_amdgcn_sinf(xr);
        ((float2*)(ws + WS_ROPE))[it] = cs; }
    { f32x4* xs = (f32x4*)(ws + WS_XS); const f32x4* cx = (const f32x4*)p.in[I_CTX]; const f32x4* xx = (const f32x4*)p.in[I_X];
      const long nc = (long)CTX * DM / 4, nt = (long)ROWS * DM / 4;
      for (long it = gt; it < nt; it += gn) xs[it] = (it < nc) ? cx[it] : xx[it - nc]; }
}

__device__ __forceinline__ void rownorm_phase(const Params& p, int l) {
    int tid_ = threadIdx.x; asm volatile("" : "+v"(tid_));
    const int tid = tid_, lane = tid & 63, wid = tid >> 6;
    unsigned char* ws = p.ws;
    const int gw = blockIdx.x * 8 + wid, nw = gridDim.x * 8;
    const float* mod = (const float*)(ws + WS_MOD);
    for (int row = gw; row < ROWS; row += nw) {
        const int isctx = row < CTX ? 1 : 0;
        if (l == 4 && isctx) continue;
        float* xrow = (float*)(ws + WS_XS) + (size_t)row * DM;
        f32x4 xv[8];
#pragma unroll
        for (int i = 0; i < 8; ++i) xv[i] = *(const f32x4*)(xrow + lane * 4 + i * 256);
        if (l > 0) {
            const float* orow = (const float*)(ws + WS_OUTB) + (size_t)row * DM;
            f32x4 ov[8]; float ss = 0.f;
#pragma unroll
            for (int i = 0; i < 8; ++i) {
                if (isctx) { const float* pp = (const float*)(ws + WS_OUTP) + (size_t)row * DM + lane * 4 + i * 256;
                    ov[i] = (*(const f32x4*)pp + *(const f32x4*)(pp + (size_t)CTX * DM)) + (*(const f32x4*)(pp + (size_t)2 * CTX * DM) + *(const f32x4*)(pp + (size_t)3 * CTX * DM)); }
                else ov[i] = *(const f32x4*)(orow + lane * 4 + i * 256);
                ss += ov[i][0] * ov[i][0] + ov[i][1] * ov[i][1] + ov[i][2] * ov[i][2] + ov[i][3] * ov[i][3]; }
            ss = wave_sum(ss);
            const float rstd = rsqrtf(ss * (1.0f / DM) + EPS);
            const float* gate = mod + (size_t)((l - 1) * 2 + isctx) * 6144 + 4096;
            const float* gpost = p.in[I_GPOST] + (size_t)(l - 1) * DM;
#pragma unroll
            for (int i = 0; i < 8; ++i) { const f32x4 g = *(const f32x4*)(gate + lane * 4 + i * 256), gp = *(const f32x4*)(gpost + lane * 4 + i * 256);
                xv[i] = xv[i] + g * ((ov[i] * rstd) * gp); }
            if (l == 4) { float* orow2 = p.out + (size_t)(row - CTX) * DM;
#pragma unroll
                for (int i = 0; i < 8; ++i) *(f32x4*)(orow2 + lane * 4 + i * 256) = xv[i];
                continue; }
#pragma unroll
            for (int i = 0; i < 8; ++i) *(f32x4*)(xrow + lane * 4 + i * 256) = xv[i];
        }
        float ss = 0.f;
#pragma unroll
        for (int i = 0; i < 8; ++i) ss += xv[i][0] * xv[i][0] + xv[i][1] * xv[i][1] + xv[i][2] * xv[i][2] + xv[i][3] * xv[i][3];
        ss = wave_sum(ss);
        const float rstd = rsqrtf(ss * (1.0f / DM) + EPS);
        const float* ml = mod + (size_t)(l * 2 + isctx) * 6144;
        const float* gpre = p.in[I_GPRE] + (size_t)l * DM;
        bf16_t* hrow = (bf16_t*)(ws + WS_H) + (size_t)row * DM;
#pragma unroll
        for (int i = 0; i < 8; ++i) { const int c = lane * 4 + i * 256;
            const f32x4 sh = *(const f32x4*)(ml + c), scl = *(const f32x4*)(ml + 2048 + c), gp = *(const f32x4*)(gpre + c);
            const f32x4 hv = ((xv[i] * rstd) * gp) * (1.0f + scl) + sh;
            u32x2 w; w.x = cvtpk(hv[0], hv[1]); w.y = cvtpk(hv[2], hv[3]);
            *(u32x2*)(hrow + c) = w; }
    }
}

__device__ __forceinline__ void ew_phase(const Params& p, int l) {
    int tid_ = threadIdx.x; asm volatile("" : "+v"(tid_));
    const int tid = tid_;
    unsigned char* ws = p.ws;
    bf16_t* P = (bf16_t*)(ws + WS_P);
    {
        const int t = tid & 15; const long grp = ((long)blockIdx.x * NTHREADS + tid) >> 4, ngrp = (long)gridDim.x * NTHREADS / 16;
        const float2* rope = (const float2*)(ws + WS_ROPE);
        const int base = ((t & 8) ? 64 : 0) + 4 * (t & 7), fi = 4 * (t & 7);
        bf16_t* KC = (bf16_t*)(ws + WS_KC);
#pragma unroll 2
        for (long it = grp; it < (long)ROWS * 20; it += ngrp) { const int row = (int)(it / 20), head = (int)(it % 20);
            const bf16_t* src_ = P + (size_t)row * INC + (head < 16 ? OQ + head * 128 : OKK + (head - 16) * 128) + base;
            bf16_t* dst_ = (head < 16) ? (P + (size_t)row * INC + OQ + head * 128 + base) : (KC + ((size_t)(head - 16) * ROWS + row) * 128 + base);
            const float* gn = (head < 16 ? p.in[I_QN] : p.in[I_KN]) + (size_t)l * 128 + base;
            const u32x2 wa = *(const u32x2*)src_, wb = *(const u32x2*)(src_ + 32);
            const f32x4 ga = *(const f32x4*)gn, gb = *(const f32x4*)(gn + 32);
            float a[4] = {bflo(wa.x), bfhi(wa.x), bflo(wa.y), bfhi(wa.y)}, b[4] = {bflo(wb.x), bfhi(wb.x), bflo(wb.y), bfhi(wb.y)};
            float ss = 0.f;
#pragma unroll
            for (int q = 0; q < 4; ++q) ss += a[q] * a[q] + b[q] * b[q];
#pragma unroll
            for (int o = 8; o >= 1; o >>= 1) ss += __shfl_xor(ss, o);
            const float rstd = rsqrtf(ss * (1.0f / 128.0f) + EPS);
#pragma unroll
            for (int q = 0; q < 4; ++q) { a[q] = a[q] * rstd * ga[q]; b[q] = b[q] * rstd * gb[q]; }
            if (row >= CTX) { const int tk = row - CTX, pos = (t & 8) ? (tk & 63) : (tk >> 6);
                const f32x4 r01 = *(const f32x4*)(rope + pos * 32 + fi), r23 = *(const f32x4*)(rope + pos * 32 + fi + 2);
                const float cs[4] = {r01[0], r01[2], r23[0], r23[2]}, sn[4] = {r01[1], r01[3], r23[1], r23[3]};
#pragma unroll
                for (int q = 0; q < 4; ++q) { const float x0 = a[q], x1 = b[q]; a[q] = x0 * cs[q] - x1 * sn[q]; b[q] = x0 * sn[q] + x1 * cs[q]; } }
            u32x2 oa, ob; oa.x = cvtpk(a[0], a[1]); oa.y = cvtpk(a[2], a[3]); ob.x = cvtpk(b[0], b[1]); ob.y = cvtpk(b[2], b[3]);
            *(u32x2*)dst_ = oa; *(u32x2*)(dst_ + 32) = ob;
        }
    }
    {
        const long gt = (long)blockIdx.x * NTHREADS + tid, gn = (long)gridDim.x * NTHREADS;
        bf16_t* VC = (bf16_t*)(ws + WS_VC);
        for (long it = gt; it < (long)ROWS * 64; it += gn) { const int row = (int)(it >> 6), c = (int)(it & 63) * 8;
            const u32x4 v = *(const u32x4*)(P + (size_t)row * INC + OV + c);
            *(u32x4*)(VC + ((size_t)(c >> 7) * ROWS + row) * 128 + (c & 127)) = v; }
    }
    {
        const long gt = (long)blockIdx.x * NTHREADS + tid, gn = (long)gridDim.x * NTHREADS;
        bf16_t* Acat = (bf16_t*)(ws + WS_ACAT);
        const float* cw = p.in[I_CW] + (size_t)l * 3 * 1024; const float* cbias = p.in[I_CB] + (size_t)l * 1024;
        for (long it = gt; it < (long)(ROWS / 4) * 128; it += gn) { const int row0 = (int)(it >> 7) * 4, c0 = (int)(it & 127) * 8;
            const bf16_t* pr = P + (size_t)row0 * INC;
            const bool hp = (row0 != 0) && (row0 != CTX), hn = (row0 + 4 != CTX) && (row0 + 4 != ROWS);
            const u32x4 z = {0u, 0u, 0u, 0u};
            u32x4 xv[6], kv[6], bb[4], gg[4];
            xv[0] = hp ? *(const u32x4*)(pr - INC + OCX + c0) : z; kv[0] = hp ? *(const u32x4*)(pr - INC + OCC + c0) : z;
#pragma unroll
            for (int r = 0; r < 4; ++r) { xv[r + 1] = *(const u32x4*)(pr + (size_t)r * INC + OCX + c0); kv[r + 1] = *(const u32x4*)(pr + (size_t)r * INC + OCC + c0);
                bb[r] = *(const u32x4*)(pr + (size_t)r * INC + OCB + c0); gg[r] = *(const u32x4*)(pr + (size_t)r * INC + OCG + c0); }
            xv[5] = hn ? *(const u32x4*)(pr + (size_t)4 * INC + OCX + c0) : z; kv[5] = hn ? *(const u32x4*)(pr + (size_t)4 * INC + OCC + c0) : z;
            float w0[8], w1[8], w2[8], bs[8];
#pragma unroll
            for (int j = 0; j < 8; ++j) { w0[j] = cw[c0 + j]; w1[j] = cw[1024 + c0 + j]; w2[j] = cw[2048 + c0 + j]; bs[j] = cbias[c0 + j]; }
            float uu[6][8];
#pragma unroll
            for (int r = 0; r < 6; ++r)
#pragma unroll
                for (int q = 0; q < 4; ++q) { uu[r][2 * q] = bflo(xv[r][q]) * bflo(kv[r][q]); uu[r][2 * q + 1] = bfhi(xv[r][q]) * bfhi(kv[r][q]); }
#pragma unroll
            for (int r = 0; r < 4; ++r) { float res[8];
#pragma unroll
                for (int q = 0; q < 4; ++q) {
                    { const int j = 2 * q; const float cv = uu[r][j] * w0[j] + uu[r + 1][j] * w1[j] + uu[r + 2][j] * w2[j] + bs[j]; res[j] = bflo(bb[r][q]) * cv * siluf_(bflo(gg[r][q])); }
                    { const int j = 2 * q + 1; const float cv = uu[r][j] * w0[j] + uu[r + 1][j] * w1[j] + uu[r + 2][j] * w2[j] + bs[j]; res[j] = bfhi(bb[r][q]) * cv * siluf_(bfhi(gg[r][q])); } }
                u32x4 w; w.x = cvtpk(res[0], res[1]); w.y = cvtpk(res[2], res[3]); w.z = cvtpk(res[4], res[5]); w.w = cvtpk(res[6], res[7]);
                *(u32x4*)(Acat + 2 * APL + (size_t)(row0 + r) * CLD + c0) = w; }
        }
    }
}

constexpr int BM = 256, BK = 64, HALF = 128, HTB = HALF * BK * 2;
constexpr int BJC = 32;
__device__ __forceinline__ int lds_byte(int r, int c) { const int st = (r >> 4) * 2 + (c >> 5), rr = r & 15, cc = c & 31, ob = rr * 64 + cc * 2; return st * 1024 + (ob ^ (((ob >> 9) & 1) << 5)); }
__device__ __forceinline__ void stage_rc(int b, int& R, int& C) { const int st = b / 1024, sb = b % 1024, swz = sb ^ (((sb >> 9) & 1) << 5); R = (st >> 1) * 16 + swz / 64; C = (st & 1) * 32 + (swz % 64) / 2; }
__device__ __forceinline__ int perm32(int rho) { const int n = rho >> 4, i = rho & 15; return 8 * (i >> 2) + 4 * n + (i & 3); }

enum { G_FOLD = 0, G_IN, G_XT, G_F1, G_F2, G_DFTC, G_MIX, G_MERGE, G_OUT, G_MERGEC };
enum { M_BF16 = 0, M_MIX, M_MERGE0, M_MERGE1, M_MERGE2, M_F32, M_F1, M_F2, M_MG0, M_MG1, M_MG2 };
struct Unit { const char* a; const char* b; char* o; const char* aux; char* m; int nt, mode, ldo; };

__device__ __forceinline__ void static_order(int w, int nM, int nN, int& pm, int& pn) {
    const int nwg = nM * nN, q = nwg / 8, r = nwg % 8, xcd = w % 8, off = w / 8;
    const int wg = (xcd < r ? xcd * (q + 1) : r * (q + 1) + (xcd - r) * q) + off;
    const int nig = 8 * nN, gid = wg / nig, fm = gid * 8, gsz = (nM - fm) < 8 ? (nM - fm) : 8;
    pm = fm + ((wg % nig) % gsz); pn = (wg % nig) / gsz;
}

__device__ __forceinline__ bool get_unit(int gid, int l, int i, unsigned char* ws, Unit& u) {
    const int G = gridDim.x, c = blockIdx.x;
    u.aux = nullptr; u.m = nullptr;
    switch (gid) {
    case G_FOLD: { const int L = i * G + c; if (L >= 128) return false;
        const int ll = L >> 5, g = (L >> 3) & 3, pm = (L >> 1) & 3, pnn = L & 1;
        u.a = (const char*)(ws + WS_WMIXR + ll * SZ_WMIXR) + ((size_t)pm * 256 * 1024 + g * 256) * 2;
        u.b = (const char*)(ws + WS_TCH) + (size_t)pnn * 256 * 256 * 2;
        u.o = (char*)(ws + WS_WMIX + ll * SZ_WMIX) + ((size_t)pm * 256 * 2048 + pnn * 1024 + g * 256) * 2;
        u.nt = 4; u.mode = M_BF16; u.ldo = 2048; return true; }
    case G_IN: { const int L = i * G + c; if (L >= 2116) return false;
        if (L < 2112) { int pm, pn; static_order(L, 33, 64, pm, pn); const int pnp = pn < 20 ? pn : pn + 4;
            u.a = (const char*)(ws + WS_H) + (size_t)pm * 256 * DM * 2;
            u.b = (const char*)(ws + WS_WINT + l * SZ_WINT) + (size_t)pnp * 256 * DM * 2;
            u.o = (char*)(ws + WS_P) + ((size_t)pm * 256 * INC + pnp * 256) * 2; u.ldo = INC; }
        else { const int pm = L - 2112;
            u.a = (const char*)(ws + WS_WINT + l * SZ_WINT) + (size_t)(OFX + pm * 256) * DM * 2;
            u.b = (const char*)(ws + WS_H);
            u.o = (char*)(ws + WS_XT) + (size_t)pm * 256 * ROWS * 2; u.ldo = ROWS; }
        u.nt = 32; u.mode = M_BF16; return true; }
    case G_XT: { const int L = i * G + ((c + G - 68) % G); if (L >= 128) return false; const int pm = L & 3, pn = 1 + (L >> 2);
        u.a = (const char*)(ws + WS_WINT + l * SZ_WINT) + (size_t)(OFX + pm * 256) * DM * 2;
        u.b = (const char*)(ws + WS_H) + (size_t)(CTX + 2 * (pn - 1)) * DM * 2;
        u.o = (char*)(ws + WS_XT) + ((size_t)pm * 256 * ROWS + pn * 256) * 2; u.ldo = ROWS;
        u.nt = 32; u.mode = M_BF16; return true; }
    case G_F1: { const int L = i * G + c; if (L >= 256) return false; const int s2 = L >> 2, ct = L & 3;
        u.a = (const char*)(ws + WS_XT) + ((size_t)ct * 256 * ROWS + CTX + s2 * 128) * 2;
        u.b = (const char*)(ws + WS_T1);
        u.o = (char*)(ws + WS_ZT) + (size_t)ct * 256 * ZCH + s2 * 8;
        u.nt = 2; u.mode = M_F1; u.ldo = s2; return true; }
    case G_F2: { if (c < 16 || c >= G - 132) return false; const int L = i * (G - 148) + (c - 16); if (L >= 256) return false; const int k1p = L >> 2, ct = L & 3;
        u.a = (const char*)(ws + WS_A2);
        u.b = (const char*)(ws + WS_ZT) + (size_t)ct * 256 * ZCH + k1p * 512;
        u.o = (char*)(ws + WS_PQ) + ((size_t)(CTX + 2 * k1p) * 2048 + ct * 256) * 2;
        u.nt = 4; u.mode = M_F2; u.ldo = 2048; return true; }
    case G_DFTC: { const int L = i * G + c; if (L >= 8) return false; const int pm = L >> 2, pn = L & 3;
        u.a = (const char*)(ws + WS_ACTX) + (size_t)pm * 256 * 256 * 2;
        u.b = (const char*)(ws + WS_XT) + (size_t)pn * 256 * ROWS * 2;
        u.o = (char*)(ws + WS_PQ) + ((size_t)pm * 1024 + pn * 256) * 2;
        u.nt = 4; u.mode = M_BF16; u.ldo = 2048; return true; }
    case G_MIX: { const int L = i * G + (G - 1 - c); if (L >= 132) return false; const int pm = L >> 2, pn = L & 3;
        u.a = (const char*)(ws + WS_PQ) + (size_t)pm * 256 * 2048 * 2;
        u.b = (const char*)(ws + WS_WMIX + l * SZ_WMIX) + (size_t)pn * 256 * 2048 * 2;
        u.aux = (const char*)(ws + WS_P) + ((size_t)pm * 256 * INC + OFG + pn * 256) * 2;
        u.o = (char*)(ws + WS_ACAT) + (APL + (size_t)pm * 256 * CLD + pn * 256) * 2;
        u.nt = 32; u.mode = M_MIX; u.ldo = CLD; return true; }
    case G_MERGE: {
        if (i < 3) { const int T = c, sub = i; if (T >= 256) return false;
            int pm, pn; static_order(T, 32, 8, pm, pn); pm += 1;
            u.a = (const char*)(ws + WS_ACAT) + ((size_t)sub * APL + (size_t)pm * 256 * CLD) * 2;
            u.b = (const char*)(ws + WS_WCAT + l * SZ_WCAT) + ((size_t)sub * WPL + (size_t)pn * 256 * CLD) * 2;
            u.aux = (const char*)(ws + WS_P) + ((size_t)pm * 256 * INC + OML + sub * 2048 + pn * 256) * 2;
            u.m = (char*)(ws + WS_MBUF) + ((size_t)pm * 256 * MLD + pn * 256) * 4;
            u.o = (char*)(ws + WS_MB) + ((size_t)pm * 256 * 2048 + pn * 256) * 2;
            u.nt = sub == 0 ? 32 : 16; u.mode = M_MG0 + sub; u.ldo = 2048; return true; }
        return false; }
    case G_MERGEC: {
        if (i == 0 && l < DEPTH - 1 && c >= G - 64) { const int pc = c - (G - 64), pn = pc >> 3, q = pc & 7;
            const int sub = q < 4 ? 0 : (q < 6 ? 1 : 2), kcol = q < 4 ? q * 512 : (q < 6 ? (q - 4) * 512 : (q - 6) * 512);
            u.a = (const char*)(ws + WS_ACAT) + ((size_t)sub * APL + kcol) * 2;
            u.b = (const char*)(ws + WS_WCAT + l * SZ_WCAT) + ((size_t)sub * WPL + (size_t)pn * 256 * CLD + kcol) * 2;
            u.aux = (const char*)(ws + WS_P) + ((size_t)OML + sub * 2048 + pn * 256) * 2;
            u.m = (char*)(ws + WS_MP) + ((size_t)q * CTX * MLD + pn * 256) * 4;
            u.o = nullptr; u.nt = 8; u.mode = M_MERGE0; u.ldo = 2048; return true; }
        return false; }
    case G_OUT: {
        const int piece = l >> 4; l &= 15;
        if (i != 0) return false;
        if (!piece) { if (c >= 256) return false; int pm, pn; static_order(c, 32, 8, pm, pn); pm += 1;
            u.a = (const char*)(ws + WS_MB) + (size_t)pm * 256 * 2048 * 2;
            u.b = (const char*)(ws + WS_WOUT + l * SZ_WOUT) + (size_t)pn * 256 * 2048 * 2;
            u.o = (char*)(ws + WS_OUTB) + ((size_t)pm * 256 * 2048 + pn * 256) * 4;
            u.nt = 32; u.mode = M_F32; u.ldo = 2048; return true; }
        if (l < DEPTH - 1 && c >= G - 32) { const int pc = c - (G - 32), pn = pc >> 2, kp = pc & 3;
            u.a = (const char*)(ws + WS_MB) + (size_t)kp * 512 * 2;
            u.b = (const char*)(ws + WS_WOUT + l * SZ_WOUT) + ((size_t)pn * 256 * 2048 + kp * 512) * 2;
            u.o = (char*)(ws + WS_OUTP) + ((size_t)kp * CTX * 2048 + pn * 256) * 4;
            u.nt = 8; u.mode = M_F32; u.ldo = 2048; return true; }
        return false; }
    }
    return false;
}

__device__ __forceinline__ void epilogue(const f32x4 (&acc)[2][2][4][2], const Unit& u, int wr, int wc, int fr, int fq) {
    unsigned r0 = wr * 64 + fr, c0 = wc * 64 + 8 * fq;
    asm volatile("" : "+v"(r0), "+v"(c0));
    if (u.mode == M_BF16) {
        const unsigned base = (r0 * (unsigned)u.ldo + c0) * 2u;
#pragma unroll
        for (int ai = 0; ai < 2; ++ai)
#pragma unroll
            for (int m = 0; m < 4; ++m) { char* rowp = u.o + (size_t)(ai * HALF + m * 16) * u.ldo * 2;
#pragma unroll
                for (int bj = 0; bj < 2; ++bj) { const f32x4 v0 = acc[ai][bj][m][0], v1 = acc[ai][bj][m][1];
                    u32x4 w; w.x = cvtpk(v0[0], v0[1]); w.y = cvtpk(v0[2], v0[3]); w.z = cvtpk(v1[0], v1[1]); w.w = cvtpk(v1[2], v1[3]);
                    *(u32x4*)(rowp + base + bj * BJC * 2) = w; } }
    } else if (u.mode == M_MIX) {
        const unsigned base = (r0 * (unsigned)u.ldo + c0) * 2u, abase = (r0 * (unsigned)INC + c0) * 2u;
#pragma unroll
        for (int ai = 0; ai < 2; ++ai) {
            u32x4 g[4][2];
#pragma unroll
            for (int m = 0; m < 4; ++m)
#pragma unroll
                for (int bj = 0; bj < 2; ++bj) g[m][bj] = *(const u32x4*)(u.aux + (size_t)(ai * HALF + m * 16) * INC * 2 + abase + bj * BJC * 2);
            __builtin_amdgcn_sched_barrier(0);
#pragma unroll
            for (int m = 0; m < 4; ++m) { char* rowp = u.o + (size_t)(ai * HALF + m * 16) * u.ldo * 2;
#pragma unroll
                for (int bj = 0; bj < 2; ++bj) { const f32x4 v0 = acc[ai][bj][m][0], v1 = acc[ai][bj][m][1]; const u32x4 gg = g[m][bj];
                    u32x4 w; w.x = cvtpk(v0[0] * siluf_(bflo(gg.x)), v0[1] * siluf_(bfhi(gg.x))); w.y = cvtpk(v0[2] * siluf_(bflo(gg.y)), v0[3] * siluf_(bfhi(gg.y)));
                    w.z = cvtpk(v1[0] * siluf_(bflo(gg.z)), v1[1] * siluf_(bfhi(gg.z))); w.w = cvtpk(v1[2] * siluf_(bflo(gg.w)), v1[3] * siluf_(bfhi(gg.w)));
                    *(u32x4*)(rowp + base + bj * BJC * 2) = w; } }
            __builtin_amdgcn_sched_barrier(0);
        }
    } else if (u.mode == M_F32) {
        const unsigned base = (r0 * (unsigned)u.ldo + c0) * 4u;
#pragma unroll
        for (int ai = 0; ai < 2; ++ai)
#pragma unroll
            for (int m = 0; m < 4; ++m) { char* rowp = u.o + (size_t)(ai * HALF + m * 16) * u.ldo * 4;
#pragma unroll
                for (int bj = 0; bj < 2; ++bj) { *(f32x4*)(rowp + base + bj * BJC * 4) = acc[ai][bj][m][0]; *(f32x4*)(rowp + base + bj * BJC * 4 + 16) = acc[ai][bj][m][1]; } }
    } else if (u.mode == M_MG0 || u.mode == M_MG1) {
    } else if (u.mode == M_MG2) {
        const unsigned abase = (r0 * (unsigned)INC + c0) * 2u, obase = (r0 * 2048u + c0) * 2u;
#pragma unroll
        for (int ai = 0; ai < 2; ++ai) {
            u32x4 g[4][2];
#pragma unroll
            for (int m = 0; m < 4; ++m)
#pragma unroll
                for (int bj = 0; bj < 2; ++bj) g[m][bj] = *(const u32x4*)(u.aux + (size_t)(ai * HALF + m * 16) * INC * 2 + abase + bj * BJC * 2);
            __builtin_amdgcn_sched_barrier(0);
#pragma unroll
            for (int m = 0; m < 4; ++m) { char* rowp = u.o + (size_t)(ai * HALF + m * 16) * 2048 * 2;
#pragma unroll
                for (int bj = 0; bj < 2; ++bj) { f32x4 v0 = acc[ai][bj][m][0], v1 = acc[ai][bj][m][1]; const u32x4 gg = g[m][bj];
                    v0[0] *= sigmoidf_(bflo(gg.x)); v0[1] *= sigmoidf_(bfhi(gg.x)); v0[2] *= sigmoidf_(bflo(gg.y)); v0[3] *= sigmoidf_(bfhi(gg.y));
                    v1[0] *= sigmoidf_(bflo(gg.z)); v1[1] *= sigmoidf_(bfhi(gg.z)); v1[2] *= sigmoidf_(bflo(gg.w)); v1[3] *= sigmoidf_(bfhi(gg.w));
                    u32x4 w; w.x = cvtpk(v0[0], v0[1]); w.y = cvtpk(v0[2], v0[3]); w.z = cvtpk(v1[0], v1[1]); w.w = cvtpk(v1[2], v1[3]); *(u32x4*)(rowp + obase + bj * BJC * 2) = w; } }
            __builtin_amdgcn_sched_barrier(0);
        }
    } else if (u.mode == M_F1) {
        const int s2 = u.ldo;
        const unsigned kb0 = (c0 >> 1);
        float tc[2][4], ts[2][4];
#pragma unroll
        for (int bj = 0; bj < 2; ++bj)
#pragma unroll
            for (int j = 0; j < 4; ++j) { const float x = (float)((bj * 16 + kb0 + j) * s2) * (1.0f / 8192.0f); tc[bj][j] = __builtin_amdgcn_cosf(x); ts[bj][j] = __builtin_amdgcn_sinf(x); }
        const unsigned base = r0 * (unsigned)ZCH + kb0 * 256u;
#pragma unroll
        for (int ai = 0; ai < 2; ++ai)
#pragma unroll
            for (int m = 0; m < 4; ++m) { char* rowp = u.o + (size_t)(ai * HALF + m * 16) * ZCH;
#pragma unroll
                for (int bj = 0; bj < 2; ++bj) { const f32x4 v0 = acc[ai][bj][m][0], v1 = acc[ai][bj][m][1];
                    const float zr[4] = {v0[0], v0[2], v1[0], v1[2]}, zi[4] = {v0[1], v0[3], v1[1], v1[3]};
#pragma unroll
                    for (int jp = 0; jp < 2; ++jp) { u32x2 w;
                        { const int j = 2 * jp; w.x = cvtpk(zr[j] * tc[bj][j] + zi[j] * ts[bj][j], zi[j] * tc[bj][j] - zr[j] * ts[bj][j]); }
                        { const int j = 2 * jp + 1; w.y = cvtpk(zr[j] * tc[bj][j] + zi[j] * ts[bj][j], zi[j] * tc[bj][j] - zr[j] * ts[bj][j]); }
                        *(u32x2*)(rowp + base + (bj * 8 + jp) * 512) = w; } } }
    } else if (u.mode == M_F2) {
        const unsigned fr_ = r0 & 15u, wr_ = r0 >> 6;
        const unsigned base = ((128u * fr_) * 2048u + wr_ * 1024u + c0) * 2u;
#pragma unroll
        for (int ai = 0; ai < 2; ++ai)
#pragma unroll
            for (int m = 0; m < 4; ++m) { char* rowp = u.o + (size_t)(ai + 2048 * m) * 2048 * 2;
#pragma unroll
                for (int bj = 0; bj < 2; ++bj) { const f32x4 v0 = acc[ai][bj][m][0], v1 = acc[ai][bj][m][1];
                    u32x4 w; w.x = cvtpk(v0[0], v0[1]); w.y = cvtpk(v0[2], v0[3]); w.z = cvtpk(v1[0], v1[1]); w.w = cvtpk(v1[2], v1[3]);
                    *(u32x4*)(rowp + base + bj * BJC * 2) = w; } }
    } else {
        const unsigned abase = (r0 * (unsigned)INC + c0) * 2u, mbase = (r0 * (unsigned)MLD + c0) * 4u;
#pragma unroll
        for (int ai = 0; ai < 2; ++ai)
#pragma unroll
            for (int m = 0; m < 4; ++m) { const int rr = ai * HALF + m * 16; const char* ap = u.aux + (size_t)rr * INC * 2; char* mp = u.m + (size_t)rr * MLD * 4;
#pragma unroll
                for (int bj = 0; bj < 2; ++bj) { f32x4 v0 = acc[ai][bj][m][0], v1 = acc[ai][bj][m][1]; const u32x4 g = *(const u32x4*)(ap + abase + bj * BJC * 2);
                    v0[0] *= sigmoidf_(bflo(g.x)); v0[1] *= sigmoidf_(bfhi(g.x)); v0[2] *= sigmoidf_(bflo(g.y)); v0[3] *= sigmoidf_(bfhi(g.y));
                    v1[0] *= sigmoidf_(bflo(g.z)); v1[1] *= sigmoidf_(bfhi(g.z)); v1[2] *= sigmoidf_(bflo(g.w)); v1[3] *= sigmoidf_(bfhi(g.w));
                    *(f32x4*)(mp + mbase + bj * BJC * 4) = v0; *(f32x4*)(mp + mbase + bj * BJC * 4 + 16) = v1; }
                if (m & 1) __builtin_amdgcn_sched_barrier(0); }
    }
}

__device__ __forceinline__ void rescale_or_reset(f32x4 (&acc)[2][2][4][2], const Unit& u, int wr, int wc, int fr, int fq) {
    const unsigned msk = (u.mode == M_MG0 || u.mode == M_MG1) ? 0xffffffffu : 0u;
    unsigned r0 = wr * 64 + fr, c0 = wc * 64 + 8 * fq;
    asm volatile("" : "+v"(r0), "+v"(c0));
    const unsigned abase = (r0 * (unsigned)INC + c0) * 2u;
#pragma unroll
    for (int ai = 0; ai < 2; ++ai)
#pragma unroll
        for (int m = 0; m < 4; ++m) { const char* ap = u.aux + (size_t)(ai * HALF + m * 16) * INC * 2;
#pragma unroll
            for (int bj = 0; bj < 2; ++bj) {
                const u32x4 ga = *(const u32x4*)(ap + abase + bj * BJC * 2), gb = *(const u32x4*)(ap + abase + bj * BJC * 2 + 4096);
                const unsigned wa[4] = {ga.x, ga.y, ga.z, ga.w}, wb[4] = {gb.x, gb.y, gb.z, gb.w};
                float f[8];
#pragma unroll
                for (int e = 0; e < 4; ++e) {
                    const float rl = (1.0f + __expf(-bflo(wb[e]))) * __builtin_amdgcn_rcpf(1.0f + __expf(-bflo(wa[e])));
                    const float rh = (1.0f + __expf(-bfhi(wb[e]))) * __builtin_amdgcn_rcpf(1.0f + __expf(-bfhi(wa[e])));
                    f[2 * e] = __uint_as_float(__float_as_uint(rl) & msk); f[2 * e + 1] = __uint_as_float(__float_as_uint(rh) & msk); }
                acc[ai][bj][m][0] *= (f32x4){f[0], f[1], f[2], f[3]}; acc[ai][bj][m][1] *= (f32x4){f[4], f[5], f[6], f[7]};
            }
            if (m & 1) __builtin_amdgcn_sched_barrier(0);
        }
}

__device__ __forceinline__ void gemm_phase(LAS unsigned char* lds, int gid, int l, unsigned char* ws) {
    int tid_ = threadIdx.x; asm volatile("" : "+v"(tid_));
    const int tid = tid_, wid = __builtin_amdgcn_readfirstlane(tid >> 6), lane = tid & 63, wr = wid >> 2, wc = wid & 3, fr = lane & 15, fq = lane >> 4;
    int lda, ldb;
    int ldbv = 0;
    switch (gid) { case G_FOLD: lda = 1024; ldb = 256; break; case G_IN: lda = 2048; ldb = 2048; break; case G_XT: lda = 2048; ldb = 2048; ldbv = 64 * 2048; break;
                   case G_F1: lda = ROWS; ldb = 128; break; case G_F2: lda = 256; ldb = ZCH / 2; break;
                   case G_DFTC: lda = 256; ldb = ROWS; break; case G_MIX: lda = 2048; ldb = 2048; break; case G_MERGE: case G_MERGEC: lda = CLD; ldb = CLD; break; default: lda = 2048; ldb = 2048; break; }
    if (ldbv == 0) ldbv = ldb;
    Unit cur, nxt; int ui = 0;
    if (!get_unit(gid, l, 0, ws, cur)) return;
    unsigned voffA[2], voffB[2];
#pragma unroll
    for (int i = 0; i < 2; ++i) { int R, C; stage_rc(tid * 16 + i * 8192, R, C); const int w_ = R >> 5, ip = perm32(R & 31);
        const int Rb = (gid == G_XT) ? (4096 * (w_ & 1) + 64 * ip + (w_ >> 1)) : (64 * w_ + ip);
        voffA[i] = (unsigned)(R * lda + C) * 2u; voffB[i] = (unsigned)(Rb * ldb + C) * 2u; }
    const size_t kstep = (size_t)(BK * 2);
    const size_t hstepA = (size_t)HALF * lda * 2, hstepB = (gid == G_XT) ? (size_t)2048 * ldb * 2 : (size_t)32 * ldb * 2;
    const unsigned ldsw = (unsigned)wid * 1024u;
    const int aoff = lds_byte(wr * 64 + fr, fq * 8), boff = lds_byte(wc * 32 + fr, fq * 8);
#define PG8_SA(b, h) (((b) * 2 + (h)) * HTB)
#define PG8_SB(b, h) ((4 + (b) * 2 + (h)) * HTB)
#define PG8_STAGE(bufoff, gbase, voff) do { _Pragma("unroll") for (int _i = 0; _i < 2; ++_i) \
        __builtin_amdgcn_global_load_lds((const unsigned*)((const char*)(gbase) + (voff)[_i]), (LAS unsigned*)(lds + (bufoff) + ldsw + _i * 8192), 16, 0, 0); } while (0)
#define PG8_LDA(dst, b, h) do { _Pragma("unroll") for (int m = 0; m < 4; ++m) _Pragma("unroll") for (int k = 0; k < 2; ++k) dst[m][k] = *(const LAS bf16x8*)(lds + PG8_SA(b, h) + aoff + m * 2048 + k * 1024); } while (0)
#define PG8_LDB(dst, b, h) do { _Pragma("unroll") for (int n = 0; n < 2; ++n) _Pragma("unroll") for (int k = 0; k < 2; ++k) dst[n][k] = *(const LAS bf16x8*)(lds + PG8_SB(b, h) + boff + n * 2048 + k * 1024); } while (0)
#define PG8_MMA(ai, bj, At, Bt) do { __builtin_amdgcn_s_setprio(1); _Pragma("unroll") for (int m = 0; m < 4; ++m) _Pragma("unroll") for (int n = 0; n < 2; ++n) _Pragma("unroll") for (int k = 0; k < 2; ++k) \
        acc[ai][bj][m][n] = __builtin_amdgcn_mfma_f32_16x16x32_bf16(Bt[n][k], At[m][k], acc[ai][bj][m][n], 0, 0, 0); __builtin_amdgcn_s_setprio(0); } while (0)
#define PG8_WAIT_V(n) asm volatile("s_waitcnt vmcnt(" #n ")" ::: "memory")
#define PG8_WAIT_L(n) asm volatile("s_waitcnt lgkmcnt(" #n ")" ::: "memory")
#define PG8_BAR __builtin_amdgcn_s_barrier()
#define PG8_SCHED __builtin_amdgcn_sched_barrier(0)
    f32x4 acc[2][2][4][2];
#pragma unroll
    for (int a = 0; a < 2; ++a)
#pragma unroll
        for (int b = 0; b < 2; ++b)
#pragma unroll
            for (int m = 0; m < 4; ++m)
#pragma unroll
                for (int n = 0; n < 2; ++n) acc[a][b][m][n] = (f32x4){0.f, 0.f, 0.f, 0.f};
    bf16x8 At[4][2], B0[2][2], B1[2][2];
    const char* cA = cur.a; const char* cB = cur.b;
    PG8_STAGE(PG8_SB(0, 0), cB, voffB); PG8_STAGE(PG8_SA(0, 0), cA, voffA); PG8_STAGE(PG8_SB(0, 1), cB + hstepB, voffB); PG8_STAGE(PG8_SA(0, 1), cA + hstepA, voffA);
    if (wr == 1) PG8_BAR;
    PG8_WAIT_V(4); PG8_BAR;
    PG8_STAGE(PG8_SB(1, 0), cB + kstep, voffB); PG8_STAGE(PG8_SA(1, 0), cA + kstep, voffA); PG8_STAGE(PG8_SB(1, 1), cB + hstepB + kstep, voffB);
    PG8_WAIT_V(6); PG8_BAR;
    for (;;) {
        const bool has_next = get_unit(gid, l, ui + 1, ws, nxt);
        const char* nA = has_next ? nxt.a : cA; const char* nB = has_next ? nxt.b : cB;
        const int nt = cur.nt;
        for (int t = 0; t < nt; t += 2) {
            const bool last = (t == nt - 2);
            const char* a1 = cA + (size_t)(t + 1) * kstep;
            const char* a2 = last ? nA : cA + (size_t)(t + 2) * kstep; const char* b2 = last ? nB : cB + (size_t)(t + 2) * kstep;
            const char* a3 = a2 + kstep; const char* b3 = b2 + kstep;
            PG8_LDB(B0, 0, 0); PG8_SCHED; PG8_LDA(At, 0, 0); PG8_STAGE(PG8_SA(1, 1), a1 + hstepA, voffA);
            PG8_WAIT_L(8); PG8_BAR; PG8_WAIT_L(0); PG8_MMA(0, 0, At, B0); PG8_BAR; PG8_SCHED;
            PG8_LDB(B1, 0, 1); PG8_STAGE(PG8_SB(0, 0), b2, voffB);
            PG8_BAR; PG8_WAIT_L(0); PG8_MMA(0, 1, At, B1); PG8_BAR;
            PG8_LDA(At, 0, 1); PG8_STAGE(PG8_SA(0, 0), a2, voffA);
            PG8_BAR; PG8_WAIT_L(0); PG8_MMA(1, 0, At, B0); PG8_BAR; PG8_SCHED;
            PG8_STAGE(PG8_SB(0, 1), b2 + hstepB, voffB);
            PG8_WAIT_V(6); PG8_BAR; PG8_MMA(1, 1, At, B1); PG8_BAR;
            PG8_LDB(B0, 1, 0); PG8_SCHED; PG8_LDA(At, 1, 0); PG8_STAGE(PG8_SA(0, 1), a2 + hstepA, voffA);
            PG8_WAIT_L(8); PG8_BAR; PG8_WAIT_L(0); PG8_MMA(0, 0, At, B0); PG8_BAR; PG8_SCHED;
            PG8_LDB(B1, 1, 1); PG8_STAGE(PG8_SB(1, 0), b3, voffB);
            PG8_BAR; PG8_WAIT_L(0); PG8_MMA(0, 1, At, B1); PG8_BAR;
            PG8_LDA(At, 1, 1); PG8_STAGE(PG8_SA(1, 0), a3, voffA);
            PG8_BAR; PG8_WAIT_L(0); PG8_MMA(1, 0, At, B0); PG8_BAR; PG8_SCHED;
            PG8_STAGE(PG8_SB(1, 1), b3 + hstepB, voffB);
            PG8_WAIT_V(6); PG8_BAR; PG8_MMA(1, 1, At, B1); PG8_BAR;
        }
        epilogue(acc, cur, wr, wc, fr, fq);
        if (!has_next) break;
        if (gid == G_MERGE) rescale_or_reset(acc, cur, wr, wc, fr, fq);
        else {
#pragma unroll
            for (int a = 0; a < 2; ++a)
#pragma unroll
                for (int b = 0; b < 2; ++b)
#pragma unroll
                    for (int m = 0; m < 4; ++m)
#pragma unroll
                        for (int n = 0; n < 2; ++n) acc[a][b][m][n] = (f32x4){0.f, 0.f, 0.f, 0.f};
        }
        cur = nxt; cA = nA; cB = nB; ++ui;
    }
    PG8_WAIT_V(0);
    if (wr == 0) PG8_BAR;
    PG8_BAR;
#undef PG8_SA
#undef PG8_SB
#undef PG8_STAGE
#undef PG8_LDA
#undef PG8_LDB
#undef PG8_MMA
#undef PG8_WAIT_V
#undef PG8_WAIT_L
#undef PG8_BAR
#undef PG8_SCHED
}

namespace att {
constexpr int D = 128, NW = 8, QBLK = 32, KVBLK = 64;
constexpr float SCALE = 0.088388347648318440f;
constexpr float THR = 8.f;
constexpr int LDQ = INC, LDK = 128, LDO = CLD;
constexpr size_t SHM_V = KVBLK * D * 2, SHM_K = KVBLK * D * 2, SHM_ATTN = 2 * SHM_V + 2 * SHM_K + NW * 64 * 4;
#define KSWZ(row, colB) ((row) * 256 + ((colB) ^ (((row) & 7) << 4)))
#define SBAR() __builtin_amdgcn_sched_barrier(0)
__device__ __forceinline__ int crow(int r, int hi) { return (r & 3) + 8 * (r >> 2) + 4 * hi; }
__device__ __forceinline__ void partialSM(f32x16& p0, f32x16& p1, float& m_reg, float& mn, float& alpha) {
  constexpr float C = SCALE * 1.4426950408889634f;
  float pmax = p0[0];
#pragma unroll
  for (int r = 1; r < 16; ++r) pmax = fmaxf(pmax, p0[r]);
#pragma unroll
  for (int r = 0; r < 16; ++r) pmax = fmaxf(pmax, p1[r]);
  { auto rr = __builtin_amdgcn_permlane32_swap(__float_as_uint(pmax), __float_as_uint(pmax), false, false);
    pmax = fmaxf(__uint_as_float(rr[0]), __uint_as_float(rr[1])); }
  if (__builtin_expect(__all(pmax - m_reg <= THR / SCALE), 1)) { mn = m_reg; alpha = 1.f; }
  else { mn = fmaxf(m_reg, pmax); alpha = __builtin_amdgcn_exp2f((m_reg - mn) * C); m_reg = mn; }
  float mnC = -mn * C;
#pragma unroll
  for (int r = 0; r < 16; ++r) p0[r] = fmaf(p0[r], C, mnC);
#pragma unroll
  for (int r = 0; r < 16; ++r) p1[r] = fmaf(p1[r], C, mnC);
#pragma unroll
  for (int r = 0; r < 16; ++r) p0[r] = __builtin_amdgcn_exp2f(p0[r]);
}
__device__ __forceinline__ void finishSM(f32x16& p0, f32x16& p1, float alpha, float& l_reg, bf16x8& pa0, bf16x8& pa1, bf16x8& pa2, bf16x8& pa3) {
#pragma unroll
  for (int r = 0; r < 16; ++r) p1[r] = __builtin_amdgcn_exp2f(p1[r]);
  float ps = 0;
#pragma unroll
  for (int r = 0; r < 16; ++r) ps += p0[r];
#pragma unroll
  for (int r = 0; r < 16; ++r) ps += p1[r];
  { auto rr = __builtin_amdgcn_permlane32_swap(__float_as_uint(ps), __float_as_uint(ps), false, false);
    ps = __uint_as_float(rr[0]) + __uint_as_float(rr[1]); }
  l_reg = l_reg * alpha + ps;
#define PK4(P, BASE, OUT) do { unsigned a0 = cvtpk(P[BASE + 0], P[BASE + 1]), a1 = cvtpk(P[BASE + 2], P[BASE + 3]);   \
    unsigned b0 = cvtpk(P[BASE + 4], P[BASE + 5]), b1 = cvtpk(P[BASE + 6], P[BASE + 7]);                              \
    auto r0 = __builtin_amdgcn_permlane32_swap(a0, b0, false, false); auto r1 = __builtin_amdgcn_permlane32_swap(a1, b1, false, false); \
    u32x4 w = {r0[0], r1[0], r0[1], r1[1]}; OUT = *reinterpret_cast<bf16x8*>(&w); } while (0)
  PK4(p0, 0, pa0); PK4(p0, 8, pa1); PK4(p1, 0, pa2); PK4(p1, 8, pa3);
#undef PK4
}
__device__ __forceinline__ void qkt(f32x16& p0, f32x16& p1, const bf16_t* Ks, const bf16x8* qr, int r32, int hi) {
  p0 = f32x16{}; p1 = f32x16{};
#pragma unroll
  for (int d0 = 0; d0 < 8; ++d0) { int cb = (d0 * 16 + hi * 8) * 2;
    bf16x8 b0 = *reinterpret_cast<const bf16x8*>((const char*)Ks + KSWZ(r32, cb));
    bf16x8 b1 = *reinterpret_cast<const bf16x8*>((const char*)Ks + KSWZ(32 + r32, cb));
    p0 = __builtin_amdgcn_mfma_f32_32x32x16_bf16(b0, qr[d0], p0, 0, 0, 0);
    p1 = __builtin_amdgcn_mfma_f32_32x32x16_bf16(b1, qr[d0], p1, 0, 0, 0); }
}
__device__ __forceinline__ int v_st(int k, int c) { const int kk = (k & ~0xC) | ((k & 4) << 1) | ((k & 8) >> 1); return ((kk >> 3) * 4 + (c >> 5)) * 512 + ((kk & 7) * 32 + (c & 31)) * 2; }
__device__ __forceinline__ int v_rd_base(int lane) { return ((lane & 3) << 3) | (((lane >> 2) & 3) << 6) | (((lane >> 4) & 1) << 5) | (((lane >> 5) & 1) << 8); }
constexpr int v_rd_off(int d0, int ks, int half) { return d0 * 512 + ks * 4096 + half * 2048; }
template <int OFF> __device__ __forceinline__ s16x4 tr_read(int vb) {
  s16x4 r; asm volatile("ds_read_b64_tr_b16 %0, %1 offset:%2" : "=&v"(r) : "v"(vb), "i"(OFF) : "memory"); return r;
}
template <int D0> __device__ __forceinline__ void pv_one(f32x16& od, int vb, bf16x8 pa0, bf16x8 pa1, bf16x8 pa2, bf16x8 pa3) {
  const s16x4 l0 = tr_read<v_rd_off(D0, 0, 0)>(vb), h0 = tr_read<v_rd_off(D0, 0, 1)>(vb), l1 = tr_read<v_rd_off(D0, 1, 0)>(vb), h1 = tr_read<v_rd_off(D0, 1, 1)>(vb);
  const s16x4 l2 = tr_read<v_rd_off(D0, 2, 0)>(vb), h2 = tr_read<v_rd_off(D0, 2, 1)>(vb), l3 = tr_read<v_rd_off(D0, 3, 0)>(vb), h3 = tr_read<v_rd_off(D0, 3, 1)>(vb);
  asm volatile("s_waitcnt lgkmcnt(0)" ::: "memory"); SBAR();
#define PK(L, H) (bf16x8){L[0], L[1], L[2], L[3], H[0], H[1], H[2], H[3]}
  od = __builtin_amdgcn_mfma_f32_32x32x16_bf16(pa0, PK(l0, h0), od, 0, 0, 0);
  od = __builtin_amdgcn_mfma_f32_32x32x16_bf16(pa1, PK(l1, h1), od, 0, 0, 0);
  od = __builtin_amdgcn_mfma_f32_32x32x16_bf16(pa2, PK(l2, h2), od, 0, 0, 0);
  od = __builtin_amdgcn_mfma_f32_32x32x16_bf16(pa3, PK(l3, h3), od, 0, 0, 0);
#undef PK
}
__device__ __forceinline__ void pv_d0(f32x16* o, int vb, bf16x8 pa0, bf16x8 pa1, bf16x8 pa2, bf16x8 pa3) {
  pv_one<0>(o[0], vb, pa0, pa1, pa2, pa3); pv_one<1>(o[1], vb, pa0, pa1, pa2, pa3); pv_one<2>(o[2], vb, pa0, pa1, pa2, pa3); pv_one<3>(o[3], vb, pa0, pa1, pa2, pa3);
}
__device__ __forceinline__ void attn_body(const bf16_t* __restrict__ Qb, const bf16_t* __restrict__ Kh, const bf16_t* __restrict__ Vh,
                                          bf16_t* __restrict__ Ob, const bf16_t* __restrict__ AGb, int seq, char* lds) {
  int tid_ = threadIdx.x; asm volatile("" : "+v"(tid_));
  const int tid = tid_, wid = tid >> 6, lane = tid & 63, r32 = lane & 31, hi = lane >> 5;
  bf16_t* V_lds = (bf16_t*)lds; bf16_t* K_lds = (bf16_t*)(lds + 2 * SHM_V);
  float* wsl = (float*)(lds + 2 * SHM_V + 2 * SHM_K) + wid * 64; float* li_l = wsl; float* al_l = wsl + 32;
  float m_reg = -1e30f, l_reg = 0; f32x16 o[4] = {}; bf16x8 qr[8];
  const bf16_t* Qw = Qb + (long)(wid * QBLK + r32) * LDQ + hi * 8;
#pragma unroll
  for (int d0 = 0; d0 < 8; ++d0) qr[d0] = *reinterpret_cast<const bf16x8*>(Qw + d0 * 16);
  const int sr = tid >> 4, sc = (tid & 15) * 8, vst0 = v_st(sr, sc), vst1 = v_st(32 + sr, sc);
  const int vb0 = (int)(uintptr_t)V_lds + v_rd_base(lane);
  const unsigned goff0 = (unsigned)(sr * LDK + sc) * 2u, goff1 = (unsigned)((32 + sr) * LDK + sc) * 2u;
  struct { bf16x8 vs0, vs1, ks0, ks1; } sr_[2];
#define SLOAD(i, k0) do { const char* vt_ = (const char*)Vh + (size_t)(k0) * (LDK * 2); const char* kt_ = (const char*)Kh + (size_t)(k0) * (LDK * 2); \
    sr_[i].vs0 = *reinterpret_cast<const bf16x8*>(vt_ + goff0); sr_[i].vs1 = *reinterpret_cast<const bf16x8*>(vt_ + goff1); \
    sr_[i].ks0 = *reinterpret_cast<const bf16x8*>(kt_ + goff0); sr_[i].ks1 = *reinterpret_cast<const bf16x8*>(kt_ + goff1); } while (0)
#define SWRITE(b, i) do { *(bf16x8*)((char*)V_lds + (b) * SHM_V + vst0) = sr_[i].vs0;          \
    *(bf16x8*)((char*)V_lds + (b) * SHM_V + vst1) = sr_[i].vs1; int kc = sc * 2;               \
    *(bf16x8*)((char*)K_lds + (b) * SHM_K + KSWZ(sr, kc)) = sr_[i].ks0;                       \
    *(bf16x8*)((char*)K_lds + (b) * SHM_K + KSWZ(32 + sr, kc)) = sr_[i].ks1; } while (0)
#define SWAIT() asm volatile("s_waitcnt vmcnt(4)" ::: "memory")
#define RESC(a) do { if (__any((a) < 1.f)) { if (hi == 0) al_l[r32] = (a); asm volatile("s_waitcnt lgkmcnt(0)" ::: "memory"); \
    _Pragma("unroll") for (int d = 0; d < 4; ++d) _Pragma("unroll") for (int r = 0; r < 16; ++r) o[d][r] *= al_l[crow(r, hi)]; } } while (0)
  f32x16 pA0, pA1, pB0, pB1; float mnA, mnB, alA, alB; bf16x8 pa0, pa1, pa2, pa3; const int NT = seq / KVBLK;
  constexpr int SE = 0, SO = 1;
  SLOAD(SE, 0); asm volatile("s_waitcnt vmcnt(0)" ::: "memory"); SWRITE(0, SE); __syncthreads();
  qkt(pA0, pA1, K_lds, qr, r32, hi); partialSM(pA0, pA1, m_reg, mnA, alA);
  SLOAD(SO, KVBLK); if (2 < NT) SLOAD(SE, 2 * KVBLK);
  SWAIT(); SWRITE(1, SO); __syncthreads();
  for (int j = 1; j + 1 < NT; j += 2) {
    SBAR(); qkt(pB0, pB1, (bf16_t*)((char*)K_lds + SHM_K), qr, r32, hi);
    finishSM(pA0, pA1, alA, l_reg, pa0, pa1, pa2, pa3); SBAR();
    SLOAD(SO, (j + 2) * KVBLK); SBAR();
    pv_d0(o, vb0, pa0, pa1, pa2, pa3); partialSM(pB0, pB1, m_reg, mnB, alB);
    __syncthreads(); SWAIT(); SWRITE(0, SE);
    RESC(alB); __syncthreads();
    SBAR(); qkt(pA0, pA1, K_lds, qr, r32, hi);
    finishSM(pB0, pB1, alB, l_reg, pa0, pa1, pa2, pa3); SBAR();
    if (j + 3 < NT) SLOAD(SE, (j + 3) * KVBLK); SBAR();
    pv_d0(o, vb0 + (int)SHM_V, pa0, pa1, pa2, pa3); partialSM(pA0, pA1, m_reg, mnA, alA);
    __syncthreads(); SWAIT(); SWRITE(1, SO);
    RESC(alA); __syncthreads();
  }
  SBAR(); qkt(pB0, pB1, (bf16_t*)((char*)K_lds + SHM_K), qr, r32, hi);
  finishSM(pA0, pA1, alA, l_reg, pa0, pa1, pa2, pa3); SBAR();
  pv_d0(o, vb0, pa0, pa1, pa2, pa3); partialSM(pB0, pB1, m_reg, mnB, alB);
  __syncthreads(); RESC(alB);
  finishSM(pB0, pB1, alB, l_reg, pa0, pa1, pa2, pa3); SBAR();
  pv_d0(o, vb0 + (int)SHM_V, pa0, pa1, pa2, pa3);
  if (hi == 0) li_l[r32] = l_reg; asm volatile("s_waitcnt lgkmcnt(0)" ::: "memory");
  char* Ow = (char*)(Ob + (long)(wid * QBLK) * LDO); const char* Gw = (const char*)(AGb + (long)(wid * QBLK) * LDQ);
  unsigned hv = hi, cv = r32;
  asm volatile("" : "+v"(hv), "+v"(cv));
  const unsigned gbase = (hv * 4u * LDQ + cv) * 2u, obase = (hv * 4u * LDO + cv) * 2u;
  unsigned short gq[16][4];
#pragma unroll
  for (int r = 0; r < 16; ++r) { const int rc = (r & 3) + 8 * (r >> 2); const unsigned go = gbase + (unsigned)(rc * LDQ * 2);
#pragma unroll
    for (int d0 = 0; d0 < 4; ++d0) gq[r][d0] = *(const bf16_t*)(Gw + go + d0 * 64); }
  SBAR();
#pragma unroll
  for (int r = 0; r < 16; ++r) { const int rc = (r & 3) + 8 * (r >> 2); const float rli = __builtin_amdgcn_rcpf(li_l[crow(r, hi)]);
    const unsigned oo = obase + (unsigned)(rc * LDO * 2);
#pragma unroll
    for (int d0 = 0; d0 < 4; ++d0) *(bf16_t*)(Ow + oo + d0 * 64) = f2bf(o[d0][r] * rli * siluf_(bf2f(gq[r][d0]))); }
#undef SLOAD
#undef SWRITE
#undef SWAIT
#undef RESC
}
}

__device__ __forceinline__ void attn_phase(const Params& p, int l, char* lds) {
    unsigned char* ws = p.ws;
    const bf16_t* P = (const bf16_t*)(ws + WS_P); bf16_t* Acat = (bf16_t*)(ws + WS_ACAT);
    const int G = gridDim.x, nunits = 512 + (l < DEPTH - 1 ? 16 : 0);
    for (int U = blockIdx.x; U < nunits; U += G) {
        int h, qrow0, seq;
        if (U < 512) { int qb;
            if (G == 256) { const int xcd = U & 7, j = (U >> 3) & 31, r = U >> 8, kvh = xcd >> 1, idx = (xcd & 1) * 64 + r * 32 + j; h = kvh * 4 + (idx & 3); qb = idx >> 2; }
            else { h = U & 15; qb = U >> 4; }
            qrow0 = CTX + qb * 256; seq = ROWS; }
        else { h = U - 512; qrow0 = 0; seq = CTX; }
        const int kvh = h >> 2;
        att::attn_body(P + (size_t)qrow0 * INC + OQ + h * 128, (const bf16_t*)(ws + WS_KC) + (size_t)kvh * ROWS * 128, (const bf16_t*)(ws + WS_VC) + (size_t)kvh * ROWS * 128,
                       Acat + (size_t)qrow0 * CLD + h * 128, P + (size_t)qrow0 * INC + OAG + h * 128, seq, lds);
        __syncthreads();
    }
}

#define XB_TMO      128
#define XB_XCNT(j)  (256  + 64 * (j))
#define XB_XSUB(j)  (1280 + 64 * (j))
#define XB_XGEN(j)  (2304 + 64 * (j))
#define XB_TOP      3328
#define XB_TOPGEN   3392
#define XCD_BAR_WORDS 3456
#define XB_SPIN_CAP (1u << 18)

__device__ __forceinline__ unsigned xb_ld(unsigned* p)              { return __hip_atomic_load(p, __ATOMIC_RELAXED, __HIP_MEMORY_SCOPE_AGENT); }
__device__ __forceinline__ unsigned xb_add(unsigned* p, unsigned v) { return __hip_atomic_fetch_add(p, v, __ATOMIC_RELAXED, __HIP_MEMORY_SCOPE_AGENT); }
__device__ __forceinline__ unsigned xb_xcc_id() { return (unsigned)__builtin_amdgcn_s_getreg((3 << 11) | 20) & 0xFu; }
#define XB_SPIN(cond, bar) do { unsigned _sp = 0; while (cond) { __builtin_amdgcn_s_sleep(1); \
    if ((++_sp & 255u) == 0u) { if (xb_ld(&(bar)[XB_TMO])) break; if (_sp > XB_SPIN_CAP) { atomicAdd(&(bar)[XB_TMO], 1u); break; } } } } while (0)

struct XcdBarrier {
    unsigned* bar; unsigned x;
    volatile LAS unsigned* st;
};

__device__ __forceinline__ XcdBarrier xcd_barrier_post(unsigned* bar, volatile LAS unsigned* st) {
    XcdBarrier b; b.bar = bar; b.x = xb_xcc_id(); b.st = st;
    if (threadIdx.x == 0) (void)xb_add(&bar[XB_XCNT(b.x)], 1u);
    return b;
}
__device__ __forceinline__ void xcd_barrier_complete(unsigned* bar, unsigned x, unsigned& nloc, unsigned& nx) {
    const unsigned G = gridDim.x * gridDim.y * gridDim.z;
    unsigned sum, cnt, mine, sp = 0u;
    for (;;) {
        sum = 0u; cnt = 0u; mine = 0u;
#pragma unroll
        for (unsigned j = 0; j < 16; ++j) { const unsigned c = xb_ld(&bar[XB_XCNT(j)]); sum += c; cnt += (c > 0u) ? 1u : 0u; mine = (j == x) ? c : mine; }
        if (sum == G) break;
        __builtin_amdgcn_s_sleep(1);
        if ((++sp & 255u) == 0u) { if (xb_ld(&bar[XB_TMO])) break; if (sp > XB_SPIN_CAP) { atomicAdd(&bar[XB_TMO], 1u); break; } }
    }
    nloc = mine > 0u ? mine : 1u; nx = cnt > 0u ? cnt : 1u;
}

__device__ __forceinline__ void xcd_barrier(const XcdBarrier& b) {
    asm volatile("s_waitcnt vmcnt(0)" ::: "memory");
    __syncthreads();
    if (threadIdx.x == 0) {
        unsigned* bar = b.bar;
        __builtin_amdgcn_s_waitcnt(0);
        unsigned nloc = b.st[0], nx = b.st[1];
        if (nloc == 0u) { xcd_barrier_complete(bar, b.x, nloc, nx); b.st[0] = nloc; b.st[1] = nx; }
        const unsigned old = xb_add(&bar[XB_XSUB(b.x)], 1u);
        const unsigned gen = old / nloc;
        if (old + 1u == (gen + 1u) * nloc) {
            __builtin_amdgcn_fence(__ATOMIC_RELEASE, "agent");
            asm volatile("s_waitcnt vmcnt(0)" ::: "memory");
            const unsigned og = xb_add(&bar[XB_TOP], 1u);
            const unsigned tg = og / nx;
            if (og + 1u == (tg + 1u) * nx) xb_add(&bar[XB_TOPGEN], 1u);
            else XB_SPIN(xb_ld(&bar[XB_TOPGEN]) == tg, bar);
            __builtin_amdgcn_fence(__ATOMIC_ACQUIRE, "agent");
            xb_add(&bar[XB_XGEN(b.x)], 1u);
            asm volatile("s_waitcnt vmcnt(0)" ::: "memory");
        } else {
            XB_SPIN(xb_ld(&bar[XB_XGEN(b.x)]) == gen, bar);
            __builtin_amdgcn_fence(__ATOMIC_ACQUIRE, "agent");
            asm volatile("s_waitcnt vmcnt(0)" ::: "memory");
        }
    }
    __syncthreads();
}

__global__ void __launch_bounds__(NTHREADS, 2) mega_fwd(Params p0) {
    extern __shared__ __attribute__((aligned(16))) unsigned char lds[];
    cg::grid_group grid = cg::this_grid();
    volatile LAS unsigned* misc = (volatile LAS unsigned*)((LAS unsigned char*)lds + LDS_STAGE);
    if (threadIdx.x < 16) misc[threadIdx.x] = 0u;
    __syncthreads();
    (void)xcd_barrier_post((unsigned*)(p0.ws + WS_BAR), misc);
#ifndef PHASE_MASK
#define PHASE_MASK 0xFFFF
#endif
#define PH(b) if constexpr ((PHASE_MASK >> (b)) & 1)
#ifndef DBL_MASK
#define DBL_MASK 0
#endif
    PH(10) prep_phase(p0, lds);
    __syncthreads();
    if constexpr ((DBL_MASK >> 10) & 1) { prep_phase(p0, lds); __syncthreads(); }
    grid.sync();
#pragma unroll 1
    for (int l = 0; l < DEPTH; ++l) {
#pragma unroll 1
        for (int slot = 0; slot < 12; ++slot) {
            Params p = p0;
            { unsigned char* w = p.ws; asm volatile("" : "+s"(w)); p.ws = w; }
            bool sync = true;
            LAS unsigned char* L = (LAS unsigned char*)lds;
            const int reps = ((DBL_MASK >> slot) & 1) ? 2 : 1;
#pragma unroll 1
            for (int rep = 0; rep < reps; ++rep) {
            if (rep) __syncthreads();
            switch (slot) {
            case 0: rownorm_phase(p, l); sync = false; break;
            case 1: if (l == 0) gemm_phase(L, G_FOLD, l, p.ws); break;
            case 2: gemm_phase(L, G_IN, l, p.ws); sync = false; break;
            case 3: gemm_phase(L, G_XT, l, p.ws); break;
            case 4: gemm_phase(L, G_F1, l, p.ws); sync = false; break;
            case 5: gemm_phase(L, G_DFTC, l, p.ws); break;
            case 6: ew_phase(p, l); break;
            case 7: case 8: sync = false; break;
            case 9: {
                const int cb = (int)blockIdx.x, Gn = (int)gridDim.x;
                unsigned* c2 = (unsigned*)(p.ws + WS_BAR) + 3540;
                const unsigned target = (unsigned)(Gn - 148) * (unsigned)(l + 1);
                if (cb >= 16 && cb < Gn - 132) {
                    gemm_phase(L, G_F2, l, p.ws);
                    __syncthreads();
                    if (threadIdx.x == 0) { __builtin_amdgcn_fence(__ATOMIC_RELEASE, "agent"); asm volatile("s_waitcnt vmcnt(0)" ::: "memory");
                        __hip_atomic_fetch_add(c2, 1u, __ATOMIC_RELAXED, __HIP_MEMORY_SCOPE_AGENT); }
                    __syncthreads();
                }
                attn_phase(p, l, (char*)lds);
                __syncthreads();
                if (cb >= Gn - 132) {
                    if (threadIdx.x == 0) { unsigned sp = 0;
                        while (__hip_atomic_load(c2, __ATOMIC_RELAXED, __HIP_MEMORY_SCOPE_AGENT) < target) { __builtin_amdgcn_s_sleep(1); if (++sp > (1u << 22)) break; }
                        __builtin_amdgcn_fence(__ATOMIC_ACQUIRE, "agent"); asm volatile("s_waitcnt vmcnt(0)" ::: "memory"); }
                    __syncthreads();
                    gemm_phase(L, G_MIX, l, p.ws);
                }
                break; }
            case 10: gemm_phase(L, G_MERGE, l, p.ws); __syncthreads(); gemm_phase(L, G_MERGEC, l, p.ws); break;
            default: {
                const bool hasctx = l < DEPTH - 1;
                unsigned* ccnt = (unsigned*)(p.ws + WS_BAR) + 3500;
                if (hasctx) {
                    int t0_ = threadIdx.x; asm volatile("" : "+v"(t0_));
                    const int idx = (int)blockIdx.x * NTHREADS + t0_, r = idx >> 9, cc = (idx & 511) * 4;
                    const float* mp = (const float*)(p.ws + WS_MP); bf16_t* mb = (bf16_t*)(p.ws + WS_MB);
                    f32x4 s = *(const f32x4*)(mp + (size_t)r * MLD + cc);
#pragma unroll
                    for (int q = 1; q < 8; ++q) s += *(const f32x4*)(mp + ((size_t)q * CTX + r) * MLD + cc);
                    u32x2 w; w.x = cvtpk(s[0], s[1]); w.y = cvtpk(s[2], s[3]); *(u32x2*)(mb + (size_t)r * DM + cc) = w;
                    asm volatile("s_waitcnt vmcnt(0)" ::: "memory"); __syncthreads();
                    if (threadIdx.x == 0) { __builtin_amdgcn_fence(__ATOMIC_RELEASE, "agent"); asm volatile("s_waitcnt vmcnt(0)" ::: "memory");
                        __hip_atomic_fetch_add(ccnt, 1u, __ATOMIC_RELAXED, __HIP_MEMORY_SCOPE_AGENT); }
                }
                const int nv = (hasctx && (int)blockIdx.x >= (int)gridDim.x - 32) ? 2 : 1;
#pragma unroll 1
                for (int v = 0; v < nv; ++v) {
                    if (v) {
                        __syncthreads();
                        if (threadIdx.x == 0) { const unsigned target = (unsigned)(l + 1) * gridDim.x; unsigned sp = 0;
                            while (__hip_atomic_load(ccnt, __ATOMIC_RELAXED, __HIP_MEMORY_SCOPE_AGENT) < target) { __builtin_amdgcn_s_sleep(1); if (++sp > (1u << 22)) break; }
                            __builtin_amdgcn_fence(__ATOMIC_ACQUIRE, "agent"); asm volatile("s_waitcnt vmcnt(0)" ::: "memory"); }
                        __syncthreads();
                    }
                    gemm_phase(L, G_OUT, l | (v << 4), p.ws);
                }
                break; }
            }
            }
            __syncthreads();
            if (sync) { XcdBarrier xb; xb.bar = (unsigned*)(p.ws + WS_BAR); xb.x = xb_xcc_id(); xb.st = (volatile LAS unsigned*)((LAS unsigned char*)lds + LDS_STAGE); xcd_barrier(xb); }
        }
    }
    PH(0) rownorm_phase(p0, DEPTH);
}

extern "C" void kernel_launch(void* const* d_in, const int* in_sizes, int n_in, void* d_out, int out_size, void* d_ws, size_t ws_size, hipStream_t stream) {
    static int grid_blocks = 0;
    if (grid_blocks == 0) {
        if (n_in != 18 || out_size != SEQ * DM || ws_size < WS_END) { fprintf(stderr, "kernel_launch: unexpected shapes: n_in %d out %d ws %zu (need %zu)\n", n_in, out_size, ws_size, (size_t)WS_END); grid_blocks = -1; return; }
        int dev = 0, cus = 0, per_cu = 0;
        hipGetDevice(&dev);
        hipDeviceGetAttribute(&cus, hipDeviceAttributeMultiprocessorCount, dev);
        if (hipFuncSetAttribute((const void*)mega_fwd, hipFuncAttributeMaxDynamicSharedMemorySize, LDS_BYTES) != hipSuccess) { fprintf(stderr, "kernel_launch: hipFuncSetAttribute failed\n"); grid_blocks = -1; return; }
        if (hipOccupancyMaxActiveBlocksPerMultiprocessor(&per_cu, (const void*)mega_fwd, NTHREADS, LDS_BYTES) != hipSuccess || per_cu < 1) { fprintf(stderr, "kernel_launch: occupancy query gave %d\n", per_cu); per_cu = 1; }
        (void)hipGetLastError();
        grid_blocks = cus * (per_cu > 1 ? 1 : per_cu);
        if (grid_blocks > 256) grid_blocks = 256;
        grid_blocks &= ~7;
        if (grid_blocks != 256) { fprintf(stderr, "kernel_launch: this kernel is laid out for 256 resident workgroups, got %d\n", grid_blocks); grid_blocks = -1; return; }
    }
    if (grid_blocks <= 0) return;
    Params p{};
    for (int i = 0; i < 18; ++i) p.in[i] = (const float*)d_in[i];
    p.out = (float*)d_out; p.ws = (unsigned char*)d_ws;
    if (hipMemsetAsync((char*)d_ws + WS_BAR, 0, BAR_BYTES, stream) != hipSuccess) { fprintf(stderr, "kernel_launch: memset of barrier words failed\n"); return; }
    void* args[] = {&p};
    hipError_t e = hipLaunchCooperativeKernel((const void*)mega_fwd, dim3(grid_blocks), dim3(NTHREADS), args, LDS_BYTES, stream);
    if (e != hipSuccess) fprintf(stderr, "cooperative launch failed: %s (grid %d)\n", hipGetErrorString(e), grid_blocks);
}
```

```cpp
#include <hip/hip_runtime.h>
#include <hip/hip_cooperative_groups.h>
#include <cstdio>
#include <cstdint>
namespace cg = cooperative_groups;

#define LAS __attribute__((address_space(3)))
typedef unsigned short bf16_t;
typedef short bf16x8 __attribute__((ext_vector_type(8)));
typedef short s16x4 __attribute__((ext_vector_type(4)));
typedef float f32x4 __attribute__((ext_vector_type(4)));
typedef float f32x16 __attribute__((ext_vector_type(16)));
typedef unsigned u32x4 __attribute__((ext_vector_type(4)));
typedef unsigned u32x2 __attribute__((ext_vector_type(2)));

constexpr int DM = 2048, SEQ = 8192, CTX = 256, ROWS = SEQ + CTX, DEPTH = 4, INC = 17408;
constexpr int OQ = 0, OKK = 2048, OV = 2560, OAG = 3072, OFX = 5120, OFG = 6144, OCX = 7168, OCB = 8192, OCC = 9216, OCG = 10240, OML = 11264;
constexpr float EPS = 1e-6f;
constexpr size_t APL = (size_t)(SEQ + CTX) * 2048, WPL = (size_t)2048 * 2048;
constexpr int CLD = 2048;
constexpr int MLD = 2048 + 64;
constexpr int ZCH = 32768 + 256;
constexpr int LDS_STAGE = 131072, LDS_BYTES = LDS_STAGE + 64;
constexpr int NTHREADS = 512;

constexpr size_t SZ_WINT = (size_t)INC * DM * 2, SZ_WCAT = 3 * WPL * 2, SZ_WOUT = (size_t)DM * DM * 2, SZ_WMIXR = (size_t)1024 * 1024 * 2, SZ_WMIX = (size_t)1024 * 2048 * 2;
constexpr size_t WS_WINT = 0;
constexpr size_t WS_WCAT = WS_WINT + DEPTH * SZ_WINT;
constexpr size_t WS_WOUT = WS_WCAT + DEPTH * SZ_WCAT;
constexpr size_t WS_WMIXR = WS_WOUT + DEPTH * SZ_WOUT;
constexpr size_t WS_WMIX = WS_WMIXR + DEPTH * SZ_WMIXR;
constexpr size_t WS_TCH = WS_WMIX + DEPTH * SZ_WMIX;
constexpr size_t WS_ZT = WS_TCH + 512 * 256 * 2;
constexpr size_t WS_T1 = WS_ZT + (size_t)1024 * ZCH;
constexpr size_t WS_A2 = WS_T1 + 256 * 128 * 2;
constexpr size_t WS_ACTX = WS_A2 + 256 * 256 * 2;
constexpr size_t WS_ROPE = WS_ACTX + 512 * 256 * 2;
constexpr size_t WS_MOD = WS_ROPE + 128 * 32 * 8;
constexpr size_t WS_XS = WS_MOD + 4 * 2 * 6144 * 4;
constexpr size_t WS_H = WS_XS + (size_t)ROWS * DM * 4;
constexpr size_t WS_P = WS_H + (size_t)ROWS * DM * 2;
constexpr size_t WS_XT = WS_P + (size_t)ROWS * INC * 2;
constexpr size_t WS_PQ = WS_XT + (size_t)1024 * ROWS * 2;
constexpr size_t WS_ACAT = WS_PQ + (size_t)ROWS * DM * 2;
constexpr size_t WS_MBUF = WS_ACAT + 3 * APL * 2;
constexpr size_t WS_MB = WS_MBUF + (size_t)ROWS * MLD * 4;
constexpr size_t WS_OUTB = WS_MB + (size_t)ROWS * DM * 2;
constexpr size_t WS_KC = WS_OUTB + (size_t)ROWS * DM * 4;
constexpr size_t WS_VC = WS_KC + (size_t)4 * ROWS * 128 * 2;
constexpr size_t WS_MP = WS_VC + (size_t)4 * ROWS * 128 * 2;
constexpr size_t WS_OUTP = WS_MP + (size_t)8 * CTX * MLD * 4;
constexpr size_t WS_BAR = WS_OUTP + (size_t)4 * CTX * DM * 4;
constexpr size_t BAR_BYTES = 16384;
constexpr size_t WS_END = WS_BAR + BAR_BYTES;

struct Params { const float* in[18]; float* out; unsigned char* ws; };
enum { I_X = 0, I_C, I_CTX, I_CCTX, I_WMOD, I_BMOD, I_GPRE, I_GPOST, I_WIN, I_QN, I_KN, I_WAO, I_WFM, I_WFO, I_CW, I_CB, I_WCO, I_WOUT };

__device__ __forceinline__ unsigned cvtpk(float lo, float hi) { unsigned r; asm volatile("v_cvt_pk_bf16_f32 %0, %1, %2" : "=v"(r) : "v"(lo), "v"(hi)); return r; }
__device__ __forceinline__ float bf2f(unsigned short b) { return __uint_as_float(((unsigned)b) << 16); }
__device__ __forceinline__ float bflo(unsigned w) { return __uint_as_float(w << 16); }
__device__ __forceinline__ float bfhi(unsigned w) { return __uint_as_float(w & 0xffff0000u); }
__device__ __forceinline__ unsigned short f2bf(float f) { return (unsigned short)(cvtpk(f, f) & 0xffffu); }
__device__ __forceinline__ float sigmoidf_(float x) { return __builtin_amdgcn_rcpf(1.0f + __expf(-x)); }
__device__ __forceinline__ float siluf_(float x) { return x * sigmoidf_(x); }
__device__ __forceinline__ float wave_sum(float v) {
#pragma unroll
    for (int o = 32; o >= 1; o >>= 1) v += __shfl_xor(v, o);
    return v;
}

__device__ __forceinline__ void prep_phase(const Params& p, unsigned char* lds_g) {
    int tid_ = threadIdx.x; asm volatile("" : "+v"(tid_));
    const int tid = tid_, G = gridDim.x, bid = blockIdx.x;
    unsigned char* ws = p.ws;
    float* tile = (float*)lds_g;
    constexpr int T_IN = 32 * 272, T_AO = 32 * 32, T_FO = 16 * 32, T_CO = 16 * 32, T_OUT = 32 * 32, T_MIX = 16 * 16;
    constexpr int T_LAYER = T_IN + T_AO + T_FO + T_CO + T_OUT + T_MIX;
    for (int t = bid; t < DEPTH * T_LAYER; t += G) {
        const int l = t / T_LAYER; int r = t % T_LAYER;
        const float* src; int ldsrc; bf16_t* dst; int lddst; int ktiles;
        if (r < T_IN) { src = p.in[I_WIN] + (size_t)l * DM * INC; ldsrc = INC; dst = (bf16_t*)(ws + WS_WINT + l * SZ_WINT); lddst = DM; ktiles = 32; }
        else if ((r -= T_IN) < T_AO) { src = p.in[I_WAO] + (size_t)l * DM * DM; ldsrc = DM; dst = (bf16_t*)(ws + WS_WCAT + l * SZ_WCAT); lddst = CLD; ktiles = 32; }
        else if ((r -= T_AO) < T_FO) { src = p.in[I_WFO] + (size_t)l * 1024 * DM; ldsrc = DM; dst = (bf16_t*)(ws + WS_WCAT + l * SZ_WCAT) + WPL; lddst = CLD; ktiles = 16; }
        else if ((r -= T_FO) < T_CO) { src = p.in[I_WCO] + (size_t)l * 1024 * DM; ldsrc = DM; dst = (bf16_t*)(ws + WS_WCAT + l * SZ_WCAT) + 2 * WPL; lddst = CLD; ktiles = 16; }
        else if ((r -= T_CO) < T_OUT) { src = p.in[I_WOUT] + (size_t)l * DM * DM; ldsrc = DM; dst = (bf16_t*)(ws + WS_WOUT + l * SZ_WOUT); lddst = DM; ktiles = 32; }
        else { r -= T_OUT; src = p.in[I_WFM] + (size_t)l * 1024 * 1024; ldsrc = 1024; dst = (bf16_t*)(ws + WS_WMIXR + l * SZ_WMIXR); lddst = 1024; ktiles = 16; }
        const int k0 = (r % ktiles) * 64, n0 = (r / ktiles) * 64;
        { const int ty = tid >> 4, tx = tid & 15;
#pragma unroll
          for (int ps = 0; ps < 2; ++ps) { const int kk = ty + 32 * ps;
              const f32x4 v = *(const f32x4*)(src + (size_t)(k0 + kk) * ldsrc + n0 + tx * 4);
              tile[kk * 65 + tx * 4 + 0] = v[0]; tile[kk * 65 + tx * 4 + 1] = v[1]; tile[kk * 65 + tx * 4 + 2] = v[2]; tile[kk * 65 + tx * 4 + 3] = v[3]; } }
        __syncthreads();
        { const int n = tid >> 3, kc = (tid & 7) * 8; u32x4 w;
          w.x = cvtpk(tile[(kc + 0) * 65 + n], tile[(kc + 1) * 65 + n]); w.y = cvtpk(tile[(kc + 2) * 65 + n], tile[(kc + 3) * 65 + n]);
          w.z = cvtpk(tile[(kc + 4) * 65 + n], tile[(kc + 5) * 65 + n]); w.w = cvtpk(tile[(kc + 6) * 65 + n], tile[(kc + 7) * 65 + n]);
          *(u32x4*)(dst + (size_t)(n0 + n) * lddst + k0 + kc) = w; }
        __syncthreads();
    }
    {
        float* sc = (float*)lds_g;
        float* red = sc + 4096;
        for (int u = bid; u < 256; u += G) {
            for (int k = tid; k < 4096; k += NTHREADS) { const float cv = (k < 2048) ? p.in[I_C][k] : p.in[I_CCTX][k - 2048]; sc[k] = siluf_(cv); }
            __syncthreads();
            const int l = u >> 6, j0 = (u & 63) * 96;
            if (tid < 504) { const int kg = tid / 24, cq = tid % 24;
                f32x4 al = {0.f, 0.f, 0.f, 0.f}, ac = {0.f, 0.f, 0.f, 0.f};
                const float* wp = p.in[I_WMOD] + (size_t)l * DM * 6144 + j0 + cq * 4;
                for (int k = kg; k < 2048; k += 21) { const f32x4 w = *(const f32x4*)(wp + (size_t)k * 6144); al += sc[k] * w; ac += sc[2048 + k] * w; }
                float* rp = red + (kg * 24 + cq) * 8;
                rp[0] = al[0]; rp[1] = al[1]; rp[2] = al[2]; rp[3] = al[3]; rp[4] = ac[0]; rp[5] = ac[1]; rp[6] = ac[2]; rp[7] = ac[3]; }
            __syncthreads();
            if (tid < 192) { const int v = tid / 96, col = tid % 96, cq = col >> 2, e = col & 3; float s = 0.f;
                for (int kg = 0; kg < 21; ++kg) s += red[(kg * 24 + cq) * 8 + v * 4 + e];
                ((float*)(ws + WS_MOD))[(size_t)(l * 2 + v) * 6144 + j0 + col] = s + p.in[I_BMOD][(size_t)l * 6144 + j0 + col]; }
            __syncthreads();
        }
    }
    const long gt = (long)bid * NTHREADS + tid, gn = (long)G * NTHREADS;
    for (long it = gt; it < 256 * 16; it += gn) { const int r = (int)(it >> 4), s0 = (int)(it & 15) * 8, k1 = r >> 1, ri = r & 1;
        float v[8];
#pragma unroll
        for (int j = 0; j < 8; ++j) { const int ph = (k1 * (s0 + j)) & 127; const float x = (float)ph * (1.0f / 128.0f); v[j] = (ri ? -__builtin_amdgcn_sinf(x) : __builtin_amdgcn_cosf(x)) * 0.08838834764831845f; }
        u32x4 w; w.x = cvtpk(v[0], v[1]); w.y = cvtpk(v[2], v[3]); w.z = cvtpk(v[4], v[5]); w.w = cvtpk(v[6], v[7]);
        *(u32x4*)((bf16_t*)(ws + WS_T1) + (size_t)r * 128 + s0) = w; }
    for (long it = gt; it < 256 * 32; it += gn) { const int rr = (int)(it >> 5), c0 = (int)(it & 31) * 8, kb = rr >> 7, pq = (rr >> 6) & 1, k2 = rr & 63;
        float v[8];
#pragma unroll
        for (int j = 0; j < 8; ++j) { const int cc = c0 + j, s2 = cc >> 2, kbc = (cc >> 1) & 1, ri = cc & 1;     const int ph = (k2 * s2) & 63; const float x = (float)ph * (1.0f / 64.0f);
            const float cs = __builtin_amdgcn_cosf(x), sn = __builtin_amdgcn_sinf(x);
            const float val = pq == 0 ? (ri == 0 ? cs : sn) : (ri == 0 ? sn : -cs);
            v[j] = (kb == kbc) ? val * 0.125f : 0.f; }
        u32x4 w; w.x = cvtpk(v[0], v[1]); w.y = cvtpk(v[2], v[3]); w.z = cvtpk(v[4], v[5]); w.w = cvtpk(v[6], v[7]);
        *(u32x4*)((bf16_t*)(ws + WS_A2) + (size_t)rr * 256 + c0) = w; }
    for (long it = gt; it < 2 * 512 * 32; it += gn) { const int which = (int)(it >> 14), rr = (int)(it & 16383), r = rr >> 5, s0 = (rr & 31) * 8, k = r & 255; const bool isin = r >= 256;
        bf16_t* A = (bf16_t*)(ws + (which ? WS_TCH : WS_ACTX)); const float sgn = (which && isin) ? -0.0625f : 0.0625f;
        float v[8];
#pragma unroll
        for (int j = 0; j < 8; ++j) { const int ph = (k * (s0 + j)) & 255; const float x = (float)ph * (1.0f / 256.0f); v[j] = (isin ? __builtin_amdgcn_sinf(x) : __builtin_amdgcn_cosf(x)) * sgn; }
        u32x4 w; w.x = cvtpk(v[0], v[1]); w.y = cvtpk(v[2], v[3]); w.z = cvtpk(v[4], v[5]); w.w = cvtpk(v[6], v[7]);
        *(u32x4*)(A + (size_t)r * 256 + s0) = w; }
    for (long it = gt; it < 128 * 32; it += gn) { const int pos = (int)(it >> 5), i = (int)(it & 31);
        const float freq = exp2f(-(float)i * (13.287712379549449f / 32.0f));
        const float ang = (float)pos * freq;
        double rev = (double)ang * 0.15915494309189535; rev -= floor(rev);
        const float xr = (float)rev;
        float2 cs; cs.x = __builtin_amdgcn_cosf(xr); cs.y = __builtin_amdgcn_sinf(xr);
        ((float2*)(ws + WS_ROPE))[it] = cs; }
    { f32x4* xs = (f32x4*)(ws + WS_XS); const f32x4* cx = (const f32x4*)p.in[I_CTX]; const f32x4* xx = (const f32x4*)p.in[I_X];
      const long nc = (long)CTX * DM / 4, nt = (long)ROWS * DM / 4;
      for (long it = gt; it < nt; it += gn) xs[it] = (it < nc) ? cx[it] : xx[it - nc]; }
}

__device__ __forceinline__ void rownorm_phase(const Params& p, int l) {
    int tid_ = threadIdx.x; asm volatile("" : "+v"(tid_));
    const int tid = tid_, lane = tid & 63, wid = tid >> 6;
    unsigned char* ws = p.ws;
    const int gw = blockIdx.x * 8 + wid, nw = gridDim.x * 8;
    const float* mod = (const float*)(ws + WS_MOD);
    for (int row = gw; row < ROWS; row += nw) {
        const int isctx = row < CTX ? 1 : 0;
        if (l == 4 && isctx) continue;
        float* xrow = (float*)(ws + WS_XS) + (size_t)row * DM;
        f32x4 xv[8];
#pragma unroll
        for (int i = 0; i < 8; ++i) xv[i] = *(const f32x4*)(xrow + lane * 4 + i * 256);
        if (l > 0) {
            const float* orow = (const float*)(ws + WS_OUTB) + (size_t)row * DM;
            f32x4 ov[8]; float ss = 0.f;
#pragma unroll
            for (int i = 0; i < 8; ++i) {
                if (isctx) { const float* pp = (const float*)(ws + WS_OUTP) + (size_t)row * DM + lane * 4 + i * 256;
                    ov[i] = (*(const f32x4*)pp + *(const f32x4*)(pp + (size_t)CTX * DM)) + (*(const f32x4*)(pp + (size_t)2 * CTX * DM) + *(const f32x4*)(pp + (size_t)3 * CTX * DM)); }
                else ov[i] = *(const f32x4*)(orow + lane * 4 + i * 256);
                ss += ov[i][0] * ov[i][0] + ov[i][1] * ov[i][1] + ov[i][2] * ov[i][2] + ov[i][3] * ov[i][3]; }
            ss = wave_sum(ss);
            const float rstd = rsqrtf(ss * (1.0f / DM) + EPS);
            const float* gate = mod + (size_t)((l - 1) * 2 + isctx) * 6144 + 4096;
            const float* gpost = p.in[I_GPOST] + (size_t)(l - 1) * DM;
#pragma unroll
            for (int i = 0; i < 8; ++i) { const f32x4 g = *(const f32x4*)(gate + lane * 4 + i * 256), gp = *(const f32x4*)(gpost + lane * 4 + i * 256);
                xv[i] = xv[i] + g * ((ov[i] * rstd) * gp); }
            if (l == 4) { float* orow2 = p.out + (size_t)(row - CTX) * DM;
#pragma unroll
                for (int i = 0; i < 8; ++i) *(f32x4*)(orow2 + lane * 4 + i * 256) = xv[i];
                continue; }
        }
        float ss = 0.f;
#pragma unroll
        for (int i = 0; i < 8; ++i) ss += xv[i][0] * xv[i][0] + xv[i][1] * xv[i][1] + xv[i][2] * xv[i][2] + xv[i][3] * xv[i][3];
        ss = wave_sum(ss);
        const float rstd = rsqrtf(ss * (1.0f / DM) + EPS);
        const float* ml = mod + (size_t)(l * 2 + isctx) * 6144;
        const float* gpre = p.in[I_GPRE] + (size_t)l * DM;
        bf16_t* hrow = (bf16_t*)(ws + WS_H) + (size_t)row * DM;
        f32x4 sh[8], scl[8], gp[8];
#pragma unroll
        for (int i = 0; i < 8; ++i) { const int c = lane * 4 + i * 256; sh[i] = *(const f32x4*)(ml + c); scl[i] = *(const f32x4*)(ml + 2048 + c); gp[i] = *(const f32x4*)(gpre + c); }
        __builtin_amdgcn_sched_barrier(0);
        if (l > 0) {
#pragma unroll
            for (int i = 0; i < 8; ++i) *(f32x4*)(xrow + lane * 4 + i * 256) = xv[i];
        }
#pragma unroll
        for (int i = 0; i < 8; ++i) { const int c = lane * 4 + i * 256;
            const f32x4 hv = ((xv[i] * rstd) * gp[i]) * (1.0f + scl[i]) + sh[i];
            u32x2 w; w.x = cvtpk(hv[0], hv[1]); w.y = cvtpk(hv[2], hv[3]);
            *(u32x2*)(hrow + c) = w; }
    }
}

__device__ __forceinline__ void ew_phase(const Params& p, int l) {
    int tid_ = threadIdx.x; asm volatile("" : "+v"(tid_));
    const int tid = tid_;
    unsigned char* ws = p.ws;
    bf16_t* P = (bf16_t*)(ws + WS_P);
    {
        const int t = tid & 15; const long grp = ((long)blockIdx.x * NTHREADS + tid) >> 4, ngrp = (long)gridDim.x * NTHREADS / 16;
        const float2* rope = (const float2*)(ws + WS_ROPE);
        const int base = ((t & 8) ? 64 : 0) + 4 * (t & 7), fi = 4 * (t & 7);
        bf16_t* KC = (bf16_t*)(ws + WS_KC);
#pragma unroll 2
        for (long it = grp; it < (long)ROWS * 20; it += ngrp) { const int row = (int)(it / 20), head = (int)(it % 20);
            const bf16_t* src_ = P + (size_t)row * INC + (head < 16 ? OQ + head * 128 : OKK + (head - 16) * 128) + base;
            bf16_t* dst_ = (head < 16) ? (P + (size_t)row * INC + OQ + head * 128 + base) : (KC + ((size_t)(head - 16) * ROWS + row) * 128 + base);
            const float* gn = (head < 16 ? p.in[I_QN] : p.in[I_KN]) + (size_t)l * 128 + base;
            const u32x2 wa = *(const u32x2*)src_, wb = *(const u32x2*)(src_ + 32);
            const f32x4 ga = *(const f32x4*)gn, gb = *(const f32x4*)(gn + 32);
            float a[4] = {bflo(wa.x), bfhi(wa.x), bflo(wa.y), bfhi(wa.y)}, b[4] = {bflo(wb.x), bfhi(wb.x), bflo(wb.y), bfhi(wb.y)};
            float ss = 0.f;
#pragma unroll
            for (int q = 0; q < 4; ++q) ss += a[q] * a[q] + b[q] * b[q];
#pragma unroll
            for (int o = 8; o >= 1; o >>= 1) ss += __shfl_xor(ss, o);
            const float rstd = rsqrtf(ss * (1.0f / 128.0f) + EPS);
#pragma unroll
            for (int q = 0; q < 4; ++q) { a[q] = a[q] * rstd * ga[q]; b[q] = b[q] * rstd * gb[q]; }
            if (row >= CTX) { const int tk = row - CTX, pos = (t & 8) ? (tk & 63) : (tk >> 6);
                const f32x4 r01 = *(const f32x4*)(rope + pos * 32 + fi), r23 = *(const f32x4*)(rope + pos * 32 + fi + 2);
                const float cs[4] = {r01[0], r01[2], r23[0], r23[2]}, sn[4] = {r01[1], r01[3], r23[1], r23[3]};
#pragma unroll
                for (int q = 0; q < 4; ++q) { const float x0 = a[q], x1 = b[q]; a[q] = x0 * cs[q] - x1 * sn[q]; b[q] = x0 * sn[q] + x1 * cs[q]; } }
            u32x2 oa, ob; oa.x = cvtpk(a[0], a[1]); oa.y = cvtpk(a[2], a[3]); ob.x = cvtpk(b[0], b[1]); ob.y = cvtpk(b[2], b[3]);
            *(u32x2*)dst_ = oa; *(u32x2*)(dst_ + 32) = ob;
        }
    }
    {
        const long gt = (long)blockIdx.x * NTHREADS + tid, gn = (long)gridDim.x * NTHREADS;
        bf16_t* VC = (bf16_t*)(ws + WS_VC);
        for (long it = gt; it < (long)ROWS * 64; it += gn) { const int row = (int)(it >> 6), c = (int)(it & 63) * 8;
            const u32x4 v = *(const u32x4*)(P + (size_t)row * INC + OV + c);
            *(u32x4*)(VC + ((size_t)(c >> 7) * ROWS + row) * 128 + (c & 127)) = v; }
    }
    {
        const long gt = (long)blockIdx.x * NTHREADS + tid, gn = (long)gridDim.x * NTHREADS;
        bf16_t* Acat = (bf16_t*)(ws + WS_ACAT);
        const float* cw = p.in[I_CW] + (size_t)l * 3 * 1024; const float* cbias = p.in[I_CB] + (size_t)l * 1024;
        for (long it = gt; it < (long)(ROWS / 4) * 128; it += gn) { const int row0 = (int)(it >> 7) * 4, c0 = (int)(it & 127) * 8;
            const bf16_t* pr = P + (size_t)row0 * INC;
            const bool hp = (row0 != 0) && (row0 != CTX), hn = (row0 + 4 != CTX) && (row0 + 4 != ROWS);
            const u32x4 z = {0u, 0u, 0u, 0u};
            u32x4 xv[6], kv[6], bb[4], gg[4];
            xv[0] = hp ? *(const u32x4*)(pr - INC + OCX + c0) : z; kv[0] = hp ? *(const u32x4*)(pr - INC + OCC + c0) : z;
#pragma unroll
            for (int r = 0; r < 4; ++r) { xv[r + 1] = *(const u32x4*)(pr + (size_t)r * INC + OCX + c0); kv[r + 1] = *(const u32x4*)(pr + (size_t)r * INC + OCC + c0);
                bb[r] = *(const u32x4*)(pr + (size_t)r * INC + OCB + c0); gg[r] = *(const u32x4*)(pr + (size_t)r * INC + OCG + c0); }
            xv[5] = hn ? *(const u32x4*)(pr + (size_t)4 * INC + OCX + c0) : z; kv[5] = hn ? *(const u32x4*)(pr + (size_t)4 * INC + OCC + c0) : z;
            float w0[8], w1[8], w2[8], bs[8];
#pragma unroll
            for (int j = 0; j < 8; ++j) { w0[j] = cw[c0 + j]; w1[j] = cw[1024 + c0 + j]; w2[j] = cw[2048 + c0 + j]; bs[j] = cbias[c0 + j]; }
            float uu[6][8];
#pragma unroll
            for (int r = 0; r < 6; ++r)
#pragma unroll
                for (int q = 0; q < 4; ++q) { uu[r][2 * q] = bflo(xv[r][q]) * bflo(kv[r][q]); uu[r][2 * q + 1] = bfhi(xv[r][q]) * bfhi(kv[r][q]); }
#pragma unroll
            for (int r = 0; r < 4; ++r) { float res[8];
#pragma unroll
                for (int q = 0; q < 4; ++q) {
                    { const int j = 2 * q; const float cv = uu[r][j] * w0[j] + uu[r + 1][j] * w1[j] + uu[r + 2][j] * w2[j] + bs[j]; res[j] = bflo(bb[r][q]) * cv * siluf_(bflo(gg[r][q])); }
                    { const int j = 2 * q + 1; const float cv = uu[r][j] * w0[j] + uu[r + 1][j] * w1[j] + uu[r + 2][j] * w2[j] + bs[j]; res[j] = bfhi(bb[r][q]) * cv * siluf_(bfhi(gg[r][q])); } }
                u32x4 w; w.x = cvtpk(res[0], res[1]); w.y = cvtpk(res[2], res[3]); w.z = cvtpk(res[4], res[5]); w.w = cvtpk(res[6], res[7]);
                *(u32x4*)(Acat + 2 * APL + (size_t)(row0 + r) * CLD + c0) = w; }
        }
    }
}

constexpr int BM = 256, BK = 64, HALF = 128, HTB = HALF * BK * 2;
constexpr int BJC = 32;
__device__ __forceinline__ int lds_byte(int r, int c) { const int st = (r >> 4) * 2 + (c >> 5), rr = r & 15, cc = c & 31, ob = rr * 64 + cc * 2; return st * 1024 + (ob ^ (((ob >> 9) & 1) << 5)); }
__device__ __forceinline__ void stage_rc(int b, int& R, int& C) { const int st = b / 1024, sb = b % 1024, swz = sb ^ (((sb >> 9) & 1) << 5); R = (st >> 1) * 16 + swz / 64; C = (st & 1) * 32 + (swz % 64) / 2; }
__device__ __forceinline__ int perm32(int rho) { const int n = rho >> 4, i = rho & 15; return 8 * (i >> 2) + 4 * n + (i & 3); }

enum { G_FOLD = 0, G_IN, G_XT, G_F1, G_F2, G_DFTC, G_MIX, G_MERGE, G_OUT, G_MERGEC };
enum { M_BF16 = 0, M_MIX, M_MERGE0, M_MERGE1, M_MERGE2, M_F32, M_F1, M_F2, M_MG0, M_MG1, M_MG2 };
struct Unit { const char* a; const char* b; char* o; const char* aux; char* m; int nt, mode, ldo; };

__device__ __forceinline__ void static_order(int w, int nM, int nN, int& pm, int& pn) {
    const int nwg = nM * nN, q = nwg / 8, r = nwg % 8, xcd = w % 8, off = w / 8;
    const int wg = (xcd < r ? xcd * (q + 1) : r * (q + 1) + (xcd - r) * q) + off;
    const int nig = 8 * nN, gid = wg / nig, fm = gid * 8, gsz = (nM - fm) < 8 ? (nM - fm) : 8;
    pm = fm + ((wg % nig) % gsz); pn = (wg % nig) / gsz;
}

__device__ __forceinline__ bool get_unit(int gid, int l, int i, unsigned char* ws, Unit& u) {
    const int G = gridDim.x, c = blockIdx.x;
    u.aux = nullptr; u.m = nullptr;
    switch (gid) {
    case G_FOLD: { const int L = i * G + c; if (L >= 128) return false;
        const int ll = L >> 5, g = (L >> 3) & 3, pm = (L >> 1) & 3, pnn = L & 1;
        u.a = (const char*)(ws + WS_WMIXR + ll * SZ_WMIXR) + ((size_t)pm * 256 * 1024 + g * 256) * 2;
        u.b = (const char*)(ws + WS_TCH) + (size_t)pnn * 256 * 256 * 2;
        u.o = (char*)(ws + WS_WMIX + ll * SZ_WMIX) + ((size_t)pm * 256 * 2048 + pnn * 1024 + g * 256) * 2;
        u.nt = 4; u.mode = M_BF16; u.ldo = 2048; return true; }
    case G_IN: { const int L = i * G + c; if (L >= 2116) return false;
        if (L < 2112) { int pm, pn; static_order(L, 33, 64, pm, pn); const int pnp = pn < 20 ? pn : pn + 4;
            u.a = (const char*)(ws + WS_H) + (size_t)pm * 256 * DM * 2;
            u.b = (const char*)(ws + WS_WINT + l * SZ_WINT) + (size_t)pnp * 256 * DM * 2;
            u.o = (char*)(ws + WS_P) + ((size_t)pm * 256 * INC + pnp * 256) * 2; u.ldo = INC; }
        else { const int pm = L - 2112;
            u.a = (const char*)(ws + WS_WINT + l * SZ_WINT) + (size_t)(OFX + pm * 256) * DM * 2;
            u.b = (const char*)(ws + WS_H);
            u.o = (char*)(ws + WS_XT) + (size_t)pm * 256 * ROWS * 2; u.ldo = ROWS; }
        u.nt = 32; u.mode = M_BF16; return true; }
    case G_XT: { const int L = i * G + ((c + G - 68) % G); if (L >= 128) return false; const int pm = L & 3, pn = 1 + (L >> 2);
        u.a = (const char*)(ws + WS_WINT + l * SZ_WINT) + (size_t)(OFX + pm * 256) * DM * 2;
        u.b = (const char*)(ws + WS_H) + (size_t)(CTX + 2 * (pn - 1)) * DM * 2;
        u.o = (char*)(ws + WS_XT) + ((size_t)pm * 256 * ROWS + pn * 256) * 2; u.ldo = ROWS;
        u.nt = 32; u.mode = M_BF16; return true; }
    case G_F1: { const int L = i * G + c; if (L >= 256) return false; const int s2 = L >> 2, ct = L & 3;
        u.a = (const char*)(ws + WS_XT) + ((size_t)ct * 256 * ROWS + CTX + s2 * 128) * 2;
        u.b = (const char*)(ws + WS_T1);
        u.o = (char*)(ws + WS_ZT) + (size_t)ct * 256 * ZCH + s2 * 8;
        u.nt = 2; u.mode = M_F1; u.ldo = s2; return true; }
    case G_F2: { if (c < 16 || c >= G - 132) return false; const int L = i * (G - 148) + (c - 16); if (L >= 256) return false; const int k1p = L >> 2, ct = L & 3;
        u.a = (const char*)(ws + WS_A2);
        u.b = (const char*)(ws + WS_ZT) + (size_t)ct * 256 * ZCH + k1p * 512;
        u.o = (char*)(ws + WS_PQ) + ((size_t)(CTX + 2 * k1p) * 2048 + ct * 256) * 2;
        u.nt = 4; u.mode = M_F2; u.ldo = 2048; return true; }
    case G_DFTC: { const int L = i * G + c; if (L >= 8) return false; const int pm = L >> 2, pn = L & 3;
        u.a = (const char*)(ws + WS_ACTX) + (size_t)pm * 256 * 256 * 2;
        u.b = (const char*)(ws + WS_XT) + (size_t)pn * 256 * ROWS * 2;
        u.o = (char*)(ws + WS_PQ) + ((size_t)pm * 1024 + pn * 256) * 2;
        u.nt = 4; u.mode = M_BF16; u.ldo = 2048; return true; }
    case G_MIX: { const int L = i * G + (G - 1 - c); if (L >= 132) return false; const int pm = L >> 2, pn = L & 3;
        u.a = (const char*)(ws + WS_PQ) + (size_t)pm * 256 * 2048 * 2;
        u.b = (const char*)(ws + WS_WMIX + l * SZ_WMIX) + (size_t)pn * 256 * 2048 * 2;
        u.aux = (const char*)(ws + WS_P) + ((size_t)pm * 256 * INC + OFG + pn * 256) * 2;
        u.o = (char*)(ws + WS_ACAT) + (APL + (size_t)pm * 256 * CLD + pn * 256) * 2;
        u.nt = 32; u.mode = M_MIX; u.ldo = CLD; return true; }
    case G_MERGE: {
        if (i < 3) { const int T = c, sub = i; if (T >= 256) return false;
            int pm, pn; static_order(T, 32, 8, pm, pn); pm += 1;
            u.a = (const char*)(ws + WS_ACAT) + ((size_t)sub * APL + (size_t)pm * 256 * CLD) * 2;
            u.b = (const char*)(ws + WS_WCAT + l * SZ_WCAT) + ((size_t)sub * WPL + (size_t)pn * 256 * CLD) * 2;
            u.aux = (const char*)(ws + WS_P) + ((size_t)pm * 256 * INC + OML + sub * 2048 + pn * 256) * 2;
            u.m = (char*)(ws + WS_MBUF) + ((size_t)pm * 256 * MLD + pn * 256) * 4;
            u.o = (char*)(ws + WS_MB) + ((size_t)pm * 256 * 2048 + pn * 256) * 2;
            u.nt = sub == 0 ? 32 : 16; u.mode = M_MG0 + sub; u.ldo = 2048; return true; }
        return false; }
    case G_MERGEC: {
        if (i == 0 && l < DEPTH - 1 && c >= G - 64) { const int pc = c - (G - 64), pn = pc >> 3, q = pc & 7;
            const int sub = q < 4 ? 0 : (q < 6 ? 1 : 2), kcol = q < 4 ? q * 512 : (q < 6 ? (q - 4) * 512 : (q - 6) * 512);
            u.a = (const char*)(ws + WS_ACAT) + ((size_t)sub * APL + kcol) * 2;
            u.b = (const char*)(ws + WS_WCAT + l * SZ_WCAT) + ((size_t)sub * WPL + (size_t)pn * 256 * CLD + kcol) * 2;
            u.aux = (const char*)(ws + WS_P) + ((size_t)OML + sub * 2048 + pn * 256) * 2;
            u.m = (char*)(ws + WS_MP) + ((size_t)q * CTX * MLD + pn * 256) * 4;
            u.o = nullptr; u.nt = 8; u.mode = M_MERGE0; u.ldo = 2048; return true; }
        return false; }
    case G_OUT: {
        const int piece = l >> 4; l &= 15;
        if (i != 0) return false;
        if (!piece) { if (c >= 256) return false; int pm, pn; static_order(c, 32, 8, pm, pn); pm += 1;
            u.a = (const char*)(ws + WS_MB) + (size_t)pm * 256 * 2048 * 2;
            u.b = (const char*)(ws + WS_WOUT + l * SZ_WOUT) + (size_t)pn * 256 * 2048 * 2;
            u.o = (char*)(ws + WS_OUTB) + ((size_t)pm * 256 * 2048 + pn * 256) * 4;
            u.nt = 32; u.mode = M_F32; u.ldo = 2048; return true; }
        if (l < DEPTH - 1 && c >= G - 32) { const int pc = c - (G - 32), pn = pc >> 2, kp = pc & 3;
            u.a = (const char*)(ws + WS_MB) + (size_t)kp * 512 * 2;
            u.b = (const char*)(ws + WS_WOUT + l * SZ_WOUT) + ((size_t)pn * 256 * 2048 + kp * 512) * 2;
            u.o = (char*)(ws + WS_OUTP) + ((size_t)kp * CTX * 2048 + pn * 256) * 4;
            u.nt = 8; u.mode = M_F32; u.ldo = 2048; return true; }
        return false; }
    }
    return false;
}

__device__ __forceinline__ void epilogue(const f32x4 (&acc)[2][2][4][2], const Unit& u, int wr, int wc, int fr, int fq) {
    unsigned r0 = wr * 64 + fr, c0 = wc * 64 + 8 * fq;
    asm volatile("" : "+v"(r0), "+v"(c0));
    if (u.mode == M_BF16) {
        const unsigned base = (r0 * (unsigned)u.ldo + c0) * 2u;
#pragma unroll
        for (int ai = 0; ai < 2; ++ai)
#pragma unroll
            for (int m = 0; m < 4; ++m) { char* rowp = u.o + (size_t)(ai * HALF + m * 16) * u.ldo * 2;
#pragma unroll
                for (int bj = 0; bj < 2; ++bj) { const f32x4 v0 = acc[ai][bj][m][0], v1 = acc[ai][bj][m][1];
                    u32x4 w; w.x = cvtpk(v0[0], v0[1]); w.y = cvtpk(v0[2], v0[3]); w.z = cvtpk(v1[0], v1[1]); w.w = cvtpk(v1[2], v1[3]);
                    *(u32x4*)(rowp + base + bj * BJC * 2) = w; } }
    } else if (u.mode == M_MIX) {
        const unsigned base = (r0 * (unsigned)u.ldo + c0) * 2u, abase = (r0 * (unsigned)INC + c0) * 2u;
#pragma unroll
        for (int ai = 0; ai < 2; ++ai) {
            u32x4 g[4][2];
#pragma unroll
            for (int m = 0; m < 4; ++m)
#pragma unroll
                for (int bj = 0; bj < 2; ++bj) g[m][bj] = *(const u32x4*)(u.aux + (size_t)(ai * HALF + m * 16) * INC * 2 + abase + bj * BJC * 2);
            __builtin_amdgcn_sched_barrier(0);
#pragma unroll
            for (int m = 0; m < 4; ++m) { char* rowp = u.o + (size_t)(ai * HALF + m * 16) * u.ldo * 2;
#pragma unroll
                for (int bj = 0; bj < 2; ++bj) { const f32x4 v0 = acc[ai][bj][m][0], v1 = acc[ai][bj][m][1]; const u32x4 gg = g[m][bj];
                    u32x4 w; w.x = cvtpk(v0[0] * siluf_(bflo(gg.x)), v0[1] * siluf_(bfhi(gg.x))); w.y = cvtpk(v0[2] * siluf_(bflo(gg.y)), v0[3] * siluf_(bfhi(gg.y)));
                    w.z = cvtpk(v1[0] * siluf_(bflo(gg.z)), v1[1] * siluf_(bfhi(gg.z))); w.w = cvtpk(v1[2] * siluf_(bflo(gg.w)), v1[3] * siluf_(bfhi(gg.w)));
                    *(u32x4*)(rowp + base + bj * BJC * 2) = w; } }
            __builtin_amdgcn_sched_barrier(0);
        }
    } else if (u.mode == M_F32) {
        const unsigned base = (r0 * (unsigned)u.ldo + c0) * 4u;
#pragma unroll
        for (int ai = 0; ai < 2; ++ai)
#pragma unroll
            for (int m = 0; m < 4; ++m) { char* rowp = u.o + (size_t)(ai * HALF + m * 16) * u.ldo * 4;
#pragma unroll
                for (int bj = 0; bj < 2; ++bj) { *(f32x4*)(rowp + base + bj * BJC * 4) = acc[ai][bj][m][0]; *(f32x4*)(rowp + base + bj * BJC * 4 + 16) = acc[ai][bj][m][1]; } }
    } else if (u.mode == M_MG0 || u.mode == M_MG1) {
    } else if (u.mode == M_MG2) {
        const unsigned abase = (r0 * (unsigned)INC + c0) * 2u, obase = (r0 * 2048u + c0) * 2u;
#pragma unroll
        for (int ai = 0; ai < 2; ++ai) {
            u32x4 g[4][2];
#pragma unroll
            for (int m = 0; m < 4; ++m)
#pragma unroll
                for (int bj = 0; bj < 2; ++bj) g[m][bj] = *(const u32x4*)(u.aux + (size_t)(ai * HALF + m * 16) * INC * 2 + abase + bj * BJC * 2);
            __builtin_amdgcn_sched_barrier(0);
#pragma unroll
            for (int m = 0; m < 4; ++m) { char* rowp = u.o + (size_t)(ai * HALF + m * 16) * 2048 * 2;
#pragma unroll
                for (int bj = 0; bj < 2; ++bj) { f32x4 v0 = acc[ai][bj][m][0], v1 = acc[ai][bj][m][1]; const u32x4 gg = g[m][bj];
                    v0[0] *= sigmoidf_(bflo(gg.x)); v0[1] *= sigmoidf_(bfhi(gg.x)); v0[2] *= sigmoidf_(bflo(gg.y)); v0[3] *= sigmoidf_(bfhi(gg.y));
                    v1[0] *= sigmoidf_(bflo(gg.z)); v1[1] *= sigmoidf_(bfhi(gg.z)); v1[2] *= sigmoidf_(bflo(gg.w)); v1[3] *= sigmoidf_(bfhi(gg.w));
                    u32x4 w; w.x = cvtpk(v0[0], v0[1]); w.y = cvtpk(v0[2], v0[3]); w.z = cvtpk(v1[0], v1[1]); w.w = cvtpk(v1[2], v1[3]); *(u32x4*)(rowp + obase + bj * BJC * 2) = w; } }
            __builtin_amdgcn_sched_barrier(0);
        }
    } else if (u.mode == M_F1) {
        const int s2 = u.ldo;
        const unsigned kb0 = (c0 >> 1);
        float tc[2][4], ts[2][4];
#pragma unroll
        for (int bj = 0; bj < 2; ++bj)
#pragma unroll
            for (int j = 0; j < 4; ++j) { const float x = (float)((bj * 16 + kb0 + j) * s2) * (1.0f / 8192.0f); tc[bj][j] = __builtin_amdgcn_cosf(x); ts[bj][j] = __builtin_amdgcn_sinf(x); }
        const unsigned base = r0 * (unsigned)ZCH + kb0 * 256u;
#pragma unroll
        for (int ai = 0; ai < 2; ++ai)
#pragma unroll
            for (int m = 0; m < 4; ++m) { char* rowp = u.o + (size_t)(ai * HALF + m * 16) * ZCH;
#pragma unroll
                for (int bj = 0; bj < 2; ++bj) { const f32x4 v0 = acc[ai][bj][m][0], v1 = acc[ai][bj][m][1];
                    const float zr[4] = {v0[0], v0[2], v1[0], v1[2]}, zi[4] = {v0[1], v0[3], v1[1], v1[3]};
#pragma unroll
                    for (int jp = 0; jp < 2; ++jp) { u32x2 w;
                        { const int j = 2 * jp; w.x = cvtpk(zr[j] * tc[bj][j] + zi[j] * ts[bj][j], zi[j] * tc[bj][j] - zr[j] * ts[bj][j]); }
                        { const int j = 2 * jp + 1; w.y = cvtpk(zr[j] * tc[bj][j] + zi[j] * ts[bj][j], zi[j] * tc[bj][j] - zr[j] * ts[bj][j]); }
                        *(u32x2*)(rowp + base + (bj * 8 + jp) * 512) = w; } } }
    } else if (u.mode == M_F2) {
        const unsigned fr_ = r0 & 15u, wr_ = r0 >> 6;
        const unsigned base = ((128u * fr_) * 2048u + wr_ * 1024u + c0) * 2u;
#pragma unroll
        for (int ai = 0; ai < 2; ++ai)
#pragma unroll
            for (int m = 0; m < 4; ++m) { char* rowp = u.o + (size_t)(ai + 2048 * m) * 2048 * 2;
#pragma unroll
                for (int bj = 0; bj < 2; ++bj) { const f32x4 v0 = acc[ai][bj][m][0], v1 = acc[ai][bj][m][1];
                    u32x4 w; w.x = cvtpk(v0[0], v0[1]); w.y = cvtpk(v0[2], v0[3]); w.z = cvtpk(v1[0], v1[1]); w.w = cvtpk(v1[2], v1[3]);
                    *(u32x4*)(rowp + base + bj * BJC * 2) = w; } }
    } else {
        const unsigned abase = (r0 * (unsigned)INC + c0) * 2u, mbase = (r0 * (unsigned)MLD + c0) * 4u;
#pragma unroll
        for (int ai = 0; ai < 2; ++ai)
#pragma unroll
            for (int m = 0; m < 4; ++m) { const int rr = ai * HALF + m * 16; const char* ap = u.aux + (size_t)rr * INC * 2; char* mp = u.m + (size_t)rr * MLD * 4;
#pragma unroll
                for (int bj = 0; bj < 2; ++bj) { f32x4 v0 = acc[ai][bj][m][0], v1 = acc[ai][bj][m][1]; const u32x4 g = *(const u32x4*)(ap + abase + bj * BJC * 2);
                    v0[0] *= sigmoidf_(bflo(g.x)); v0[1] *= sigmoidf_(bfhi(g.x)); v0[2] *= sigmoidf_(bflo(g.y)); v0[3] *= sigmoidf_(bfhi(g.y));
                    v1[0] *= sigmoidf_(bflo(g.z)); v1[1] *= sigmoidf_(bfhi(g.z)); v1[2] *= sigmoidf_(bflo(g.w)); v1[3] *= sigmoidf_(bfhi(g.w));
                    *(f32x4*)(mp + mbase + bj * BJC * 4) = v0; *(f32x4*)(mp + mbase + bj * BJC * 4 + 16) = v1; }
                if (m & 1) __builtin_amdgcn_sched_barrier(0); }
    }
}

__device__ __forceinline__ void rescale_or_reset(f32x4 (&acc)[2][2][4][2], const Unit& u, int wr, int wc, int fr, int fq) {
    const unsigned msk = (u.mode == M_MG0 || u.mode == M_MG1) ? 0xffffffffu : 0u;
    unsigned r0 = wr * 64 + fr, c0 = wc * 64 + 8 * fq;
    asm volatile("" : "+v"(r0), "+v"(c0));
    const unsigned abase = (r0 * (unsigned)INC + c0) * 2u;
#pragma unroll
    for (int ai = 0; ai < 2; ++ai)
#pragma unroll
        for (int m = 0; m < 4; ++m) { const char* ap = u.aux + (size_t)(ai * HALF + m * 16) * INC * 2;
#pragma unroll
            for (int bj = 0; bj < 2; ++bj) {
                const u32x4 ga = *(const u32x4*)(ap + abase + bj * BJC * 2), gb = *(const u32x4*)(ap + abase + bj * BJC * 2 + 4096);
                const unsigned wa[4] = {ga.x, ga.y, ga.z, ga.w}, wb[4] = {gb.x, gb.y, gb.z, gb.w};
                float f[8];
#pragma unroll
                for (int e = 0; e < 4; ++e) {
                    const float rl = (1.0f + __expf(-bflo(wb[e]))) * __builtin_amdgcn_rcpf(1.0f + __expf(-bflo(wa[e])));
                    const float rh = (1.0f + __expf(-bfhi(wb[e]))) * __builtin_amdgcn_rcpf(1.0f + __expf(-bfhi(wa[e])));
                    f[2 * e] = __uint_as_float(__float_as_uint(rl) & msk); f[2 * e + 1] = __uint_as_float(__float_as_uint(rh) & msk); }
                acc[ai][bj][m][0] *= (f32x4){f[0], f[1], f[2], f[3]}; acc[ai][bj][m][1] *= (f32x4){f[4], f[5], f[6], f[7]};
            }
            if (m & 1) __builtin_amdgcn_sched_barrier(0);
        }
}

__device__ __forceinline__ void gemm_phase(LAS unsigned char* lds, int gid, int l, unsigned char* ws) {
    int tid_ = threadIdx.x; asm volatile("" : "+v"(tid_));
    const int tid = tid_, wid = __builtin_amdgcn_readfirstlane(tid >> 6), lane = tid & 63, wr = wid >> 2, wc = wid & 3, fr = lane & 15, fq = lane >> 4;
    int lda, ldb;
    int ldbv = 0;
    switch (gid) { case G_FOLD: lda = 1024; ldb = 256; break; case G_IN: lda = 2048; ldb = 2048; break; case G_XT: lda = 2048; ldb = 2048; ldbv = 64 * 2048; break;
                   case G_F1: lda = ROWS; ldb = 128; break; case G_F2: lda = 256; ldb = ZCH / 2; break;
                   case G_DFTC: lda = 256; ldb = ROWS; break; case G_MIX: lda = 2048; ldb = 2048; break; case G_MERGE: case G_MERGEC: lda = CLD; ldb = CLD; break; default: lda = 2048; ldb = 2048; break; }
    if (ldbv == 0) ldbv = ldb;
    Unit cur, nxt; int ui = 0;
    if (!get_unit(gid, l, 0, ws, cur)) return;
    unsigned voffA[2], voffB[2];
#pragma unroll
    for (int i = 0; i < 2; ++i) { int R, C; stage_rc(tid * 16 + i * 8192, R, C); const int w_ = R >> 5, ip = perm32(R & 31);
        const int Rb = (gid == G_XT) ? (4096 * (w_ & 1) + 64 * ip + (w_ >> 1)) : (64 * w_ + ip);
        voffA[i] = (unsigned)(R * lda + C) * 2u; voffB[i] = (unsigned)(Rb * ldb + C) * 2u; }
    const size_t kstep = (size_t)(BK * 2);
    const size_t hstepA = (size_t)HALF * lda * 2, hstepB = (gid == G_XT) ? (size_t)2048 * ldb * 2 : (size_t)32 * ldb * 2;
    const unsigned ldsw = (unsigned)wid * 1024u;
    const int aoff = lds_byte(wr * 64 + fr, fq * 8), boff = lds_byte(wc * 32 + fr, fq * 8);
#define PG8_SA(b, h) (((b) * 2 + (h)) * HTB)
#define PG8_SB(b, h) ((4 + (b) * 2 + (h)) * HTB)
#define PG8_STAGE(bufoff, gbase, voff) do { _Pragma("unroll") for (int _i = 0; _i < 2; ++_i) \
        __builtin_amdgcn_global_load_lds((const unsigned*)((const char*)(gbase) + (voff)[_i]), (LAS unsigned*)(lds + (bufoff) + ldsw + _i * 8192), 16, 0, 0); } while (0)
#define PG8_LDA(dst, b, h) do { _Pragma("unroll") for (int m = 0; m < 4; ++m) _Pragma("unroll") for (int k = 0; k < 2; ++k) dst[m][k] = *(const LAS bf16x8*)(lds + PG8_SA(b, h) + aoff + m * 2048 + k * 1024); } while (0)
#define PG8_LDB(dst, b, h) do { _Pragma("unroll") for (int n = 0; n < 2; ++n) _Pragma("unroll") for (int k = 0; k < 2; ++k) dst[n][k] = *(const LAS bf16x8*)(lds + PG8_SB(b, h) + boff + n * 2048 + k * 1024); } while (0)
#define PG8_MMA(ai, bj, At, Bt) do { __builtin_amdgcn_s_setprio(1); _Pragma("unroll") for (int m = 0; m < 4; ++m) _Pragma("unroll") for (int n = 0; n < 2; ++n) _Pragma("unroll") for (int k = 0; k < 2; ++k) \
        acc[ai][bj][m][n] = __builtin_amdgcn_mfma_f32_16x16x32_bf16(Bt[n][k], At[m][k], acc[ai][bj][m][n], 0, 0, 0); __builtin_amdgcn_s_setprio(0); } while (0)
#define PG8_WAIT_V(n) asm volatile("s_waitcnt vmcnt(" #n ")" ::: "memory")
#define PG8_WAIT_L(n) asm volatile("s_waitcnt lgkmcnt(" #n ")" ::: "memory")
#define PG8_BAR __builtin_amdgcn_s_barrier()
#define PG8_SCHED __builtin_amdgcn_sched_barrier(0)
    f32x4 acc[2][2][4][2];
#pragma unroll
    for (int a = 0; a < 2; ++a)
#pragma unroll
        for (int b = 0; b < 2; ++b)
#pragma unroll
            for (int m = 0; m < 4; ++m)
#pragma unroll
                for (int n = 0; n < 2; ++n) acc[a][b][m][n] = (f32x4){0.f, 0.f, 0.f, 0.f};
    bf16x8 At[4][2], B0[2][2], B1[2][2];
    const char* cA = cur.a; const char* cB = cur.b;
    PG8_STAGE(PG8_SB(0, 0), cB, voffB); PG8_STAGE(PG8_SA(0, 0), cA, voffA); PG8_STAGE(PG8_SB(0, 1), cB + hstepB, voffB); PG8_STAGE(PG8_SA(0, 1), cA + hstepA, voffA);
    if (wr == 1) PG8_BAR;
    PG8_WAIT_V(4); PG8_BAR;
    PG8_STAGE(PG8_SB(1, 0), cB + kstep, voffB); PG8_STAGE(PG8_SA(1, 0), cA + kstep, voffA); PG8_STAGE(PG8_SB(1, 1), cB + hstepB + kstep, voffB);
    PG8_WAIT_V(6); PG8_BAR;
    for (;;) {
        const bool has_next = get_unit(gid, l, ui + 1, ws, nxt);
        const char* nA = has_next ? nxt.a : cA; const char* nB = has_next ? nxt.b : cB;
        const int nt = cur.nt;
        for (int t = 0; t < nt; t += 2) {
            const bool last = (t == nt - 2);
            const char* a1 = cA + (size_t)(t + 1) * kstep;
            const char* a2 = last ? nA : cA + (size_t)(t + 2) * kstep; const char* b2 = last ? nB : cB + (size_t)(t + 2) * kstep;
            const char* a3 = a2 + kstep; const char* b3 = b2 + kstep;
            PG8_LDB(B0, 0, 0); PG8_SCHED; PG8_LDA(At, 0, 0); PG8_STAGE(PG8_SA(1, 1), a1 + hstepA, voffA);
            PG8_WAIT_L(8); PG8_BAR; PG8_WAIT_L(0); PG8_MMA(0, 0, At, B0); PG8_BAR; PG8_SCHED;
            PG8_LDB(B1, 0, 1); PG8_STAGE(PG8_SB(0, 0), b2, voffB);
            PG8_BAR; PG8_WAIT_L(0); PG8_MMA(0, 1, At, B1); PG8_BAR;
            PG8_LDA(At, 0, 1); PG8_STAGE(PG8_SA(0, 0), a2, voffA);
            PG8_BAR; PG8_WAIT_L(0); PG8_MMA(1, 0, At, B0); PG8_BAR; PG8_SCHED;
            PG8_STAGE(PG8_SB(0, 1), b2 + hstepB, voffB);
            PG8_WAIT_V(6); PG8_BAR; PG8_MMA(1, 1, At, B1); PG8_BAR;
            PG8_LDB(B0, 1, 0); PG8_SCHED; PG8_LDA(At, 1, 0); PG8_STAGE(PG8_SA(0, 1), a2 + hstepA, voffA);
            PG8_WAIT_L(8); PG8_BAR; PG8_WAIT_L(0); PG8_MMA(0, 0, At, B0); PG8_BAR; PG8_SCHED;
            PG8_LDB(B1, 1, 1); PG8_STAGE(PG8_SB(1, 0), b3, voffB);
            PG8_BAR; PG8_WAIT_L(0); PG8_MMA(0, 1, At, B1); PG8_BAR;
            PG8_LDA(At, 1, 1); PG8_STAGE(PG8_SA(1, 0), a3, voffA);
            PG8_BAR; PG8_WAIT_L(0); PG8_MMA(1, 0, At, B0); PG8_BAR; PG8_SCHED;
            PG8_STAGE(PG8_SB(1, 1), b3 + hstepB, voffB);
            PG8_WAIT_V(6); PG8_BAR; PG8_MMA(1, 1, At, B1); PG8_BAR;
        }
        epilogue(acc, cur, wr, wc, fr, fq);
        if (!has_next) break;
        if (gid == G_MERGE) rescale_or_reset(acc, cur, wr, wc, fr, fq);
        else {
#pragma unroll
            for (int a = 0; a < 2; ++a)
#pragma unroll
                for (int b = 0; b < 2; ++b)
#pragma unroll
                    for (int m = 0; m < 4; ++m)
#pragma unroll
                        for (int n = 0; n < 2; ++n) acc[a][b][m][n] = (f32x4){0.f, 0.f, 0.f, 0.f};
        }
        cur = nxt; cA = nA; cB = nB; ++ui;
    }
    PG8_WAIT_V(0);
    if (wr == 0) PG8_BAR;
    PG8_BAR;
#undef PG8_SA
#undef PG8_SB
#undef PG8_STAGE
#undef PG8_LDA
#undef PG8_LDB
#undef PG8_MMA
#undef PG8_WAIT_V
#undef PG8_WAIT_L
#undef PG8_BAR
#undef PG8_SCHED
}

namespace att {
constexpr int D = 128, NW = 8, QBLK = 32, KVBLK = 64;
constexpr float SCALE = 0.088388347648318440f;
constexpr float THR = 8.f;
constexpr int LDQ = INC, LDK = 128, LDO = CLD;
constexpr size_t SHM_V = KVBLK * D * 2, SHM_K = KVBLK * D * 2, SHM_ATTN = 2 * SHM_V + 2 * SHM_K + NW * 64 * 4;
#define KSWZ(row, colB) ((row) * 256 + ((colB) ^ (((row) & 7) << 4)))
#define SBAR() __builtin_amdgcn_sched_barrier(0)
__device__ __forceinline__ int crow(int r, int hi) { return (r & 3) + 8 * (r >> 2) + 4 * hi; }
__device__ __forceinline__ void partialSM(f32x16& p0, f32x16& p1, float& m_reg, float& mn, float& alpha) {
  constexpr float C = SCALE * 1.4426950408889634f;
  float pmax = p0[0];
#pragma unroll
  for (int r = 1; r < 16; ++r) pmax = fmaxf(pmax, p0[r]);
#pragma unroll
  for (int r = 0; r < 16; ++r) pmax = fmaxf(pmax, p1[r]);
  { auto rr = __builtin_amdgcn_permlane32_swap(__float_as_uint(pmax), __float_as_uint(pmax), false, false);
    pmax = fmaxf(__uint_as_float(rr[0]), __uint_as_float(rr[1])); }
  if (__builtin_expect(__all(pmax - m_reg <= THR / SCALE), 1)) { mn = m_reg; alpha = 1.f; }
  else { mn = fmaxf(m_reg, pmax); alpha = __builtin_amdgcn_exp2f((m_reg - mn) * C); m_reg = mn; }
  float mnC = -mn * C;
#pragma unroll
  for (int r = 0; r < 16; ++r) p0[r] = fmaf(p0[r], C, mnC);
#pragma unroll
  for (int r = 0; r < 16; ++r) p1[r] = fmaf(p1[r], C, mnC);
#pragma unroll
  for (int r = 0; r < 16; ++r) p0[r] = __builtin_amdgcn_exp2f(p0[r]);
}
__device__ __forceinline__ void finishSM(f32x16& p0, f32x16& p1, float alpha, float& l_reg, bf16x8& pa0, bf16x8& pa1, bf16x8& pa2, bf16x8& pa3) {
#pragma unroll
  for (int r = 0; r < 16; ++r) p1[r] = __builtin_amdgcn_exp2f(p1[r]);
  float ps = 0;
#pragma unroll
  for (int r = 0; r < 16; ++r) ps += p0[r];
#pragma unroll
  for (int r = 0; r < 16; ++r) ps += p1[r];
  { auto rr = __builtin_amdgcn_permlane32_swap(__float_as_uint(ps), __float_as_uint(ps), false, false);
    ps = __uint_as_float(rr[0]) + __uint_as_float(rr[1]); }
  l_reg = l_reg * alpha + ps;
#define PK4(P, BASE, OUT) do { unsigned a0 = cvtpk(P[BASE + 0], P[BASE + 1]), a1 = cvtpk(P[BASE + 2], P[BASE + 3]);   \
    unsigned b0 = cvtpk(P[BASE + 4], P[BASE + 5]), b1 = cvtpk(P[BASE + 6], P[BASE + 7]);                              \
    auto r0 = __builtin_amdgcn_permlane32_swap(a0, b0, false, false); auto r1 = __builtin_amdgcn_permlane32_swap(a1, b1, false, false); \
    u32x4 w = {r0[0], r1[0], r0[1], r1[1]}; OUT = *reinterpret_cast<bf16x8*>(&w); } while (0)
  PK4(p0, 0, pa0); PK4(p0, 8, pa1); PK4(p1, 0, pa2); PK4(p1, 8, pa3);
#undef PK4
}
__device__ __forceinline__ void qkt(f32x16& p0, f32x16& p1, const bf16_t* Ks, const bf16x8* qr, int r32, int hi) {
  p0 = f32x16{}; p1 = f32x16{};
#pragma unroll
  for (int d0 = 0; d0 < 8; ++d0) { int cb = (d0 * 16 + hi * 8) * 2;
    bf16x8 b0 = *reinterpret_cast<const bf16x8*>((const char*)Ks + KSWZ(r32, cb));
    bf16x8 b1 = *reinterpret_cast<const bf16x8*>((const char*)Ks + KSWZ(32 + r32, cb));
    p0 = __builtin_amdgcn_mfma_f32_32x32x16_bf16(b0, qr[d0], p0, 0, 0, 0);
    p1 = __builtin_amdgcn_mfma_f32_32x32x16_bf16(b1, qr[d0], p1, 0, 0, 0); }
}
__device__ __forceinline__ int v_st(int k, int c) { const int kk = (k & ~0xC) | ((k & 4) << 1) | ((k & 8) >> 1); return ((kk >> 3) * 4 + (c >> 5)) * 512 + ((kk & 7) * 32 + (c & 31)) * 2; }
__device__ __forceinline__ int v_rd_base(int lane) { return ((lane & 3) << 3) | (((lane >> 2) & 3) << 6) | (((lane >> 4) & 1) << 5) | (((lane >> 5) & 1) << 8); }
constexpr int v_rd_off(int d0, int ks, int half) { return d0 * 512 + ks * 4096 + half * 2048; }
template <int OFF> __device__ __forceinline__ s16x4 tr_read(int vb) {
  s16x4 r; asm volatile("ds_read_b64_tr_b16 %0, %1 offset:%2" : "=&v"(r) : "v"(vb), "i"(OFF) : "memory"); return r;
}
template <int D0> __device__ __forceinline__ void pv_one(f32x16& od, int vb, bf16x8 pa0, bf16x8 pa1, bf16x8 pa2, bf16x8 pa3) {
  const s16x4 l0 = tr_read<v_rd_off(D0, 0, 0)>(vb), h0 = tr_read<v_rd_off(D0, 0, 1)>(vb), l1 = tr_read<v_rd_off(D0, 1, 0)>(vb), h1 = tr_read<v_rd_off(D0, 1, 1)>(vb);
  const s16x4 l2 = tr_read<v_rd_off(D0, 2, 0)>(vb), h2 = tr_read<v_rd_off(D0, 2, 1)>(vb), l3 = tr_read<v_rd_off(D0, 3, 0)>(vb), h3 = tr_read<v_rd_off(D0, 3, 1)>(vb);
  asm volatile("s_waitcnt lgkmcnt(0)" ::: "memory"); SBAR();
#define PK(L, H) (bf16x8){L[0], L[1], L[2], L[3], H[0], H[1], H[2], H[3]}
  od = __builtin_amdgcn_mfma_f32_32x32x16_bf16(pa0, PK(l0, h0), od, 0, 0, 0);
  od = __builtin_amdgcn_mfma_f32_32x32x16_bf16(pa1, PK(l1, h1), od, 0, 0, 0);
  od = __builtin_amdgcn_mfma_f32_32x32x16_bf16(pa2, PK(l2, h2), od, 0, 0, 0);
  od = __builtin_amdgcn_mfma_f32_32x32x16_bf16(pa3, PK(l3, h3), od, 0, 0, 0);
#undef PK
}
__device__ __forceinline__ void pv_d0(f32x16* o, int vb, bf16x8 pa0, bf16x8 pa1, bf16x8 pa2, bf16x8 pa3) {
  pv_one<0>(o[0], vb, pa0, pa1, pa2, pa3); pv_one<1>(o[1], vb, pa0, pa1, pa2, pa3); pv_one<2>(o[2], vb, pa0, pa1, pa2, pa3); pv_one<3>(o[3], vb, pa0, pa1, pa2, pa3);
}
__device__ __forceinline__ void attn_body(const bf16_t* __restrict__ Qb, const bf16_t* __restrict__ Kh, const bf16_t* __restrict__ Vh,
                                          bf16_t* __restrict__ Ob, const bf16_t* __restrict__ AGb, int seq, char* lds) {
  int tid_ = threadIdx.x; asm volatile("" : "+v"(tid_));
  const int tid = tid_, wid = tid >> 6, lane = tid & 63, r32 = lane & 31, hi = lane >> 5;
  bf16_t* V_lds = (bf16_t*)lds; bf16_t* K_lds = (bf16_t*)(lds + 2 * SHM_V);
  float* wsl = (float*)(lds + 2 * SHM_V + 2 * SHM_K) + wid * 64; float* li_l = wsl; float* al_l = wsl + 32;
  float m_reg = -1e30f, l_reg = 0; f32x16 o[4] = {}; bf16x8 qr[8];
  const bf16_t* Qw = Qb + (long)(wid * QBLK + r32) * LDQ + hi * 8;
#pragma unroll
  for (int d0 = 0; d0 < 8; ++d0) qr[d0] = *reinterpret_cast<const bf16x8*>(Qw + d0 * 16);
  const int sr = tid >> 4, sc = (tid & 15) * 8, vst0 = v_st(sr, sc), vst1 = v_st(32 + sr, sc);
  const int vb0 = (int)(uintptr_t)V_lds + v_rd_base(lane);
  const unsigned goff0 = (unsigned)(sr * LDK + sc) * 2u, goff1 = (unsigned)((32 + sr) * LDK + sc) * 2u;
  struct { bf16x8 vs0, vs1, ks0, ks1; } sr_[2];
#define SLOAD(i, k0) do { const char* vt_ = (const char*)Vh + (size_t)(k0) * (LDK * 2); const char* kt_ = (const char*)Kh + (size_t)(k0) * (LDK * 2); \
    sr_[i].vs0 = *reinterpret_cast<const bf16x8*>(vt_ + goff0); sr_[i].vs1 = *reinterpret_cast<const bf16x8*>(vt_ + goff1); \
    sr_[i].ks0 = *reinterpret_cast<const bf16x8*>(kt_ + goff0); sr_[i].ks1 = *reinterpret_cast<const bf16x8*>(kt_ + goff1); } while (0)
#define SWRITE(b, i) do { *(bf16x8*)((char*)V_lds + (b) * SHM_V + vst0) = sr_[i].vs0;          \
    *(bf16x8*)((char*)V_lds + (b) * SHM_V + vst1) = sr_[i].vs1; int kc = sc * 2;               \
    *(bf16x8*)((char*)K_lds + (b) * SHM_K + KSWZ(sr, kc)) = sr_[i].ks0;                       \
    *(bf16x8*)((char*)K_lds + (b) * SHM_K + KSWZ(32 + sr, kc)) = sr_[i].ks1; } while (0)
#define SWAIT() asm volatile("s_waitcnt vmcnt(4)" ::: "memory")
#define RESC(a) do { if (__any((a) < 1.f)) { if (hi == 0) al_l[r32] = (a); asm volatile("s_waitcnt lgkmcnt(0)" ::: "memory"); \
    _Pragma("unroll") for (int d = 0; d < 4; ++d) _Pragma("unroll") for (int r = 0; r < 16; ++r) o[d][r] *= al_l[crow(r, hi)]; } } while (0)
  f32x16 pA0, pA1, pB0, pB1; float mnA, mnB, alA, alB; bf16x8 pa0, pa1, pa2, pa3; const int NT = seq / KVBLK;
  constexpr int SE = 0, SO = 1;
  SLOAD(SE, 0); asm volatile("s_waitcnt vmcnt(0)" ::: "memory"); SWRITE(0, SE); __syncthreads();
  qkt(pA0, pA1, K_lds, qr, r32, hi); partialSM(pA0, pA1, m_reg, mnA, alA);
  SLOAD(SO, KVBLK); if (2 < NT) SLOAD(SE, 2 * KVBLK);
  SWAIT(); SWRITE(1, SO); __syncthreads();
  for (int j = 1; j + 1 < NT; j += 2) {
    SBAR(); qkt(pB0, pB1, (bf16_t*)((char*)K_lds + SHM_K), qr, r32, hi);
    finishSM(pA0, pA1, alA, l_reg, pa0, pa1, pa2, pa3); SBAR();
    SLOAD(SO, (j + 2) * KVBLK); SBAR();
    pv_d0(o, vb0, pa0, pa1, pa2, pa3); partialSM(pB0, pB1, m_reg, mnB, alB);
    __syncthreads(); SWAIT(); SWRITE(0, SE);
    RESC(alB); __syncthreads();
    SBAR(); qkt(pA0, pA1, K_lds, qr, r32, hi);
    finishSM(pB0, pB1, alB, l_reg, pa0, pa1, pa2, pa3); SBAR();
    if (j + 3 < NT) SLOAD(SE, (j + 3) * KVBLK); SBAR();
    pv_d0(o, vb0 + (int)SHM_V, pa0, pa1, pa2, pa3); partialSM(pA0, pA1, m_reg, mnA, alA);
    __syncthreads(); SWAIT(); SWRITE(1, SO);
    RESC(alA); __syncthreads();
  }
  SBAR(); qkt(pB0, pB1, (bf16_t*)((char*)K_lds + SHM_K), qr, r32, hi);
  finishSM(pA0, pA1, alA, l_reg, pa0, pa1, pa2, pa3); SBAR();
  pv_d0(o, vb0, pa0, pa1, pa2, pa3); partialSM(pB0, pB1, m_reg, mnB, alB);
  __syncthreads(); RESC(alB);
  finishSM(pB0, pB1, alB, l_reg, pa0, pa1, pa2, pa3); SBAR();
  pv_d0(o, vb0 + (int)SHM_V, pa0, pa1, pa2, pa3);
  if (hi == 0) li_l[r32] = l_reg; asm volatile("s_waitcnt lgkmcnt(0)" ::: "memory");
  char* Ow = (char*)(Ob + (long)(wid * QBLK) * LDO); const char* Gw = (const char*)(AGb + (long)(wid * QBLK) * LDQ);
  unsigned hv = hi, cv = r32;
  asm volatile("" : "+v"(hv), "+v"(cv));
  const unsigned gbase = (hv * 4u * LDQ + cv) * 2u, obase = (hv * 4u * LDO + cv) * 2u;
  unsigned short gq[16][4];
#pragma unroll
  for (int r = 0; r < 16; ++r) { const int rc = (r & 3) + 8 * (r >> 2); const unsigned go = gbase + (unsigned)(rc * LDQ * 2);
#pragma unroll
    for (int d0 = 0; d0 < 4; ++d0) gq[r][d0] = *(const bf16_t*)(Gw + go + d0 * 64); }
  SBAR();
#pragma unroll
  for (int r = 0; r < 16; ++r) { const int rc = (r & 3) + 8 * (r >> 2); const float rli = __builtin_amdgcn_rcpf(li_l[crow(r, hi)]);
    const unsigned oo = obase + (unsigned)(rc * LDO * 2);
#pragma unroll
    for (int d0 = 0; d0 < 4; ++d0) *(bf16_t*)(Ow + oo + d0 * 64) = f2bf(o[d0][r] * rli * siluf_(bf2f(gq[r][d0]))); }
#undef SLOAD
#undef SWRITE
#undef SWAIT
#undef RESC
}
}

__device__ __forceinline__ void attn_phase(const Params& p, int l, char* lds) {
    unsigned char* ws = p.ws;
    const bf16_t* P = (const bf16_t*)(ws + WS_P); bf16_t* Acat = (bf16_t*)(ws + WS_ACAT);
    const int G = gridDim.x, nunits = 512 + (l < DEPTH - 1 ? 16 : 0);
    for (int U = blockIdx.x; U < nunits; U += G) {
        int h, qrow0, seq;
        if (U < 512) { int qb;
            if (G == 256) { const int xcd = U & 7, j = (U >> 3) & 31, r = U >> 8, kvh = xcd >> 1, idx = (xcd & 1) * 64 + r * 32 + j; h = kvh * 4 + (idx & 3); qb = idx >> 2; }
            else { h = U & 15; qb = U >> 4; }
            qrow0 = CTX + qb * 256; seq = ROWS; }
        else { h = U - 512; qrow0 = 0; seq = CTX; }
        const int kvh = h >> 2;
        att::attn_body(P + (size_t)qrow0 * INC + OQ + h * 128, (const bf16_t*)(ws + WS_KC) + (size_t)kvh * ROWS * 128, (const bf16_t*)(ws + WS_VC) + (size_t)kvh * ROWS * 128,
                       Acat + (size_t)qrow0 * CLD + h * 128, P + (size_t)qrow0 * INC + OAG + h * 128, seq, lds);
        __syncthreads();
    }
}

#define XB_TMO      128
#define XB_XCNT(j)  (256  + 64 * (j))
#define XB_XSUB(j)  (1280 + 64 * (j))
#define XB_XGEN(j)  (2304 + 64 * (j))
#define XB_TOP      3328
#define XB_TOPGEN   3392
#define XCD_BAR_WORDS 3456
#define XB_SPIN_CAP (1u << 18)

__device__ __forceinline__ unsigned xb_ld(unsigned* p)              { return __hip_atomic_load(p, __ATOMIC_RELAXED, __HIP_MEMORY_SCOPE_AGENT); }
__device__ __forceinline__ unsigned xb_add(unsigned* p, unsigned v) { return __hip_atomic_fetch_add(p, v, __ATOMIC_RELAXED, __HIP_MEMORY_SCOPE_AGENT); }
__device__ __forceinline__ unsigned xb_xcc_id() { return (unsigned)__builtin_amdgcn_s_getreg((3 << 11) | 20) & 0xFu; }
#define XB_SPIN(cond, bar) do { unsigned _sp = 0; while (cond) { __builtin_amdgcn_s_sleep(1); \
    if ((++_sp & 255u) == 0u) { if (xb_ld(&(bar)[XB_TMO])) break; if (_sp > XB_SPIN_CAP) { atomicAdd(&(bar)[XB_TMO], 1u); break; } } } } while (0)

struct XcdBarrier {
    unsigned* bar; unsigned x;
    volatile LAS unsigned* st;
};

__device__ __forceinline__ XcdBarrier xcd_barrier_post(unsigned* bar, volatile LAS unsigned* st) {
    XcdBarrier b; b.bar = bar; b.x = xb_xcc_id(); b.st = st;
    if (threadIdx.x == 0) (void)xb_add(&bar[XB_XCNT(b.x)], 1u);
    return b;
}
__device__ __forceinline__ void xcd_barrier_complete(unsigned* bar, unsigned x, unsigned& nloc, unsigned& nx) {
    const unsigned G = gridDim.x * gridDim.y * gridDim.z;
    unsigned sum, cnt, mine, sp = 0u;
    for (;;) {
        sum = 0u; cnt = 0u; mine = 0u;
#pragma unroll
        for (unsigned j = 0; j < 16; ++j) { const unsigned c = xb_ld(&bar[XB_XCNT(j)]); sum += c; cnt += (c > 0u) ? 1u : 0u; mine = (j == x) ? c : mine; }
        if (sum == G) break;
        __builtin_amdgcn_s_sleep(1);
        if ((++sp & 255u) == 0u) { if (xb_ld(&bar[XB_TMO])) break; if (sp > XB_SPIN_CAP) { atomicAdd(&bar[XB_TMO], 1u); break; } }
    }
    nloc = mine > 0u ? mine : 1u; nx = cnt > 0u ? cnt : 1u;
}

__device__ __forceinline__ void xcd_barrier(const XcdBarrier& b) {
    asm volatile("s_waitcnt vmcnt(0)" ::: "memory");
    __syncthreads();
    if (threadIdx.x == 0) {
        unsigned* bar = b.bar;
        __builtin_amdgcn_s_waitcnt(0);
        unsigned nloc = b.st[0], nx = b.st[1];
        if (nloc == 0u) { xcd_barrier_complete(bar, b.x, nloc, nx); b.st[0] = nloc; b.st[1] = nx; }
        const unsigned old = xb_add(&bar[XB_XSUB(b.x)], 1u);
        const unsigned gen = old / nloc;
        if (old + 1u == (gen + 1u) * nloc) {
            __builtin_amdgcn_fence(__ATOMIC_RELEASE, "agent");
            asm volatile("s_waitcnt vmcnt(0)" ::: "memory");
            const unsigned og = xb_add(&bar[XB_TOP], 1u);
            const unsigned tg = og / nx;
            if (og + 1u == (tg + 1u) * nx) xb_add(&bar[XB_TOPGEN], 1u);
            else XB_SPIN(xb_ld(&bar[XB_TOPGEN]) == tg, bar);
            __builtin_amdgcn_fence(__ATOMIC_ACQUIRE, "agent");
            xb_add(&bar[XB_XGEN(b.x)], 1u);
            asm volatile("s_waitcnt vmcnt(0)" ::: "memory");
        } else {
            XB_SPIN(xb_ld(&bar[XB_XGEN(b.x)]) == gen, bar);
            __builtin_amdgcn_fence(__ATOMIC_ACQUIRE, "agent");
            asm volatile("s_waitcnt vmcnt(0)" ::: "memory");
        }
    }
    __syncthreads();
}

__global__ void __launch_bounds__(NTHREADS, 2) mega_fwd(Params p0) {
    extern __shared__ __attribute__((aligned(16))) unsigned char lds[];
    cg::grid_group grid = cg::this_grid();
    volatile LAS unsigned* misc = (volatile LAS unsigned*)((LAS unsigned char*)lds + LDS_STAGE);
    if (threadIdx.x < 16) misc[threadIdx.x] = 0u;
    __syncthreads();
    (void)xcd_barrier_post((unsigned*)(p0.ws + WS_BAR), misc);
#ifndef PHASE_MASK
#define PHASE_MASK 0xFFFF
#endif
#define PH(b) if constexpr ((PHASE_MASK >> (b)) & 1)
#ifndef DBL_MASK
#define DBL_MASK 0
#endif
    PH(10) prep_phase(p0, lds);
    __syncthreads();
    if constexpr ((DBL_MASK >> 10) & 1) { prep_phase(p0, lds); __syncthreads(); }
    grid.sync();
#pragma unroll 1
    for (int l = 0; l < DEPTH; ++l) {
#pragma unroll 1
        for (int slot = 0; slot < 12; ++slot) {
            Params p = p0;
            { unsigned char* w = p.ws; asm volatile("" : "+s"(w)); p.ws = w; }
            bool sync = true;
            LAS unsigned char* L = (LAS unsigned char*)lds;
            const int reps = ((DBL_MASK >> slot) & 1) ? 2 : 1;
#pragma unroll 1
            for (int rep = 0; rep < reps; ++rep) {
            if (rep) __syncthreads();
            switch (slot) {
            case 0: rownorm_phase(p, l); sync = false; break;
            case 1: if (l == 0) gemm_phase(L, G_FOLD, l, p.ws); break;
            case 2: gemm_phase(L, G_IN, l, p.ws); sync = false; break;
            case 3: gemm_phase(L, G_XT, l, p.ws); break;
            case 4: gemm_phase(L, G_F1, l, p.ws); sync = false; break;
            case 5: gemm_phase(L, G_DFTC, l, p.ws); break;
            case 6: ew_phase(p, l); break;
            case 7: case 8: sync = false; break;
            case 9: {
                const int cb = (int)blockIdx.x, Gn = (int)gridDim.x;
                unsigned* c2 = (unsigned*)(p.ws + WS_BAR) + 3540;
                const unsigned target = (unsigned)(Gn - 148) * (unsigned)(l + 1);
                if (cb >= 16 && cb < Gn - 132) {
                    gemm_phase(L, G_F2, l, p.ws);
                    __syncthreads();
                    if (threadIdx.x == 0) { __builtin_amdgcn_fence(__ATOMIC_RELEASE, "agent"); asm volatile("s_waitcnt vmcnt(0)" ::: "memory");
                        __hip_atomic_fetch_add(c2, 1u, __ATOMIC_RELAXED, __HIP_MEMORY_SCOPE_AGENT); }
                    __syncthreads();
                }
                attn_phase(p, l, (char*)lds);
                __syncthreads();
                if (cb >= Gn - 132) {
                    if (threadIdx.x == 0) { unsigned sp = 0;
                        while (__hip_atomic_load(c2, __ATOMIC_RELAXED, __HIP_MEMORY_SCOPE_AGENT) < target) { __builtin_amdgcn_s_sleep(1); if (++sp > (1u << 22)) break; }
                        __builtin_amdgcn_fence(__ATOMIC_ACQUIRE, "agent"); asm volatile("s_waitcnt vmcnt(0)" ::: "memory"); }
                    __syncthreads();
                    gemm_phase(L, G_MIX, l, p.ws);
                }
                break; }
            case 10: gemm_phase(L, G_MERGE, l, p.ws); __syncthreads(); gemm_phase(L, G_MERGEC, l, p.ws); break;
            default: {
                const bool hasctx = l < DEPTH - 1;
                unsigned* ccnt = (unsigned*)(p.ws + WS_BAR) + 3500;
                if (hasctx) {
                    int t0_ = threadIdx.x; asm volatile("" : "+v"(t0_));
                    const int idx = (int)blockIdx.x * NTHREADS + t0_, r = idx >> 9, cc = (idx & 511) * 4;
                    const float* mp = (const float*)(p.ws + WS_MP); bf16_t* mb = (bf16_t*)(p.ws + WS_MB);
                    f32x4 s = *(const f32x4*)(mp + (size_t)r * MLD + cc);
#pragma unroll
                    for (int q = 1; q < 8; ++q) s += *(const f32x4*)(mp + ((size_t)q * CTX + r) * MLD + cc);
                    u32x2 w; w.x = cvtpk(s[0], s[1]); w.y = cvtpk(s[2], s[3]); *(u32x2*)(mb + (size_t)r * DM + cc) = w;
                    asm volatile("s_waitcnt vmcnt(0)" ::: "memory"); __syncthreads();
                    if (threadIdx.x == 0) { __builtin_amdgcn_fence(__ATOMIC_RELEASE, "agent"); asm volatile("s_waitcnt vmcnt(0)" ::: "memory");
                        __hip_atomic_fetch_add(ccnt, 1u, __ATOMIC_RELAXED, __HIP_MEMORY_SCOPE_AGENT); }
                }
                const int nv = (hasctx && (int)blockIdx.x >= (int)gridDim.x - 32) ? 2 : 1;
#pragma unroll 1
                for (int v = 0; v < nv; ++v) {
                    if (v) {
                        __syncthreads();
                        if (threadIdx.x == 0) { const unsigned target = (unsigned)(l + 1) * gridDim.x; unsigned sp = 0;
                            while (__hip_atomic_load(ccnt, __ATOMIC_RELAXED, __HIP_MEMORY_SCOPE_AGENT) < target) { __builtin_amdgcn_s_sleep(1); if (++sp > (1u << 22)) break; }
                            __builtin_amdgcn_fence(__ATOMIC_ACQUIRE, "agent"); asm volatile("s_waitcnt vmcnt(0)" ::: "memory"); }
                        __syncthreads();
                    }
                    gemm_phase(L, G_OUT, l | (v << 4), p.ws);
                }
                break; }
            }
            }
            __syncthreads();
            if (sync) { XcdBarrier xb; xb.bar = (unsigned*)(p.ws + WS_BAR); xb.x = xb_xcc_id(); xb.st = (volatile LAS unsigned*)((LAS unsigned char*)lds + LDS_STAGE); xcd_barrier(xb); }
        }
    }
    PH(0) rownorm_phase(p0, DEPTH);
}

extern "C" void kernel_launch(void* const* d_in, const int* in_sizes, int n_in, void* d_out, int out_size, void* d_ws, size_t ws_size, hipStream_t stream) {
    static int grid_blocks = 0;
    if (grid_blocks == 0) {
        if (n_in != 18 || out_size != SEQ * DM || ws_size < WS_END) { fprintf(stderr, "kernel_launch: unexpected shapes: n_in %d out %d ws %zu (need %zu)\n", n_in, out_size, ws_size, (size_t)WS_END); grid_blocks = -1; return; }
        int dev = 0, cus = 0, per_cu = 0;
        hipGetDevice(&dev);
        hipDeviceGetAttribute(&cus, hipDeviceAttributeMultiprocessorCount, dev);
        if (hipFuncSetAttribute((const void*)mega_fwd, hipFuncAttributeMaxDynamicSharedMemorySize, LDS_BYTES) != hipSuccess) { fprintf(stderr, "kernel_launch: hipFuncSetAttribute failed\n"); grid_blocks = -1; return; }
        if (hipOccupancyMaxActiveBlocksPerMultiprocessor(&per_cu, (const void*)mega_fwd, NTHREADS, LDS_BYTES) != hipSuccess || per_cu < 1) { fprintf(stderr, "kernel_launch: occupancy query gave %d\n", per_cu); per_cu = 1; }
        (void)hipGetLastError();
        grid_blocks = cus * (per_cu > 1 ? 1 : per_cu);
        if (grid_blocks > 256) grid_blocks = 256;
        grid_blocks &= ~7;
        if (grid_blocks != 256) { fprintf(stderr, "kernel_launch: this kernel is laid out for 256 resident workgroups, got %d\n", grid_blocks); grid_blocks = -1; return; }
    }
    if (grid_blocks <= 0) return;
    Params p{};
    for (int i = 0; i < 18; ++i) p.in[i] = (const float*)d_in[i];
    p.out = (float*)d_out; p.ws = (unsigned char*)d_ws;
    if (hipMemsetAsync((char*)d_ws + WS_BAR, 0, BAR_BYTES, stream) != hipSuccess) { fprintf(stderr, "kernel_launch: memset of barrier words failed\n"); return; }
    void* args[] = {&p};
    hipError_t e = hipLaunchCooperativeKernel((const void*)mega_fwd, dim3(grid_blocks), dim3(NTHREADS), args, LDS_BYTES, stream);
    if (e != hipSuccess) fprintf(stderr, "cooperative launch failed: %s (grid %d)\n", hipGetErrorString(e), grid_blocks);
}
```

```cpp
#include <hip/hip_runtime.h>
#include <hip/hip_cooperative_groups.h>
#include <cstdio>
#include <cstdint>
namespace cg = cooperative_groups;

#define LAS __attribute__((address_space(3)))
typedef unsigned short bf16_t;
typedef short bf16x8 __attribute__((ext_vector_type(8)));
typedef short s16x4 __attribute__((ext_vector_type(4)));
typedef float f32x4 __attribute__((ext_vector_type(4)));
typedef float f32x16 __attribute__((ext_vector_type(16)));
typedef unsigned u32x4 __attribute__((ext_vector_type(4)));
typedef unsigned u32x2 __attribute__((ext_vector_type(2)));

constexpr int DM = 2048, SEQ = 8192, CTX = 256, ROWS = SEQ + CTX, DEPTH = 4, INC = 17408;
constexpr int OQ = 0, OKK = 2048, OV = 2560, OAG = 3072, OFX = 5120, OFG = 6144, OCX = 7168, OCB = 8192, OCC = 9216, OCG = 10240, OML = 11264;
constexpr float EPS = 1e-6f;
constexpr size_t APL = (size_t)(SEQ + CTX) * 2048, WPL = (size_t)2048 * 2048;
constexpr int CLD = 2048;
constexpr int MLD = 2048 + 64;
constexpr int ZCH = 32768 + 256;
constexpr int LDS_STAGE = 131072, LDS_BYTES = LDS_STAGE + 64;
constexpr int NTHREADS = 512;

constexpr size_t SZ_WINT = (size_t)INC * DM * 2, SZ_WCAT = 3 * WPL * 2, SZ_WOUT = (size_t)DM * DM * 2, SZ_WMIXR = (size_t)1024 * 1024 * 2, SZ_WMIX = (size_t)1024 * 2048 * 2;
constexpr size_t WS_WINT = 0;
constexpr size_t WS_WCAT = WS_WINT + DEPTH * SZ_WINT;
constexpr size_t WS_WOUT = WS_WCAT + DEPTH * SZ_WCAT;
constexpr size_t WS_WMIXR = WS_WOUT + DEPTH * SZ_WOUT;
constexpr size_t WS_WMIX = WS_WMIXR + DEPTH * SZ_WMIXR;
constexpr size_t WS_TCH = WS_WMIX + DEPTH * SZ_WMIX;
constexpr size_t WS_ZT = WS_TCH + 512 * 256 * 2;
constexpr size_t WS_T1 = WS_ZT + (size_t)1024 * ZCH;
constexpr size_t WS_A2 = WS_T1 + 256 * 128 * 2;
constexpr size_t WS_ACTX = WS_A2 + 256 * 256 * 2;
constexpr size_t WS_ROPE = WS_ACTX + 512 * 256 * 2;
constexpr size_t WS_MOD = WS_ROPE + 128 * 32 * 8;
constexpr size_t WS_XS = WS_MOD + 4 * 2 * 6144 * 4;
constexpr size_t WS_H = WS_XS + (size_t)ROWS * DM * 4;
constexpr size_t WS_P = WS_H + (size_t)ROWS * DM * 2;
constexpr size_t WS_XT = WS_P + (size_t)ROWS * INC * 2;
constexpr size_t WS_PQ = WS_XT + (size_t)1024 * ROWS * 2;
constexpr size_t WS_ACAT = WS_PQ + (size_t)ROWS * DM * 2;
constexpr size_t WS_MBUF = WS_ACAT + 3 * APL * 2;
constexpr size_t WS_MB = WS_MBUF + (size_t)ROWS * MLD * 4;
constexpr size_t WS_OUTB = WS_MB + (size_t)ROWS * DM * 2;
constexpr size_t WS_KC = WS_OUTB + (size_t)ROWS * DM * 4;
constexpr size_t WS_VC = WS_KC + (size_t)4 * ROWS * 128 * 2;
constexpr size_t WS_MP = WS_VC + (size_t)4 * ROWS * 128 * 2;
constexpr size_t WS_OUTP = WS_MP + (size_t)8 * CTX * MLD * 4;
constexpr size_t WS_BAR = WS_OUTP + (size_t)4 * CTX * DM * 4;
constexpr size_t BAR_BYTES = 16384;
constexpr size_t WS_END = WS_BAR + BAR_BYTES;

struct Params { const float* in[18]; float* out; unsigned char* ws; };
enum { I_X = 0, I_C, I_CTX, I_CCTX, I_WMOD, I_BMOD, I_GPRE, I_GPOST, I_WIN, I_QN, I_KN, I_WAO, I_WFM, I_WFO, I_CW, I_CB, I_WCO, I_WOUT };

__device__ __forceinline__ unsigned cvtpk(float lo, float hi) { unsigned r; asm volatile("v_cvt_pk_bf16_f32 %0, %1, %2" : "=v"(r) : "v"(lo), "v"(hi)); return r; }
__device__ __forceinline__ float bf2f(unsigned short b) { return __uint_as_float(((unsigned)b) << 16); }
__device__ __forceinline__ float bflo(unsigned w) { return __uint_as_float(w << 16); }
__device__ __forceinline__ float bfhi(unsigned w) { return __uint_as_float(w & 0xffff0000u); }
__device__ __forceinline__ unsigned short f2bf(float f) { return (unsigned short)(cvtpk(f, f) & 0xffffu); }
__device__ __forceinline__ float sigmoidf_(float x) { return __builtin_amdgcn_rcpf(1.0f + __expf(-x)); }
__device__ __forceinline__ float siluf_(float x) { return x * sigmoidf_(x); }
__device__ __forceinline__ float wave_sum(float v) {
#pragma unroll
    for (int o = 32; o >= 1; o >>= 1) v += __shfl_xor(v, o);
    return v;
}

__device__ __forceinline__ void prep_phase(const Params& p, unsigned char* lds_g) {
    int tid_ = threadIdx.x; asm volatile("" : "+v"(tid_));
    const int tid = tid_, G = gridDim.x, bid = blockIdx.x;
    unsigned char* ws = p.ws;
    float* tile = (float*)lds_g;
    constexpr int T_IN = 32 * 272, T_AO = 32 * 32, T_FO = 16 * 32, T_CO = 16 * 32, T_OUT = 32 * 32, T_MIX = 16 * 16;
    constexpr int T_LAYER = T_IN + T_AO + T_FO + T_CO + T_OUT + T_MIX;
    for (int t = bid; t < DEPTH * T_LAYER; t += G) {
        const int l = t / T_LAYER; int r = t % T_LAYER;
        const float* src; int ldsrc; bf16_t* dst; int lddst; int ktiles;
        if (r < T_IN) { src = p.in[I_WIN] + (size_t)l * DM * INC; ldsrc = INC; dst = (bf16_t*)(ws + WS_WINT + l * SZ_WINT); lddst = DM; ktiles = 32; }
        else if ((r -= T_IN) < T_AO) { src = p.in[I_WAO] + (size_t)l * DM * DM; ldsrc = DM; dst = (bf16_t*)(ws + WS_WCAT + l * SZ_WCAT); lddst = CLD; ktiles = 32; }
        else if ((r -= T_AO) < T_FO) { src = p.in[I_WFO] + (size_t)l * 1024 * DM; ldsrc = DM; dst = (bf16_t*)(ws + WS_WCAT + l * SZ_WCAT) + WPL; lddst = CLD; ktiles = 16; }
        else if ((r -= T_FO) < T_CO) { src = p.in[I_WCO] + (size_t)l * 1024 * DM; ldsrc = DM; dst = (bf16_t*)(ws + WS_WCAT + l * SZ_WCAT) + 2 * WPL; lddst = CLD; ktiles = 16; }
        else if ((r -= T_CO) < T_OUT) { src = p.in[I_WOUT] + (size_t)l * DM * DM; ldsrc = DM; dst = (bf16_t*)(ws + WS_WOUT + l * SZ_WOUT); lddst = DM; ktiles = 32; }
        else { r -= T_OUT; src = p.in[I_WFM] + (size_t)l * 1024 * 1024; ldsrc = 1024; dst = (bf16_t*)(ws + WS_WMIXR + l * SZ_WMIXR); lddst = 1024; ktiles = 16; }
        const int k0 = (r % ktiles) * 64, n0 = (r / ktiles) * 64;
        { const int ty = tid >> 4, tx = tid & 15;
#pragma unroll
          for (int ps = 0; ps < 2; ++ps) { const int kk = ty + 32 * ps;
              const f32x4 v = *(const f32x4*)(src + (size_t)(k0 + kk) * ldsrc + n0 + tx * 4);
              tile[kk * 65 + tx * 4 + 0] = v[0]; tile[kk * 65 + tx * 4 + 1] = v[1]; tile[kk * 65 + tx * 4 + 2] = v[2]; tile[kk * 65 + tx * 4 + 3] = v[3]; } }
        __syncthreads();
        { const int n = tid >> 3, kc = (tid & 7) * 8; u32x4 w;
          w.x = cvtpk(tile[(kc + 0) * 65 + n], tile[(kc + 1) * 65 + n]); w.y = cvtpk(tile[(kc + 2) * 65 + n], tile[(kc + 3) * 65 + n]);
          w.z = cvtpk(tile[(kc + 4) * 65 + n], tile[(kc + 5) * 65 + n]); w.w = cvtpk(tile[(kc + 6) * 65 + n], tile[(kc + 7) * 65 + n]);
          *(u32x4*)(dst + (size_t)(n0 + n) * lddst + k0 + kc) = w; }
        __syncthreads();
    }
    {
        float* sc = (float*)lds_g;
        float* red = sc + 4096;
        for (int u = bid; u < 256; u += G) {
            for (int k = tid; k < 4096; k += NTHREADS) { const float cv = (k < 2048) ? p.in[I_C][k] : p.in[I_CCTX][k - 2048]; sc[k] = siluf_(cv); }
            __syncthreads();
            const int l = u >> 6, j0 = (u & 63) * 96;
            if (tid < 504) { const int kg = tid / 24, cq = tid % 24;
                f32x4 al = {0.f, 0.f, 0.f, 0.f}, ac = {0.f, 0.f, 0.f, 0.f};
                const float* wp = p.in[I_WMOD] + (size_t)l * DM * 6144 + j0 + cq * 4;
                for (int k = kg; k < 2048; k += 21) { const f32x4 w = *(const f32x4*)(wp + (size_t)k * 6144); al += sc[k] * w; ac += sc[2048 + k] * w; }
                float* rp = red + (kg * 24 + cq) * 8;
                rp[0] = al[0]; rp[1] = al[1]; rp[2] = al[2]; rp[3] = al[3]; rp[4] = ac[0]; rp[5] = ac[1]; rp[6] = ac[2]; rp[7] = ac[3]; }
            __syncthreads();
            if (tid < 192) { const int v = tid / 96, col = tid % 96, cq = col >> 2, e = col & 3; float s = 0.f;
                for (int kg = 0; kg < 21; ++kg) s += red[(kg * 24 + cq) * 8 + v * 4 + e];
                ((float*)(ws + WS_MOD))[(size_t)(l * 2 + v) * 6144 + j0 + col] = s + p.in[I_BMOD][(size_t)l * 6144 + j0 + col]; }
            __syncthreads();
        }
    }
    const long gt = (long)bid * NTHREADS + tid, gn = (long)G * NTHREADS;
    for (long it = gt; it < 256 * 16; it += gn) { const int r = (int)(it >> 4), s0 = (int)(it & 15) * 8, k1 = r >> 1, ri = r & 1;
        float v[8];
#pragma unroll
        for (int j = 0; j < 8; ++j) { const int ph = (k1 * (s0 + j)) & 127; const float x = (float)ph * (1.0f / 128.0f); v[j] = (ri ? -__builtin_amdgcn_sinf(x) : __builtin_amdgcn_cosf(x)) * 0.08838834764831845f; }
        u32x4 w; w.x = cvtpk(v[0], v[1]); w.y = cvtpk(v[2], v[3]); w.z = cvtpk(v[4], v[5]); w.w = cvtpk(v[6], v[7]);
        *(u32x4*)((bf16_t*)(ws + WS_T1) + (size_t)r * 128 + s0) = w; }
    for (long it = gt; it < 256 * 32; it += gn) { const int rr = (int)(it >> 5), c0 = (int)(it & 31) * 8, kb = rr >> 7, pq = (rr >> 6) & 1, k2 = rr & 63;
        float v[8];
#pragma unroll
        for (int j = 0; j < 8; ++j) { const int cc = c0 + j, s2 = cc >> 2, kbc = (cc >> 1) & 1, ri = cc & 1;     const int ph = (k2 * s2) & 63; const float x = (float)ph * (1.0f / 64.0f);
            const float cs = __builtin_amdgcn_cosf(x), sn = __builtin_amdgcn_sinf(x);
            const float val = pq == 0 ? (ri == 0 ? cs : sn) : (ri == 0 ? sn : -cs);
            v[j] = (kb == kbc) ? val * 0.125f : 0.f; }
        u32x4 w; w.x = cvtpk(v[0], v[1]); w.y = cvtpk(v[2], v[3]); w.z = cvtpk(v[4], v[5]); w.w = cvtpk(v[6], v[7]);
        *(u32x4*)((bf16_t*)(ws + WS_A2) + (size_t)rr * 256 + c0) = w; }
    for (long it = gt; it < 2 * 512 * 32; it += gn) { const int which = (int)(it >> 14), rr = (int)(it & 16383), r = rr >> 5, s0 = (rr & 31) * 8, k = r & 255; const bool isin = r >= 256;
        bf16_t* A = (bf16_t*)(ws + (which ? WS_TCH : WS_ACTX)); const float sgn = (which && isin) ? -0.0625f : 0.0625f;
        float v[8];
#pragma unroll
        for (int j = 0; j < 8; ++j) { const int ph = (k * (s0 + j)) & 255; const float x = (float)ph * (1.0f / 256.0f); v[j] = (isin ? __builtin_amdgcn_sinf(x) : __builtin_amdgcn_cosf(x)) * sgn; }
        u32x4 w; w.x = cvtpk(v[0], v[1]); w.y = cvtpk(v[2], v[3]); w.z = cvtpk(v[4], v[5]); w.w = cvtpk(v[6], v[7]);
        *(u32x4*)(A + (size_t)r * 256 + s0) = w; }
    for (long it = gt; it < 128 * 32; it += gn) { const int pos = (int)(it >> 5), i = (int)(it & 31);
        const float freq = exp2f(-(float)i * (13.287712379549449f / 32.0f));
        const float ang = (float)pos * freq;
        double rev = (double)ang * 0.15915494309189535; rev -= floor(rev);
        const float xr = (float)rev;
        float2 cs; cs.x = __builtin_amdgcn_cosf(xr); cs.y = __builtin_amdgcn_sinf(xr);
        ((float2*)(ws + WS_ROPE))[it] = cs; }
    { f32x4* xs = (f32x4*)(ws + WS_XS); const f32x4* cx = (const f32x4*)p.in[I_CTX]; const f32x4* xx = (const f32x4*)p.in[I_X];
      const long nc = (long)CTX * DM / 4, nt = (long)ROWS * DM / 4;
      for (long it = gt; it < nt; it += gn) xs[it] = (it < nc) ? cx[it] : xx[it - nc]; }
}

__device__ __forceinline__ void rownorm_phase(const Params& p, int l) {
    int tid_ = threadIdx.x; asm volatile("" : "+v"(tid_));
    const int tid = tid_, lane = tid & 63, wid = tid >> 6;
    unsigned char* ws = p.ws;
    const int gw = blockIdx.x * 8 + wid, nw = gridDim.x * 8;
    const float* mod = (const float*)(ws + WS_MOD);
    for (int row = gw; row < ROWS; row += nw) {
        const int isctx = row < CTX ? 1 : 0;
        if (l == 4 && isctx) continue;
        float* xrow = (float*)(ws + WS_XS) + (size_t)row * DM;
        f32x4 xv[8];
#pragma unroll
        for (int i = 0; i < 8; ++i) xv[i] = *(const f32x4*)(xrow + lane * 4 + i * 256);
        if (l > 0) {
            const float* orow = (const float*)(ws + WS_OUTB) + (size_t)row * DM;
            f32x4 ov[8]; float ss = 0.f;
#pragma unroll
            for (int i = 0; i < 8; ++i) {
                if (isctx) { const float* pp = (const float*)(ws + WS_OUTP) + (size_t)row * DM + lane * 4 + i * 256;
                    ov[i] = (*(const f32x4*)pp + *(const f32x4*)(pp + (size_t)CTX * DM)) + (*(const f32x4*)(pp + (size_t)2 * CTX * DM) + *(const f32x4*)(pp + (size_t)3 * CTX * DM)); }
                else ov[i] = *(const f32x4*)(orow + lane * 4 + i * 256);
                ss += ov[i][0] * ov[i][0] + ov[i][1] * ov[i][1] + ov[i][2] * ov[i][2] + ov[i][3] * ov[i][3]; }
            ss = wave_sum(ss);
            const float rstd = rsqrtf(ss * (1.0f / DM) + EPS);
            const float* gate = mod + (size_t)((l - 1) * 2 + isctx) * 6144 + 4096;
            const float* gpost = p.in[I_GPOST] + (size_t)(l - 1) * DM;
#pragma unroll
            for (int i = 0; i < 8; ++i) { const f32x4 g = *(const f32x4*)(gate + lane * 4 + i * 256), gp = *(const f32x4*)(gpost + lane * 4 + i * 256);
                xv[i] = xv[i] + g * ((ov[i] * rstd) * gp); }
            if (l == 4) { float* orow2 = p.out + (size_t)(row - CTX) * DM;
#pragma unroll
                for (int i = 0; i < 8; ++i) *(f32x4*)(orow2 + lane * 4 + i * 256) = xv[i];
                continue; }
        }
        float ss = 0.f;
#pragma unroll
        for (int i = 0; i < 8; ++i) ss += xv[i][0] * xv[i][0] + xv[i][1] * xv[i][1] + xv[i][2] * xv[i][2] + xv[i][3] * xv[i][3];
        ss = wave_sum(ss);
        const float rstd = rsqrtf(ss * (1.0f / DM) + EPS);
        const float* ml = mod + (size_t)(l * 2 + isctx) * 6144;
        const float* gpre = p.in[I_GPRE] + (size_t)l * DM;
        bf16_t* hrow = (bf16_t*)(ws + WS_H) + (size_t)row * DM;
        f32x4 sh[8], scl[8], gp[8];
#pragma unroll
        for (int i = 0; i < 8; ++i) { const int c = lane * 4 + i * 256; sh[i] = *(const f32x4*)(ml + c); scl[i] = *(const f32x4*)(ml + 2048 + c); gp[i] = *(const f32x4*)(gpre + c); }
        __builtin_amdgcn_sched_barrier(0);
        if (l > 0) {
#pragma unroll
            for (int i = 0; i < 8; ++i) *(f32x4*)(xrow + lane * 4 + i * 256) = xv[i];
        }
#pragma unroll
        for (int i = 0; i < 8; ++i) { const int c = lane * 4 + i * 256;
            const f32x4 hv = ((xv[i] * rstd) * gp[i]) * (1.0f + scl[i]) + sh[i];
            u32x2 w; w.x = cvtpk(hv[0], hv[1]); w.y = cvtpk(hv[2], hv[3]);
            *(u32x2*)(hrow + c) = w; }
    }
}

__device__ __forceinline__ void ew_phase(const Params& p, int l) {
    int tid_ = threadIdx.x; asm volatile("" : "+v"(tid_));
    const int tid = tid_;
    unsigned char* ws = p.ws;
    bf16_t* P = (bf16_t*)(ws + WS_P);
    {
        const int t = tid & 15; const long grp = ((long)blockIdx.x * NTHREADS + tid) >> 4, ngrp = (long)gridDim.x * NTHREADS / 16;
        const float2* rope = (const float2*)(ws + WS_ROPE);
        const int base = ((t & 8) ? 64 : 0) + 4 * (t & 7), fi = 4 * (t & 7);
        bf16_t* KC = (bf16_t*)(ws + WS_KC);
#pragma unroll 2
        for (long it = grp; it < (long)ROWS * 20; it += ngrp) { const int row = (int)(it / 20), head = (int)(it % 20);
            const bf16_t* src_ = P + (size_t)row * INC + (head < 16 ? OQ + head * 128 : OKK + (head - 16) * 128) + base;
            bf16_t* dst_ = (head < 16) ? (P + (size_t)row * INC + OQ + head * 128 + base) : (KC + ((size_t)(head - 16) * ROWS + row) * 128 + base);
            const float* gn = (head < 16 ? p.in[I_QN] : p.in[I_KN]) + (size_t)l * 128 + base;
            const u32x2 wa = *(const u32x2*)src_, wb = *(const u32x2*)(src_ + 32);
            const f32x4 ga = *(const f32x4*)gn, gb = *(const f32x4*)(gn + 32);
            float a[4] = {bflo(wa.x), bfhi(wa.x), bflo(wa.y), bfhi(wa.y)}, b[4] = {bflo(wb.x), bfhi(wb.x), bflo(wb.y), bfhi(wb.y)};
            float ss = 0.f;
#pragma unroll
            for (int q = 0; q < 4; ++q) ss += a[q] * a[q] + b[q] * b[q];
#pragma unroll
            for (int o = 8; o >= 1; o >>= 1) ss += __shfl_xor(ss, o);
            const float rstd = rsqrtf(ss * (1.0f / 128.0f) + EPS);
#pragma unroll
            for (int q = 0; q < 4; ++q) { a[q] = a[q] * rstd * ga[q]; b[q] = b[q] * rstd * gb[q]; }
            if (row >= CTX) { const int tk = row - CTX, pos = (t & 8) ? (tk & 63) : (tk >> 6);
                const f32x4 r01 = *(const f32x4*)(rope + pos * 32 + fi), r23 = *(const f32x4*)(rope + pos * 32 + fi + 2);
                const float cs[4] = {r01[0], r01[2], r23[0], r23[2]}, sn[4] = {r01[1], r01[3], r23[1], r23[3]};
#pragma unroll
                for (int q = 0; q < 4; ++q) { const float x0 = a[q], x1 = b[q]; a[q] = x0 * cs[q] - x1 * sn[q]; b[q] = x0 * sn[q] + x1 * cs[q]; } }
            u32x2 oa, ob; oa.x = cvtpk(a[0], a[1]); oa.y = cvtpk(a[2], a[3]); ob.x = cvtpk(b[0], b[1]); ob.y = cvtpk(b[2], b[3]);
            *(u32x2*)dst_ = oa; *(u32x2*)(dst_ + 32) = ob;
        }
    }
    {
        const long gt = (long)blockIdx.x * NTHREADS + tid, gn = (long)gridDim.x * NTHREADS;
        bf16_t* VC = (bf16_t*)(ws + WS_VC);
        for (long it = gt; it < (long)ROWS * 64; it += gn) { const int row = (int)(it >> 6), c = (int)(it & 63) * 8;
            const u32x4 v = *(const u32x4*)(P + (size_t)row * INC + OV + c);
            *(u32x4*)(VC + ((size_t)(c >> 7) * ROWS + row) * 128 + (c & 127)) = v; }
    }
    {
        const long gt = (long)blockIdx.x * NTHREADS + tid, gn = (long)gridDim.x * NTHREADS;
        bf16_t* Acat = (bf16_t*)(ws + WS_ACAT);
        const float* cw = p.in[I_CW] + (size_t)l * 3 * 1024; const float* cbias = p.in[I_CB] + (size_t)l * 1024;
        for (long it = gt; it < (long)(ROWS / 4) * 128; it += gn) { const int row0 = (int)(it >> 7) * 4, c0 = (int)(it & 127) * 8;
            const bf16_t* pr = P + (size_t)row0 * INC;
            const bool hp = (row0 != 0) && (row0 != CTX), hn = (row0 + 4 != CTX) && (row0 + 4 != ROWS);
            const u32x4 z = {0u, 0u, 0u, 0u};
            u32x4 xv[6], kv[6], bb[4], gg[4];
            xv[0] = hp ? *(const u32x4*)(pr - INC + OCX + c0) : z; kv[0] = hp ? *(const u32x4*)(pr - INC + OCC + c0) : z;
#pragma unroll
            for (int r = 0; r < 4; ++r) { xv[r + 1] = *(const u32x4*)(pr + (size_t)r * INC + OCX + c0); kv[r + 1] = *(const u32x4*)(pr + (size_t)r * INC + OCC + c0);
                bb[r] = *(const u32x4*)(pr + (size_t)r * INC + OCB + c0); gg[r] = *(const u32x4*)(pr + (size_t)r * INC + OCG + c0); }
            xv[5] = hn ? *(const u32x4*)(pr + (size_t)4 * INC + OCX + c0) : z; kv[5] = hn ? *(const u32x4*)(pr + (size_t)4 * INC + OCC + c0) : z;
            float w0[8], w1[8], w2[8], bs[8];
#pragma unroll
            for (int j = 0; j < 8; ++j) { w0[j] = cw[c0 + j]; w1[j] = cw[1024 + c0 + j]; w2[j] = cw[2048 + c0 + j]; bs[j] = cbias[c0 + j]; }
            float uu[6][8];
#pragma unroll
            for (int r = 0; r < 6; ++r)
#pragma unroll
                for (int q = 0; q < 4; ++q) { uu[r][2 * q] = bflo(xv[r][q]) * bflo(kv[r][q]); uu[r][2 * q + 1] = bfhi(xv[r][q]) * bfhi(kv[r][q]); }
#pragma unroll
            for (int r = 0; r < 4; ++r) { float res[8];
#pragma unroll
                for (int q = 0; q < 4; ++q) {
                    { const int j = 2 * q; const float cv = uu[r][j] * w0[j] + uu[r + 1][j] * w1[j] + uu[r + 2][j] * w2[j] + bs[j]; res[j] = bflo(bb[r][q]) * cv * siluf_(bflo(gg[r][q])); }
                    { const int j = 2 * q + 1; const float cv = uu[r][j] * w0[j] + uu[r + 1][j] * w1[j] + uu[r + 2][j] * w2[j] + bs[j]; res[j] = bfhi(bb[r][q]) * cv * siluf_(bfhi(gg[r][q])); } }
                u32x4 w; w.x = cvtpk(res[0], res[1]); w.y = cvtpk(res[2], res[3]); w.z = cvtpk(res[4], res[5]); w.w = cvtpk(res[6], res[7]);
                *(u32x4*)(Acat + 2 * APL + (size_t)(row0 + r) * CLD + c0) = w; }
        }
    }
}

constexpr int BM = 256, BK = 64, HALF = 128, HTB = HALF * BK * 2;
constexpr int BJC = 32;
__device__ __forceinline__ int lds_byte(int r, int c) { const int st = (r >> 4) * 2 + (c >> 5), rr = r & 15, cc = c & 31, ob = rr * 64 + cc * 2; return st * 1024 + (ob ^ (((ob >> 9) & 1) << 5)); }
__device__ __forceinline__ void stage_rc(int b, int& R, int& C) { const int st = b / 1024, sb = b % 1024, swz = sb ^ (((sb >> 9) & 1) << 5); R = (st >> 1) * 16 + swz / 64; C = (st & 1) * 32 + (swz % 64) / 2; }
__device__ __forceinline__ int perm32(int rho) { const int n = rho >> 4, i = rho & 15; return 8 * (i >> 2) + 4 * n + (i & 3); }

enum { G_FOLD = 0, G_IN, G_XT, G_F1, G_F2, G_DFTC, G_MIX, G_MERGE, G_OUT, G_MERGEC };
enum { M_BF16 = 0, M_MIX, M_MERGE0, M_MERGE1, M_MERGE2, M_F32, M_F1, M_F2, M_MG0, M_MG1, M_MG2 };
struct Unit { const char* a; const char* b; char* o; const char* aux; char* m; int nt, mode, ldo; };

__device__ __forceinline__ void static_order(int w, int nM, int nN, int& pm, int& pn) {
    const int nwg = nM * nN, q = nwg / 8, r = nwg % 8, xcd = w % 8, off = w / 8;
    const int wg = (xcd < r ? xcd * (q + 1) : r * (q + 1) + (xcd - r) * q) + off;
    const int nig = 8 * nN, gid = wg / nig, fm = gid * 8, gsz = (nM - fm) < 8 ? (nM - fm) : 8;
    pm = fm + ((wg % nig) % gsz); pn = (wg % nig) / gsz;
}

__device__ __forceinline__ bool get_unit(int gid, int l, int i, unsigned char* ws, Unit& u) {
    const int G = gridDim.x, c = blockIdx.x;
    u.aux = nullptr; u.m = nullptr;
    switch (gid) {
    case G_FOLD: { const int L = i * G + c; if (L >= 128) return false;
        const int ll = L >> 5, g = (L >> 3) & 3, pm = (L >> 1) & 3, pnn = L & 1;
        u.a = (const char*)(ws + WS_WMIXR + ll * SZ_WMIXR) + ((size_t)pm * 256 * 1024 + g * 256) * 2;
        u.b = (const char*)(ws + WS_TCH) + (size_t)pnn * 256 * 256 * 2;
        u.o = (char*)(ws + WS_WMIX + ll * SZ_WMIX) + ((size_t)pm * 256 * 2048 + pnn * 1024 + g * 256) * 2;
        u.nt = 4; u.mode = M_BF16; u.ldo = 2048; return true; }
    case G_IN: { const int L = i * G + c; if (L >= 2116) return false;
        if (L < 2112) { int pm, pn; static_order(L, 33, 64, pm, pn); const int pnp = pn < 20 ? pn : pn + 4;
            u.a = (const char*)(ws + WS_H) + (size_t)pm * 256 * DM * 2;
            u.b = (const char*)(ws + WS_WINT + l * SZ_WINT) + (size_t)pnp * 256 * DM * 2;
            u.o = (char*)(ws + WS_P) + ((size_t)pm * 256 * INC + pnp * 256) * 2; u.ldo = INC; }
        else { const int pm = L - 2112;
            u.a = (const char*)(ws + WS_WINT + l * SZ_WINT) + (size_t)(OFX + pm * 256) * DM * 2;
            u.b = (const char*)(ws + WS_H);
            u.o = (char*)(ws + WS_XT) + (size_t)pm * 256 * ROWS * 2; u.ldo = ROWS; }
        u.nt = 32; u.mode = M_BF16; return true; }
    case G_XT: { const int L = i * G + ((c + G - 68) % G); if (L >= 128) return false; const int pm = L & 3, pn = 1 + (L >> 2);
        u.a = (const char*)(ws + WS_WINT + l * SZ_WINT) + (size_t)(OFX + pm * 256) * DM * 2;
        u.b = (const char*)(ws + WS_H) + (size_t)(CTX + 2 * (pn - 1)) * DM * 2;
        u.o = (char*)(ws + WS_XT) + ((size_t)pm * 256 * ROWS + pn * 256) * 2; u.ldo = ROWS;
        u.nt = 32; u.mode = M_BF16; return true; }
    case G_F1: { const int L = i * G + c; if (L >= 256) return false; const int s2 = L >> 2, ct = L & 3;
        u.a = (const char*)(ws + WS_XT) + ((size_t)ct * 256 * ROWS + CTX + s2 * 128) * 2;
        u.b = (const char*)(ws + WS_T1);
        u.o = (char*)(ws + WS_ZT) + (size_t)ct * 256 * ZCH + s2 * 8;
        u.nt = 2; u.mode = M_F1; u.ldo = s2; return true; }
    case G_F2: { if (c < 16 || c >= G - 132) return false; const int L = i * (G - 148) + (c - 16); if (L >= 256) return false; const int k1p = L >> 2, ct = L & 3;
        u.a = (const char*)(ws + WS_A2);
        u.b = (const char*)(ws + WS_ZT) + (size_t)ct * 256 * ZCH + k1p * 512;
        u.o = (char*)(ws + WS_PQ) + ((size_t)(CTX + 2 * k1p) * 2048 + ct * 256) * 2;
        u.nt = 4; u.mode = M_F2; u.ldo = 2048; return true; }
    case G_DFTC: { const int L = i * G + c; if (L >= 8) return false; const int pm = L >> 2, pn = L & 3;
        u.a = (const char*)(ws + WS_ACTX) + (size_t)pm * 256 * 256 * 2;
        u.b = (const char*)(ws + WS_XT) + (size_t)pn * 256 * ROWS * 2;
        u.o = (char*)(ws + WS_PQ) + ((size_t)pm * 1024 + pn * 256) * 2;
        u.nt = 4; u.mode = M_BF16; u.ldo = 2048; return true; }
    case G_MIX: { const int L = i * G + (G - 1 - c); if (L >= 132) return false; const int pm = L >> 2, pn = L & 3;
        u.a = (const char*)(ws + WS_PQ) + (size_t)pm * 256 * 2048 * 2;
        u.b = (const char*)(ws + WS_WMIX + l * SZ_WMIX) + (size_t)pn * 256 * 2048 * 2;
        u.aux = (const char*)(ws + WS_P) + ((size_t)pm * 256 * INC + OFG + pn * 256) * 2;
        u.o = (char*)(ws + WS_ACAT) + (APL + (size_t)pm * 256 * CLD + pn * 256) * 2;
        u.nt = 32; u.mode = M_MIX; u.ldo = CLD; return true; }
    case G_MERGE: {
        if (i < 3) { const int T = c, sub = i; if (T >= 256) return false;
            int pm, pn; static_order(T, 32, 8, pm, pn); pm += 1;
            u.a = (const char*)(ws + WS_ACAT) + ((size_t)sub * APL + (size_t)pm * 256 * CLD) * 2;
            u.b = (const char*)(ws + WS_WCAT + l * SZ_WCAT) + ((size_t)sub * WPL + (size_t)pn * 256 * CLD) * 2;
            u.aux = (const char*)(ws + WS_P) + ((size_t)pm * 256 * INC + OML + sub * 2048 + pn * 256) * 2;
            u.m = (char*)(ws + WS_MBUF) + ((size_t)pm * 256 * MLD + pn * 256) * 4;
            u.o = (char*)(ws + WS_MB) + ((size_t)pm * 256 * 2048 + pn * 256) * 2;
            u.nt = sub == 0 ? 32 : 16; u.mode = M_MG0 + sub; u.ldo = 2048; return true; }
        return false; }
    case G_MERGEC: {
        if (i == 0 && l < DEPTH - 1 && c >= G - 64) { const int pc = c - (G - 64), pn = pc >> 3, q = pc & 7;
            const int sub = q < 4 ? 0 : (q < 6 ? 1 : 2), kcol = q < 4 ? q * 512 : (q < 6 ? (q - 4) * 512 : (q - 6) * 512);
            u.a = (const char*)(ws + WS_ACAT) + ((size_t)sub * APL + kcol) * 2;
            u.b = (const char*)(ws + WS_WCAT + l * SZ_WCAT) + ((size_t)sub * WPL + (size_t)pn * 256 * CLD + kcol) * 2;
            u.aux = (const char*)(ws + WS_P) + ((size_t)OML + sub * 2048 + pn * 256) * 2;
            u.m = (char*)(ws + WS_MP) + ((size_t)q * CTX * MLD + pn * 256) * 4;
            u.o = nullptr; u.nt = 8; u.mode = M_MERGE0; u.ldo = 2048; return true; }
        return false; }
    case G_OUT: {
        const int piece = l >> 4; l &= 15;
        if (i != 0) return false;
        if (!piece) { if (c >= 256) return false; int pm, pn; static_order(c, 32, 8, pm, pn); pm += 1;
            u.a = (const char*)(ws + WS_MB) + (size_t)pm * 256 * 2048 * 2;
            u.b = (const char*)(ws + WS_WOUT + l * SZ_WOUT) + (size_t)pn * 256 * 2048 * 2;
            u.o = (char*)(ws + WS_OUTB) + ((size_t)pm * 256 * 2048 + pn * 256) * 4;
            u.nt = 32; u.mode = M_F32; u.ldo = 2048; return true; }
        if (l < DEPTH - 1 && c >= G - 32) { const int pc = c - (G - 32), pn = pc >> 2, kp = pc & 3;
            u.a = (const char*)(ws + WS_MB) + (size_t)kp * 512 * 2;
            u.b = (const char*)(ws + WS_WOUT + l * SZ_WOUT) + ((size_t)pn * 256 * 2048 + kp * 512) * 2;
            u.o = (char*)(ws + WS_OUTP) + ((size_t)kp * CTX * 2048 + pn * 256) * 4;
            u.nt = 8; u.mode = M_F32; u.ldo = 2048; return true; }
        return false; }
    }
    return false;
}

__device__ __forceinline__ void epilogue(const f32x4 (&acc)[2][2][4][2], const Unit& u, int wr, int wc, int fr, int fq) {
    unsigned r0 = wr * 64 + fr, c0 = wc * 64 + 8 * fq;
    asm volatile("" : "+v"(r0), "+v"(c0));
    if (u.mode == M_BF16) {
        const unsigned base = (r0 * (unsigned)u.ldo + c0) * 2u;
#pragma unroll
        for (int ai = 0; ai < 2; ++ai)
#pragma unroll
            for (int m = 0; m < 4; ++m) { char* rowp = u.o + (size_t)(ai * HALF + m * 16) * u.ldo * 2;
#pragma unroll
                for (int bj = 0; bj < 2; ++bj) { const f32x4 v0 = acc[ai][bj][m][0], v1 = acc[ai][bj][m][1];
                    u32x4 w; w.x = cvtpk(v0[0], v0[1]); w.y = cvtpk(v0[2], v0[3]); w.z = cvtpk(v1[0], v1[1]); w.w = cvtpk(v1[2], v1[3]);
                    *(u32x4*)(rowp + base + bj * BJC * 2) = w; } }
    } else if (u.mode == M_MIX) {
        const unsigned base = (r0 * (unsigned)u.ldo + c0) * 2u, abase = (r0 * (unsigned)INC + c0) * 2u;
#pragma unroll
        for (int ai = 0; ai < 2; ++ai) {
            u32x4 g[4][2];
#pragma unroll
            for (int m = 0; m < 4; ++m)
#pragma unroll
                for (int bj = 0; bj < 2; ++bj) g[m][bj] = *(const u32x4*)(u.aux + (size_t)(ai * HALF + m * 16) * INC * 2 + abase + bj * BJC * 2);
            __builtin_amdgcn_sched_barrier(0);
#pragma unroll
            for (int m = 0; m < 4; ++m) { char* rowp = u.o + (size_t)(ai * HALF + m * 16) * u.ldo * 2;
#pragma unroll
                for (int bj = 0; bj < 2; ++bj) { const f32x4 v0 = acc[ai][bj][m][0], v1 = acc[ai][bj][m][1]; const u32x4 gg = g[m][bj];
                    u32x4 w; w.x = cvtpk(v0[0] * siluf_(bflo(gg.x)), v0[1] * siluf_(bfhi(gg.x))); w.y = cvtpk(v0[2] * siluf_(bflo(gg.y)), v0[3] * siluf_(bfhi(gg.y)));
                    w.z = cvtpk(v1[0] * siluf_(bflo(gg.z)), v1[1] * siluf_(bfhi(gg.z))); w.w = cvtpk(v1[2] * siluf_(bflo(gg.w)), v1[3] * siluf_(bfhi(gg.w)));
                    *(u32x4*)(rowp + base + bj * BJC * 2) = w; } }
            __builtin_amdgcn_sched_barrier(0);
        }
    } else if (u.mode == M_F32) {
        const unsigned base = (r0 * (unsigned)u.ldo + c0) * 4u;
#pragma unroll
        for (int ai = 0; ai < 2; ++ai)
#pragma unroll
            for (int m = 0; m < 4; ++m) { char* rowp = u.o + (size_t)(ai * HALF + m * 16) * u.ldo * 4;
#pragma unroll
                for (int bj = 0; bj < 2; ++bj) { *(f32x4*)(rowp + base + bj * BJC * 4) = acc[ai][bj][m][0]; *(f32x4*)(rowp + base + bj * BJC * 4 + 16) = acc[ai][bj][m][1]; } }
    } else if (u.mode == M_MG0 || u.mode == M_MG1) {
    } else if (u.mode == M_MG2) {
        const unsigned abase = (r0 * (unsigned)INC + c0) * 2u, obase = (r0 * 2048u + c0) * 2u;
#pragma unroll
        for (int ai = 0; ai < 2; ++ai) {
            u32x4 g[4][2];
#pragma unroll
            for (int m = 0; m < 4; ++m)
#pragma unroll
                for (int bj = 0; bj < 2; ++bj) g[m][bj] = *(const u32x4*)(u.aux + (size_t)(ai * HALF + m * 16) * INC * 2 + abase + bj * BJC * 2);
            __builtin_amdgcn_sched_barrier(0);
#pragma unroll
            for (int m = 0; m < 4; ++m) { char* rowp = u.o + (size_t)(ai * HALF + m * 16) * 2048 * 2;
#pragma unroll
                for (int bj = 0; bj < 2; ++bj) { f32x4 v0 = acc[ai][bj][m][0], v1 = acc[ai][bj][m][1]; const u32x4 gg = g[m][bj];
                    v0[0] *= sigmoidf_(bflo(gg.x)); v0[1] *= sigmoidf_(bfhi(gg.x)); v0[2] *= sigmoidf_(bflo(gg.y)); v0[3] *= sigmoidf_(bfhi(gg.y));
                    v1[0] *= sigmoidf_(bflo(gg.z)); v1[1] *= sigmoidf_(bfhi(gg.z)); v1[2] *= sigmoidf_(bflo(gg.w)); v1[3] *= sigmoidf_(bfhi(gg.w));
                    u32x4 w; w.x = cvtpk(v0[0], v0[1]); w.y = cvtpk(v0[2], v0[3]); w.z = cvtpk(v1[0], v1[1]); w.w = cvtpk(v1[2], v1[3]); *(u32x4*)(rowp + obase + bj * BJC * 2) = w; } }
            __builtin_amdgcn_sched_barrier(0);
        }
    } else if (u.mode == M_F1) {
        const int s2 = u.ldo;
        const unsigned kb0 = (c0 >> 1);
        float tc[2][4], ts[2][4];
#pragma unroll
        for (int bj = 0; bj < 2; ++bj)
#pragma unroll
            for (int j = 0; j < 4; ++j) { const float x = (float)((bj * 16 + kb0 + j) * s2) * (1.0f / 8192.0f); tc[bj][j] = __builtin_amdgcn_cosf(x); ts[bj][j] = __builtin_amdgcn_sinf(x); }
        const unsigned base = r0 * (unsigned)ZCH + kb0 * 256u;
#pragma unroll
        for (int ai = 0; ai < 2; ++ai)
#pragma unroll
            for (int m = 0; m < 4; ++m) { char* rowp = u.o + (size_t)(ai * HALF + m * 16) * ZCH;
#pragma unroll
                for (int bj = 0; bj < 2; ++bj) { const f32x4 v0 = acc[ai][bj][m][0], v1 = acc[ai][bj][m][1];
                    const float zr[4] = {v0[0], v0[2], v1[0], v1[2]}, zi[4] = {v0[1], v0[3], v1[1], v1[3]};
#pragma unroll
                    for (int jp = 0; jp < 2; ++jp) { u32x2 w;
                        { const int j = 2 * jp; w.x = cvtpk(zr[j] * tc[bj][j] + zi[j] * ts[bj][j], zi[j] * tc[bj][j] - zr[j] * ts[bj][j]); }
                        { const int j = 2 * jp + 1; w.y = cvtpk(zr[j] * tc[bj][j] + zi[j] * ts[bj][j], zi[j] * tc[bj][j] - zr[j] * ts[bj][j]); }
                        *(u32x2*)(rowp + base + (bj * 8 + jp) * 512) = w; } } }
    } else if (u.mode == M_F2) {
        const unsigned fr_ = r0 & 15u, wr_ = r0 >> 6;
        const unsigned base = ((128u * fr_) * 2048u + wr_ * 1024u + c0) * 2u;
#pragma unroll
        for (int ai = 0; ai < 2; ++ai)
#pragma unroll
            for (int m = 0; m < 4; ++m) { char* rowp = u.o + (size_t)(ai + 2048 * m) * 2048 * 2;
#pragma unroll
                for (int bj = 0; bj < 2; ++bj) { const f32x4 v0 = acc[ai][bj][m][0], v1 = acc[ai][bj][m][1];
                    u32x4 w; w.x = cvtpk(v0[0], v0[1]); w.y = cvtpk(v0[2], v0[3]); w.z = cvtpk(v1[0], v1[1]); w.w = cvtpk(v1[2], v1[3]);
                    *(u32x4*)(rowp + base + bj * BJC * 2) = w; } }
    } else {
        const unsigned abase = (r0 * (unsigned)INC + c0) * 2u, mbase = (r0 * (unsigned)MLD + c0) * 4u;
#pragma unroll
        for (int ai = 0; ai < 2; ++ai) {
            u32x4 g[4][2];
#pragma unroll
            for (int m = 0; m < 4; ++m)
#pragma unroll
                for (int bj = 0; bj < 2; ++bj) g[m][bj] = *(const u32x4*)(u.aux + (size_t)(ai * HALF + m * 16) * INC * 2 + abase + bj * BJC * 2);
            __builtin_amdgcn_sched_barrier(0);
#pragma unroll
            for (int m = 0; m < 4; ++m) { char* mp = u.m + (size_t)(ai * HALF + m * 16) * MLD * 4;
#pragma unroll
                for (int bj = 0; bj < 2; ++bj) { f32x4 v0 = acc[ai][bj][m][0], v1 = acc[ai][bj][m][1]; const u32x4 gg = g[m][bj];
                    v0[0] *= sigmoidf_(bflo(gg.x)); v0[1] *= sigmoidf_(bfhi(gg.x)); v0[2] *= sigmoidf_(bflo(gg.y)); v0[3] *= sigmoidf_(bfhi(gg.y));
                    v1[0] *= sigmoidf_(bflo(gg.z)); v1[1] *= sigmoidf_(bfhi(gg.z)); v1[2] *= sigmoidf_(bflo(gg.w)); v1[3] *= sigmoidf_(bfhi(gg.w));
                    *(f32x4*)(mp + mbase + bj * BJC * 4) = v0; *(f32x4*)(mp + mbase + bj * BJC * 4 + 16) = v1; } }
            __builtin_amdgcn_sched_barrier(0);
        }
    }
}

__device__ __forceinline__ void rescale_or_reset(f32x4 (&acc)[2][2][4][2], const Unit& u, int wr, int wc, int fr, int fq) {
    const unsigned msk = (u.mode == M_MG0 || u.mode == M_MG1) ? 0xffffffffu : 0u;
    unsigned r0 = wr * 64 + fr, c0 = wc * 64 + 8 * fq;
    asm volatile("" : "+v"(r0), "+v"(c0));
    const unsigned abase = (r0 * (unsigned)INC + c0) * 2u;
#pragma unroll
    for (int ai = 0; ai < 2; ++ai)
#pragma unroll
        for (int m = 0; m < 4; ++m) { const char* ap = u.aux + (size_t)(ai * HALF + m * 16) * INC * 2;
#pragma unroll
            for (int bj = 0; bj < 2; ++bj) {
                const u32x4 ga = *(const u32x4*)(ap + abase + bj * BJC * 2), gb = *(const u32x4*)(ap + abase + bj * BJC * 2 + 4096);
                const unsigned wa[4] = {ga.x, ga.y, ga.z, ga.w}, wb[4] = {gb.x, gb.y, gb.z, gb.w};
                float f[8];
#pragma unroll
                for (int e = 0; e < 4; ++e) {
                    const float rl = (1.0f + __expf(-bflo(wb[e]))) * __builtin_amdgcn_rcpf(1.0f + __expf(-bflo(wa[e])));
                    const float rh = (1.0f + __expf(-bfhi(wb[e]))) * __builtin_amdgcn_rcpf(1.0f + __expf(-bfhi(wa[e])));
                    f[2 * e] = __uint_as_float(__float_as_uint(rl) & msk); f[2 * e + 1] = __uint_as_float(__float_as_uint(rh) & msk); }
                acc[ai][bj][m][0] *= (f32x4){f[0], f[1], f[2], f[3]}; acc[ai][bj][m][1] *= (f32x4){f[4], f[5], f[6], f[7]};
            }
            if (m & 1) __builtin_amdgcn_sched_barrier(0);
        }
}

__device__ __forceinline__ void gemm_phase(LAS unsigned char* lds, int gid, int l, unsigned char* ws) {
    int tid_ = threadIdx.x; asm volatile("" : "+v"(tid_));
    const int tid = tid_, wid = __builtin_amdgcn_readfirstlane(tid >> 6), lane = tid & 63, wr = wid >> 2, wc = wid & 3, fr = lane & 15, fq = lane >> 4;
    int lda, ldb;
    int ldbv = 0;
    switch (gid) { case G_FOLD: lda = 1024; ldb = 256; break; case G_IN: lda = 2048; ldb = 2048; break; case G_XT: lda = 2048; ldb = 2048; ldbv = 64 * 2048; break;
                   case G_F1: lda = ROWS; ldb = 128; break; case G_F2: lda = 256; ldb = ZCH / 2; break;
                   case G_DFTC: lda = 256; ldb = ROWS; break; case G_MIX: lda = 2048; ldb = 2048; break; case G_MERGE: case G_MERGEC: lda = CLD; ldb = CLD; break; default: lda = 2048; ldb = 2048; break; }
    if (ldbv == 0) ldbv = ldb;
    Unit cur, nxt; int ui = 0;
    if (!get_unit(gid, l, 0, ws, cur)) return;
    unsigned voffA[2], voffB[2];
#pragma unroll
    for (int i = 0; i < 2; ++i) { int R, C; stage_rc(tid * 16 + i * 8192, R, C); const int w_ = R >> 5, ip = perm32(R & 31);
        const int Rb = (gid == G_XT) ? (4096 * (w_ & 1) + 64 * ip + (w_ >> 1)) : (64 * w_ + ip);
        voffA[i] = (unsigned)(R * lda + C) * 2u; voffB[i] = (unsigned)(Rb * ldb + C) * 2u; }
    const size_t kstep = (size_t)(BK * 2);
    const size_t hstepA = (size_t)HALF * lda * 2, hstepB = (gid == G_XT) ? (size_t)2048 * ldb * 2 : (size_t)32 * ldb * 2;
    const unsigned ldsw = (unsigned)wid * 1024u;
    const int aoff = lds_byte(wr * 64 + fr, fq * 8), boff = lds_byte(wc * 32 + fr, fq * 8);
#define PG8_SA(b, h) (((b) * 2 + (h)) * HTB)
#define PG8_SB(b, h) ((4 + (b) * 2 + (h)) * HTB)
#define PG8_STAGE(bufoff, gbase, voff) do { _Pragma("unroll") for (int _i = 0; _i < 2; ++_i) \
        __builtin_amdgcn_global_load_lds((const unsigned*)((const char*)(gbase) + (voff)[_i]), (LAS unsigned*)(lds + (bufoff) + ldsw + _i * 8192), 16, 0, 0); } while (0)
#define PG8_LDA(dst, b, h) do { _Pragma("unroll") for (int m = 0; m < 4; ++m) _Pragma("unroll") for (int k = 0; k < 2; ++k) dst[m][k] = *(const LAS bf16x8*)(lds + PG8_SA(b, h) + aoff + m * 2048 + k * 1024); } while (0)
#define PG8_LDB(dst, b, h) do { _Pragma("unroll") for (int n = 0; n < 2; ++n) _Pragma("unroll") for (int k = 0; k < 2; ++k) dst[n][k] = *(const LAS bf16x8*)(lds + PG8_SB(b, h) + boff + n * 2048 + k * 1024); } while (0)
#define PG8_MMA(ai, bj, At, Bt) do { __builtin_amdgcn_s_setprio(1); _Pragma("unroll") for (int m = 0; m < 4; ++m) _Pragma("unroll") for (int n = 0; n < 2; ++n) _Pragma("unroll") for (int k = 0; k < 2; ++k) \
        acc[ai][bj][m][n] = __builtin_amdgcn_mfma_f32_16x16x32_bf16(Bt[n][k], At[m][k], acc[ai][bj][m][n], 0, 0, 0); __builtin_amdgcn_s_setprio(0); } while (0)
#define PG8_WAIT_V(n) asm volatile("s_waitcnt vmcnt(" #n ")" ::: "memory")
#define PG8_WAIT_L(n) asm volatile("s_waitcnt lgkmcnt(" #n ")" ::: "memory")
#define PG8_BAR __builtin_amdgcn_s_barrier()
#define PG8_SCHED __builtin_amdgcn_sched_barrier(0)
    f32x4 acc[2][2][4][2];
#pragma unroll
    for (int a = 0; a < 2; ++a)
#pragma unroll
        for (int b = 0; b < 2; ++b)
#pragma unroll
            for (int m = 0; m < 4; ++m)
#pragma unroll
                for (int n = 0; n < 2; ++n) acc[a][b][m][n] = (f32x4){0.f, 0.f, 0.f, 0.f};
    bf16x8 At[4][2], B0[2][2], B1[2][2];
    const char* cA = cur.a; const char* cB = cur.b;
    PG8_STAGE(PG8_SB(0, 0), cB, voffB); PG8_STAGE(PG8_SA(0, 0), cA, voffA); PG8_STAGE(PG8_SB(0, 1), cB + hstepB, voffB); PG8_STAGE(PG8_SA(0, 1), cA + hstepA, voffA);
    if (wr == 1) PG8_BAR;
    PG8_WAIT_V(4); PG8_BAR;
    PG8_STAGE(PG8_SB(1, 0), cB + kstep, voffB); PG8_STAGE(PG8_SA(1, 0), cA + kstep, voffA); PG8_STAGE(PG8_SB(1, 1), cB + hstepB + kstep, voffB);
    PG8_WAIT_V(6); PG8_BAR;
    for (;;) {
        const bool has_next = get_unit(gid, l, ui + 1, ws, nxt);
        const char* nA = has_next ? nxt.a : cA; const char* nB = has_next ? nxt.b : cB;
        const int nt = cur.nt;
        for (int t = 0; t < nt; t += 2) {
            const bool last = (t == nt - 2);
            const char* a1 = cA + (size_t)(t + 1) * kstep;
            const char* a2 = last ? nA : cA + (size_t)(t + 2) * kstep; const char* b2 = last ? nB : cB + (size_t)(t + 2) * kstep;
            const char* a3 = a2 + kstep; const char* b3 = b2 + kstep;
            PG8_LDB(B0, 0, 0); PG8_SCHED; PG8_LDA(At, 0, 0); PG8_STAGE(PG8_SA(1, 1), a1 + hstepA, voffA);
            PG8_WAIT_L(8); PG8_BAR; PG8_WAIT_L(0); PG8_MMA(0, 0, At, B0); PG8_BAR; PG8_SCHED;
            PG8_LDB(B1, 0, 1); PG8_STAGE(PG8_SB(0, 0), b2, voffB);
            PG8_BAR; PG8_WAIT_L(0); PG8_MMA(0, 1, At, B1); PG8_BAR;
            PG8_LDA(At, 0, 1); PG8_STAGE(PG8_SA(0, 0), a2, voffA);
            PG8_BAR; PG8_WAIT_L(0); PG8_MMA(1, 0, At, B0); PG8_BAR; PG8_SCHED;
            PG8_STAGE(PG8_SB(0, 1), b2 + hstepB, voffB);
            PG8_WAIT_V(6); PG8_BAR; PG8_MMA(1, 1, At, B1); PG8_BAR;
            PG8_LDB(B0, 1, 0); PG8_SCHED; PG8_LDA(At, 1, 0); PG8_STAGE(PG8_SA(0, 1), a2 + hstepA, voffA);
            PG8_WAIT_L(8); PG8_BAR; PG8_WAIT_L(0); PG8_MMA(0, 0, At, B0); PG8_BAR; PG8_SCHED;
            PG8_LDB(B1, 1, 1); PG8_STAGE(PG8_SB(1, 0), b3, voffB);
            PG8_BAR; PG8_WAIT_L(0); PG8_MMA(0, 1, At, B1); PG8_BAR;
            PG8_LDA(At, 1, 1); PG8_STAGE(PG8_SA(1, 0), a3, voffA);
            PG8_BAR; PG8_WAIT_L(0); PG8_MMA(1, 0, At, B0); PG8_BAR; PG8_SCHED;
            PG8_STAGE(PG8_SB(1, 1), b3 + hstepB, voffB);
            PG8_WAIT_V(6); PG8_BAR; PG8_MMA(1, 1, At, B1); PG8_BAR;
        }
        epilogue(acc, cur, wr, wc, fr, fq);
        if (!has_next) break;
        if (gid == G_MERGE) rescale_or_reset(acc, cur, wr, wc, fr, fq);
        else {
#pragma unroll
            for (int a = 0; a < 2; ++a)
#pragma unroll
                for (int b = 0; b < 2; ++b)
#pragma unroll
                    for (int m = 0; m < 4; ++m)
#pragma unroll
                        for (int n = 0; n < 2; ++n) acc[a][b][m][n] = (f32x4){0.f, 0.f, 0.f, 0.f};
        }
        cur = nxt; cA = nA; cB = nB; ++ui;
    }
    PG8_WAIT_V(0);
    if (wr == 0) PG8_BAR;
    PG8_BAR;
#undef PG8_SA
#undef PG8_SB
#undef PG8_STAGE
#undef PG8_LDA
#undef PG8_LDB
#undef PG8_MMA
#undef PG8_WAIT_V
#undef PG8_WAIT_L
#undef PG8_BAR
#undef PG8_SCHED
}

namespace att {
constexpr int D = 128, NW = 8, QBLK = 32, KVBLK = 64;
constexpr float SCALE = 0.088388347648318440f;
constexpr float THR = 8.f;
constexpr int LDQ = INC, LDK = 128, LDO = CLD;
constexpr size_t SHM_V = KVBLK * D * 2, SHM_K = KVBLK * D * 2, SHM_ATTN = 2 * SHM_V + 2 * SHM_K + NW * 64 * 4;
#define KSWZ(row, colB) ((row) * 256 + ((colB) ^ (((row) & 7) << 4)))
#define SBAR() __builtin_amdgcn_sched_barrier(0)
__device__ __forceinline__ int crow(int r, int hi) { return (r & 3) + 8 * (r >> 2) + 4 * hi; }
__device__ __forceinline__ void partialSM(f32x16& p0, f32x16& p1, float& m_reg, float& mn, float& alpha) {
  constexpr float C = SCALE * 1.4426950408889634f;
  float pmax = p0[0];
#pragma unroll
  for (int r = 1; r < 16; ++r) pmax = fmaxf(pmax, p0[r]);
#pragma unroll
  for (int r = 0; r < 16; ++r) pmax = fmaxf(pmax, p1[r]);
  { auto rr = __builtin_amdgcn_permlane32_swap(__float_as_uint(pmax), __float_as_uint(pmax), false, false);
    pmax = fmaxf(__uint_as_float(rr[0]), __uint_as_float(rr[1])); }
  if (__builtin_expect(__all(pmax - m_reg <= THR / SCALE), 1)) { mn = m_reg; alpha = 1.f; }
  else { mn = fmaxf(m_reg, pmax); alpha = __builtin_amdgcn_exp2f((m_reg - mn) * C); m_reg = mn; }
  float mnC = -mn * C;
#pragma unroll
  for (int r = 0; r < 16; ++r) p0[r] = fmaf(p0[r], C, mnC);
#pragma unroll
  for (int r = 0; r < 16; ++r) p1[r] = fmaf(p1[r], C, mnC);
#pragma unroll
  for (int r = 0; r < 16; ++r) p0[r] = __builtin_amdgcn_exp2f(p0[r]);
}
__device__ __forceinline__ void finishSM(f32x16& p0, f32x16& p1, float alpha, float& l_reg, bf16x8& pa0, bf16x8& pa1, bf16x8& pa2, bf16x8& pa3) {
#pragma unroll
  for (int r = 0; r < 16; ++r) p1[r] = __builtin_amdgcn_exp2f(p1[r]);
  float ps = 0;
#pragma unroll
  for (int r = 0; r < 16; ++r) ps += p0[r];
#pragma unroll
  for (int r = 0; r < 16; ++r) ps += p1[r];
  { auto rr = __builtin_amdgcn_permlane32_swap(__float_as_uint(ps), __float_as_uint(ps), false, false);
    ps = __uint_as_float(rr[0]) + __uint_as_float(rr[1]); }
  l_reg = l_reg * alpha + ps;
#define PK4(P, BASE, OUT) do { unsigned a0 = cvtpk(P[BASE + 0], P[BASE + 1]), a1 = cvtpk(P[BASE + 2], P[BASE + 3]);   \
    unsigned b0 = cvtpk(P[BASE + 4], P[BASE + 5]), b1 = cvtpk(P[BASE + 6], P[BASE + 7]);                              \
    auto r0 = __builtin_amdgcn_permlane32_swap(a0, b0, false, false); auto r1 = __builtin_amdgcn_permlane32_swap(a1, b1, false, false); \
    u32x4 w = {r0[0], r1[0], r0[1], r1[1]}; OUT = *reinterpret_cast<bf16x8*>(&w); } while (0)
  PK4(p0, 0, pa0); PK4(p0, 8, pa1); PK4(p1, 0, pa2); PK4(p1, 8, pa3);
#undef PK4
}
__device__ __forceinline__ void qkt(f32x16& p0, f32x16& p1, const bf16_t* Ks, const bf16x8* qr, int r32, int hi) {
  p0 = f32x16{}; p1 = f32x16{};
#pragma unroll
  for (int d0 = 0; d0 < 8; ++d0) { int cb = (d0 * 16 + hi * 8) * 2;
    bf16x8 b0 = *reinterpret_cast<const bf16x8*>((const char*)Ks + KSWZ(r32, cb));
    bf16x8 b1 = *reinterpret_cast<const bf16x8*>((const char*)Ks + KSWZ(32 + r32, cb));
    p0 = __builtin_amdgcn_mfma_f32_32x32x16_bf16(b0, qr[d0], p0, 0, 0, 0);
    p1 = __builtin_amdgcn_mfma_f32_32x32x16_bf16(b1, qr[d0], p1, 0, 0, 0); }
}
__device__ __forceinline__ int v_st(int k, int c) { const int kk = (k & ~0xC) | ((k & 4) << 1) | ((k & 8) >> 1); return ((kk >> 3) * 4 + (c >> 5)) * 512 + ((kk & 7) * 32 + (c & 31)) * 2; }
__device__ __forceinline__ int v_rd_base(int lane) { return ((lane & 3) << 3) | (((lane >> 2) & 3) << 6) | (((lane >> 4) & 1) << 5) | (((lane >> 5) & 1) << 8); }
constexpr int v_rd_off(int d0, int ks, int half) { return d0 * 512 + ks * 4096 + half * 2048; }
template <int OFF> __device__ __forceinline__ s16x4 tr_read(int vb) {
  s16x4 r; asm volatile("ds_read_b64_tr_b16 %0, %1 offset:%2" : "=&v"(r) : "v"(vb), "i"(OFF) : "memory"); return r;
}
template <int D0> __device__ __forceinline__ void pv_one(f32x16& od, int vb, bf16x8 pa0, bf16x8 pa1, bf16x8 pa2, bf16x8 pa3) {
  const s16x4 l0 = tr_read<v_rd_off(D0, 0, 0)>(vb), h0 = tr_read<v_rd_off(D0, 0, 1)>(vb), l1 = tr_read<v_rd_off(D0, 1, 0)>(vb), h1 = tr_read<v_rd_off(D0, 1, 1)>(vb);
  const s16x4 l2 = tr_read<v_rd_off(D0, 2, 0)>(vb), h2 = tr_read<v_rd_off(D0, 2, 1)>(vb), l3 = tr_read<v_rd_off(D0, 3, 0)>(vb), h3 = tr_read<v_rd_off(D0, 3, 1)>(vb);
  asm volatile("s_waitcnt lgkmcnt(0)" ::: "memory"); SBAR();
#define PK(L, H) (bf16x8){L[0], L[1], L[2], L[3], H[0], H[1], H[2], H[3]}
  od = __builtin_amdgcn_mfma_f32_32x32x16_bf16(pa0, PK(l0, h0), od, 0, 0, 0);
  od = __builtin_amdgcn_mfma_f32_32x32x16_bf16(pa1, PK(l1, h1), od, 0, 0, 0);
  od = __builtin_amdgcn_mfma_f32_32x32x16_bf16(pa2, PK(l2, h2), od, 0, 0, 0);
  od = __builtin_amdgcn_mfma_f32_32x32x16_bf16(pa3, PK(l3, h3), od, 0, 0, 0);
#undef PK
}
__device__ __forceinline__ void pv_d0(f32x16* o, int vb, bf16x8 pa0, bf16x8 pa1, bf16x8 pa2, bf16x8 pa3) {
  pv_one<0>(o[0], vb, pa0, pa1, pa2, pa3); pv_one<1>(o[1], vb, pa0, pa1, pa2, pa3); pv_one<2>(o[2], vb, pa0, pa1, pa2, pa3); pv_one<3>(o[3], vb, pa0, pa1, pa2, pa3);
}
__device__ __forceinline__ void attn_body(const bf16_t* __restrict__ Qb, const bf16_t* __restrict__ Kh, const bf16_t* __restrict__ Vh,
                                          bf16_t* __restrict__ Ob, const bf16_t* __restrict__ AGb, int seq, char* lds) {
  int tid_ = threadIdx.x; asm volatile("" : "+v"(tid_));
  const int tid = tid_, wid = tid >> 6, lane = tid & 63, r32 = lane & 31, hi = lane >> 5;
  bf16_t* V_lds = (bf16_t*)lds; bf16_t* K_lds = (bf16_t*)(lds + 2 * SHM_V);
  float* wsl = (float*)(lds + 2 * SHM_V + 2 * SHM_K) + wid * 64; float* li_l = wsl; float* al_l = wsl + 32;
  float m_reg = -1e30f, l_reg = 0; f32x16 o[4] = {}; bf16x8 qr[8];
  const bf16_t* Qw = Qb + (long)(wid * QBLK + r32) * LDQ + hi * 8;
#pragma unroll
  for (int d0 = 0; d0 < 8; ++d0) qr[d0] = *reinterpret_cast<const bf16x8*>(Qw + d0 * 16);
  const int sr = tid >> 4, sc = (tid & 15) * 8, vst0 = v_st(sr, sc), vst1 = v_st(32 + sr, sc);
  const int vb0 = (int)(uintptr_t)V_lds + v_rd_base(lane);
  const unsigned goff0 = (unsigned)(sr * LDK + sc) * 2u, goff1 = (unsigned)((32 + sr) * LDK + sc) * 2u;
  struct { bf16x8 vs0, vs1, ks0, ks1; } sr_[2];
#define SLOAD(i, k0) do { const char* vt_ = (const char*)Vh + (size_t)(k0) * (LDK * 2); const char* kt_ = (const char*)Kh + (size_t)(k0) * (LDK * 2); \
    sr_[i].vs0 = *reinterpret_cast<const bf16x8*>(vt_ + goff0); sr_[i].vs1 = *reinterpret_cast<const bf16x8*>(vt_ + goff1); \
    sr_[i].ks0 = *reinterpret_cast<const bf16x8*>(kt_ + goff0); sr_[i].ks1 = *reinterpret_cast<const bf16x8*>(kt_ + goff1); } while (0)
#define SWRITE(b, i) do { *(bf16x8*)((char*)V_lds + (b) * SHM_V + vst0) = sr_[i].vs0;          \
    *(bf16x8*)((char*)V_lds + (b) * SHM_V + vst1) = sr_[i].vs1; int kc = sc * 2;               \
    *(bf16x8*)((char*)K_lds + (b) * SHM_K + KSWZ(sr, kc)) = sr_[i].ks0;                       \
    *(bf16x8*)((char*)K_lds + (b) * SHM_K + KSWZ(32 + sr, kc)) = sr_[i].ks1; } while (0)
#define SWAIT() asm volatile("s_waitcnt vmcnt(4)" ::: "memory")
#define RESC(a) do { if (__any((a) < 1.f)) { if (hi == 0) al_l[r32] = (a); asm volatile("s_waitcnt lgkmcnt(0)" ::: "memory"); \
    _Pragma("unroll") for (int d = 0; d < 4; ++d) _Pragma("unroll") for (int r = 0; r < 16; ++r) o[d][r] *= al_l[crow(r, hi)]; } } while (0)
  f32x16 pA0, pA1, pB0, pB1; float mnA, mnB, alA, alB; bf16x8 pa0, pa1, pa2, pa3; const int NT = seq / KVBLK;
  constexpr int SE = 0, SO = 1;
  SLOAD(SE, 0); asm volatile("s_waitcnt vmcnt(0)" ::: "memory"); SWRITE(0, SE); __syncthreads();
  qkt(pA0, pA1, K_lds, qr, r32, hi); partialSM(pA0, pA1, m_reg, mnA, alA);
  SLOAD(SO, KVBLK); if (2 < NT) SLOAD(SE, 2 * KVBLK);
  SWAIT(); SWRITE(1, SO); __syncthreads();
  for (int j = 1; j + 1 < NT; j += 2) {
    SBAR(); qkt(pB0, pB1, (bf16_t*)((char*)K_lds + SHM_K), qr, r32, hi);
    finishSM(pA0, pA1, alA, l_reg, pa0, pa1, pa2, pa3); SBAR();
    SLOAD(SO, (j + 2) * KVBLK); SBAR();
    pv_d0(o, vb0, pa0, pa1, pa2, pa3); partialSM(pB0, pB1, m_reg, mnB, alB);
    __syncthreads(); SWAIT(); SWRITE(0, SE);
    RESC(alB); __syncthreads();
    SBAR(); qkt(pA0, pA1, K_lds, qr, r32, hi);
    finishSM(pB0, pB1, alB, l_reg, pa0, pa1, pa2, pa3); SBAR();
    if (j + 3 < NT) SLOAD(SE, (j + 3) * KVBLK); SBAR();
    pv_d0(o, vb0 + (int)SHM_V, pa0, pa1, pa2, pa3); partialSM(pA0, pA1, m_reg, mnA, alA);
    __syncthreads(); SWAIT(); SWRITE(1, SO);
    RESC(alA); __syncthreads();
  }
  SBAR(); qkt(pB0, pB1, (bf16_t*)((char*)K_lds + SHM_K), qr, r32, hi);
  finishSM(pA0, pA1, alA, l_reg, pa0, pa1, pa2, pa3); SBAR();
  pv_d0(o, vb0, pa0, pa1, pa2, pa3); partialSM(pB0, pB1, m_reg, mnB, alB);
  __syncthreads(); RESC(alB);
  finishSM(pB0, pB1, alB, l_reg, pa0, pa1, pa2, pa3); SBAR();
  pv_d0(o, vb0 + (int)SHM_V, pa0, pa1, pa2, pa3);
  if (hi == 0) li_l[r32] = l_reg; asm volatile("s_waitcnt lgkmcnt(0)" ::: "memory");
  char* Ow = (char*)(Ob + (long)(wid * QBLK) * LDO); const char* Gw = (const char*)(AGb + (long)(wid * QBLK) * LDQ);
  unsigned hv = hi, cv = r32;
  asm volatile("" : "+v"(hv), "+v"(cv));
  const unsigned gbase = (hv * 4u * LDQ + cv) * 2u, obase = (hv * 4u * LDO + cv) * 2u;
  unsigned short gq[16][4];
#pragma unroll
  for (int r = 0; r < 16; ++r) { const int rc = (r & 3) + 8 * (r >> 2); const unsigned go = gbase + (unsigned)(rc * LDQ * 2);
#pragma unroll
    for (int d0 = 0; d0 < 4; ++d0) gq[r][d0] = *(const bf16_t*)(Gw + go + d0 * 64); }
  SBAR();
#pragma unroll
  for (int r = 0; r < 16; ++r) { const int rc = (r & 3) + 8 * (r >> 2); const float rli = __builtin_amdgcn_rcpf(li_l[crow(r, hi)]);
    const unsigned oo = obase + (unsigned)(rc * LDO * 2);
#pragma unroll
    for (int d0 = 0; d0 < 4; ++d0) *(bf16_t*)(Ow + oo + d0 * 64) = f2bf(o[d0][r] * rli * siluf_(bf2f(gq[r][d0]))); }
#undef SLOAD
#undef SWRITE
#undef SWAIT
#undef RESC
}
}

__device__ __forceinline__ void attn_phase(const Params& p, int l, char* lds) {
    unsigned char* ws = p.ws;
    const bf16_t* P = (const bf16_t*)(ws + WS_P); bf16_t* Acat = (bf16_t*)(ws + WS_ACAT);
    const int G = gridDim.x, nunits = 512 + (l < DEPTH - 1 ? 16 : 0);
    for (int U = blockIdx.x; U < nunits; U += G) {
        int h, qrow0, seq;
        if (U < 512) { int qb;
            if (G == 256) { const int xcd = U & 7, j = (U >> 3) & 31, r = U >> 8, kvh = xcd >> 1, idx = (xcd & 1) * 64 + r * 32 + j; h = kvh * 4 + (idx & 3); qb = idx >> 2; }
            else { h = U & 15; qb = U >> 4; }
            qrow0 = CTX + qb * 256; seq = ROWS; }
        else { h = U - 512; qrow0 = 0; seq = CTX; }
        const int kvh = h >> 2;
        att::attn_body(P + (size_t)qrow0 * INC + OQ + h * 128, (const bf16_t*)(ws + WS_KC) + (size_t)kvh * ROWS * 128, (const bf16_t*)(ws + WS_VC) + (size_t)kvh * ROWS * 128,
                       Acat + (size_t)qrow0 * CLD + h * 128, P + (size_t)qrow0 * INC + OAG + h * 128, seq, lds);
        __syncthreads();
    }
}

#define XB_TMO      128
#define XB_XCNT(j)  (256  + 64 * (j))
#define XB_XSUB(j)  (1280 + 64 * (j))
#define XB_XGEN(j)  (2304 + 64 * (j))
#define XB_TOP      3328
#define XB_TOPGEN   3392
#define XCD_BAR_WORDS 3456
#define XB_SPIN_CAP (1u << 18)

__device__ __forceinline__ unsigned xb_ld(unsigned* p)              { return __hip_atomic_load(p, __ATOMIC_RELAXED, __HIP_MEMORY_SCOPE_AGENT); }
__device__ __forceinline__ unsigned xb_add(unsigned* p, unsigned v) { return __hip_atomic_fetch_add(p, v, __ATOMIC_RELAXED, __HIP_MEMORY_SCOPE_AGENT); }
__device__ __forceinline__ unsigned xb_xcc_id() { return (unsigned)__builtin_amdgcn_s_getreg((3 << 11) | 20) & 0xFu; }
#define XB_SPIN(cond, bar) do { unsigned _sp = 0; while (cond) { __builtin_amdgcn_s_sleep(1); \
    if ((++_sp & 255u) == 0u) { if (xb_ld(&(bar)[XB_TMO])) break; if (_sp > XB_SPIN_CAP) { atomicAdd(&(bar)[XB_TMO], 1u); break; } } } } while (0)

struct XcdBarrier {
    unsigned* bar; unsigned x;
    volatile LAS unsigned* st;
};

__device__ __forceinline__ XcdBarrier xcd_barrier_post(unsigned* bar, volatile LAS unsigned* st) {
    XcdBarrier b; b.bar = bar; b.x = xb_xcc_id(); b.st = st;
    if (threadIdx.x == 0) (void)xb_add(&bar[XB_XCNT(b.x)], 1u);
    return b;
}
__device__ __forceinline__ void xcd_barrier_complete(unsigned* bar, unsigned x, unsigned& nloc, unsigned& nx) {
    const unsigned G = gridDim.x * gridDim.y * gridDim.z;
    unsigned sum, cnt, mine, sp = 0u;
    for (;;) {
        sum = 0u; cnt = 0u; mine = 0u;
#pragma unroll
        for (unsigned j = 0; j < 16; ++j) { const unsigned c = xb_ld(&bar[XB_XCNT(j)]); sum += c; cnt += (c > 0u) ? 1u : 0u; mine = (j == x) ? c : mine; }
        if (sum == G) break;
        __builtin_amdgcn_s_sleep(1);
        if ((++sp & 255u) == 0u) { if (xb_ld(&bar[XB_TMO])) break; if (sp > XB_SPIN_CAP) { atomicAdd(&bar[XB_TMO], 1u); break; } }
    }
    nloc = mine > 0u ? mine : 1u; nx = cnt > 0u ? cnt : 1u;
}

__device__ __forceinline__ void xcd_barrier(const XcdBarrier& b) {
    asm volatile("s_waitcnt vmcnt(0)" ::: "memory");
    __syncthreads();
    if (threadIdx.x == 0) {
        unsigned* bar = b.bar;
        __builtin_amdgcn_s_waitcnt(0);
        unsigned nloc = b.st[0], nx = b.st[1];
        if (nloc == 0u) { xcd_barrier_complete(bar, b.x, nloc, nx); b.st[0] = nloc; b.st[1] = nx; }
        const unsigned old = xb_add(&bar[XB_XSUB(b.x)], 1u);
        const unsigned gen = old / nloc;
        if (old + 1u == (gen + 1u) * nloc) {
            __builtin_amdgcn_fence(__ATOMIC_RELEASE, "agent");
            asm volatile("s_waitcnt vmcnt(0)" ::: "memory");
            const unsigned og = xb_add(&bar[XB_TOP], 1u);
            const unsigned tg = og / nx;
            if (og + 1u == (tg + 1u) * nx) xb_add(&bar[XB_TOPGEN], 1u);
            else XB_SPIN(xb_ld(&bar[XB_TOPGEN]) == tg, bar);
            __builtin_amdgcn_fence(__ATOMIC_ACQUIRE, "agent");
            xb_add(&bar[XB_XGEN(b.x)], 1u);
            asm volatile("s_waitcnt vmcnt(0)" ::: "memory");
        } else {
            XB_SPIN(xb_ld(&bar[XB_XGEN(b.x)]) == gen, bar);
            __builtin_amdgcn_fence(__ATOMIC_ACQUIRE, "agent");
            asm volatile("s_waitcnt vmcnt(0)" ::: "memory");
        }
    }
    __syncthreads();
}

__global__ void __launch_bounds__(NTHREADS, 2) mega_fwd(Params p0) {
    extern __shared__ __attribute__((aligned(16))) unsigned char lds[];
    cg::grid_group grid = cg::this_grid();
    volatile LAS unsigned* misc = (volatile LAS unsigned*)((LAS unsigned char*)lds + LDS_STAGE);
    if (threadIdx.x < 16) misc[threadIdx.x] = 0u;
    __syncthreads();
    (void)xcd_barrier_post((unsigned*)(p0.ws + WS_BAR), misc);
#ifndef PHASE_MASK
#define PHASE_MASK 0xFFFF
#endif
#define PH(b) if constexpr ((PHASE_MASK >> (b)) & 1)
#ifndef DBL_MASK
#define DBL_MASK 0
#endif
    PH(10) prep_phase(p0, lds);
    __syncthreads();
    if constexpr ((DBL_MASK >> 10) & 1) { prep_phase(p0, lds); __syncthreads(); }
    grid.sync();
#pragma unroll 1
    for (int l = 0; l < DEPTH; ++l) {
#pragma unroll 1
        for (int slot = 0; slot < 12; ++slot) {
            Params p = p0;
            { unsigned char* w = p.ws; asm volatile("" : "+s"(w)); p.ws = w; }
            bool sync = true;
            LAS unsigned char* L = (LAS unsigned char*)lds;
            const int reps = ((DBL_MASK >> slot) & 1) ? 2 : 1;
#pragma unroll 1
            for (int rep = 0; rep < reps; ++rep) {
            if (rep) __syncthreads();
            switch (slot) {
            case 0: rownorm_phase(p, l); sync = false; break;
            case 1: if (l == 0) gemm_phase(L, G_FOLD, l, p.ws); break;
            case 2: gemm_phase(L, G_IN, l, p.ws); sync = false; break;
            case 3: gemm_phase(L, G_XT, l, p.ws); break;
            case 4: gemm_phase(L, G_F1, l, p.ws); sync = false; break;
            case 5: gemm_phase(L, G_DFTC, l, p.ws); break;
            case 6: ew_phase(p, l); break;
            case 7: case 8: sync = false; break;
            case 9: {
                const int cb = (int)blockIdx.x, Gn = (int)gridDim.x;
                unsigned* c2 = (unsigned*)(p.ws + WS_BAR) + 3540;
                const unsigned target = (unsigned)(Gn - 148) * (unsigned)(l + 1);
                if (cb >= 16 && cb < Gn - 132) {
                    gemm_phase(L, G_F2, l, p.ws);
                    __syncthreads();
                    if (threadIdx.x == 0) { __builtin_amdgcn_fence(__ATOMIC_RELEASE, "agent"); asm volatile("s_waitcnt vmcnt(0)" ::: "memory");
                        __hip_atomic_fetch_add(c2, 1u, __ATOMIC_RELAXED, __HIP_MEMORY_SCOPE_AGENT); }
                    __syncthreads();
                }
                attn_phase(p, l, (char*)lds);
                __syncthreads();
                if (cb >= Gn - 132) {
                    if (threadIdx.x == 0) { unsigned sp = 0;
                        while (__hip_atomic_load(c2, __ATOMIC_RELAXED, __HIP_MEMORY_SCOPE_AGENT) < target) { __builtin_amdgcn_s_sleep(1); if (++sp > (1u << 22)) break; }
                        __builtin_amdgcn_fence(__ATOMIC_ACQUIRE, "agent"); asm volatile("s_waitcnt vmcnt(0)" ::: "memory"); }
                    __syncthreads();
                    gemm_phase(L, G_MIX, l, p.ws);
                }
                break; }
            case 10: gemm_phase(L, G_MERGE, l, p.ws); __syncthreads(); gemm_phase(L, G_MERGEC, l, p.ws); break;
            default: {
                const bool hasctx = l < DEPTH - 1;
                unsigned* ccnt = (unsigned*)(p.ws + WS_BAR) + 3500;
                if (hasctx) {
                    int t0_ = threadIdx.x; asm volatile("" : "+v"(t0_));
                    const int idx = (int)blockIdx.x * NTHREADS + t0_, r = idx >> 9, cc = (idx & 511) * 4;
                    const float* mp = (const float*)(p.ws + WS_MP); bf16_t* mb = (bf16_t*)(p.ws + WS_MB);
                    f32x4 s = *(const f32x4*)(mp + (size_t)r * MLD + cc);
#pragma unroll
                    for (int q = 1; q < 8; ++q) s += *(const f32x4*)(mp + ((size_t)q * CTX + r) * MLD + cc);
                    u32x2 w; w.x = cvtpk(s[0], s[1]); w.y = cvtpk(s[2], s[3]); *(u32x2*)(mb + (size_t)r * DM + cc) = w;
                    asm volatile("s_waitcnt vmcnt(0)" ::: "memory"); __syncthreads();
                    if (threadIdx.x == 0) { __builtin_amdgcn_fence(__ATOMIC_RELEASE, "agent"); asm volatile("s_waitcnt vmcnt(0)" ::: "memory");
                        __hip_atomic_fetch_add(ccnt, 1u, __ATOMIC_RELAXED, __HIP_MEMORY_SCOPE_AGENT); }
                }
                const int nv = (hasctx && (int)blockIdx.x >= (int)gridDim.x - 32) ? 2 : 1;
#pragma unroll 1
                for (int v = 0; v < nv; ++v) {
                    if (v) {
                        __syncthreads();
                        if (threadIdx.x == 0) { const unsigned target = (unsigned)(l + 1) * gridDim.x; unsigned sp = 0;
                            while (__hip_atomic_load(ccnt, __ATOMIC_RELAXED, __HIP_MEMORY_SCOPE_AGENT) < target) { __builtin_amdgcn_s_sleep(1); if (++sp > (1u << 22)) break; }
                            __builtin_amdgcn_fence(__ATOMIC_ACQUIRE, "agent"); asm volatile("s_waitcnt vmcnt(0)" ::: "memory"); }
                        __syncthreads();
                    }
                    gemm_phase(L, G_OUT, l | (v << 4), p.ws);
                }
                break; }
            }
            }
            __syncthreads();
            if (sync) { XcdBarrier xb; xb.bar = (unsigned*)(p.ws + WS_BAR); xb.x = xb_xcc_id(); xb.st = (volatile LAS unsigned*)((LAS unsigned char*)lds + LDS_STAGE); xcd_barrier(xb); }
        }
    }
    PH(0) rownorm_phase(p0, DEPTH);
}

extern "C" void kernel_launch(void* const* d_in, const int* in_sizes, int n_in, void* d_out, int out_size, void* d_ws, size_t ws_size, hipStream_t stream) {
    static int grid_blocks = 0;
    if (grid_blocks == 0) {
        if (n_in != 18 || out_size != SEQ * DM || ws_size < WS_END) { fprintf(stderr, "kernel_launch: unexpected shapes: n_in %d out %d ws %zu (need %zu)\n", n_in, out_size, ws_size, (size_t)WS_END); grid_blocks = -1; return; }
        int dev = 0, cus = 0, per_cu = 0;
        hipGetDevice(&dev);
        hipDeviceGetAttribute(&cus, hipDeviceAttributeMultiprocessorCount, dev);
        if (hipFuncSetAttribute((const void*)mega_fwd, hipFuncAttributeMaxDynamicSharedMemorySize, LDS_BYTES) != hipSuccess) { fprintf(stderr, "kernel_launch: hipFuncSetAttribute failed\n"); grid_blocks = -1; return; }
        if (hipOccupancyMaxActiveBlocksPerMultiprocessor(&per_cu, (const void*)mega_fwd, NTHREADS, LDS_BYTES) != hipSuccess || per_cu < 1) { fprintf(stderr, "kernel_launch: occupancy query gave %d\n", per_cu); per_cu = 1; }
        (void)hipGetLastError();
        grid_blocks = cus * (per_cu > 1 ? 1 : per_cu);
        if (grid_blocks > 256) grid_blocks = 256;
        grid_blocks &= ~7;
        if (grid_blocks != 256) { fprintf(stderr, "kernel_launch: this kernel is laid out for 256 resident workgroups, got %d\n", grid_blocks); grid_blocks = -1; return; }
    }
    if (grid_blocks <= 0) return;
    Params p{};
    for (int i = 0; i < 18; ++i) p.in[i] = (const float*)d_in[i];
    p.out = (float*)d_out; p.ws = (unsigned char*)d_ws;
    if (hipMemsetAsync((char*)d_ws + WS_BAR, 0, BAR_BYTES, stream) != hipSuccess) { fprintf(stderr, "kernel_launch: memset of barrier words failed\n"); return; }
    void* args[] = {&p};
    hipError_t e = hipLaunchCooperativeKernel((const void*)mega_fwd, dim3(grid_blocks), dim3(NTHREADS), args, LDS_BYTES, stream);
    if (e != hipSuccess) fprintf(stderr, "cooperative launch failed: %s (grid %d)\n", hipGetErrorString(e), grid_blocks);
}
```

```cpp
#include <hip/hip_runtime.h>
#include <hip/hip_cooperative_groups.h>
#include <cstdio>
#include <cstdint>
namespace cg = cooperative_groups;

#define LAS __attribute__((address_space(3)))
typedef unsigned short bf16_t;
typedef short bf16x8 __attribute__((ext_vector_type(8)));
typedef short s16x4 __attribute__((ext_vector_type(4)));
typedef float f32x4 __attribute__((ext_vector_type(4)));
typedef float f32x16 __attribute__((ext_vector_type(16)));
typedef unsigned u32x4 __attribute__((ext_vector_type(4)));
typedef unsigned u32x2 __attribute__((ext_vector_type(2)));

constexpr int DM = 2048, SEQ = 8192, CTX = 256, ROWS = SEQ + CTX, DEPTH = 4, INC = 17408;
constexpr int OQ = 0, OKK = 2048, OV = 2560, OAG = 3072, OFX = 5120, OFG = 6144, OCX = 7168, OCB = 8192, OCC = 9216, OCG = 10240, OML = 11264;
constexpr float EPS = 1e-6f;
constexpr size_t APL = (size_t)(SEQ + CTX) * 2048, WPL = (size_t)2048 * 2048;
constexpr int CLD = 2048;
constexpr int MLD = 2048 + 64;
constexpr int ZCH = 32768 + 256;
constexpr int LDS_STAGE = 131072, LDS_BYTES = LDS_STAGE + 64;
constexpr int NTHREADS = 512;

constexpr size_t SZ_WINT = (size_t)INC * DM * 2, SZ_WCAT = 3 * WPL * 2, SZ_WOUT = (size_t)DM * DM * 2, SZ_WMIXR = (size_t)1024 * 1024 * 2, SZ_WMIX = (size_t)1024 * 2048 * 2;
constexpr size_t WS_WINT = 0;
constexpr size_t WS_WCAT = WS_WINT + DEPTH * SZ_WINT;
constexpr size_t WS_WOUT = WS_WCAT + DEPTH * SZ_WCAT;
constexpr size_t WS_WMIXR = WS_WOUT + DEPTH * SZ_WOUT;
constexpr size_t WS_WMIX = WS_WMIXR + DEPTH * SZ_WMIXR;
constexpr size_t WS_TCH = WS_WMIX + DEPTH * SZ_WMIX;
constexpr size_t WS_ZT = WS_TCH + 512 * 256 * 2;
constexpr size_t WS_T1 = WS_ZT + (size_t)1024 * ZCH;
constexpr size_t WS_A2 = WS_T1 + 256 * 128 * 2;
constexpr size_t WS_ACTX = WS_A2 + 256 * 256 * 2;
constexpr size_t WS_ROPE = WS_ACTX + 512 * 256 * 2;
constexpr size_t WS_MOD = WS_ROPE + 128 * 32 * 8;
constexpr size_t WS_XS = WS_MOD + 4 * 2 * 6144 * 4;
constexpr size_t WS_H = WS_XS + (size_t)ROWS * DM * 4;
constexpr size_t WS_P = WS_H + (size_t)ROWS * DM * 2;
constexpr size_t WS_XT = WS_P + (size_t)ROWS * INC * 2;
constexpr size_t WS_PQ = WS_XT + (size_t)1024 * ROWS * 2;
constexpr size_t WS_ACAT = WS_PQ + (size_t)ROWS * DM * 2;
constexpr size_t WS_MBUF = WS_ACAT + 3 * APL * 2;
constexpr size_t WS_MB = WS_MBUF + (size_t)ROWS * MLD * 4;
constexpr size_t WS_OUTB = WS_MB + (size_t)ROWS * DM * 2;
constexpr size_t WS_KC = WS_OUTB + (size_t)ROWS * DM * 4;
constexpr size_t WS_VC = WS_KC + (size_t)4 * ROWS * 128 * 2;
constexpr size_t WS_MP = WS_VC + (size_t)4 * ROWS * 128 * 2;
constexpr size_t WS_OUTP = WS_MP + (size_t)8 * CTX * MLD * 4;
constexpr size_t WS_BAR = WS_OUTP + (size_t)4 * CTX * DM * 4;
constexpr size_t BAR_BYTES = 16384;
constexpr size_t WS_END = WS_BAR + BAR_BYTES;

struct Params { const float* in[18]; float* out; unsigned char* ws; };
enum { I_X = 0, I_C, I_CTX, I_CCTX, I_WMOD, I_BMOD, I_GPRE, I_GPOST, I_WIN, I_QN, I_KN, I_WAO, I_WFM, I_WFO, I_CW, I_CB, I_WCO, I_WOUT };

__device__ __forceinline__ unsigned cvtpk(float lo, float hi) { unsigned r; asm volatile("v_cvt_pk_bf16_f32 %0, %1, %2" : "=v"(r) : "v"(lo), "v"(hi)); return r; }
__device__ __forceinline__ float bf2f(unsigned short b) { return __uint_as_float(((unsigned)b) << 16); }
__device__ __forceinline__ float bflo(unsigned w) { return __uint_as_float(w << 16); }
__device__ __forceinline__ float bfhi(unsigned w) { return __uint_as_float(w & 0xffff0000u); }
__device__ __forceinline__ unsigned short f2bf(float f) { return (unsigned short)(cvtpk(f, f) & 0xffffu); }
__device__ __forceinline__ float sigmoidf_(float x) { return __builtin_amdgcn_rcpf(1.0f + __expf(-x)); }
__device__ __forceinline__ float siluf_(float x) { return x * sigmoidf_(x); }
__device__ __forceinline__ float wave_sum(float v) {
#pragma unroll
    for (int o = 32; o >= 1; o >>= 1) v += __shfl_xor(v, o);
    return v;
}

__device__ __forceinline__ void prep_phase(const Params& p, unsigned char* lds_g) {
    int tid_ = threadIdx.x; asm volatile("" : "+v"(tid_));
    const int tid = tid_, G = gridDim.x, bid = blockIdx.x;
    unsigned char* ws = p.ws;
    float* tile = (float*)lds_g;
    constexpr int T_IN = 32 * 272, T_AO = 32 * 32, T_FO = 16 * 32, T_CO = 16 * 32, T_OUT = 32 * 32, T_MIX = 16 * 16;
    constexpr int T_LAYER = T_IN + T_AO + T_FO + T_CO + T_OUT + T_MIX;
    for (int t = bid; t < DEPTH * T_LAYER; t += G) {
        const int l = t / T_LAYER; int r = t % T_LAYER;
        const float* src; int ldsrc; bf16_t* dst; int lddst; int ktiles;
        if (r < T_IN) { src = p.in[I_WIN] + (size_t)l * DM * INC; ldsrc = INC; dst = (bf16_t*)(ws + WS_WINT + l * SZ_WINT); lddst = DM; ktiles = 32; }
        else if ((r -= T_IN) < T_AO) { src = p.in[I_WAO] + (size_t)l * DM * DM; ldsrc = DM; dst = (bf16_t*)(ws + WS_WCAT + l * SZ_WCAT); lddst = CLD; ktiles = 32; }
        else if ((r -= T_AO) < T_FO) { src = p.in[I_WFO] + (size_t)l * 1024 * DM; ldsrc = DM; dst = (bf16_t*)(ws + WS_WCAT + l * SZ_WCAT) + WPL; lddst = CLD; ktiles = 16; }
        else if ((r -= T_FO) < T_CO) { src = p.in[I_WCO] + (size_t)l * 1024 * DM; ldsrc = DM; dst = (bf16_t*)(ws + WS_WCAT + l * SZ_WCAT) + 2 * WPL; lddst = CLD; ktiles = 16; }
        else if ((r -= T_CO) < T_OUT) { src = p.in[I_WOUT] + (size_t)l * DM * DM; ldsrc = DM; dst = (bf16_t*)(ws + WS_WOUT + l * SZ_WOUT); lddst = DM; ktiles = 32; }
        else { r -= T_OUT; src = p.in[I_WFM] + (size_t)l * 1024 * 1024; ldsrc = 1024; dst = (bf16_t*)(ws + WS_WMIXR + l * SZ_WMIXR); lddst = 1024; ktiles = 16; }
        const int k0 = (r % ktiles) * 64, n0 = (r / ktiles) * 64;
        { const int ty = tid >> 4, tx = tid & 15;
#pragma unroll
          for (int ps = 0; ps < 2; ++ps) { const int kk = ty + 32 * ps;
              const f32x4 v = *(const f32x4*)(src + (size_t)(k0 + kk) * ldsrc + n0 + tx * 4);
              tile[kk * 65 + tx * 4 + 0] = v[0]; tile[kk * 65 + tx * 4 + 1] = v[1]; tile[kk * 65 + tx * 4 + 2] = v[2]; tile[kk * 65 + tx * 4 + 3] = v[3]; } }
        __syncthreads();
        { const int n = tid >> 3, kc = (tid & 7) * 8; u32x4 w;
          w.x = cvtpk(tile[(kc + 0) * 65 + n], tile[(kc + 1) * 65 + n]); w.y = cvtpk(tile[(kc + 2) * 65 + n], tile[(kc + 3) * 65 + n]);
          w.z = cvtpk(tile[(kc + 4) * 65 + n], tile[(kc + 5) * 65 + n]); w.w = cvtpk(tile[(kc + 6) * 65 + n], tile[(kc + 7) * 65 + n]);
          *(u32x4*)(dst + (size_t)(n0 + n) * lddst + k0 + kc) = w; }
        __syncthreads();
    }
    {
        float* sc = (float*)lds_g;
        float* red = sc + 4096;
        for (int u = bid; u < 256; u += G) {
            for (int k = tid; k < 4096; k += NTHREADS) { const float cv = (k < 2048) ? p.in[I_C][k] : p.in[I_CCTX][k - 2048]; sc[k] = siluf_(cv); }
            __syncthreads();
            const int l = u >> 6, j0 = (u & 63) * 96;
            if (tid < 504) { const int kg = tid / 24, cq = tid % 24;
                f32x4 al = {0.f, 0.f, 0.f, 0.f}, ac = {0.f, 0.f, 0.f, 0.f};
                const float* wp = p.in[I_WMOD] + (size_t)l * DM * 6144 + j0 + cq * 4;
                for (int k = kg; k < 2048; k += 21) { const f32x4 w = *(const f32x4*)(wp + (size_t)k * 6144); al += sc[k] * w; ac += sc[2048 + k] * w; }
                float* rp = red + (kg * 24 + cq) * 8;
                rp[0] = al[0]; rp[1] = al[1]; rp[2] = al[2]; rp[3] = al[3]; rp[4] = ac[0]; rp[5] = ac[1]; rp[6] = ac[2]; rp[7] = ac[3]; }
            __syncthreads();
            if (tid < 192) { const int v = tid / 96, col = tid % 96, cq = col >> 2, e = col & 3; float s = 0.f;
                for (int kg = 0; kg < 21; ++kg) s += red[(kg * 24 + cq) * 8 + v * 4 + e];
                ((float*)(ws + WS_MOD))[(size_t)(l * 2 + v) * 6144 + j0 + col] = s + p.in[I_BMOD][(size_t)l * 6144 + j0 + col]; }
            __syncthreads();
        }
    }
    const long gt = (long)bid * NTHREADS + tid, gn = (long)G * NTHREADS;
    for (long it = gt; it < 256 * 16; it += gn) { const int r = (int)(it >> 4), s0 = (int)(it & 15) * 8, k1 = r >> 1, ri = r & 1;
        float v[8];
#pragma unroll
        for (int j = 0; j < 8; ++j) { const int ph = (k1 * (s0 + j)) & 127; const float x = (float)ph * (1.0f / 128.0f); v[j] = (ri ? -__builtin_amdgcn_sinf(x) : __builtin_amdgcn_cosf(x)) * 0.08838834764831845f; }
        u32x4 w; w.x = cvtpk(v[0], v[1]); w.y = cvtpk(v[2], v[3]); w.z = cvtpk(v[4], v[5]); w.w = cvtpk(v[6], v[7]);
        *(u32x4*)((bf16_t*)(ws + WS_T1) + (size_t)r * 128 + s0) = w; }
    for (long it = gt; it < 256 * 32; it += gn) { const int rr = (int)(it >> 5), c0 = (int)(it & 31) * 8, kb = rr >> 7, pq = (rr >> 6) & 1, k2 = rr & 63;
        float v[8];
#pragma unroll
        for (int j = 0; j < 8; ++j) { const int cc = c0 + j, s2 = cc >> 2, kbc = (cc >> 1) & 1, ri = cc & 1;     const int ph = (k2 * s2) & 63; const float x = (float)ph * (1.0f / 64.0f);
            const float cs = __builtin_amdgcn_cosf(x), sn = __builtin_amdgcn_sinf(x);
            const float val = pq == 0 ? (ri == 0 ? cs : sn) : (ri == 0 ? sn : -cs);
            v[j] = (kb == kbc) ? val * 0.125f : 0.f; }
        u32x4 w; w.x = cvtpk(v[0], v[1]); w.y = cvtpk(v[2], v[3]); w.z = cvtpk(v[4], v[5]); w.w = cvtpk(v[6], v[7]);
        *(u32x4*)((bf16_t*)(ws + WS_A2) + (size_t)rr * 256 + c0) = w; }
    for (long it = gt; it < 2 * 512 * 32; it += gn) { const int which = (int)(it >> 14), rr = (int)(it & 16383), r = rr >> 5, s0 = (rr & 31) * 8, k = r & 255; const bool isin = r >= 256;
        bf16_t* A = (bf16_t*)(ws + (which ? WS_TCH : WS_ACTX)); const float sgn = (which && isin) ? -0.0625f : 0.0625f;
        float v[8];
#pragma unroll
        for (int j = 0; j < 8; ++j) { const int ph = (k * (s0 + j)) & 255; const float x = (float)ph * (1.0f / 256.0f); v[j] = (isin ? __builtin_amdgcn_sinf(x) : __builtin_amdgcn_cosf(x)) * sgn; }
        u32x4 w; w.x = cvtpk(v[0], v[1]); w.y = cvtpk(v[2], v[3]); w.z = cvtpk(v[4], v[5]); w.w = cvtpk(v[6], v[7]);
        *(u32x4*)(A + (size_t)r * 256 + s0) = w; }
    for (long it = gt; it < 128 * 32; it += gn) { const int pos = (int)(it >> 5), i = (int)(it & 31);
        const float freq = exp2f(-(float)i * (13.287712379549449f / 32.0f));
        const float ang = (float)pos * freq;
        double rev = (double)ang * 0.15915494309189535; rev -= floor(rev);
        const float xr = (float)rev;
        float2 cs; cs.x = __builtin_amdgcn_cosf(xr); cs.y = __builtin_amdgcn_sinf(xr);
        ((float2*)(ws + WS_ROPE))[it] = cs; }
    { f32x4* xs = (f32x4*)(ws + WS_XS); const f32x4* cx = (const f32x4*)p.in[I_CTX]; const f32x4* xx = (const f32x4*)p.in[I_X];
      const long nc = (long)CTX * DM / 4, nt = (long)ROWS * DM / 4;
      for (long it = gt; it < nt; it += gn) xs[it] = (it < nc) ? cx[it] : xx[it - nc]; }
}

__device__ __forceinline__ void rownorm_phase(const Params& p, int l) {
    int tid_ = threadIdx.x; asm volatile("" : "+v"(tid_));
    const int tid = tid_, lane = tid & 63, wid = tid >> 6;
    unsigned char* ws = p.ws;
    const int gw = blockIdx.x * 8 + wid, nw = gridDim.x * 8;
    const float* mod = (const float*)(ws + WS_MOD);
    for (int row = gw; row < ROWS; row += nw) {
        const int isctx = row < CTX ? 1 : 0;
        if (l == 4 && isctx) continue;
        float* xrow = (float*)(ws + WS_XS) + (size_t)row * DM;
        f32x4 xv[8];
#pragma unroll
        for (int i = 0; i < 8; ++i) xv[i] = *(const f32x4*)(xrow + lane * 4 + i * 256);
        if (l > 0) {
            const bf16_t* orow = (const bf16_t*)(ws + WS_OUTB) + (size_t)row * DM;
            f32x4 ov[8]; float ss = 0.f;
#pragma unroll
            for (int i = 0; i < 8; ++i) {
                if (isctx) { const float* pp = (const float*)(ws + WS_OUTP) + (size_t)row * DM + lane * 4 + i * 256;
                    ov[i] = (*(const f32x4*)pp + *(const f32x4*)(pp + (size_t)CTX * DM)) + (*(const f32x4*)(pp + (size_t)2 * CTX * DM) + *(const f32x4*)(pp + (size_t)3 * CTX * DM)); }
                else { const u32x2 w = *(const u32x2*)(orow + lane * 4 + i * 256); ov[i] = (f32x4){bflo(w.x), bfhi(w.x), bflo(w.y), bfhi(w.y)}; }
                ss += ov[i][0] * ov[i][0] + ov[i][1] * ov[i][1] + ov[i][2] * ov[i][2] + ov[i][3] * ov[i][3]; }
            ss = wave_sum(ss);
            const float rstd = rsqrtf(ss * (1.0f / DM) + EPS);
            const float* gate = mod + (size_t)((l - 1) * 2 + isctx) * 6144 + 4096;
            const float* gpost = p.in[I_GPOST] + (size_t)(l - 1) * DM;
#pragma unroll
            for (int i = 0; i < 8; ++i) { const f32x4 g = *(const f32x4*)(gate + lane * 4 + i * 256), gp = *(const f32x4*)(gpost + lane * 4 + i * 256);
                xv[i] = xv[i] + g * ((ov[i] * rstd) * gp); }
            if (l == 4) { float* orow2 = p.out + (size_t)(row - CTX) * DM;
#pragma unroll
                for (int i = 0; i < 8; ++i) *(f32x4*)(orow2 + lane * 4 + i * 256) = xv[i];
                continue; }
        }
        float ss = 0.f;
#pragma unroll
        for (int i = 0; i < 8; ++i) ss += xv[i][0] * xv[i][0] + xv[i][1] * xv[i][1] + xv[i][2] * xv[i][2] + xv[i][3] * xv[i][3];
        ss = wave_sum(ss);
        const float rstd = rsqrtf(ss * (1.0f / DM) + EPS);
        const float* ml = mod + (size_t)(l * 2 + isctx) * 6144;
        const float* gpre = p.in[I_GPRE] + (size_t)l * DM;
        bf16_t* hrow = (bf16_t*)(ws + WS_H) + (size_t)row * DM;
        f32x4 sh[8], scl[8], gp[8];
#pragma unroll
        for (int i = 0; i < 8; ++i) { const int c = lane * 4 + i * 256; sh[i] = *(const f32x4*)(ml + c); scl[i] = *(const f32x4*)(ml + 2048 + c); gp[i] = *(const f32x4*)(gpre + c); }
        __builtin_amdgcn_sched_barrier(0);
        if (l > 0) {
#pragma unroll
            for (int i = 0; i < 8; ++i) *(f32x4*)(xrow + lane * 4 + i * 256) = xv[i];
        }
#pragma unroll
        for (int i = 0; i < 8; ++i) { const int c = lane * 4 + i * 256;
            const f32x4 hv = ((xv[i] * rstd) * gp[i]) * (1.0f + scl[i]) + sh[i];
            u32x2 w; w.x = cvtpk(hv[0], hv[1]); w.y = cvtpk(hv[2], hv[3]);
            *(u32x2*)(hrow + c) = w; }
    }
}

__device__ __forceinline__ void ew_phase(const Params& p, int l) {
    int tid_ = threadIdx.x; asm volatile("" : "+v"(tid_));
    const int tid = tid_;
    unsigned char* ws = p.ws;
    bf16_t* P = (bf16_t*)(ws + WS_P);
    {
        const int t = tid & 15; const long grp = ((long)blockIdx.x * NTHREADS + tid) >> 4, ngrp = (long)gridDim.x * NTHREADS / 16;
        const float2* rope = (const float2*)(ws + WS_ROPE);
        const int base = ((t & 8) ? 64 : 0) + 4 * (t & 7), fi = 4 * (t & 7);
        bf16_t* KC = (bf16_t*)(ws + WS_KC);
#pragma unroll 2
        for (long it = grp; it < (long)ROWS * 20; it += ngrp) { const int row = (int)(it / 20), head = (int)(it % 20);
            const bf16_t* src_ = P + (size_t)row * INC + (head < 16 ? OQ + head * 128 : OKK + (head - 16) * 128) + base;
            bf16_t* dst_ = (head < 16) ? (P + (size_t)row * INC + OQ + head * 128 + base) : (KC + ((size_t)(head - 16) * ROWS + row) * 128 + base);
            const float* gn = (head < 16 ? p.in[I_QN] : p.in[I_KN]) + (size_t)l * 128 + base;
            const u32x2 wa = *(const u32x2*)src_, wb = *(const u32x2*)(src_ + 32);
            const f32x4 ga = *(const f32x4*)gn, gb = *(const f32x4*)(gn + 32);
            float a[4] = {bflo(wa.x), bfhi(wa.x), bflo(wa.y), bfhi(wa.y)}, b[4] = {bflo(wb.x), bfhi(wb.x), bflo(wb.y), bfhi(wb.y)};
            float ss = 0.f;
#pragma unroll
            for (int q = 0; q < 4; ++q) ss += a[q] * a[q] + b[q] * b[q];
#pragma unroll
            for (int o = 8; o >= 1; o >>= 1) ss += __shfl_xor(ss, o);
            const float rstd = rsqrtf(ss * (1.0f / 128.0f) + EPS);
#pragma unroll
            for (int q = 0; q < 4; ++q) { a[q] = a[q] * rstd * ga[q]; b[q] = b[q] * rstd * gb[q]; }
            if (row >= CTX) { const int tk = row - CTX, pos = (t & 8) ? (tk & 63) : (tk >> 6);
                const f32x4 r01 = *(const f32x4*)(rope + pos * 32 + fi), r23 = *(const f32x4*)(rope + pos * 32 + fi + 2);
                const float cs[4] = {r01[0], r01[2], r23[0], r23[2]}, sn[4] = {r01[1], r01[3], r23[1], r23[3]};
#pragma unroll
                for (int q = 0; q < 4; ++q) { const float x0 = a[q], x1 = b[q]; a[q] = x0 * cs[q] - x1 * sn[q]; b[q] = x0 * sn[q] + x1 * cs[q]; } }
            u32x2 oa, ob; oa.x = cvtpk(a[0], a[1]); oa.y = cvtpk(a[2], a[3]); ob.x = cvtpk(b[0], b[1]); ob.y = cvtpk(b[2], b[3]);
            *(u32x2*)dst_ = oa; *(u32x2*)(dst_ + 32) = ob;
        }
    }
    {
        const long gt = (long)blockIdx.x * NTHREADS + tid, gn = (long)gridDim.x * NTHREADS;
        bf16_t* VC = (bf16_t*)(ws + WS_VC);
        for (long it = gt; it < (long)ROWS * 64; it += gn) { const int row = (int)(it >> 6), c = (int)(it & 63) * 8;
            const u32x4 v = *(const u32x4*)(P + (size_t)row * INC + OV + c);
            *(u32x4*)(VC + ((size_t)(c >> 7) * ROWS + row) * 128 + (c & 127)) = v; }
    }
    {
        const long gt = (long)blockIdx.x * NTHREADS + tid, gn = (long)gridDim.x * NTHREADS;
        bf16_t* Acat = (bf16_t*)(ws + WS_ACAT);
        const float* cw = p.in[I_CW] + (size_t)l * 3 * 1024; const float* cbias = p.in[I_CB] + (size_t)l * 1024;
        for (long it = gt; it < (long)(ROWS / 4) * 128; it += gn) { const int row0 = (int)(it >> 7) * 4, c0 = (int)(it & 127) * 8;
            const bf16_t* pr = P + (size_t)row0 * INC;
            const bool hp = (row0 != 0) && (row0 != CTX), hn = (row0 + 4 != CTX) && (row0 + 4 != ROWS);
            const u32x4 z = {0u, 0u, 0u, 0u};
            u32x4 xv[6], kv[6], bb[4], gg[4];
            xv[0] = hp ? *(const u32x4*)(pr - INC + OCX + c0) : z; kv[0] = hp ? *(const u32x4*)(pr - INC + OCC + c0) : z;
#pragma unroll
            for (int r = 0; r < 4; ++r) { xv[r + 1] = *(const u32x4*)(pr + (size_t)r * INC + OCX + c0); kv[r + 1] = *(const u32x4*)(pr + (size_t)r * INC + OCC + c0);
                bb[r] = *(const u32x4*)(pr + (size_t)r * INC + OCB + c0); gg[r] = *(const u32x4*)(pr + (size_t)r * INC + OCG + c0); }
            xv[5] = hn ? *(const u32x4*)(pr + (size_t)4 * INC + OCX + c0) : z; kv[5] = hn ? *(const u32x4*)(pr + (size_t)4 * INC + OCC + c0) : z;
            float w0[8], w1[8], w2[8], bs[8];
#pragma unroll
            for (int j = 0; j < 8; ++j) { w0[j] = cw[c0 + j]; w1[j] = cw[1024 + c0 + j]; w2[j] = cw[2048 + c0 + j]; bs[j] = cbias[c0 + j]; }
            float uu[6][8];
#pragma unroll
            for (int r = 0; r < 6; ++r)
#pragma unroll
                for (int q = 0; q < 4; ++q) { uu[r][2 * q] = bflo(xv[r][q]) * bflo(kv[r][q]); uu[r][2 * q + 1] = bfhi(xv[r][q]) * bfhi(kv[r][q]); }
#pragma unroll
            for (int r = 0; r < 4; ++r) { float res[8];
#pragma unroll
                for (int q = 0; q < 4; ++q) {
                    { const int j = 2 * q; const float cv = uu[r][j] * w0[j] + uu[r + 1][j] * w1[j] + uu[r + 2][j] * w2[j] + bs[j]; res[j] = bflo(bb[r][q]) * cv * siluf_(bflo(gg[r][q])); }
                    { const int j = 2 * q + 1; const float cv = uu[r][j] * w0[j] + uu[r + 1][j] * w1[j] + uu[r + 2][j] * w2[j] + bs[j]; res[j] = bfhi(bb[r][q]) * cv * siluf_(bfhi(gg[r][q])); } }
                u32x4 w; w.x = cvtpk(res[0], res[1]); w.y = cvtpk(res[2], res[3]); w.z = cvtpk(res[4], res[5]); w.w = cvtpk(res[6], res[7]);
                *(u32x4*)(Acat + 2 * APL + (size_t)(row0 + r) * CLD + c0) = w; }
        }
    }
}

constexpr int BM = 256, BK = 64, HALF = 128, HTB = HALF * BK * 2;
constexpr int BJC = 32;
__device__ __forceinline__ int lds_byte(int r, int c) { const int st = (r >> 4) * 2 + (c >> 5), rr = r & 15, cc = c & 31, ob = rr * 64 + cc * 2; return st * 1024 + (ob ^ (((ob >> 9) & 1) << 5)); }
__device__ __forceinline__ void stage_rc(int b, int& R, int& C) { const int st = b / 1024, sb = b % 1024, swz = sb ^ (((sb >> 9) & 1) << 5); R = (st >> 1) * 16 + swz / 64; C = (st & 1) * 32 + (swz % 64) / 2; }
__device__ __forceinline__ int perm32(int rho) { const int n = rho >> 4, i = rho & 15; return 8 * (i >> 2) + 4 * n + (i & 3); }

enum { G_FOLD = 0, G_IN, G_XT, G_F1, G_F2, G_DFTC, G_MIX, G_MERGE, G_OUT, G_MERGEC };
enum { M_BF16 = 0, M_MIX, M_MERGE0, M_MERGE1, M_MERGE2, M_F32, M_F1, M_F2, M_MG0, M_MG1, M_MG2 };
struct Unit { const char* a; const char* b; char* o; const char* aux; char* m; int nt, mode, ldo; };

__device__ __forceinline__ void static_order(int w, int nM, int nN, int& pm, int& pn) {
    const int nwg = nM * nN, q = nwg / 8, r = nwg % 8, xcd = w % 8, off = w / 8;
    const int wg = (xcd < r ? xcd * (q + 1) : r * (q + 1) + (xcd - r) * q) + off;
    const int nig = 8 * nN, gid = wg / nig, fm = gid * 8, gsz = (nM - fm) < 8 ? (nM - fm) : 8;
    pm = fm + ((wg % nig) % gsz); pn = (wg % nig) / gsz;
}

__device__ __forceinline__ bool get_unit(int gid, int l, int i, unsigned char* ws, Unit& u) {
    const int G = gridDim.x, c = blockIdx.x;
    u.aux = nullptr; u.m = nullptr;
    switch (gid) {
    case G_FOLD: { const int L = i * G + c; if (L >= 128) return false;
        const int ll = L >> 5, g = (L >> 3) & 3, pm = (L >> 1) & 3, pnn = L & 1;
        u.a = (const char*)(ws + WS_WMIXR + ll * SZ_WMIXR) + ((size_t)pm * 256 * 1024 + g * 256) * 2;
        u.b = (const char*)(ws + WS_TCH) + (size_t)pnn * 256 * 256 * 2;
        u.o = (char*)(ws + WS_WMIX + ll * SZ_WMIX) + ((size_t)pm * 256 * 2048 + pnn * 1024 + g * 256) * 2;
        u.nt = 4; u.mode = M_BF16; u.ldo = 2048; return true; }
    case G_IN: { const int L = i * G + c; if (L >= 2116) return false;
        if (L < 2112) { int pm, pn; static_order(L, 33, 64, pm, pn); const int pnp = pn < 20 ? pn : pn + 4;
            u.a = (const char*)(ws + WS_H) + (size_t)pm * 256 * DM * 2;
            u.b = (const char*)(ws + WS_WINT + l * SZ_WINT) + (size_t)pnp * 256 * DM * 2;
            u.o = (char*)(ws + WS_P) + ((size_t)pm * 256 * INC + pnp * 256) * 2; u.ldo = INC; }
        else { const int pm = L - 2112;
            u.a = (const char*)(ws + WS_WINT + l * SZ_WINT) + (size_t)(OFX + pm * 256) * DM * 2;
            u.b = (const char*)(ws + WS_H);
            u.o = (char*)(ws + WS_XT) + (size_t)pm * 256 * ROWS * 2; u.ldo = ROWS; }
        u.nt = 32; u.mode = M_BF16; return true; }
    case G_XT: { const int L = i * G + ((c + G - 68) % G); if (L >= 128) return false; const int pm = L & 3, pn = 1 + (L >> 2);
        u.a = (const char*)(ws + WS_WINT + l * SZ_WINT) + (size_t)(OFX + pm * 256) * DM * 2;
        u.b = (const char*)(ws + WS_H) + (size_t)(CTX + 2 * (pn - 1)) * DM * 2;
        u.o = (char*)(ws + WS_XT) + ((size_t)pm * 256 * ROWS + pn * 256) * 2; u.ldo = ROWS;
        u.nt = 32; u.mode = M_BF16; return true; }
    case G_F1: { const int L = i * G + c; if (L >= 256) return false; const int s2 = L >> 2, ct = L & 3;
        u.a = (const char*)(ws + WS_XT) + ((size_t)ct * 256 * ROWS + CTX + s2 * 128) * 2;
        u.b = (const char*)(ws + WS_T1);
        u.o = (char*)(ws + WS_ZT) + (size_t)ct * 256 * ZCH + s2 * 8;
        u.nt = 2; u.mode = M_F1; u.ldo = s2; return true; }
    case G_F2: { if (c < 16 || c >= G - 132) return false; const int L = i * (G - 148) + (c - 16); if (L >= 256) return false; const int k1p = L >> 2, ct = L & 3;
        u.a = (const char*)(ws + WS_A2);
        u.b = (const char*)(ws + WS_ZT) + (size_t)ct * 256 * ZCH + k1p * 512;
        u.o = (char*)(ws + WS_PQ) + ((size_t)(CTX + 2 * k1p) * 2048 + ct * 256) * 2;
        u.nt = 4; u.mode = M_F2; u.ldo = 2048; return true; }
    case G_DFTC: { const int L = i * G + c; if (L >= 8) return false; const int pm = L >> 2, pn = L & 3;
        u.a = (const char*)(ws + WS_ACTX) + (size_t)pm * 256 * 256 * 2;
        u.b = (const char*)(ws + WS_XT) + (size_t)pn * 256 * ROWS * 2;
        u.o = (char*)(ws + WS_PQ) + ((size_t)pm * 1024 + pn * 256) * 2;
        u.nt = 4; u.mode = M_BF16; u.ldo = 2048; return true; }
    case G_MIX: { const int L = i * G + (G - 1 - c); if (L >= 132) return false; const int pm = L >> 2, pn = L & 3;
        u.a = (const char*)(ws + WS_PQ) + (size_t)pm * 256 * 2048 * 2;
        u.b = (const char*)(ws + WS_WMIX + l * SZ_WMIX) + (size_t)pn * 256 * 2048 * 2;
        u.aux = (const char*)(ws + WS_P) + ((size_t)pm * 256 * INC + OFG + pn * 256) * 2;
        u.o = (char*)(ws + WS_ACAT) + (APL + (size_t)pm * 256 * CLD + pn * 256) * 2;
        u.nt = 32; u.mode = M_MIX; u.ldo = CLD; return true; }
    case G_MERGE: {
        if (i < 3) { const int T = c, sub = i; if (T >= 256) return false;
            int pm, pn; static_order(T, 32, 8, pm, pn); pm += 1;
            u.a = (const char*)(ws + WS_ACAT) + ((size_t)sub * APL + (size_t)pm * 256 * CLD) * 2;
            u.b = (const char*)(ws + WS_WCAT + l * SZ_WCAT) + ((size_t)sub * WPL + (size_t)pn * 256 * CLD) * 2;
            u.aux = (const char*)(ws + WS_P) + ((size_t)pm * 256 * INC + OML + sub * 2048 + pn * 256) * 2;
            u.m = (char*)(ws + WS_MBUF) + ((size_t)pm * 256 * MLD + pn * 256) * 4;
            u.o = (char*)(ws + WS_MB) + ((size_t)pm * 256 * 2048 + pn * 256) * 2;
            u.nt = sub == 0 ? 32 : 16; u.mode = M_MG0 + sub; u.ldo = 2048; return true; }
        return false; }
    case G_MERGEC: {
        if (i == 0 && l < DEPTH - 1 && c >= G - 64) { const int pc = c - (G - 64), pn = pc >> 3, q = pc & 7;
            const int sub = q < 4 ? 0 : (q < 6 ? 1 : 2), kcol = q < 4 ? q * 512 : (q < 6 ? (q - 4) * 512 : (q - 6) * 512);
            u.a = (const char*)(ws + WS_ACAT) + ((size_t)sub * APL + kcol) * 2;
            u.b = (const char*)(ws + WS_WCAT + l * SZ_WCAT) + ((size_t)sub * WPL + (size_t)pn * 256 * CLD + kcol) * 2;
            u.aux = (const char*)(ws + WS_P) + ((size_t)OML + sub * 2048 + pn * 256) * 2;
            u.m = (char*)(ws + WS_MP) + ((size_t)q * CTX * MLD + pn * 256) * 4;
            u.o = nullptr; u.nt = 8; u.mode = M_MERGE0; u.ldo = 2048; return true; }
        return false; }
    case G_OUT: {
        const int piece = l >> 4; l &= 15;
        if (i != 0) return false;
        if (!piece) { if (c >= 256) return false; int pm, pn; static_order(c, 32, 8, pm, pn); pm += 1;
            u.a = (const char*)(ws + WS_MB) + (size_t)pm * 256 * 2048 * 2;
            u.b = (const char*)(ws + WS_WOUT + l * SZ_WOUT) + (size_t)pn * 256 * 2048 * 2;
            u.o = (char*)(ws + WS_OUTB) + ((size_t)pm * 256 * 2048 + pn * 256) * 2;
            u.nt = 32; u.mode = M_BF16; u.ldo = 2048; return true; }
        if (l < DEPTH - 1 && c >= G - 32) { const int pc = c - (G - 32), pn = pc >> 2, kp = pc & 3;
            u.a = (const char*)(ws + WS_MB) + (size_t)kp * 512 * 2;
            u.b = (const char*)(ws + WS_WOUT + l * SZ_WOUT) + ((size_t)pn * 256 * 2048 + kp * 512) * 2;
            u.o = (char*)(ws + WS_OUTP) + ((size_t)kp * CTX * 2048 + pn * 256) * 4;
            u.nt = 8; u.mode = M_F32; u.ldo = 2048; return true; }
        return false; }
    }
    return false;
}

__device__ __forceinline__ void epilogue(const f32x4 (&acc)[2][2][4][2], const Unit& u, int wr, int wc, int fr, int fq) {
    unsigned r0 = wr * 64 + fr, c0 = wc * 64 + 8 * fq;
    asm volatile("" : "+v"(r0), "+v"(c0));
    if (u.mode == M_BF16) {
        const unsigned base = (r0 * (unsigned)u.ldo + c0) * 2u;
#pragma unroll
        for (int ai = 0; ai < 2; ++ai)
#pragma unroll
            for (int m = 0; m < 4; ++m) { char* rowp = u.o + (size_t)(ai * HALF + m * 16) * u.ldo * 2;
#pragma unroll
                for (int bj = 0; bj < 2; ++bj) { const f32x4 v0 = acc[ai][bj][m][0], v1 = acc[ai][bj][m][1];
                    u32x4 w; w.x = cvtpk(v0[0], v0[1]); w.y = cvtpk(v0[2], v0[3]); w.z = cvtpk(v1[0], v1[1]); w.w = cvtpk(v1[2], v1[3]);
                    *(u32x4*)(rowp + base + bj * BJC * 2) = w; } }
    } else if (u.mode == M_MIX) {
        const unsigned base = (r0 * (unsigned)u.ldo + c0) * 2u, abase = (r0 * (unsigned)INC + c0) * 2u;
#pragma unroll
        for (int ai = 0; ai < 2; ++ai) {
            u32x4 g[4][2];
#pragma unroll
            for (int m = 0; m < 4; ++m)
#pragma unroll
                for (int bj = 0; bj < 2; ++bj) g[m][bj] = *(const u32x4*)(u.aux + (size_t)(ai * HALF + m * 16) * INC * 2 + abase + bj * BJC * 2);
            __builtin_amdgcn_sched_barrier(0);
#pragma unroll
            for (int m = 0; m < 4; ++m) { char* rowp = u.o + (size_t)(ai * HALF + m * 16) * u.ldo * 2;
#pragma unroll
                for (int bj = 0; bj < 2; ++bj) { const f32x4 v0 = acc[ai][bj][m][0], v1 = acc[ai][bj][m][1]; const u32x4 gg = g[m][bj];
                    u32x4 w; w.x = cvtpk(v0[0] * siluf_(bflo(gg.x)), v0[1] * siluf_(bfhi(gg.x))); w.y = cvtpk(v0[2] * siluf_(bflo(gg.y)), v0[3] * siluf_(bfhi(gg.y)));
                    w.z = cvtpk(v1[0] * siluf_(bflo(gg.z)), v1[1] * siluf_(bfhi(gg.z))); w.w = cvtpk(v1[2] * siluf_(bflo(gg.w)), v1[3] * siluf_(bfhi(gg.w)));
                    *(u32x4*)(rowp + base + bj * BJC * 2) = w; } }
            __builtin_amdgcn_sched_barrier(0);
        }
    } else if (u.mode == M_F32) {
        const unsigned base = (r0 * (unsigned)u.ldo + c0) * 4u;
#pragma unroll
        for (int ai = 0; ai < 2; ++ai)
#pragma unroll
            for (int m = 0; m < 4; ++m) { char* rowp = u.o + (size_t)(ai * HALF + m * 16) * u.ldo * 4;
#pragma unroll
                for (int bj = 0; bj < 2; ++bj) { *(f32x4*)(rowp + base + bj * BJC * 4) = acc[ai][bj][m][0]; *(f32x4*)(rowp + base + bj * BJC * 4 + 16) = acc[ai][bj][m][1]; } }
    } else if (u.mode == M_MG0 || u.mode == M_MG1) {
    } else if (u.mode == M_MG2) {
        const unsigned abase = (r0 * (unsigned)INC + c0) * 2u, obase = (r0 * 2048u + c0) * 2u;
#pragma unroll
        for (int ai = 0; ai < 2; ++ai) {
            u32x4 g[4][2];
#pragma unroll
            for (int m = 0; m < 4; ++m)
#pragma unroll
                for (int bj = 0; bj < 2; ++bj) g[m][bj] = *(const u32x4*)(u.aux + (size_t)(ai * HALF + m * 16) * INC * 2 + abase + bj * BJC * 2);
            __builtin_amdgcn_sched_barrier(0);
#pragma unroll
            for (int m = 0; m < 4; ++m) { char* rowp = u.o + (size_t)(ai * HALF + m * 16) * 2048 * 2;
#pragma unroll
                for (int bj = 0; bj < 2; ++bj) { f32x4 v0 = acc[ai][bj][m][0], v1 = acc[ai][bj][m][1]; const u32x4 gg = g[m][bj];
                    v0[0] *= sigmoidf_(bflo(gg.x)); v0[1] *= sigmoidf_(bfhi(gg.x)); v0[2] *= sigmoidf_(bflo(gg.y)); v0[3] *= sigmoidf_(bfhi(gg.y));
                    v1[0] *= sigmoidf_(bflo(gg.z)); v1[1] *= sigmoidf_(bfhi(gg.z)); v1[2] *= sigmoidf_(bflo(gg.w)); v1[3] *= sigmoidf_(bfhi(gg.w));
                    u32x4 w; w.x = cvtpk(v0[0], v0[1]); w.y = cvtpk(v0[2], v0[3]); w.z = cvtpk(v1[0], v1[1]); w.w = cvtpk(v1[2], v1[3]); *(u32x4*)(rowp + obase + bj * BJC * 2) = w; } }
            __builtin_amdgcn_sched_barrier(0);
        }
    } else if (u.mode == M_F1) {
        const int s2 = u.ldo;
        const unsigned kb0 = (c0 >> 1);
        float tc[2][4], ts[2][4];
#pragma unroll
        for (int bj = 0; bj < 2; ++bj)
#pragma unroll
            for (int j = 0; j < 4; ++j) { const float x = (float)((bj * 16 + kb0 + j) * s2) * (1.0f / 8192.0f); tc[bj][j] = __builtin_amdgcn_cosf(x); ts[bj][j] = __builtin_amdgcn_sinf(x); }
        const unsigned base = r0 * (unsigned)ZCH + kb0 * 256u;
#pragma unroll
        for (int ai = 0; ai < 2; ++ai)
#pragma unroll
            for (int m = 0; m < 4; ++m) { char* rowp = u.o + (size_t)(ai * HALF + m * 16) * ZCH;
#pragma unroll
                for (int bj = 0; bj < 2; ++bj) { const f32x4 v0 = acc[ai][bj][m][0], v1 = acc[ai][bj][m][1];
                    const float zr[4] = {v0[0], v0[2], v1[0], v1[2]}, zi[4] = {v0[1], v0[3], v1[1], v1[3]};
#pragma unroll
                    for (int jp = 0; jp < 2; ++jp) { u32x2 w;
                        { const int j = 2 * jp; w.x = cvtpk(zr[j] * tc[bj][j] + zi[j] * ts[bj][j], zi[j] * tc[bj][j] - zr[j] * ts[bj][j]); }
                        { const int j = 2 * jp + 1; w.y = cvtpk(zr[j] * tc[bj][j] + zi[j] * ts[bj][j], zi[j] * tc[bj][j] - zr[j] * ts[bj][j]); }
                        *(u32x2*)(rowp + base + (bj * 8 + jp) * 512) = w; } } }
    } else if (u.mode == M_F2) {
        const unsigned fr_ = r0 & 15u, wr_ = r0 >> 6;
        const unsigned base = ((128u * fr_) * 2048u + wr_ * 1024u + c0) * 2u;
#pragma unroll
        for (int ai = 0; ai < 2; ++ai)
#pragma unroll
            for (int m = 0; m < 4; ++m) { char* rowp = u.o + (size_t)(ai + 2048 * m) * 2048 * 2;
#pragma unroll
                for (int bj = 0; bj < 2; ++bj) { const f32x4 v0 = acc[ai][bj][m][0], v1 = acc[ai][bj][m][1];
                    u32x4 w; w.x = cvtpk(v0[0], v0[1]); w.y = cvtpk(v0[2], v0[3]); w.z = cvtpk(v1[0], v1[1]); w.w = cvtpk(v1[2], v1[3]);
                    *(u32x4*)(rowp + base + bj * BJC * 2) = w; } }
    } else {
        const unsigned abase = (r0 * (unsigned)INC + c0) * 2u, mbase = (r0 * (unsigned)MLD + c0) * 4u;
#pragma unroll
        for (int ai = 0; ai < 2; ++ai) {
            u32x4 g[4][2];
#pragma unroll
            for (int m = 0; m < 4; ++m)
#pragma unroll
                for (int bj = 0; bj < 2; ++bj) g[m][bj] = *(const u32x4*)(u.aux + (size_t)(ai * HALF + m * 16) * INC * 2 + abase + bj * BJC * 2);
            __builtin_amdgcn_sched_barrier(0);
#pragma unroll
            for (int m = 0; m < 4; ++m) { char* mp = u.m + (size_t)(ai * HALF + m * 16) * MLD * 4;
#pragma unroll
                for (int bj = 0; bj < 2; ++bj) { f32x4 v0 = acc[ai][bj][m][0], v1 = acc[ai][bj][m][1]; const u32x4 gg = g[m][bj];
                    v0[0] *= sigmoidf_(bflo(gg.x)); v0[1] *= sigmoidf_(bfhi(gg.x)); v0[2] *= sigmoidf_(bflo(gg.y)); v0[3] *= sigmoidf_(bfhi(gg.y));
                    v1[0] *= sigmoidf_(bflo(gg.z)); v1[1] *= sigmoidf_(bfhi(gg.z)); v1[2] *= sigmoidf_(bflo(gg.w)); v1[3] *= sigmoidf_(bfhi(gg.w));
                    *(f32x4*)(mp + mbase + bj * BJC * 4) = v0; *(f32x4*)(mp + mbase + bj * BJC * 4 + 16) = v1; } }
            __builtin_amdgcn_sched_barrier(0);
        }
    }
}

__device__ __forceinline__ void rescale_or_reset(f32x4 (&acc)[2][2][4][2], const Unit& u, int wr, int wc, int fr, int fq) {
    const unsigned msk = (u.mode == M_MG0 || u.mode == M_MG1) ? 0xffffffffu : 0u;
    unsigned r0 = wr * 64 + fr, c0 = wc * 64 + 8 * fq;
    asm volatile("" : "+v"(r0), "+v"(c0));
    const unsigned abase = (r0 * (unsigned)INC + c0) * 2u;
#pragma unroll
    for (int ai = 0; ai < 2; ++ai)
#pragma unroll
        for (int m = 0; m < 4; ++m) { const char* ap = u.aux + (size_t)(ai * HALF + m * 16) * INC * 2;
#pragma unroll
            for (int bj = 0; bj < 2; ++bj) {
                const u32x4 ga = *(const u32x4*)(ap + abase + bj * BJC * 2), gb = *(const u32x4*)(ap + abase + bj * BJC * 2 + 4096);
                const unsigned wa[4] = {ga.x, ga.y, ga.z, ga.w}, wb[4] = {gb.x, gb.y, gb.z, gb.w};
                float f[8];
#pragma unroll
                for (int e = 0; e < 4; ++e) {
                    const float rl = (1.0f + __expf(-bflo(wb[e]))) * __builtin_amdgcn_rcpf(1.0f + __expf(-bflo(wa[e])));
                    const float rh = (1.0f + __expf(-bfhi(wb[e]))) * __builtin_amdgcn_rcpf(1.0f + __expf(-bfhi(wa[e])));
                    f[2 * e] = __uint_as_float(__float_as_uint(rl) & msk); f[2 * e + 1] = __uint_as_float(__float_as_uint(rh) & msk); }
                acc[ai][bj][m][0] *= (f32x4){f[0], f[1], f[2], f[3]}; acc[ai][bj][m][1] *= (f32x4){f[4], f[5], f[6], f[7]};
            }
            if (m & 1) __builtin_amdgcn_sched_barrier(0);
        }
}

__device__ __forceinline__ void gemm_phase(LAS unsigned char* lds, int gid, int l, unsigned char* ws) {
    int tid_ = threadIdx.x; asm volatile("" : "+v"(tid_));
    const int tid = tid_, wid = __builtin_amdgcn_readfirstlane(tid >> 6), lane = tid & 63, wr = wid >> 2, wc = wid & 3, fr = lane & 15, fq = lane >> 4;
    int lda, ldb;
    int ldbv = 0;
    switch (gid) { case G_FOLD: lda = 1024; ldb = 256; break; case G_IN: lda = 2048; ldb = 2048; break; case G_XT: lda = 2048; ldb = 2048; ldbv = 64 * 2048; break;
                   case G_F1: lda = ROWS; ldb = 128; break; case G_F2: lda = 256; ldb = ZCH / 2; break;
                   case G_DFTC: lda = 256; ldb = ROWS; break; case G_MIX: lda = 2048; ldb = 2048; break; case G_MERGE: case G_MERGEC: lda = CLD; ldb = CLD; break; default: lda = 2048; ldb = 2048; break; }
    if (ldbv == 0) ldbv = ldb;
    Unit cur, nxt; int ui = 0;
    if (!get_unit(gid, l, 0, ws, cur)) return;
    unsigned voffA[2], voffB[2];
#pragma unroll
    for (int i = 0; i < 2; ++i) { int R, C; stage_rc(tid * 16 + i * 8192, R, C); const int w_ = R >> 5, ip = perm32(R & 31);
        const int Rb = (gid == G_XT) ? (4096 * (w_ & 1) + 64 * ip + (w_ >> 1)) : (64 * w_ + ip);
        voffA[i] = (unsigned)(R * lda + C) * 2u; voffB[i] = (unsigned)(Rb * ldb + C) * 2u; }
    const size_t kstep = (size_t)(BK * 2);
    const size_t hstepA = (size_t)HALF * lda * 2, hstepB = (gid == G_XT) ? (size_t)2048 * ldb * 2 : (size_t)32 * ldb * 2;
    const unsigned ldsw = (unsigned)wid * 1024u;
    const int aoff = lds_byte(wr * 64 + fr, fq * 8), boff = lds_byte(wc * 32 + fr, fq * 8);
#define PG8_SA(b, h) (((b) * 2 + (h)) * HTB)
#define PG8_SB(b, h) ((4 + (b) * 2 + (h)) * HTB)
#define PG8_STAGE(bufoff, gbase, voff) do { _Pragma("unroll") for (int _i = 0; _i < 2; ++_i) \
        __builtin_amdgcn_global_load_lds((const unsigned*)((const char*)(gbase) + (voff)[_i]), (LAS unsigned*)(lds + (bufoff) + ldsw + _i * 8192), 16, 0, 0); } while (0)
#define PG8_LDA(dst, b, h) do { _Pragma("unroll") for (int m = 0; m < 4; ++m) _Pragma("unroll") for (int k = 0; k < 2; ++k) dst[m][k] = *(const LAS bf16x8*)(lds + PG8_SA(b, h) + aoff + m * 2048 + k * 1024); } while (0)
#define PG8_LDB(dst, b, h) do { _Pragma("unroll") for (int n = 0; n < 2; ++n) _Pragma("unroll") for (int k = 0; k < 2; ++k) dst[n][k] = *(const LAS bf16x8*)(lds + PG8_SB(b, h) + boff + n * 2048 + k * 1024); } while (0)
#define PG8_MMA(ai, bj, At, Bt) do { __builtin_amdgcn_s_setprio(1); _Pragma("unroll") for (int m = 0; m < 4; ++m) _Pragma("unroll") for (int n = 0; n < 2; ++n) _Pragma("unroll") for (int k = 0; k < 2; ++k) \
        acc[ai][bj][m][n] = __builtin_amdgcn_mfma_f32_16x16x32_bf16(Bt[n][k], At[m][k], acc[ai][bj][m][n], 0, 0, 0); __builtin_amdgcn_s_setprio(0); } while (0)
#define PG8_WAIT_V(n) asm volatile("s_waitcnt vmcnt(" #n ")" ::: "memory")
#define PG8_WAIT_L(n) asm volatile("s_waitcnt lgkmcnt(" #n ")" ::: "memory")
#define PG8_BAR __builtin_amdgcn_s_barrier()
#define PG8_SCHED __builtin_amdgcn_sched_barrier(0)
    f32x4 acc[2][2][4][2];
#pragma unroll
    for (int a = 0; a < 2; ++a)
#pragma unroll
        for (int b = 0; b < 2; ++b)
#pragma unroll
            for (int m = 0; m < 4; ++m)
#pragma unroll
                for (int n = 0; n < 2; ++n) acc[a][b][m][n] = (f32x4){0.f, 0.f, 0.f, 0.f};
    bf16x8 At[4][2], B0[2][2], B1[2][2];
    const char* cA = cur.a; const char* cB = cur.b;
    PG8_STAGE(PG8_SB(0, 0), cB, voffB); PG8_STAGE(PG8_SA(0, 0), cA, voffA); PG8_STAGE(PG8_SB(0, 1), cB + hstepB, voffB); PG8_STAGE(PG8_SA(0, 1), cA + hstepA, voffA);
    if (wr == 1) PG8_BAR;
    PG8_WAIT_V(4); PG8_BAR;
    PG8_STAGE(PG8_SB(1, 0), cB + kstep, voffB); PG8_STAGE(PG8_SA(1, 0), cA + kstep, voffA); PG8_STAGE(PG8_SB(1, 1), cB + hstepB + kstep, voffB);
    PG8_WAIT_V(6); PG8_BAR;
    for (;;) {
        const bool has_next = get_unit(gid, l, ui + 1, ws, nxt);
        const char* nA = has_next ? nxt.a : cA; const char* nB = has_next ? nxt.b : cB;
        const int nt = cur.nt;
        for (int t = 0; t < nt; t += 2) {
            const bool last = (t == nt - 2);
            const char* a1 = cA + (size_t)(t + 1) * kstep;
            const char* a2 = last ? nA : cA + (size_t)(t + 2) * kstep; const char* b2 = last ? nB : cB + (size_t)(t + 2) * kstep;
            const char* a3 = a2 + kstep; const char* b3 = b2 + kstep;
            PG8_LDB(B0, 0, 0); PG8_SCHED; PG8_LDA(At, 0, 0); PG8_STAGE(PG8_SA(1, 1), a1 + hstepA, voffA);
            PG8_WAIT_L(8); PG8_BAR; PG8_WAIT_L(0); PG8_MMA(0, 0, At, B0); PG8_BAR; PG8_SCHED;
            PG8_LDB(B1, 0, 1); PG8_STAGE(PG8_SB(0, 0), b2, voffB);
            PG8_BAR; PG8_WAIT_L(0); PG8_MMA(0, 1, At, B1); PG8_BAR;
            PG8_LDA(At, 0, 1); PG8_STAGE(PG8_SA(0, 0), a2, voffA);
            PG8_BAR; PG8_WAIT_L(0); PG8_MMA(1, 0, At, B0); PG8_BAR; PG8_SCHED;
            PG8_STAGE(PG8_SB(0, 1), b2 + hstepB, voffB);
            PG8_WAIT_V(6); PG8_BAR; PG8_MMA(1, 1, At, B1); PG8_BAR;
            PG8_LDB(B0, 1, 0); PG8_SCHED; PG8_LDA(At, 1, 0); PG8_STAGE(PG8_SA(0, 1), a2 + hstepA, voffA);
            PG8_WAIT_L(8); PG8_BAR; PG8_WAIT_L(0); PG8_MMA(0, 0, At, B0); PG8_BAR; PG8_SCHED;
            PG8_LDB(B1, 1, 1); PG8_STAGE(PG8_SB(1, 0), b3, voffB);
            PG8_BAR; PG8_WAIT_L(0); PG8_MMA(0, 1, At, B1); PG8_BAR;
            PG8_LDA(At, 1, 1); PG8_STAGE(PG8_SA(1, 0), a3, voffA);
            PG8_BAR; PG8_WAIT_L(0); PG8_MMA(1, 0, At, B0); PG8_BAR; PG8_SCHED;
            PG8_STAGE(PG8_SB(1, 1), b3 + hstepB, voffB);
            PG8_WAIT_V(6); PG8_BAR; PG8_MMA(1, 1, At, B1); PG8_BAR;
        }
        epilogue(acc, cur, wr, wc, fr, fq);
        if (!has_next) break;
        if (gid == G_MERGE) rescale_or_reset(acc, cur, wr, wc, fr, fq);
        else {
#pragma unroll
            for (int a = 0; a < 2; ++a)
#pragma unroll
                for (int b = 0; b < 2; ++b)
#pragma unroll
                    for (int m = 0; m < 4; ++m)
#pragma unroll
                        for (int n = 0; n < 2; ++n) acc[a][b][m][n] = (f32x4){0.f, 0.f, 0.f, 0.f};
        }
        cur = nxt; cA = nA; cB = nB; ++ui;
    }
    PG8_WAIT_V(0);
    if (wr == 0) PG8_BAR;
    PG8_BAR;
#undef PG8_SA
#undef PG8_SB
#undef PG8_STAGE
#undef PG8_LDA
#undef PG8_LDB
#undef PG8_MMA
#undef PG8_WAIT_V
#undef PG8_WAIT_L
#undef PG8_BAR
#undef PG8_SCHED
}

namespace att {
constexpr int D = 128, NW = 8, QBLK = 32, KVBLK = 64;
constexpr float SCALE = 0.088388347648318440f;
constexpr float THR = 8.f;
constexpr int LDQ = INC, LDK = 128, LDO = CLD;
constexpr size_t SHM_V = KVBLK * D * 2, SHM_K = KVBLK * D * 2, SHM_ATTN = 2 * SHM_V + 2 * SHM_K + NW * 64 * 4;
#define KSWZ(row, colB) ((row) * 256 + ((colB) ^ (((row) & 7) << 4)))
#define SBAR() __builtin_amdgcn_sched_barrier(0)
__device__ __forceinline__ int crow(int r, int hi) { return (r & 3) + 8 * (r >> 2) + 4 * hi; }
__device__ __forceinline__ void partialSM(f32x16& p0, f32x16& p1, float& m_reg, float& mn, float& alpha) {
  constexpr float C = SCALE * 1.4426950408889634f;
  float pmax = p0[0];
#pragma unroll
  for (int r = 1; r < 16; ++r) pmax = fmaxf(pmax, p0[r]);
#pragma unroll
  for (int r = 0; r < 16; ++r) pmax = fmaxf(pmax, p1[r]);
  { auto rr = __builtin_amdgcn_permlane32_swap(__float_as_uint(pmax), __float_as_uint(pmax), false, false);
    pmax = fmaxf(__uint_as_float(rr[0]), __uint_as_float(rr[1])); }
  if (__builtin_expect(__all(pmax - m_reg <= THR / SCALE), 1)) { mn = m_reg; alpha = 1.f; }
  else { mn = fmaxf(m_reg, pmax); alpha = __builtin_amdgcn_exp2f((m_reg - mn) * C); m_reg = mn; }
  float mnC = -mn * C;
#pragma unroll
  for (int r = 0; r < 16; ++r) p0[r] = fmaf(p0[r], C, mnC);
#pragma unroll
  for (int r = 0; r < 16; ++r) p1[r] = fmaf(p1[r], C, mnC);
#pragma unroll
  for (int r = 0; r < 16; ++r) p0[r] = __builtin_amdgcn_exp2f(p0[r]);
}
__device__ __forceinline__ void finishSM(f32x16& p0, f32x16& p1, float alpha, float& l_reg, bf16x8& pa0, bf16x8& pa1, bf16x8& pa2, bf16x8& pa3) {
#pragma unroll
  for (int r = 0; r < 16; ++r) p1[r] = __builtin_amdgcn_exp2f(p1[r]);
  float ps = 0;
#pragma unroll
  for (int r = 0; r < 16; ++r) ps += p0[r];
#pragma unroll
  for (int r = 0; r < 16; ++r) ps += p1[r];
  { auto rr = __builtin_amdgcn_permlane32_swap(__float_as_uint(ps), __float_as_uint(ps), false, false);
    ps = __uint_as_float(rr[0]) + __uint_as_float(rr[1]); }
  l_reg = l_reg * alpha + ps;
#define PK4(P, BASE, OUT) do { unsigned a0 = cvtpk(P[BASE + 0], P[BASE + 1]), a1 = cvtpk(P[BASE + 2], P[BASE + 3]);   \
    unsigned b0 = cvtpk(P[BASE + 4], P[BASE + 5]), b1 = cvtpk(P[BASE + 6], P[BASE + 7]);                              \
    auto r0 = __builtin_amdgcn_permlane32_swap(a0, b0, false, false); auto r1 = __builtin_amdgcn_permlane32_swap(a1, b1, false, false); \
    u32x4 w = {r0[0], r1[0], r0[1], r1[1]}; OUT = *reinterpret_cast<bf16x8*>(&w); } while (0)
  PK4(p0, 0, pa0); PK4(p0, 8, pa1); PK4(p1, 0, pa2); PK4(p1, 8, pa3);
#undef PK4
}
__device__ __forceinline__ void qkt(f32x16& p0, f32x16& p1, const bf16_t* Ks, const bf16x8* qr, int r32, int hi) {
  p0 = f32x16{}; p1 = f32x16{};
#pragma unroll
  for (int d0 = 0; d0 < 8; ++d0) { int cb = (d0 * 16 + hi * 8) * 2;
    bf16x8 b0 = *reinterpret_cast<const bf16x8*>((const char*)Ks + KSWZ(r32, cb));
    bf16x8 b1 = *reinterpret_cast<const bf16x8*>((const char*)Ks + KSWZ(32 + r32, cb));
    p0 = __builtin_amdgcn_mfma_f32_32x32x16_bf16(b0, qr[d0], p0, 0, 0, 0);
    p1 = __builtin_amdgcn_mfma_f32_32x32x16_bf16(b1, qr[d0], p1, 0, 0, 0); }
}
__device__ __forceinline__ int v_st(int k, int c) { const int kk = (k & ~0xC) | ((k & 4) << 1) | ((k & 8) >> 1); return ((kk >> 3) * 4 + (c >> 5)) * 512 + ((kk & 7) * 32 + (c & 31)) * 2; }
__device__ __forceinline__ int v_rd_base(int lane) { return ((lane & 3) << 3) | (((lane >> 2) & 3) << 6) | (((lane >> 4) & 1) << 5) | (((lane >> 5) & 1) << 8); }
constexpr int v_rd_off(int d0, int ks, int half) { return d0 * 512 + ks * 4096 + half * 2048; }
template <int OFF> __device__ __forceinline__ s16x4 tr_read(int vb) {
  s16x4 r; asm volatile("ds_read_b64_tr_b16 %0, %1 offset:%2" : "=&v"(r) : "v"(vb), "i"(OFF) : "memory"); return r;
}
template <int D0> __device__ __forceinline__ void pv_one(f32x16& od, int vb, bf16x8 pa0, bf16x8 pa1, bf16x8 pa2, bf16x8 pa3) {
  const s16x4 l0 = tr_read<v_rd_off(D0, 0, 0)>(vb), h0 = tr_read<v_rd_off(D0, 0, 1)>(vb), l1 = tr_read<v_rd_off(D0, 1, 0)>(vb), h1 = tr_read<v_rd_off(D0, 1, 1)>(vb);
  const s16x4 l2 = tr_read<v_rd_off(D0, 2, 0)>(vb), h2 = tr_read<v_rd_off(D0, 2, 1)>(vb), l3 = tr_read<v_rd_off(D0, 3, 0)>(vb), h3 = tr_read<v_rd_off(D0, 3, 1)>(vb);
  asm volatile("s_waitcnt lgkmcnt(0)" ::: "memory"); SBAR();
#define PK(L, H) (bf16x8){L[0], L[1], L[2], L[3], H[0], H[1], H[2], H[3]}
  od = __builtin_amdgcn_mfma_f32_32x32x16_bf16(pa0, PK(l0, h0), od, 0, 0, 0);
  od = __builtin_amdgcn_mfma_f32_32x32x16_bf16(pa1, PK(l1, h1), od, 0, 0, 0);
  od = __builtin_amdgcn_mfma_f32_32x32x16_bf16(pa2, PK(l2, h2), od, 0, 0, 0);
  od = __builtin_amdgcn_mfma_f32_32x32x16_bf16(pa3, PK(l3, h3), od, 0, 0, 0);
#undef PK
}
__device__ __forceinline__ void pv_d0(f32x16* o, int vb, bf16x8 pa0, bf16x8 pa1, bf16x8 pa2, bf16x8 pa3) {
  pv_one<0>(o[0], vb, pa0, pa1, pa2, pa3); pv_one<1>(o[1], vb, pa0, pa1, pa2, pa3); pv_one<2>(o[2], vb, pa0, pa1, pa2, pa3); pv_one<3>(o[3], vb, pa0, pa1, pa2, pa3);
}
__device__ __forceinline__ void attn_body(const bf16_t* __restrict__ Qb, const bf16_t* __restrict__ Kh, const bf16_t* __restrict__ Vh,
                                          bf16_t* __restrict__ Ob, const bf16_t* __restrict__ AGb, int seq, char* lds) {
  int tid_ = threadIdx.x; asm volatile("" : "+v"(tid_));
  const int tid = tid_, wid = tid >> 6, lane = tid & 63, r32 = lane & 31, hi = lane >> 5;
  bf16_t* V_lds = (bf16_t*)lds; bf16_t* K_lds = (bf16_t*)(lds + 2 * SHM_V);
  float* wsl = (float*)(lds + 2 * SHM_V + 2 * SHM_K) + wid * 64; float* li_l = wsl; float* al_l = wsl + 32;
  float m_reg = -1e30f, l_reg = 0; f32x16 o[4] = {}; bf16x8 qr[8];
  const bf16_t* Qw = Qb + (long)(wid * QBLK + r32) * LDQ + hi * 8;
#pragma unroll
  for (int d0 = 0; d0 < 8; ++d0) qr[d0] = *reinterpret_cast<const bf16x8*>(Qw + d0 * 16);
  const int sr = tid >> 4, sc = (tid & 15) * 8, vst0 = v_st(sr, sc), vst1 = v_st(32 + sr, sc);
  const int vb0 = (int)(uintptr_t)V_lds + v_rd_base(lane);
  const unsigned goff0 = (unsigned)(sr * LDK + sc) * 2u, goff1 = (unsigned)((32 + sr) * LDK + sc) * 2u;
  struct { bf16x8 vs0, vs1, ks0, ks1; } sr_[2];
#define SLOAD(i, k0) do { const char* vt_ = (const char*)Vh + (size_t)(k0) * (LDK * 2); const char* kt_ = (const char*)Kh + (size_t)(k0) * (LDK * 2); \
    sr_[i].vs0 = *reinterpret_cast<const bf16x8*>(vt_ + goff0); sr_[i].vs1 = *reinterpret_cast<const bf16x8*>(vt_ + goff1); \
    sr_[i].ks0 = *reinterpret_cast<const bf16x8*>(kt_ + goff0); sr_[i].ks1 = *reinterpret_cast<const bf16x8*>(kt_ + goff1); } while (0)
#define SWRITE(b, i) do { *(bf16x8*)((char*)V_lds + (b) * SHM_V + vst0) = sr_[i].vs0;          \
    *(bf16x8*)((char*)V_lds + (b) * SHM_V + vst1) = sr_[i].vs1; int kc = sc * 2;               \
    *(bf16x8*)((char*)K_lds + (b) * SHM_K + KSWZ(sr, kc)) = sr_[i].ks0;                       \
    *(bf16x8*)((char*)K_lds + (b) * SHM_K + KSWZ(32 + sr, kc)) = sr_[i].ks1; } while (0)
#define SWAIT() asm volatile("s_waitcnt vmcnt(4)" ::: "memory")
#define RESC(a) do { if (__any((a) < 1.f)) { if (hi == 0) al_l[r32] = (a); asm volatile("s_waitcnt lgkmcnt(0)" ::: "memory"); \
    _Pragma("unroll") for (int d = 0; d < 4; ++d) _Pragma("unroll") for (int r = 0; r < 16; ++r) o[d][r] *= al_l[crow(r, hi)]; } } while (0)
  f32x16 pA0, pA1, pB0, pB1; float mnA, mnB, alA, alB; bf16x8 pa0, pa1, pa2, pa3; const int NT = seq / KVBLK;
  constexpr int SE = 0, SO = 1;
  SLOAD(SE, 0); asm volatile("s_waitcnt vmcnt(0)" ::: "memory"); SWRITE(0, SE); __syncthreads();
  qkt(pA0, pA1, K_lds, qr, r32, hi); partialSM(pA0, pA1, m_reg, mnA, alA);
  SLOAD(SO, KVBLK); if (2 < NT) SLOAD(SE, 2 * KVBLK);
  SWAIT(); SWRITE(1, SO); __syncthreads();
  for (int j = 1; j + 1 < NT; j += 2) {
    SBAR(); qkt(pB0, pB1, (bf16_t*)((char*)K_lds + SHM_K), qr, r32, hi);
    finishSM(pA0, pA1, alA, l_reg, pa0, pa1, pa2, pa3); SBAR();
    SLOAD(SO, (j + 2) * KVBLK); SBAR();
    pv_d0(o, vb0, pa0, pa1, pa2, pa3); partialSM(pB0, pB1, m_reg, mnB, alB);
    __syncthreads(); SWAIT(); SWRITE(0, SE);
    RESC(alB); __syncthreads();
    SBAR(); qkt(pA0, pA1, K_lds, qr, r32, hi);
    finishSM(pB0, pB1, alB, l_reg, pa0, pa1, pa2, pa3); SBAR();
    if (j + 3 < NT) SLOAD(SE, (j + 3) * KVBLK); SBAR();
    pv_d0(o, vb0 + (int)SHM_V, pa0, pa1, pa2, pa3); partialSM(pA0, pA1, m_reg, mnA, alA);
    __syncthreads(); SWAIT(); SWRITE(1, SO);
    RESC(alA); __syncthreads();
  }
  SBAR(); qkt(pB0, pB1, (bf16_t*)((char*)K_lds + SHM_K), qr, r32, hi);
  finishSM(pA0, pA1, alA, l_reg, pa0, pa1, pa2, pa3); SBAR();
  pv_d0(o, vb0, pa0, pa1, pa2, pa3); partialSM(pB0, pB1, m_reg, mnB, alB);
  __syncthreads(); RESC(alB);
  finishSM(pB0, pB1, alB, l_reg, pa0, pa1, pa2, pa3); SBAR();
  pv_d0(o, vb0 + (int)SHM_V, pa0, pa1, pa2, pa3);
  if (hi == 0) li_l[r32] = l_reg; asm volatile("s_waitcnt lgkmcnt(0)" ::: "memory");
  char* Ow = (char*)(Ob + (long)(wid * QBLK) * LDO); const char* Gw = (const char*)(AGb + (long)(wid * QBLK) * LDQ);
  unsigned hv = hi, cv = r32;
  asm volatile("" : "+v"(hv), "+v"(cv));
  const unsigned gbase = (hv * 4u * LDQ + cv) * 2u, obase = (hv * 4u * LDO + cv) * 2u;
  unsigned short gq[16][4];
#pragma unroll
  for (int r = 0; r < 16; ++r) { const int rc = (r & 3) + 8 * (r >> 2); const unsigned go = gbase + (unsigned)(rc * LDQ * 2);
#pragma unroll
    for (int d0 = 0; d0 < 4; ++d0) gq[r][d0] = *(const bf16_t*)(Gw + go + d0 * 64); }
  SBAR();
#pragma unroll
  for (int r = 0; r < 16; ++r) { const int rc = (r & 3) + 8 * (r >> 2); const float rli = __builtin_amdgcn_rcpf(li_l[crow(r, hi)]);
    const unsigned oo = obase + (unsigned)(rc * LDO * 2);
#pragma unroll
    for (int d0 = 0; d0 < 4; ++d0) *(bf16_t*)(Ow + oo + d0 * 64) = f2bf(o[d0][r] * rli * siluf_(bf2f(gq[r][d0]))); }
#undef SLOAD
#undef SWRITE
#undef SWAIT
#undef RESC
}
}

__device__ __forceinline__ void attn_phase(const Params& p, int l, char* lds) {
    unsigned char* ws = p.ws;
    const bf16_t* P = (const bf16_t*)(ws + WS_P); bf16_t* Acat = (bf16_t*)(ws + WS_ACAT);
    const int G = gridDim.x, nunits = 512 + (l < DEPTH - 1 ? 16 : 0);
    for (int U = blockIdx.x; U < nunits; U += G) {
        int h, qrow0, seq;
        if (U < 512) { int qb;
            if (G == 256) { const int xcd = U & 7, j = (U >> 3) & 31, r = U >> 8, kvh = xcd >> 1, idx = (xcd & 1) * 64 + r * 32 + j; h = kvh * 4 + (idx & 3); qb = idx >> 2; }
            else { h = U & 15; qb = U >> 4; }
            qrow0 = CTX + qb * 256; seq = ROWS; }
        else { h = U - 512; qrow0 = 0; seq = CTX; }
        const int kvh = h >> 2;
        att::attn_body(P + (size_t)qrow0 * INC + OQ + h * 128, (const bf16_t*)(ws + WS_KC) + (size_t)kvh * ROWS * 128, (const bf16_t*)(ws + WS_VC) + (size_t)kvh * ROWS * 128,
                       Acat + (size_t)qrow0 * CLD + h * 128, P + (size_t)qrow0 * INC + OAG + h * 128, seq, lds);
        __syncthreads();
    }
}

#define XB_TMO      128
#define XB_XCNT(j)  (256  + 64 * (j))
#define XB_XSUB(j)  (1280 + 64 * (j))
#define XB_XGEN(j)  (2304 + 64 * (j))
#define XB_TOP      3328
#define XB_TOPGEN   3392
#define XCD_BAR_WORDS 3456
#define XB_SPIN_CAP (1u << 18)

__device__ __forceinline__ unsigned xb_ld(unsigned* p)              { return __hip_atomic_load(p, __ATOMIC_RELAXED, __HIP_MEMORY_SCOPE_AGENT); }
__device__ __forceinline__ unsigned xb_add(unsigned* p, unsigned v) { return __hip_atomic_fetch_add(p, v, __ATOMIC_RELAXED, __HIP_MEMORY_SCOPE_AGENT); }
__device__ __forceinline__ unsigned xb_xcc_id() { return (unsigned)__builtin_amdgcn_s_getreg((3 << 11) | 20) & 0xFu; }
#define XB_SPIN(cond, bar) do { unsigned _sp = 0; while (cond) { __builtin_amdgcn_s_sleep(1); \
    if ((++_sp & 255u) == 0u) { if (xb_ld(&(bar)[XB_TMO])) break; if (_sp > XB_SPIN_CAP) { atomicAdd(&(bar)[XB_TMO], 1u); break; } } } } while (0)

struct XcdBarrier {
    unsigned* bar; unsigned x;
    volatile LAS unsigned* st;
};

__device__ __forceinline__ XcdBarrier xcd_barrier_post(unsigned* bar, volatile LAS unsigned* st) {
    XcdBarrier b; b.bar = bar; b.x = xb_xcc_id(); b.st = st;
    if (threadIdx.x == 0) (void)xb_add(&bar[XB_XCNT(b.x)], 1u);
    return b;
}
__device__ __forceinline__ void xcd_barrier_complete(unsigned* bar, unsigned x, unsigned& nloc, unsigned& nx) {
    const unsigned G = gridDim.x * gridDim.y * gridDim.z;
    unsigned sum, cnt, mine, sp = 0u;
    for (;;) {
        sum = 0u; cnt = 0u; mine = 0u;
#pragma unroll
        for (unsigned j = 0; j < 16; ++j) { const unsigned c = xb_ld(&bar[XB_XCNT(j)]); sum += c; cnt += (c > 0u) ? 1u : 0u; mine = (j == x) ? c : mine; }
        if (sum == G) break;
        __builtin_amdgcn_s_sleep(1);
        if ((++sp & 255u) == 0u) { if (xb_ld(&bar[XB_TMO])) break; if (sp > XB_SPIN_CAP) { atomicAdd(&bar[XB_TMO], 1u); break; } }
    }
    nloc = mine > 0u ? mine : 1u; nx = cnt > 0u ? cnt : 1u;
}

__device__ __forceinline__ void xcd_barrier(const XcdBarrier& b) {
    asm volatile("s_waitcnt vmcnt(0)" ::: "memory");
    __syncthreads();
    if (threadIdx.x == 0) {
        unsigned* bar = b.bar;
        __builtin_amdgcn_s_waitcnt(0);
        unsigned nloc = b.st[0], nx = b.st[1];
        if (nloc == 0u) { xcd_barrier_complete(bar, b.x, nloc, nx); b.st[0] = nloc; b.st[1] = nx; }
        const unsigned old = xb_add(&bar[XB_XSUB(b.x)], 1u);
        const unsigned gen = old / nloc;
        if (old + 1u == (gen + 1u) * nloc) {
            __builtin_amdgcn_fence(__ATOMIC_RELEASE, "agent");
            asm volatile("s_waitcnt vmcnt(0)" ::: "memory");
            const unsigned og = xb_add(&bar[XB_TOP], 1u);
            const unsigned tg = og / nx;
            if (og + 1u == (tg + 1u) * nx) xb_add(&bar[XB_TOPGEN], 1u);
            else XB_SPIN(xb_ld(&bar[XB_TOPGEN]) == tg, bar);
            __builtin_amdgcn_fence(__ATOMIC_ACQUIRE, "agent");
            xb_add(&bar[XB_XGEN(b.x)], 1u);
            asm volatile("s_waitcnt vmcnt(0)" ::: "memory");
        } else {
            XB_SPIN(xb_ld(&bar[XB_XGEN(b.x)]) == gen, bar);
            __builtin_amdgcn_fence(__ATOMIC_ACQUIRE, "agent");
            asm volatile("s_waitcnt vmcnt(0)" ::: "memory");
        }
    }
    __syncthreads();
}

__global__ void __launch_bounds__(NTHREADS, 2) mega_fwd(Params p0) {
    extern __shared__ __attribute__((aligned(16))) unsigned char lds[];
    cg::grid_group grid = cg::this_grid();
    volatile LAS unsigned* misc = (volatile LAS unsigned*)((LAS unsigned char*)lds + LDS_STAGE);
    if (threadIdx.x < 16) misc[threadIdx.x] = 0u;
    __syncthreads();
    (void)xcd_barrier_post((unsigned*)(p0.ws + WS_BAR), misc);
#ifndef PHASE_MASK
#define PHASE_MASK 0xFFFF
#endif
#define PH(b) if constexpr ((PHASE_MASK >> (b)) & 1)
#ifndef DBL_MASK
#define DBL_MASK 0
#endif
    PH(10) prep_phase(p0, lds);
    __syncthreads();
    if constexpr ((DBL_MASK >> 10) & 1) { prep_phase(p0, lds); __syncthreads(); }
    grid.sync();
#pragma unroll 1
    for (int l = 0; l < DEPTH; ++l) {
#pragma unroll 1
        for (int slot = 0; slot < 12; ++slot) {
            Params p = p0;
            { unsigned char* w = p.ws; asm volatile("" : "+s"(w)); p.ws = w; }
            bool sync = true;
            LAS unsigned char* L = (LAS unsigned char*)lds;
            const int reps = ((DBL_MASK >> slot) & 1) ? 2 : 1;
#pragma unroll 1
            for (int rep = 0; rep < reps; ++rep) {
            if (rep) __syncthreads();
            switch (slot) {
            case 0: rownorm_phase(p, l); sync = false; break;
            case 1: if (l == 0) gemm_phase(L, G_FOLD, l, p.ws); break;
            case 2: gemm_phase(L, G_IN, l, p.ws); sync = false; break;
            case 3: gemm_phase(L, G_XT, l, p.ws); break;
            case 4: gemm_phase(L, G_F1, l, p.ws); sync = false; break;
            case 5: gemm_phase(L, G_DFTC, l, p.ws); break;
            case 6: ew_phase(p, l); break;
            case 7: case 8: sync = false; break;
            case 9: {
                const int cb = (int)blockIdx.x, Gn = (int)gridDim.x;
                unsigned* c2 = (unsigned*)(p.ws + WS_BAR) + 3540;
                const unsigned target = (unsigned)(Gn - 148) * (unsigned)(l + 1);
                if (cb >= 16 && cb < Gn - 132) {
                    gemm_phase(L, G_F2, l, p.ws);
                    __syncthreads();
                    if (threadIdx.x == 0) { __builtin_amdgcn_fence(__ATOMIC_RELEASE, "agent"); asm volatile("s_waitcnt vmcnt(0)" ::: "memory");
                        __hip_atomic_fetch_add(c2, 1u, __ATOMIC_RELAXED, __HIP_MEMORY_SCOPE_AGENT); }
                    __syncthreads();
                }
                attn_phase(p, l, (char*)lds);
                __syncthreads();
                if (cb >= Gn - 132) {
                    if (threadIdx.x == 0) { unsigned sp = 0;
                        while (__hip_atomic_load(c2, __ATOMIC_RELAXED, __HIP_MEMORY_SCOPE_AGENT) < target) { __builtin_amdgcn_s_sleep(1); if (++sp > (1u << 22)) break; }
                        __builtin_amdgcn_fence(__ATOMIC_ACQUIRE, "agent"); asm volatile("s_waitcnt vmcnt(0)" ::: "memory"); }
                    __syncthreads();
                    gemm_phase(L, G_MIX, l, p.ws);
                }
                break; }
            case 10: gemm_phase(L, G_MERGE, l, p.ws); __syncthreads(); gemm_phase(L, G_MERGEC, l, p.ws); break;
            default: {
                const bool hasctx = l < DEPTH - 1;
                unsigned* ccnt = (unsigned*)(p.ws + WS_BAR) + 3500;
                if (hasctx) {
                    int t0_ = threadIdx.x; asm volatile("" : "+v"(t0_));
                    const int idx = (int)blockIdx.x * NTHREADS + t0_, r = idx >> 9, cc = (idx & 511) * 4;
                    const float* mp = (const float*)(p.ws + WS_MP); bf16_t* mb = (bf16_t*)(p.ws + WS_MB);
                    f32x4 s = *(const f32x4*)(mp + (size_t)r * MLD + cc);
#pragma unroll
                    for (int q = 1; q < 8; ++q) s += *(const f32x4*)(mp + ((size_t)q * CTX + r) * MLD + cc);
                    u32x2 w; w.x = cvtpk(s[0], s[1]); w.y = cvtpk(s[2], s[3]); *(u32x2*)(mb + (size_t)r * DM + cc) = w;
                    asm volatile("s_waitcnt vmcnt(0)" ::: "memory"); __syncthreads();
                    if (threadIdx.x == 0) { __builtin_amdgcn_fence(__ATOMIC_RELEASE, "agent"); asm volatile("s_waitcnt vmcnt(0)" ::: "memory");
                        __hip_atomic_fetch_add(ccnt, 1u, __ATOMIC_RELAXED, __HIP_MEMORY_SCOPE_AGENT); }
                }
                const int nv = (hasctx && (int)blockIdx.x >= (int)gridDim.x - 32) ? 2 : 1;
#pragma unroll 1
                for (int v = 0; v < nv; ++v) {
                    if (v) {
                        __syncthreads();
                        if (threadIdx.x == 0) { const unsigned target = (unsigned)(l + 1) * gridDim.x; unsigned sp = 0;
                            while (__hip_atomic_load(ccnt, __ATOMIC_RELAXED, __HIP_MEMORY_SCOPE_AGENT) < target) { __builtin_amdgcn_s_sleep(1); if (++sp > (1u << 22)) break; }
                            __builtin_amdgcn_fence(__ATOMIC_ACQUIRE, "agent"); asm volatile("s_waitcnt vmcnt(0)" ::: "memory"); }
                        __syncthreads();
                    }
                    gemm_phase(L, G_OUT, l | (v << 4), p.ws);
                }
                break; }
            }
            }
            __syncthreads();
            if (sync) { XcdBarrier xb; xb.bar = (unsigned*)(p.ws + WS_BAR); xb.x = xb_xcc_id(); xb.st = (volatile LAS unsigned*)((LAS unsigned char*)lds + LDS_STAGE); xcd_barrier(xb); }
        }
    }
    PH(0) rownorm_phase(p0, DEPTH);
}

extern "C" void kernel_launch(void* const* d_in, const int* in_sizes, int n_in, void* d_out, int out_size, void* d_ws, size_t ws_size, hipStream_t stream) {
    static int grid_blocks = 0;
    if (grid_blocks == 0) {
        if (n_in != 18 || out_size != SEQ * DM || ws_size < WS_END) { fprintf(stderr, "kernel_launch: unexpected shapes: n_in %d out %d ws %zu (need %zu)\n", n_in, out_size, ws_size, (size_t)WS_END); grid_blocks = -1; return; }
        int dev = 0, cus = 0, per_cu = 0;
        hipGetDevice(&dev);
        hipDeviceGetAttribute(&cus, hipDeviceAttributeMultiprocessorCount, dev);
        if (hipFuncSetAttribute((const void*)mega_fwd, hipFuncAttributeMaxDynamicSharedMemorySize, LDS_BYTES) != hipSuccess) { fprintf(stderr, "kernel_launch: hipFuncSetAttribute failed\n"); grid_blocks = -1; return; }
        if (hipOccupancyMaxActiveBlocksPerMultiprocessor(&per_cu, (const void*)mega_fwd, NTHREADS, LDS_BYTES) != hipSuccess || per_cu < 1) { fprintf(stderr, "kernel_launch: occupancy query gave %d\n", per_cu); per_cu = 1; }
        (void)hipGetLastError();
        grid_blocks = cus * (per_cu > 1 ? 1 : per_cu);
        if (grid_blocks > 256) grid_blocks = 256;
        grid_blocks &= ~7;
        if (grid_blocks != 256) { fprintf(stderr, "kernel_launch: this kernel is laid out for 256 resident workgroups, got %d\n", grid_blocks); grid_blocks = -1; return; }
    }
    if (grid_blocks <= 0) return;
    Params p{};
    for (int i = 0; i < 18; ++i) p.in[i] = (const float*)d_in[i];
    p.out = (float*)d_out; p.ws = (unsigned char*)d_ws;
    if (hipMemsetAsync((char*)d_ws + WS_BAR, 0, BAR_BYTES, stream) != hipSuccess) { fprintf(stderr, "kernel_launch: memset of barrier words failed\n"); return; }
    void* args[] = {&p};
    hipError_t e = hipLaunchCooperativeKernel((const void*)mega_fwd, dim3(grid_blocks), dim3(NTHREADS), args, LDS_BYTES, stream);
    if (e != hipSuccess) fprintf(stderr, "cooperative launch failed: %s (grid %d)\n", hipGetErrorString(e), grid_blocks);
}
```

```cpp
#include <hip/hip_runtime.h>
#include <hip/hip_cooperative_groups.h>
#include <cstdio>
#include <cstdint>
namespace cg = cooperative_groups;

#define LAS __attribute__((address_space(3)))
typedef unsigned short bf16_t;
typedef short bf16x8 __attribute__((ext_vector_type(8)));
typedef short s16x4 __attribute__((ext_vector_type(4)));
typedef float f32x4 __attribute__((ext_vector_type(4)));
typedef float f32x16 __attribute__((ext_vector_type(16)));
typedef unsigned u32x4 __attribute__((ext_vector_type(4)));
typedef unsigned u32x2 __attribute__((ext_vector_type(2)));

constexpr int DM = 2048, SEQ = 8192, CTX = 256, ROWS = SEQ + CTX, DEPTH = 4, INC = 17408;
constexpr int OQ = 0, OKK = 2048, OV = 2560, OAG = 3072, OFX = 5120, OFG = 6144, OCX = 7168, OCB = 8192, OCC = 9216, OCG = 10240, OML = 11264;
constexpr float EPS = 1e-6f;
constexpr size_t APL = (size_t)(SEQ + CTX) * 2048, WPL = (size_t)2048 * 2048;
constexpr int CLD = 2048;
constexpr int MLD = 2048 + 64;
constexpr int ZCH = 32768 + 256;
constexpr int LDS_STAGE = 131072, LDS_BYTES = LDS_STAGE + 64;
constexpr int NTHREADS = 512;

constexpr size_t SZ_WINT = (size_t)INC * DM * 2, SZ_WCAT = 3 * WPL * 2, SZ_WOUT = (size_t)DM * DM * 2, SZ_WMIXR = (size_t)1024 * 1024 * 2, SZ_WMIX = (size_t)1024 * 2048 * 2;
constexpr size_t WS_WINT = 0;
constexpr size_t WS_WCAT = WS_WINT + DEPTH * SZ_WINT;
constexpr size_t WS_WOUT = WS_WCAT + DEPTH * SZ_WCAT;
constexpr size_t WS_WMIXR = WS_WOUT + DEPTH * SZ_WOUT;
constexpr size_t WS_WMIX = WS_WMIXR + DEPTH * SZ_WMIXR;
constexpr size_t WS_TCH = WS_WMIX + DEPTH * SZ_WMIX;
constexpr size_t WS_ZT = WS_TCH + 512 * 256 * 2;
constexpr size_t WS_T1 = WS_ZT + (size_t)1024 * ZCH;
constexpr size_t WS_A2 = WS_T1 + 256 * 128 * 2;
constexpr size_t WS_ACTX = WS_A2 + 256 * 256 * 2;
constexpr size_t WS_ROPE = WS_ACTX + 512 * 256 * 2;
constexpr size_t WS_MOD = WS_ROPE + 128 * 32 * 8;
constexpr size_t WS_XS = WS_MOD + 4 * 2 * 6144 * 4;
constexpr size_t WS_H = WS_XS + (size_t)ROWS * DM * 4;
constexpr size_t WS_P = WS_H + (size_t)ROWS * DM * 2;
constexpr size_t WS_XT = WS_P + (size_t)ROWS * INC * 2;
constexpr size_t WS_PQ = WS_XT + (size_t)1024 * ROWS * 2;
constexpr size_t WS_ACAT = WS_PQ + (size_t)ROWS * DM * 2;
constexpr size_t WS_MBUF = WS_ACAT + 3 * APL * 2;
constexpr size_t WS_MB = WS_MBUF + (size_t)ROWS * MLD * 4;
constexpr size_t WS_OUTB = WS_MB + (size_t)ROWS * DM * 2;
constexpr size_t WS_KC = WS_OUTB + (size_t)ROWS * DM * 4;
constexpr size_t WS_VC = WS_KC + (size_t)4 * ROWS * 128 * 2;
constexpr size_t WS_MP = WS_VC + (size_t)4 * ROWS * 128 * 2;
constexpr size_t WS_OUTP = WS_MP + (size_t)8 * CTX * MLD * 4;
constexpr size_t WS_BAR = WS_OUTP + (size_t)4 * CTX * DM * 4;
constexpr size_t BAR_BYTES = 16384;
constexpr size_t WS_END = WS_BAR + BAR_BYTES;

struct Params { const float* in[18]; float* out; unsigned char* ws; };
enum { I_X = 0, I_C, I_CTX, I_CCTX, I_WMOD, I_BMOD, I_GPRE, I_GPOST, I_WIN, I_QN, I_KN, I_WAO, I_WFM, I_WFO, I_CW, I_CB, I_WCO, I_WOUT };

__device__ __forceinline__ unsigned cvtpk(float lo, float hi) { unsigned r; asm volatile("v_cvt_pk_bf16_f32 %0, %1, %2" : "=v"(r) : "v"(lo), "v"(hi)); return r; }
__device__ __forceinline__ float bf2f(unsigned short b) { return __uint_as_float(((unsigned)b) << 16); }
__device__ __forceinline__ float bflo(unsigned w) { return __uint_as_float(w << 16); }
__device__ __forceinline__ float bfhi(unsigned w) { return __uint_as_float(w & 0xffff0000u); }
__device__ __forceinline__ unsigned short f2bf(float f) { return (unsigned short)(cvtpk(f, f) & 0xffffu); }
__device__ __forceinline__ float sigmoidf_(float x) { return __builtin_amdgcn_rcpf(1.0f + __expf(-x)); }
__device__ __forceinline__ float siluf_(float x) { return x * sigmoidf_(x); }
__device__ __forceinline__ float wave_sum(float v) {
#pragma unroll
    for (int o = 32; o >= 1; o >>= 1) v += __shfl_xor(v, o);
    return v;
}

__device__ __forceinline__ void prep_phase(const Params& p, unsigned char* lds_g) {
    int tid_ = threadIdx.x; asm volatile("" : "+v"(tid_));
    const int tid = tid_, G = gridDim.x, bid = blockIdx.x;
    unsigned char* ws = p.ws;
    float* tile = (float*)lds_g;
    constexpr int T_IN = 32 * 272, T_AO = 32 * 32, T_FO = 16 * 32, T_CO = 16 * 32, T_OUT = 32 * 32, T_MIX = 16 * 16;
    constexpr int T_LAYER = T_IN + T_AO + T_FO + T_CO + T_OUT + T_MIX;
    for (int t = bid; t < DEPTH * T_LAYER; t += G) {
        const int l = t / T_LAYER; int r = t % T_LAYER;
        const float* src; int ldsrc; bf16_t* dst; int lddst; int ktiles;
        if (r < T_IN) { src = p.in[I_WIN] + (size_t)l * DM * INC; ldsrc = INC; dst = (bf16_t*)(ws + WS_WINT + l * SZ_WINT); lddst = DM; ktiles = 32; }
        else if ((r -= T_IN) < T_AO) { src = p.in[I_WAO] + (size_t)l * DM * DM; ldsrc = DM; dst = (bf16_t*)(ws + WS_WCAT + l * SZ_WCAT); lddst = CLD; ktiles = 32; }
        else if ((r -= T_AO) < T_FO) { src = p.in[I_WFO] + (size_t)l * 1024 * DM; ldsrc = DM; dst = (bf16_t*)(ws + WS_WCAT + l * SZ_WCAT) + WPL; lddst = CLD; ktiles = 16; }
        else if ((r -= T_FO) < T_CO) { src = p.in[I_WCO] + (size_t)l * 1024 * DM; ldsrc = DM; dst = (bf16_t*)(ws + WS_WCAT + l * SZ_WCAT) + 2 * WPL; lddst = CLD; ktiles = 16; }
        else if ((r -= T_CO) < T_OUT) { src = p.in[I_WOUT] + (size_t)l * DM * DM; ldsrc = DM; dst = (bf16_t*)(ws + WS_WOUT + l * SZ_WOUT); lddst = DM; ktiles = 32; }
        else { r -= T_OUT; src = p.in[I_WFM] + (size_t)l * 1024 * 1024; ldsrc = 1024; dst = (bf16_t*)(ws + WS_WMIXR + l * SZ_WMIXR); lddst = 1024; ktiles = 16; }
        const int k0 = (r % ktiles) * 64, n0 = (r / ktiles) * 64;
        { const int ty = tid >> 4, tx = tid & 15;
#pragma unroll
          for (int ps = 0; ps < 2; ++ps) { const int kk = ty + 32 * ps;
              const f32x4 v = *(const f32x4*)(src + (size_t)(k0 + kk) * ldsrc + n0 + tx * 4);
              tile[kk * 65 + tx * 4 + 0] = v[0]; tile[kk * 65 + tx * 4 + 1] = v[1]; tile[kk * 65 + tx * 4 + 2] = v[2]; tile[kk * 65 + tx * 4 + 3] = v[3]; } }
        __syncthreads();
        { const int n = tid >> 3, kc = (tid & 7) * 8; u32x4 w;
          w.x = cvtpk(tile[(kc + 0) * 65 + n], tile[(kc + 1) * 65 + n]); w.y = cvtpk(tile[(kc + 2) * 65 + n], tile[(kc + 3) * 65 + n]);
          w.z = cvtpk(tile[(kc + 4) * 65 + n], tile[(kc + 5) * 65 + n]); w.w = cvtpk(tile[(kc + 6) * 65 + n], tile[(kc + 7) * 65 + n]);
          *(u32x4*)(dst + (size_t)(n0 + n) * lddst + k0 + kc) = w; }
        __syncthreads();
    }
    {
        float* sc = (float*)lds_g;
        float* red = sc + 4096;
        for (int u = bid; u < 256; u += G) {
            for (int k = tid; k < 4096; k += NTHREADS) { const float cv = (k < 2048) ? p.in[I_C][k] : p.in[I_CCTX][k - 2048]; sc[k] = siluf_(cv); }
            __syncthreads();
            const int l = u >> 6, j0 = (u & 63) * 96;
            if (tid < 504) { const int kg = tid / 24, cq = tid % 24;
                f32x4 al = {0.f, 0.f, 0.f, 0.f}, ac = {0.f, 0.f, 0.f, 0.f};
                const float* wp = p.in[I_WMOD] + (size_t)l * DM * 6144 + j0 + cq * 4;
                for (int k = kg; k < 2048; k += 21) { const f32x4 w = *(const f32x4*)(wp + (size_t)k * 6144); al += sc[k] * w; ac += sc[2048 + k] * w; }
                float* rp = red + (kg * 24 + cq) * 8;
                rp[0] = al[0]; rp[1] = al[1]; rp[2] = al[2]; rp[3] = al[3]; rp[4] = ac[0]; rp[5] = ac[1]; rp[6] = ac[2]; rp[7] = ac[3]; }
            __syncthreads();
            if (tid < 192) { const int v = tid / 96, col = tid % 96, cq = col >> 2, e = col & 3; float s = 0.f;
                for (int kg = 0; kg < 21; ++kg) s += red[(kg * 24 + cq) * 8 + v * 4 + e];
                ((float*)(ws + WS_MOD))[(size_t)(l * 2 + v) * 6144 + j0 + col] = s + p.in[I_BMOD][(size_t)l * 6144 + j0 + col]; }
            __syncthreads();
        }
    }
    const long gt = (long)bid * NTHREADS + tid, gn = (long)G * NTHREADS;
    for (long it = gt; it < 256 * 16; it += gn) { const int r = (int)(it >> 4), s0 = (int)(it & 15) * 8, k1 = r >> 1, ri = r & 1;
        float v[8];
#pragma unroll
        for (int j = 0; j < 8; ++j) { const int ph = (k1 * (s0 + j)) & 127; const float x = (float)ph * (1.0f / 128.0f); v[j] = (ri ? -__builtin_amdgcn_sinf(x) : __builtin_amdgcn_cosf(x)) * 0.08838834764831845f; }
        u32x4 w; w.x = cvtpk(v[0], v[1]); w.y = cvtpk(v[2], v[3]); w.z = cvtpk(v[4], v[5]); w.w = cvtpk(v[6], v[7]);
        *(u32x4*)((bf16_t*)(ws + WS_T1) + (size_t)r * 128 + s0) = w; }
    for (long it = gt; it < 256 * 32; it += gn) { const int rr = (int)(it >> 5), c0 = (int)(it & 31) * 8, kb = rr >> 7, pq = (rr >> 6) & 1, k2 = rr & 63;
        float v[8];
#pragma unroll
        for (int j = 0; j < 8; ++j) { const int cc = c0 + j, s2 = cc >> 2, kbc = (cc >> 1) & 1, ri = cc & 1;     const int ph = (k2 * s2) & 63; const float x = (float)ph * (1.0f / 64.0f);
            const float cs = __builtin_amdgcn_cosf(x), sn = __builtin_amdgcn_sinf(x);
            const float val = pq == 0 ? (ri == 0 ? cs : sn) : (ri == 0 ? sn : -cs);
            v[j] = (kb == kbc) ? val * 0.125f : 0.f; }
        u32x4 w; w.x = cvtpk(v[0], v[1]); w.y = cvtpk(v[2], v[3]); w.z = cvtpk(v[4], v[5]); w.w = cvtpk(v[6], v[7]);
        *(u32x4*)((bf16_t*)(ws + WS_A2) + (size_t)rr * 256 + c0) = w; }
    for (long it = gt; it < 2 * 512 * 32; it += gn) { const int which = (int)(it >> 14), rr = (int)(it & 16383), r = rr >> 5, s0 = (rr & 31) * 8, k = r & 255; const bool isin = r >= 256;
        bf16_t* A = (bf16_t*)(ws + (which ? WS_TCH : WS_ACTX)); const float sgn = (which && isin) ? -0.0625f : 0.0625f;
        float v[8];
#pragma unroll
        for (int j = 0; j < 8; ++j) { const int ph = (k * (s0 + j)) & 255; const float x = (float)ph * (1.0f / 256.0f); v[j] = (isin ? __builtin_amdgcn_sinf(x) : __builtin_amdgcn_cosf(x)) * sgn; }
        u32x4 w; w.x = cvtpk(v[0], v[1]); w.y = cvtpk(v[2], v[3]); w.z = cvtpk(v[4], v[5]); w.w = cvtpk(v[6], v[7]);
        *(u32x4*)(A + (size_t)r * 256 + s0) = w; }
    for (long it = gt; it < 128 * 32; it += gn) { const int pos = (int)(it >> 5), i = (int)(it & 31);
        const float freq = exp2f(-(float)i * (13.287712379549449f / 32.0f));
        const float ang = (float)pos * freq;
        double rev = (double)ang * 0.15915494309189535; rev -= floor(rev);
        const float xr = (float)rev;
        float2 cs; cs.x = __builtin_amdgcn_cosf(xr); cs.y = __builtin_amdgcn_sinf(xr);
        ((float2*)(ws + WS_ROPE))[it] = cs; }
}

__device__ __forceinline__ void rownorm_phase(const Params& p, int l) {
    int tid_ = threadIdx.x; asm volatile("" : "+v"(tid_));
    const int tid = tid_, lane = tid & 63, wid = tid >> 6;
    unsigned char* ws = p.ws;
    const int gw = blockIdx.x * 8 + wid, nw = gridDim.x * 8;
    const float* mod = (const float*)(ws + WS_MOD);
    for (int row = gw; row < ROWS; row += nw) {
        const int isctx = row < CTX ? 1 : 0;
        if (l == 4 && isctx) continue;
        float* xrow = (float*)(ws + WS_XS) + (size_t)row * DM;
        const float* xsrc = (l <= 1) ? (isctx ? p.in[I_CTX] + (size_t)row * DM : p.in[I_X] + (size_t)(row - CTX) * DM) : xrow;
        f32x4 xv[8];
#pragma unroll
        for (int i = 0; i < 8; ++i) xv[i] = *(const f32x4*)(xsrc + lane * 4 + i * 256);
        if (l > 0) {
            const bf16_t* orow = (const bf16_t*)(ws + WS_OUTB) + (size_t)row * DM;
            f32x4 ov[8]; float ss = 0.f;
#pragma unroll
            for (int i = 0; i < 8; ++i) {
                if (isctx) { const float* pp = (const float*)(ws + WS_OUTP) + (size_t)row * DM + lane * 4 + i * 256;
                    ov[i] = (*(const f32x4*)pp + *(const f32x4*)(pp + (size_t)CTX * DM)) + (*(const f32x4*)(pp + (size_t)2 * CTX * DM) + *(const f32x4*)(pp + (size_t)3 * CTX * DM)); }
                else { const u32x2 w = *(const u32x2*)(orow + lane * 4 + i * 256); ov[i] = (f32x4){bflo(w.x), bfhi(w.x), bflo(w.y), bfhi(w.y)}; }
                ss += ov[i][0] * ov[i][0] + ov[i][1] * ov[i][1] + ov[i][2] * ov[i][2] + ov[i][3] * ov[i][3]; }
            ss = wave_sum(ss);
            const float rstd = rsqrtf(ss * (1.0f / DM) + EPS);
            const float* gate = mod + (size_t)((l - 1) * 2 + isctx) * 6144 + 4096;
            const float* gpost = p.in[I_GPOST] + (size_t)(l - 1) * DM;
#pragma unroll
            for (int i = 0; i < 8; ++i) { const f32x4 g = *(const f32x4*)(gate + lane * 4 + i * 256), gp = *(const f32x4*)(gpost + lane * 4 + i * 256);
                xv[i] = xv[i] + g * ((ov[i] * rstd) * gp); }
            if (l == 4) { float* orow2 = p.out + (size_t)(row - CTX) * DM;
#pragma unroll
                for (int i = 0; i < 8; ++i) *(f32x4*)(orow2 + lane * 4 + i * 256) = xv[i];
                continue; }
        }
        float ss = 0.f;
#pragma unroll
        for (int i = 0; i < 8; ++i) ss += xv[i][0] * xv[i][0] + xv[i][1] * xv[i][1] + xv[i][2] * xv[i][2] + xv[i][3] * xv[i][3];
        ss = wave_sum(ss);
        const float rstd = rsqrtf(ss * (1.0f / DM) + EPS);
        const float* ml = mod + (size_t)(l * 2 + isctx) * 6144;
        const float* gpre = p.in[I_GPRE] + (size_t)l * DM;
        bf16_t* hrow = (bf16_t*)(ws + WS_H) + (size_t)row * DM;
        f32x4 sh[8], scl[8], gp[8];
#pragma unroll
        for (int i = 0; i < 8; ++i) { const int c = lane * 4 + i * 256; sh[i] = *(const f32x4*)(ml + c); scl[i] = *(const f32x4*)(ml + 2048 + c); gp[i] = *(const f32x4*)(gpre + c); }
        __builtin_amdgcn_sched_barrier(0);
        if (l > 0) {
#pragma unroll
            for (int i = 0; i < 8; ++i) *(f32x4*)(xrow + lane * 4 + i * 256) = xv[i];
        }
#pragma unroll
        for (int i = 0; i < 8; ++i) { const int c = lane * 4 + i * 256;
            const f32x4 hv = ((xv[i] * rstd) * gp[i]) * (1.0f + scl[i]) + sh[i];
            u32x2 w; w.x = cvtpk(hv[0], hv[1]); w.y = cvtpk(hv[2], hv[3]);
            *(u32x2*)(hrow + c) = w; }
    }
}

__device__ __forceinline__ void ew_phase(const Params& p, int l) {
    int tid_ = threadIdx.x; asm volatile("" : "+v"(tid_));
    const int tid = tid_;
    unsigned char* ws = p.ws;
    bf16_t* P = (bf16_t*)(ws + WS_P);
    {
        const int t = tid & 15; const long grp = ((long)blockIdx.x * NTHREADS + tid) >> 4, ngrp = (long)gridDim.x * NTHREADS / 16;
        const float2* rope = (const float2*)(ws + WS_ROPE);
        const int base = ((t & 8) ? 64 : 0) + 4 * (t & 7), fi = 4 * (t & 7);
        bf16_t* KC = (bf16_t*)(ws + WS_KC);
#pragma unroll 2
        for (long it = grp; it < (long)ROWS * 20; it += ngrp) { const int row = (int)(it / 20), head = (int)(it % 20);
            const bf16_t* src_ = P + (size_t)row * INC + (head < 16 ? OQ + head * 128 : OKK + (head - 16) * 128) + base;
            bf16_t* dst_ = (head < 16) ? (P + (size_t)row * INC + OQ + head * 128 + base) : (KC + ((size_t)(head - 16) * ROWS + row) * 128 + base);
            const float* gn = (head < 16 ? p.in[I_QN] : p.in[I_KN]) + (size_t)l * 128 + base;
            const u32x2 wa = *(const u32x2*)src_, wb = *(const u32x2*)(src_ + 32);
            const f32x4 ga = *(const f32x4*)gn, gb = *(const f32x4*)(gn + 32);
            float a[4] = {bflo(wa.x), bfhi(wa.x), bflo(wa.y), bfhi(wa.y)}, b[4] = {bflo(wb.x), bfhi(wb.x), bflo(wb.y), bfhi(wb.y)};
            float ss = 0.f;
#pragma unroll
            for (int q = 0; q < 4; ++q) ss += a[q] * a[q] + b[q] * b[q];
#pragma unroll
            for (int o = 8; o >= 1; o >>= 1) ss += __shfl_xor(ss, o);
            const float rstd = rsqrtf(ss * (1.0f / 128.0f) + EPS);
#pragma unroll
            for (int q = 0; q < 4; ++q) { a[q] = a[q] * rstd * ga[q]; b[q] = b[q] * rstd * gb[q]; }
            if (row >= CTX) { const int tk = row - CTX, pos = (t & 8) ? (tk & 63) : (tk >> 6);
                const f32x4 r01 = *(const f32x4*)(rope + pos * 32 + fi), r23 = *(const f32x4*)(rope + pos * 32 + fi + 2);
                const float cs[4] = {r01[0], r01[2], r23[0], r23[2]}, sn[4] = {r01[1], r01[3], r23[1], r23[3]};
#pragma unroll
                for (int q = 0; q < 4; ++q) { const float x0 = a[q], x1 = b[q]; a[q] = x0 * cs[q] - x1 * sn[q]; b[q] = x0 * sn[q] + x1 * cs[q]; } }
            u32x2 oa, ob; oa.x = cvtpk(a[0], a[1]); oa.y = cvtpk(a[2], a[3]); ob.x = cvtpk(b[0], b[1]); ob.y = cvtpk(b[2], b[3]);
            *(u32x2*)dst_ = oa; *(u32x2*)(dst_ + 32) = ob;
        }
    }
    {
        const long gt = (long)blockIdx.x * NTHREADS + tid, gn = (long)gridDim.x * NTHREADS;
        bf16_t* VC = (bf16_t*)(ws + WS_VC);
        for (long it = gt; it < (long)ROWS * 64; it += gn) { const int row = (int)(it >> 6), c = (int)(it & 63) * 8;
            const u32x4 v = *(const u32x4*)(P + (size_t)row * INC + OV + c);
            *(u32x4*)(VC + ((size_t)(c >> 7) * ROWS + row) * 128 + (c & 127)) = v; }
    }
    {
        const long gt = (long)blockIdx.x * NTHREADS + tid, gn = (long)gridDim.x * NTHREADS;
        bf16_t* Acat = (bf16_t*)(ws + WS_ACAT);
        const float* cw = p.in[I_CW] + (size_t)l * 3 * 1024; const float* cbias = p.in[I_CB] + (size_t)l * 1024;
        for (long it = gt; it < (long)(ROWS / 4) * 128; it += gn) { const int row0 = (int)(it >> 7) * 4, c0 = (int)(it & 127) * 8;
            const bf16_t* pr = P + (size_t)row0 * INC;
            const bool hp = (row0 != 0) && (row0 != CTX), hn = (row0 + 4 != CTX) && (row0 + 4 != ROWS);
            const u32x4 z = {0u, 0u, 0u, 0u};
            u32x4 xv[6], kv[6], bb[4], gg[4];
            xv[0] = hp ? *(const u32x4*)(pr - INC + OCX + c0) : z; kv[0] = hp ? *(const u32x4*)(pr - INC + OCC + c0) : z;
#pragma unroll
            for (int r = 0; r < 4; ++r) { xv[r + 1] = *(const u32x4*)(pr + (size_t)r * INC + OCX + c0); kv[r + 1] = *(const u32x4*)(pr + (size_t)r * INC + OCC + c0);
                bb[r] = *(const u32x4*)(pr + (size_t)r * INC + OCB + c0); gg[r] = *(const u32x4*)(pr + (size_t)r * INC + OCG + c0); }
            xv[5] = hn ? *(const u32x4*)(pr + (size_t)4 * INC + OCX + c0) : z; kv[5] = hn ? *(const u32x4*)(pr + (size_t)4 * INC + OCC + c0) : z;
            float w0[8], w1[8], w2[8], bs[8];
#pragma unroll
            for (int j = 0; j < 8; ++j) { w0[j] = cw[c0 + j]; w1[j] = cw[1024 + c0 + j]; w2[j] = cw[2048 + c0 + j]; bs[j] = cbias[c0 + j]; }
            float uu[6][8];
#pragma unroll
            for (int r = 0; r < 6; ++r)
#pragma unroll
                for (int q = 0; q < 4; ++q) { uu[r][2 * q] = bflo(xv[r][q]) * bflo(kv[r][q]); uu[r][2 * q + 1] = bfhi(xv[r][q]) * bfhi(kv[r][q]); }
#pragma unroll
            for (int r = 0; r < 4; ++r) { float res[8];
#pragma unroll
                for (int q = 0; q < 4; ++q) {
                    { const int j = 2 * q; const float cv = uu[r][j] * w0[j] + uu[r + 1][j] * w1[j] + uu[r + 2][j] * w2[j] + bs[j]; res[j] = bflo(bb[r][q]) * cv * siluf_(bflo(gg[r][q])); }
                    { const int j = 2 * q + 1; const float cv = uu[r][j] * w0[j] + uu[r + 1][j] * w1[j] + uu[r + 2][j] * w2[j] + bs[j]; res[j] = bfhi(bb[r][q]) * cv * siluf_(bfhi(gg[r][q])); } }
                u32x4 w; w.x = cvtpk(res[0], res[1]); w.y = cvtpk(res[2], res[3]); w.z = cvtpk(res[4], res[5]); w.w = cvtpk(res[6], res[7]);
                *(u32x4*)(Acat + 2 * APL + (size_t)(row0 + r) * CLD + c0) = w; }
        }
    }
}

constexpr int BM = 256, BK = 64, HALF = 128, HTB = HALF * BK * 2;
constexpr int BJC = 32;
__device__ __forceinline__ int lds_byte(int r, int c) { const int st = (r >> 4) * 2 + (c >> 5), rr = r & 15, cc = c & 31, ob = rr * 64 + cc * 2; return st * 1024 + (ob ^ (((ob >> 9) & 1) << 5)); }
__device__ __forceinline__ void stage_rc(int b, int& R, int& C) { const int st = b / 1024, sb = b % 1024, swz = sb ^ (((sb >> 9) & 1) << 5); R = (st >> 1) * 16 + swz / 64; C = (st & 1) * 32 + (swz % 64) / 2; }
__device__ __forceinline__ int perm32(int rho) { const int n = rho >> 4, i = rho & 15; return 8 * (i >> 2) + 4 * n + (i & 3); }

enum { G_FOLD = 0, G_IN, G_XT, G_F1, G_F2, G_DFTC, G_MIX, G_MERGE, G_OUT, G_MERGEC };
enum { M_BF16 = 0, M_MIX, M_MERGE0, M_MERGE1, M_MERGE2, M_F32, M_F1, M_F2, M_MG0, M_MG1, M_MG2 };
struct Unit { const char* a; const char* b; char* o; const char* aux; char* m; int nt, mode, ldo; };

__device__ __forceinline__ void static_order(int w, int nM, int nN, int& pm, int& pn) {
    const int nwg = nM * nN, q = nwg / 8, r = nwg % 8, xcd = w % 8, off = w / 8;
    const int wg = (xcd < r ? xcd * (q + 1) : r * (q + 1) + (xcd - r) * q) + off;
    const int nig = 8 * nN, gid = wg / nig, fm = gid * 8, gsz = (nM - fm) < 8 ? (nM - fm) : 8;
    pm = fm + ((wg % nig) % gsz); pn = (wg % nig) / gsz;
}

__device__ __forceinline__ bool get_unit(int gid, int l, int i, unsigned char* ws, Unit& u) {
    const int G = gridDim.x, c = blockIdx.x;
    u.aux = nullptr; u.m = nullptr;
    switch (gid) {
    case G_FOLD: { const int L = i * G + c; if (L >= 128) return false;
        const int ll = L >> 5, g = (L >> 3) & 3, pm = (L >> 1) & 3, pnn = L & 1;
        u.a = (const char*)(ws + WS_WMIXR + ll * SZ_WMIXR) + ((size_t)pm * 256 * 1024 + g * 256) * 2;
        u.b = (const char*)(ws + WS_TCH) + (size_t)pnn * 256 * 256 * 2;
        u.o = (char*)(ws + WS_WMIX + ll * SZ_WMIX) + ((size_t)pm * 256 * 2048 + pnn * 1024 + g * 256) * 2;
        u.nt = 4; u.mode = M_BF16; u.ldo = 2048; return true; }
    case G_IN: { const int L = i * G + c; if (L >= 2116) return false;
        if (L < 2112) { int pm, pn; static_order(L, 33, 64, pm, pn); const int pnp = pn < 20 ? pn : pn + 4;
            u.a = (const char*)(ws + WS_H) + (size_t)pm * 256 * DM * 2;
            u.b = (const char*)(ws + WS_WINT + l * SZ_WINT) + (size_t)pnp * 256 * DM * 2;
            u.o = (char*)(ws + WS_P) + ((size_t)pm * 256 * INC + pnp * 256) * 2; u.ldo = INC; }
        else { const int pm = L - 2112;
            u.a = (const char*)(ws + WS_WINT + l * SZ_WINT) + (size_t)(OFX + pm * 256) * DM * 2;
            u.b = (const char*)(ws + WS_H);
            u.o = (char*)(ws + WS_XT) + (size_t)pm * 256 * ROWS * 2; u.ldo = ROWS; }
        u.nt = 32; u.mode = M_BF16; return true; }
    case G_XT: { const int L = i * G + ((c + G - 68) % G); if (L >= 128) return false; const int pm = L & 3, pn = 1 + (L >> 2);
        u.a = (const char*)(ws + WS_WINT + l * SZ_WINT) + (size_t)(OFX + pm * 256) * DM * 2;
        u.b = (const char*)(ws + WS_H) + (size_t)(CTX + 2 * (pn - 1)) * DM * 2;
        u.o = (char*)(ws + WS_XT) + ((size_t)pm * 256 * ROWS + pn * 256) * 2; u.ldo = ROWS;
        u.nt = 32; u.mode = M_BF16; return true; }
    case G_F1: { const int L = i * G + c; if (L >= 256) return false; const int s2 = L >> 2, ct = L & 3;
        u.a = (const char*)(ws + WS_XT) + ((size_t)ct * 256 * ROWS + CTX + s2 * 128) * 2;
        u.b = (const char*)(ws + WS_T1);
        u.o = (char*)(ws + WS_ZT) + (size_t)ct * 256 * ZCH + s2 * 8;
        u.nt = 2; u.mode = M_F1; u.ldo = s2; return true; }
    case G_F2: { if (c < 16 || c >= G - 132) return false; const int L = i * (G - 148) + (c - 16); if (L >= 256) return false; const int k1p = L >> 2, ct = L & 3;
        u.a = (const char*)(ws + WS_A2);
        u.b = (const char*)(ws + WS_ZT) + (size_t)ct * 256 * ZCH + k1p * 512;
        u.o = (char*)(ws + WS_PQ) + ((size_t)(CTX + 2 * k1p) * 2048 + ct * 256) * 2;
        u.nt = 4; u.mode = M_F2; u.ldo = 2048; return true; }
    case G_DFTC: { const int L = i * G + c; if (L >= 8) return false; const int pm = L >> 2, pn = L & 3;
        u.a = (const char*)(ws + WS_ACTX) + (size_t)pm * 256 * 256 * 2;
        u.b = (const char*)(ws + WS_XT) + (size_t)pn * 256 * ROWS * 2;
        u.o = (char*)(ws + WS_PQ) + ((size_t)pm * 1024 + pn * 256) * 2;
        u.nt = 4; u.mode = M_BF16; u.ldo = 2048; return true; }
    case G_MIX: { const int L = i * G + (G - 1 - c); if (L >= 132) return false; const int pm = L >> 2, pn = L & 3;
        u.a = (const char*)(ws + WS_PQ) + (size_t)pm * 256 * 2048 * 2;
        u.b = (const char*)(ws + WS_WMIX + l * SZ_WMIX) + (size_t)pn * 256 * 2048 * 2;
        u.aux = (const char*)(ws + WS_P) + ((size_t)pm * 256 * INC + OFG + pn * 256) * 2;
        u.o = (char*)(ws + WS_ACAT) + (APL + (size_t)pm * 256 * CLD + pn * 256) * 2;
        u.nt = 32; u.mode = M_MIX; u.ldo = CLD; return true; }
    case G_MERGE: {
        if (i < 3) { const int T = c, sub = i; if (T >= 256) return false;
            int pm, pn; static_order(T, 32, 8, pm, pn); pm += 1;
            u.a = (const char*)(ws + WS_ACAT) + ((size_t)sub * APL + (size_t)pm * 256 * CLD) * 2;
            u.b = (const char*)(ws + WS_WCAT + l * SZ_WCAT) + ((size_t)sub * WPL + (size_t)pn * 256 * CLD) * 2;
            u.aux = (const char*)(ws + WS_P) + ((size_t)pm * 256 * INC + OML + sub * 2048 + pn * 256) * 2;
            u.m = (char*)(ws + WS_MBUF) + ((size_t)pm * 256 * MLD + pn * 256) * 4;
            u.o = (char*)(ws + WS_MB) + ((size_t)pm * 256 * 2048 + pn * 256) * 2;
            u.nt = sub == 0 ? 32 : 16; u.mode = M_MG0 + sub; u.ldo = 2048; return true; }
        return false; }
    case G_MERGEC: {
        if (i == 0 && l < DEPTH - 1 && c >= G - 64) { const int pc = c - (G - 64), pn = pc >> 3, q = pc & 7;
            const int sub = q < 4 ? 0 : (q < 6 ? 1 : 2), kcol = q < 4 ? q * 512 : (q < 6 ? (q - 4) * 512 : (q - 6) * 512);
            u.a = (const char*)(ws + WS_ACAT) + ((size_t)sub * APL + kcol) * 2;
            u.b = (const char*)(ws + WS_WCAT + l * SZ_WCAT) + ((size_t)sub * WPL + (size_t)pn * 256 * CLD + kcol) * 2;
            u.aux = (const char*)(ws + WS_P) + ((size_t)OML + sub * 2048 + pn * 256) * 2;
            u.m = (char*)(ws + WS_MP) + ((size_t)q * CTX * MLD + pn * 256) * 4;
            u.o = nullptr; u.nt = 8; u.mode = M_MERGE0; u.ldo = 2048; return true; }
        return false; }
    case G_OUT: {
        const int piece = l >> 4; l &= 15;
        if (i != 0) return false;
        if (!piece) { if (c >= 256) return false; int pm, pn; static_order(c, 32, 8, pm, pn); pm += 1;
            u.a = (const char*)(ws + WS_MB) + (size_t)pm * 256 * 2048 * 2;
            u.b = (const char*)(ws + WS_WOUT + l * SZ_WOUT) + (size_t)pn * 256 * 2048 * 2;
            u.o = (char*)(ws + WS_OUTB) + ((size_t)pm * 256 * 2048 + pn * 256) * 2;
            u.nt = 32; u.mode = M_BF16; u.ldo = 2048; return true; }
        if (l < DEPTH - 1 && c >= G - 32) { const int pc = c - (G - 32), pn = pc >> 2, kp = pc & 3;
            u.a = (const char*)(ws + WS_MB) + (size_t)kp * 512 * 2;
            u.b = (const char*)(ws + WS_WOUT + l * SZ_WOUT) + ((size_t)pn * 256 * 2048 + kp * 512) * 2;
            u.o = (char*)(ws + WS_OUTP) + ((size_t)kp * CTX * 2048 + pn * 256) * 4;
            u.nt = 8; u.mode = M_F32; u.ldo = 2048; return true; }
        return false; }
    }
    return false;
}

__device__ __forceinline__ void epilogue(const f32x4 (&acc)[2][2][4][2], const Unit& u, int wr, int wc, int fr, int fq) {
    unsigned r0 = wr * 64 + fr, c0 = wc * 64 + 8 * fq;
    asm volatile("" : "+v"(r0), "+v"(c0));
    if (u.mode == M_BF16) {
        const unsigned base = (r0 * (unsigned)u.ldo + c0) * 2u;
#pragma unroll
        for (int ai = 0; ai < 2; ++ai)
#pragma unroll
            for (int m = 0; m < 4; ++m) { char* rowp = u.o + (size_t)(ai * HALF + m * 16) * u.ldo * 2;
#pragma unroll
                for (int bj = 0; bj < 2; ++bj) { const f32x4 v0 = acc[ai][bj][m][0], v1 = acc[ai][bj][m][1];
                    u32x4 w; w.x = cvtpk(v0[0], v0[1]); w.y = cvtpk(v0[2], v0[3]); w.z = cvtpk(v1[0], v1[1]); w.w = cvtpk(v1[2], v1[3]);
                    *(u32x4*)(rowp + base + bj * BJC * 2) = w; } }
    } else if (u.mode == M_MIX) {
        const unsigned base = (r0 * (unsigned)u.ldo + c0) * 2u, abase = (r0 * (unsigned)INC + c0) * 2u;
#pragma unroll
        for (int ai = 0; ai < 2; ++ai) {
            u32x4 g[4][2];
#pragma unroll
            for (int m = 0; m < 4; ++m)
#pragma unroll
                for (int bj = 0; bj < 2; ++bj) g[m][bj] = *(const u32x4*)(u.aux + (size_t)(ai * HALF + m * 16) * INC * 2 + abase + bj * BJC * 2);
            __builtin_amdgcn_sched_barrier(0);
#pragma unroll
            for (int m = 0; m < 4; ++m) { char* rowp = u.o + (size_t)(ai * HALF + m * 16) * u.ldo * 2;
#pragma unroll
                for (int bj = 0; bj < 2; ++bj) { const f32x4 v0 = acc[ai][bj][m][0], v1 = acc[ai][bj][m][1]; const u32x4 gg = g[m][bj];
                    u32x4 w; w.x = cvtpk(v0[0] * siluf_(bflo(gg.x)), v0[1] * siluf_(bfhi(gg.x))); w.y = cvtpk(v0[2] * siluf_(bflo(gg.y)), v0[3] * siluf_(bfhi(gg.y)));
                    w.z = cvtpk(v1[0] * siluf_(bflo(gg.z)), v1[1] * siluf_(bfhi(gg.z))); w.w = cvtpk(v1[2] * siluf_(bflo(gg.w)), v1[3] * siluf_(bfhi(gg.w)));
                    *(u32x4*)(rowp + base + bj * BJC * 2) = w; } }
            __builtin_amdgcn_sched_barrier(0);
        }
    } else if (u.mode == M_F32) {
        const unsigned base = (r0 * (unsigned)u.ldo + c0) * 4u;
#pragma unroll
        for (int ai = 0; ai < 2; ++ai)
#pragma unroll
            for (int m = 0; m < 4; ++m) { char* rowp = u.o + (size_t)(ai * HALF + m * 16) * u.ldo * 4;
#pragma unroll
                for (int bj = 0; bj < 2; ++bj) { *(f32x4*)(rowp + base + bj * BJC * 4) = acc[ai][bj][m][0]; *(f32x4*)(rowp + base + bj * BJC * 4 + 16) = acc[ai][bj][m][1]; } }
    } else if (u.mode == M_MG0 || u.mode == M_MG1) {
    } else if (u.mode == M_MG2) {
        const unsigned abase = (r0 * (unsigned)INC + c0) * 2u, obase = (r0 * 2048u + c0) * 2u;
#pragma unroll
        for (int ai = 0; ai < 2; ++ai) {
            u32x4 g[4][2];
#pragma unroll
            for (int m = 0; m < 4; ++m)
#pragma unroll
                for (int bj = 0; bj < 2; ++bj) g[m][bj] = *(const u32x4*)(u.aux + (size_t)(ai * HALF + m * 16) * INC * 2 + abase + bj * BJC * 2);
            __builtin_amdgcn_sched_barrier(0);
#pragma unroll
            for (int m = 0; m < 4; ++m) { char* rowp = u.o + (size_t)(ai * HALF + m * 16) * 2048 * 2;
#pragma unroll
                for (int bj = 0; bj < 2; ++bj) { f32x4 v0 = acc[ai][bj][m][0], v1 = acc[ai][bj][m][1]; const u32x4 gg = g[m][bj];
                    v0[0] *= sigmoidf_(bflo(gg.x)); v0[1] *= sigmoidf_(bfhi(gg.x)); v0[2] *= sigmoidf_(bflo(gg.y)); v0[3] *= sigmoidf_(bfhi(gg.y));
                    v1[0] *= sigmoidf_(bflo(gg.z)); v1[1] *= sigmoidf_(bfhi(gg.z)); v1[2] *= sigmoidf_(bflo(gg.w)); v1[3] *= sigmoidf_(bfhi(gg.w));
                    u32x4 w; w.x = cvtpk(v0[0], v0[1]); w.y = cvtpk(v0[2], v0[3]); w.z = cvtpk(v1[0], v1[1]); w.w = cvtpk(v1[2], v1[3]); *(u32x4*)(rowp + obase + bj * BJC * 2) = w; } }
            __builtin_amdgcn_sched_barrier(0);
        }
    } else if (u.mode == M_F1) {
        const int s2 = u.ldo;
        const unsigned kb0 = (c0 >> 1);
        float tc[2][4], ts[2][4];
#pragma unroll
        for (int bj = 0; bj < 2; ++bj)
#pragma unroll
            for (int j = 0; j < 4; ++j) { const float x = (float)((bj * 16 + kb0 + j) * s2) * (1.0f / 8192.0f); tc[bj][j] = __builtin_amdgcn_cosf(x); ts[bj][j] = __builtin_amdgcn_sinf(x); }
        const unsigned base = r0 * (unsigned)ZCH + kb0 * 256u;
#pragma unroll
        for (int ai = 0; ai < 2; ++ai)
#pragma unroll
            for (int m = 0; m < 4; ++m) { char* rowp = u.o + (size_t)(ai * HALF + m * 16) * ZCH;
#pragma unroll
                for (int bj = 0; bj < 2; ++bj) { const f32x4 v0 = acc[ai][bj][m][0], v1 = acc[ai][bj][m][1];
                    const float zr[4] = {v0[0], v0[2], v1[0], v1[2]}, zi[4] = {v0[1], v0[3], v1[1], v1[3]};
#pragma unroll
                    for (int jp = 0; jp < 2; ++jp) { u32x2 w;
                        { const int j = 2 * jp; w.x = cvtpk(zr[j] * tc[bj][j] + zi[j] * ts[bj][j], zi[j] * tc[bj][j] - zr[j] * ts[bj][j]); }
                        { const int j = 2 * jp + 1; w.y = cvtpk(zr[j] * tc[bj][j] + zi[j] * ts[bj][j], zi[j] * tc[bj][j] - zr[j] * ts[bj][j]); }
                        *(u32x2*)(rowp + base + (bj * 8 + jp) * 512) = w; } } }
    } else if (u.mode == M_F2) {
        const unsigned fr_ = r0 & 15u, wr_ = r0 >> 6;
        const unsigned base = ((128u * fr_) * 2048u + wr_ * 1024u + c0) * 2u;
#pragma unroll
        for (int ai = 0; ai < 2; ++ai)
#pragma unroll
            for (int m = 0; m < 4; ++m) { char* rowp = u.o + (size_t)(ai + 2048 * m) * 2048 * 2;
#pragma unroll
                for (int bj = 0; bj < 2; ++bj) { const f32x4 v0 = acc[ai][bj][m][0], v1 = acc[ai][bj][m][1];
                    u32x4 w; w.x = cvtpk(v0[0], v0[1]); w.y = cvtpk(v0[2], v0[3]); w.z = cvtpk(v1[0], v1[1]); w.w = cvtpk(v1[2], v1[3]);
                    *(u32x4*)(rowp + base + bj * BJC * 2) = w; } }
    } else {
        const unsigned abase = (r0 * (unsigned)INC + c0) * 2u, mbase = (r0 * (unsigned)MLD + c0) * 4u;
#pragma unroll
        for (int ai = 0; ai < 2; ++ai) {
            u32x4 g[4][2];
#pragma unroll
            for (int m = 0; m < 4; ++m)
#pragma unroll
                for (int bj = 0; bj < 2; ++bj) g[m][bj] = *(const u32x4*)(u.aux + (size_t)(ai * HALF + m * 16) * INC * 2 + abase + bj * BJC * 2);
            __builtin_amdgcn_sched_barrier(0);
#pragma unroll
            for (int m = 0; m < 4; ++m) { char* mp = u.m + (size_t)(ai * HALF + m * 16) * MLD * 4;
#pragma unroll
                for (int bj = 0; bj < 2; ++bj) { f32x4 v0 = acc[ai][bj][m][0], v1 = acc[ai][bj][m][1]; const u32x4 gg = g[m][bj];
                    v0[0] *= sigmoidf_(bflo(gg.x)); v0[1] *= sigmoidf_(bfhi(gg.x)); v0[2] *= sigmoidf_(bflo(gg.y)); v0[3] *= sigmoidf_(bfhi(gg.y));
                    v1[0] *= sigmoidf_(bflo(gg.z)); v1[1] *= sigmoidf_(bfhi(gg.z)); v1[2] *= sigmoidf_(bflo(gg.w)); v1[3] *= sigmoidf_(bfhi(gg.w));
                    *(f32x4*)(mp + mbase + bj * BJC * 4) = v0; *(f32x4*)(mp + mbase + bj * BJC * 4 + 16) = v1; } }
            __builtin_amdgcn_sched_barrier(0);
        }
    }
}

__device__ __forceinline__ void rescale_or_reset(f32x4 (&acc)[2][2][4][2], const Unit& u, int wr, int wc, int fr, int fq) {
    const unsigned msk = (u.mode == M_MG0 || u.mode == M_MG1) ? 0xffffffffu : 0u;
    unsigned r0 = wr * 64 + fr, c0 = wc * 64 + 8 * fq;
    asm volatile("" : "+v"(r0), "+v"(c0));
    const unsigned abase = (r0 * (unsigned)INC + c0) * 2u;
#pragma unroll
    for (int ai = 0; ai < 2; ++ai)
#pragma unroll
        for (int m = 0; m < 4; ++m) { const char* ap = u.aux + (size_t)(ai * HALF + m * 16) * INC * 2;
#pragma unroll
            for (int bj = 0; bj < 2; ++bj) {
                const u32x4 ga = *(const u32x4*)(ap + abase + bj * BJC * 2), gb = *(const u32x4*)(ap + abase + bj * BJC * 2 + 4096);
                const unsigned wa[4] = {ga.x, ga.y, ga.z, ga.w}, wb[4] = {gb.x, gb.y, gb.z, gb.w};
                float f[8];
#pragma unroll
                for (int e = 0; e < 4; ++e) {
                    const float rl = (1.0f + __expf(-bflo(wb[e]))) * __builtin_amdgcn_rcpf(1.0f + __expf(-bflo(wa[e])));
                    const float rh = (1.0f + __expf(-bfhi(wb[e]))) * __builtin_amdgcn_rcpf(1.0f + __expf(-bfhi(wa[e])));
                    f[2 * e] = __uint_as_float(__float_as_uint(rl) & msk); f[2 * e + 1] = __uint_as_float(__float_as_uint(rh) & msk); }
                acc[ai][bj][m][0] *= (f32x4){f[0], f[1], f[2], f[3]}; acc[ai][bj][m][1] *= (f32x4){f[4], f[5], f[6], f[7]};
            }
            if (m & 1) __builtin_amdgcn_sched_barrier(0);
        }
}

__device__ __forceinline__ void gemm_phase(LAS unsigned char* lds, int gid, int l, unsigned char* ws) {
    int tid_ = threadIdx.x; asm volatile("" : "+v"(tid_));
    const int tid = tid_, wid = __builtin_amdgcn_readfirstlane(tid >> 6), lane = tid & 63, wr = wid >> 2, wc = wid & 3, fr = lane & 15, fq = lane >> 4;
    int lda, ldb;
    int ldbv = 0;
    switch (gid) { case G_FOLD: lda = 1024; ldb = 256; break; case G_IN: lda = 2048; ldb = 2048; break; case G_XT: lda = 2048; ldb = 2048; ldbv = 64 * 2048; break;
                   case G_F1: lda = ROWS; ldb = 128; break; case G_F2: lda = 256; ldb = ZCH / 2; break;
                   case G_DFTC: lda = 256; ldb = ROWS; break; case G_MIX: lda = 2048; ldb = 2048; break; case G_MERGE: case G_MERGEC: lda = CLD; ldb = CLD; break; default: lda = 2048; ldb = 2048; break; }
    if (ldbv == 0) ldbv = ldb;
    Unit cur, nxt; int ui = 0;
    if (!get_unit(gid, l, 0, ws, cur)) return;
    unsigned voffA[2], voffB[2];
#pragma unroll
    for (int i = 0; i < 2; ++i) { int R, C; stage_rc(tid * 16 + i * 8192, R, C); const int w_ = R >> 5, ip = perm32(R & 31);
        const int Rb = (gid == G_XT) ? (4096 * (w_ & 1) + 64 * ip + (w_ >> 1)) : (64 * w_ + ip);
        voffA[i] = (unsigned)(R * lda + C) * 2u; voffB[i] = (unsigned)(Rb * ldb + C) * 2u; }
    const size_t kstep = (size_t)(BK * 2);
    const size_t hstepA = (size_t)HALF * lda * 2, hstepB = (gid == G_XT) ? (size_t)2048 * ldb * 2 : (size_t)32 * ldb * 2;
    const unsigned ldsw = (unsigned)wid * 1024u;
    const int aoff = lds_byte(wr * 64 + fr, fq * 8), boff = lds_byte(wc * 32 + fr, fq * 8);
#define PG8_SA(b, h) (((b) * 2 + (h)) * HTB)
#define PG8_SB(b, h) ((4 + (b) * 2 + (h)) * HTB)
#define PG8_STAGE(bufoff, gbase, voff) do { _Pragma("unroll") for (int _i = 0; _i < 2; ++_i) \
        __builtin_amdgcn_global_load_lds((const unsigned*)((const char*)(gbase) + (voff)[_i]), (LAS unsigned*)(lds + (bufoff) + ldsw + _i * 8192), 16, 0, 0); } while (0)
#define PG8_LDA(dst, b, h) do { _Pragma("unroll") for (int m = 0; m < 4; ++m) _Pragma("unroll") for (int k = 0; k < 2; ++k) dst[m][k] = *(const LAS bf16x8*)(lds + PG8_SA(b, h) + aoff + m * 2048 + k * 1024); } while (0)
#define PG8_LDB(dst, b, h) do { _Pragma("unroll") for (int n = 0; n < 2; ++n) _Pragma("unroll") for (int k = 0; k < 2; ++k) dst[n][k] = *(const LAS bf16x8*)(lds + PG8_SB(b, h) + boff + n * 2048 + k * 1024); } while (0)
#define PG8_MMA(ai, bj, At, Bt) do { __builtin_amdgcn_s_setprio(1); _Pragma("unroll") for (int m = 0; m < 4; ++m) _Pragma("unroll") for (int n = 0; n < 2; ++n) _Pragma("unroll") for (int k = 0; k < 2; ++k) \
        acc[ai][bj][m][n] = __builtin_amdgcn_mfma_f32_16x16x32_bf16(Bt[n][k], At[m][k], acc[ai][bj][m][n], 0, 0, 0); __builtin_amdgcn_s_setprio(0); } while (0)
#define PG8_WAIT_V(n) asm volatile("s_waitcnt vmcnt(" #n ")" ::: "memory")
#define PG8_WAIT_L(n) asm volatile("s_waitcnt lgkmcnt(" #n ")" ::: "memory")
#define PG8_BAR __builtin_amdgcn_s_barrier()
#define PG8_SCHED __builtin_amdgcn_sched_barrier(0)
    f32x4 acc[2][2][4][2];
#pragma unroll
    for (int a = 0; a < 2; ++a)
#pragma unroll
        for (int b = 0; b < 2; ++b)
#pragma unroll
            for (int m = 0; m < 4; ++m)
#pragma unroll
                for (int n = 0; n < 2; ++n) acc[a][b][m][n] = (f32x4){0.f, 0.f, 0.f, 0.f};
    bf16x8 At[4][2], B0[2][2], B1[2][2];
    const char* cA = cur.a; const char* cB = cur.b;
    PG8_STAGE(PG8_SB(0, 0), cB, voffB); PG8_STAGE(PG8_SA(0, 0), cA, voffA); PG8_STAGE(PG8_SB(0, 1), cB + hstepB, voffB); PG8_STAGE(PG8_SA(0, 1), cA + hstepA, voffA);
    if (wr == 1) PG8_BAR;
    PG8_WAIT_V(4); PG8_BAR;
    PG8_STAGE(PG8_SB(1, 0), cB + kstep, voffB); PG8_STAGE(PG8_SA(1, 0), cA + kstep, voffA); PG8_STAGE(PG8_SB(1, 1), cB + hstepB + kstep, voffB);
    PG8_WAIT_V(6); PG8_BAR;
    for (;;) {
        const bool has_next = get_unit(gid, l, ui + 1, ws, nxt);
        const char* nA = has_next ? nxt.a : cA; const char* nB = has_next ? nxt.b : cB;
        const int nt = cur.nt;
        for (int t = 0; t < nt; t += 2) {
            const bool last = (t == nt - 2);
            const char* a1 = cA + (size_t)(t + 1) * kstep;
            const char* a2 = last ? nA : cA + (size_t)(t + 2) * kstep; const char* b2 = last ? nB : cB + (size_t)(t + 2) * kstep;
            const char* a3 = a2 + kstep; const char* b3 = b2 + kstep;
            PG8_LDB(B0, 0, 0); PG8_SCHED; PG8_LDA(At, 0, 0); PG8_STAGE(PG8_SA(1, 1), a1 + hstepA, voffA);
            PG8_WAIT_L(8); PG8_BAR; PG8_WAIT_L(0); PG8_MMA(0, 0, At, B0); PG8_BAR; PG8_SCHED;
            PG8_LDB(B1, 0, 1); PG8_STAGE(PG8_SB(0, 0), b2, voffB);
            PG8_BAR; PG8_WAIT_L(0); PG8_MMA(0, 1, At, B1); PG8_BAR;
            PG8_LDA(At, 0, 1); PG8_STAGE(PG8_SA(0, 0), a2, voffA);
            PG8_BAR; PG8_WAIT_L(0); PG8_MMA(1, 0, At, B0); PG8_BAR; PG8_SCHED;
            PG8_STAGE(PG8_SB(0, 1), b2 + hstepB, voffB);
            PG8_WAIT_V(6); PG8_BAR; PG8_MMA(1, 1, At, B1); PG8_BAR;
            PG8_LDB(B0, 1, 0); PG8_SCHED; PG8_LDA(At, 1, 0); PG8_STAGE(PG8_SA(0, 1), a2 + hstepA, voffA);
            PG8_WAIT_L(8); PG8_BAR; PG8_WAIT_L(0); PG8_MMA(0, 0, At, B0); PG8_BAR; PG8_SCHED;
            PG8_LDB(B1, 1, 1); PG8_STAGE(PG8_SB(1, 0), b3, voffB);
            PG8_BAR; PG8_WAIT_L(0); PG8_MMA(0, 1, At, B1); PG8_BAR;
            PG8_LDA(At, 1, 1); PG8_STAGE(PG8_SA(1, 0), a3, voffA);
            PG8_BAR; PG8_WAIT_L(0); PG8_MMA(1, 0, At, B0); PG8_BAR; PG8_SCHED;
            PG8_STAGE(PG8_SB(1, 1), b3 + hstepB, voffB);
            PG8_WAIT_V(6); PG8_BAR; PG8_MMA(1, 1, At, B1); PG8_BAR;
        }
        epilogue(acc, cur, wr, wc, fr, fq);
        if (!has_next) break;
        if (gid == G_MERGE) rescale_or_reset(acc, cur, wr, wc, fr, fq);
        else {
#pragma unroll
            for (int a = 0; a < 2; ++a)
#pragma unroll
                for (int b = 0; b < 2; ++b)
#pragma unroll
                    for (int m = 0; m < 4; ++m)
#pragma unroll
                        for (int n = 0; n < 2; ++n) acc[a][b][m][n] = (f32x4){0.f, 0.f, 0.f, 0.f};
        }
        cur = nxt; cA = nA; cB = nB; ++ui;
    }
    PG8_WAIT_V(0);
    if (wr == 0) PG8_BAR;
    PG8_BAR;
#undef PG8_SA
#undef PG8_SB
#undef PG8_STAGE
#undef PG8_LDA
#undef PG8_LDB
#undef PG8_MMA
#undef PG8_WAIT_V
#undef PG8_WAIT_L
#undef PG8_BAR
#undef PG8_SCHED
}

namespace att {
constexpr int D = 128, NW = 8, QBLK = 32, KVBLK = 64;
constexpr float SCALE = 0.088388347648318440f;
constexpr float THR = 8.f;
constexpr int LDQ = INC, LDK = 128, LDO = CLD;
constexpr size_t SHM_V = KVBLK * D * 2, SHM_K = KVBLK * D * 2, SHM_ATTN = 2 * SHM_V + 2 * SHM_K + NW * 64 * 4;
#define KSWZ(row, colB) ((row) * 256 + ((colB) ^ (((row) & 7) << 4)))
#define SBAR() __builtin_amdgcn_sched_barrier(0)
__device__ __forceinline__ int crow(int r, int hi) { return (r & 3) + 8 * (r >> 2) + 4 * hi; }
__device__ __forceinline__ void partialSM(f32x16& p0, f32x16& p1, float& m_reg, float& mn, float& alpha) {
  constexpr float C = SCALE * 1.4426950408889634f;
  float pmax = p0[0];
#pragma unroll
  for (int r = 1; r < 16; ++r) pmax = fmaxf(pmax, p0[r]);
#pragma unroll
  for (int r = 0; r < 16; ++r) pmax = fmaxf(pmax, p1[r]);
  { auto rr = __builtin_amdgcn_permlane32_swap(__float_as_uint(pmax), __float_as_uint(pmax), false, false);
    pmax = fmaxf(__uint_as_float(rr[0]), __uint_as_float(rr[1])); }
  if (__builtin_expect(__all(pmax - m_reg <= THR / SCALE), 1)) { mn = m_reg; alpha = 1.f; }
  else { mn = fmaxf(m_reg, pmax); alpha = __builtin_amdgcn_exp2f((m_reg - mn) * C); m_reg = mn; }
  float mnC = -mn * C;
#pragma unroll
  for (int r = 0; r < 16; ++r) p0[r] = fmaf(p0[r], C, mnC);
#pragma unroll
  for (int r = 0; r < 16; ++r) p1[r] = fmaf(p1[r], C, mnC);
#pragma unroll
  for (int r = 0; r < 16; ++r) p0[r] = __builtin_amdgcn_exp2f(p0[r]);
}
__device__ __forceinline__ void finishSM(f32x16& p0, f32x16& p1, float alpha, float& l_reg, bf16x8& pa0, bf16x8& pa1, bf16x8& pa2, bf16x8& pa3) {
#pragma unroll
  for (int r = 0; r < 16; ++r) p1[r] = __builtin_amdgcn_exp2f(p1[r]);
  float ps = 0;
#pragma unroll
  for (int r = 0; r < 16; ++r) ps += p0[r];
#pragma unroll
  for (int r = 0; r < 16; ++r) ps += p1[r];
  { auto rr = __builtin_amdgcn_permlane32_swap(__float_as_uint(ps), __float_as_uint(ps), false, false);
    ps = __uint_as_float(rr[0]) + __uint_as_float(rr[1]); }
  l_reg = l_reg * alpha + ps;
#define PK4(P, BASE, OUT) do { unsigned a0 = cvtpk(P[BASE + 0], P[BASE + 1]), a1 = cvtpk(P[BASE + 2], P[BASE + 3]);   \
    unsigned b0 = cvtpk(P[BASE + 4], P[BASE + 5]), b1 = cvtpk(P[BASE + 6], P[BASE + 7]);                              \
    auto r0 = __builtin_amdgcn_permlane32_swap(a0, b0, false, false); auto r1 = __builtin_amdgcn_permlane32_swap(a1, b1, false, false); \
    u32x4 w = {r0[0], r1[0], r0[1], r1[1]}; OUT = *reinterpret_cast<bf16x8*>(&w); } while (0)
  PK4(p0, 0, pa0); PK4(p0, 8, pa1); PK4(p1, 0, pa2); PK4(p1, 8, pa3);
#undef PK4
}
__device__ __forceinline__ void qkt(f32x16& p0, f32x16& p1, const bf16_t* Ks, const bf16x8* qr, int r32, int hi) {
  p0 = f32x16{}; p1 = f32x16{};
#pragma unroll
  for (int d0 = 0; d0 < 8; ++d0) { int cb = (d0 * 16 + hi * 8) * 2;
    bf16x8 b0 = *reinterpret_cast<const bf16x8*>((const char*)Ks + KSWZ(r32, cb));
    bf16x8 b1 = *reinterpret_cast<const bf16x8*>((const char*)Ks + KSWZ(32 + r32, cb));
    p0 = __builtin_amdgcn_mfma_f32_32x32x16_bf16(b0, qr[d0], p0, 0, 0, 0);
    p1 = __builtin_amdgcn_mfma_f32_32x32x16_bf16(b1, qr[d0], p1, 0, 0, 0); }
}
__device__ __forceinline__ int v_st(int k, int c) { const int kk = (k & ~0xC) | ((k & 4) << 1) | ((k & 8) >> 1); return ((kk >> 3) * 4 + (c >> 5)) * 512 + ((kk & 7) * 32 + (c & 31)) * 2; }
__device__ __forceinline__ int v_rd_base(int lane) { return ((lane & 3) << 3) | (((lane >> 2) & 3) << 6) | (((lane >> 4) & 1) << 5) | (((lane >> 5) & 1) << 8); }
constexpr int v_rd_off(int d0, int ks, int half) { return d0 * 512 + ks * 4096 + half * 2048; }
template <int OFF> __device__ __forceinline__ s16x4 tr_read(int vb) {
  s16x4 r; asm volatile("ds_read_b64_tr_b16 %0, %1 offset:%2" : "=&v"(r) : "v"(vb), "i"(OFF) : "memory"); return r;
}
template <int D0> __device__ __forceinline__ void pv_one(f32x16& od, int vb, bf16x8 pa0, bf16x8 pa1, bf16x8 pa2, bf16x8 pa3) {
  const s16x4 l0 = tr_read<v_rd_off(D0, 0, 0)>(vb), h0 = tr_read<v_rd_off(D0, 0, 1)>(vb), l1 = tr_read<v_rd_off(D0, 1, 0)>(vb), h1 = tr_read<v_rd_off(D0, 1, 1)>(vb);
  const s16x4 l2 = tr_read<v_rd_off(D0, 2, 0)>(vb), h2 = tr_read<v_rd_off(D0, 2, 1)>(vb), l3 = tr_read<v_rd_off(D0, 3, 0)>(vb), h3 = tr_read<v_rd_off(D0, 3, 1)>(vb);
  asm volatile("s_waitcnt lgkmcnt(0)" ::: "memory"); SBAR();
#define PK(L, H) (bf16x8){L[0], L[1], L[2], L[3], H[0], H[1], H[2], H[3]}
  od = __builtin_amdgcn_mfma_f32_32x32x16_bf16(pa0, PK(l0, h0), od, 0, 0, 0);
  od = __builtin_amdgcn_mfma_f32_32x32x16_bf16(pa1, PK(l1, h1), od, 0, 0, 0);
  od = __builtin_amdgcn_mfma_f32_32x32x16_bf16(pa2, PK(l2, h2), od, 0, 0, 0);
  od = __builtin_amdgcn_mfma_f32_32x32x16_bf16(pa3, PK(l3, h3), od, 0, 0, 0);
#undef PK
}
__device__ __forceinline__ void pv_d0(f32x16* o, int vb, bf16x8 pa0, bf16x8 pa1, bf16x8 pa2, bf16x8 pa3) {
  pv_one<0>(o[0], vb, pa0, pa1, pa2, pa3); pv_one<1>(o[1], vb, pa0, pa1, pa2, pa3); pv_one<2>(o[2], vb, pa0, pa1, pa2, pa3); pv_one<3>(o[3], vb, pa0, pa1, pa2, pa3);
}
__device__ __forceinline__ void attn_body(const bf16_t* __restrict__ Qb, const bf16_t* __restrict__ Kh, const bf16_t* __restrict__ Vh,
                                          bf16_t* __restrict__ Ob, const bf16_t* __restrict__ AGb, int seq, char* lds) {
  int tid_ = threadIdx.x; asm volatile("" : "+v"(tid_));
  const int tid = tid_, wid = tid >> 6, lane = tid & 63, r32 = lane & 31, hi = lane >> 5;
  bf16_t* V_lds = (bf16_t*)lds; bf16_t* K_lds = (bf16_t*)(lds + 2 * SHM_V);
  float* wsl = (float*)(lds + 2 * SHM_V + 2 * SHM_K) + wid * 64; float* li_l = wsl; float* al_l = wsl + 32;
  float m_reg = -1e30f, l_reg = 0; f32x16 o[4] = {}; bf16x8 qr[8];
  const bf16_t* Qw = Qb + (long)(wid * QBLK + r32) * LDQ + hi * 8;
#pragma unroll
  for (int d0 = 0; d0 < 8; ++d0) qr[d0] = *reinterpret_cast<const bf16x8*>(Qw + d0 * 16);
  const int sr = tid >> 4, sc = (tid & 15) * 8, vst0 = v_st(sr, sc), vst1 = v_st(32 + sr, sc);
  const int vb0 = (int)(uintptr_t)V_lds + v_rd_base(lane);
  const unsigned goff0 = (unsigned)(sr * LDK + sc) * 2u, goff1 = (unsigned)((32 + sr) * LDK + sc) * 2u;
  struct { bf16x8 vs0, vs1, ks0, ks1; } sr_[2];
#define SLOAD(i, k0) do { const char* vt_ = (const char*)Vh + (size_t)(k0) * (LDK * 2); const char* kt_ = (const char*)Kh + (size_t)(k0) * (LDK * 2); \
    sr_[i].vs0 = *reinterpret_cast<const bf16x8*>(vt_ + goff0); sr_[i].vs1 = *reinterpret_cast<const bf16x8*>(vt_ + goff1); \
    sr_[i].ks0 = *reinterpret_cast<const bf16x8*>(kt_ + goff0); sr_[i].ks1 = *reinterpret_cast<const bf16x8*>(kt_ + goff1); } while (0)
#define SWRITE(b, i) do { *(bf16x8*)((char*)V_lds + (b) * SHM_V + vst0) = sr_[i].vs0;          \
    *(bf16x8*)((char*)V_lds + (b) * SHM_V + vst1) = sr_[i].vs1; int kc = sc * 2;               \
    *(bf16x8*)((char*)K_lds + (b) * SHM_K + KSWZ(sr, kc)) = sr_[i].ks0;                       \
    *(bf16x8*)((char*)K_lds + (b) * SHM_K + KSWZ(32 + sr, kc)) = sr_[i].ks1; } while (0)
#define SWAIT() asm volatile("s_waitcnt vmcnt(4)" ::: "memory")
#define RESC(a) do { if (__any((a) < 1.f)) { if (hi == 0) al_l[r32] = (a); asm volatile("s_waitcnt lgkmcnt(0)" ::: "memory"); \
    _Pragma("unroll") for (int d = 0; d < 4; ++d) _Pragma("unroll") for (int r = 0; r < 16; ++r) o[d][r] *= al_l[crow(r, hi)]; } } while (0)
  f32x16 pA0, pA1, pB0, pB1; float mnA, mnB, alA, alB; bf16x8 pa0, pa1, pa2, pa3; const int NT = seq / KVBLK;
  constexpr int SE = 0, SO = 1;
  SLOAD(SE, 0); asm volatile("s_waitcnt vmcnt(0)" ::: "memory"); SWRITE(0, SE); __syncthreads();
  qkt(pA0, pA1, K_lds, qr, r32, hi); partialSM(pA0, pA1, m_reg, mnA, alA);
  SLOAD(SO, KVBLK); if (2 < NT) SLOAD(SE, 2 * KVBLK);
  SWAIT(); SWRITE(1, SO); __syncthreads();
  for (int j = 1; j + 1 < NT; j += 2) {
    SBAR(); qkt(pB0, pB1, (bf16_t*)((char*)K_lds + SHM_K), qr, r32, hi);
    finishSM(pA0, pA1, alA, l_reg, pa0, pa1, pa2, pa3); SBAR();
    SLOAD(SO, (j + 2) * KVBLK); SBAR();
    pv_d0(o, vb0, pa0, pa1, pa2, pa3); partialSM(pB0, pB1, m_reg, mnB, alB);
    __syncthreads(); SWAIT(); SWRITE(0, SE);
    RESC(alB); __syncthreads();
    SBAR(); qkt(pA0, pA1, K_lds, qr, r32, hi);
    finishSM(pB0, pB1, alB, l_reg, pa0, pa1, pa2, pa3); SBAR();
    if (j + 3 < NT) SLOAD(SE, (j + 3) * KVBLK); SBAR();
    pv_d0(o, vb0 + (int)SHM_V, pa0, pa1, pa2, pa3); partialSM(pA0, pA1, m_reg, mnA, alA);
    __syncthreads(); SWAIT(); SWRITE(1, SO);
    RESC(alA); __syncthreads();
  }
  SBAR(); qkt(pB0, pB1, (bf16_t*)((char*)K_lds + SHM_K), qr, r32, hi);
  finishSM(pA0, pA1, alA, l_reg, pa0, pa1, pa2, pa3); SBAR();
  pv_d0(o, vb0, pa0, pa1, pa2, pa3); partialSM(pB0, pB1, m_reg, mnB, alB);
  __syncthreads(); RESC(alB);
  finishSM(pB0, pB1, alB, l_reg, pa0, pa1, pa2, pa3); SBAR();
  pv_d0(o, vb0 + (int)SHM_V, pa0, pa1, pa2, pa3);
  if (hi == 0) li_l[r32] = l_reg; asm volatile("s_waitcnt lgkmcnt(0)" ::: "memory");
  char* Ow = (char*)(Ob + (long)(wid * QBLK) * LDO); const char* Gw = (const char*)(AGb + (long)(wid * QBLK) * LDQ);
  unsigned hv = hi, cv = r32;
  asm volatile("" : "+v"(hv), "+v"(cv));
  const unsigned gbase = (hv * 4u * LDQ + cv) * 2u, obase = (hv * 4u * LDO + cv) * 2u;
  unsigned short gq[16][4];
#pragma unroll
  for (int r = 0; r < 16; ++r) { const int rc = (r & 3) + 8 * (r >> 2); const unsigned go = gbase + (unsigned)(rc * LDQ * 2);
#pragma unroll
    for (int d0 = 0; d0 < 4; ++d0) gq[r][d0] = *(const bf16_t*)(Gw + go + d0 * 64); }
  SBAR();
#pragma unroll
  for (int r = 0; r < 16; ++r) { const int rc = (r & 3) + 8 * (r >> 2); const float rli = __builtin_amdgcn_rcpf(li_l[crow(r, hi)]);
    const unsigned oo = obase + (unsigned)(rc * LDO * 2);
#pragma unroll
    for (int d0 = 0; d0 < 4; ++d0) *(bf16_t*)(Ow + oo + d0 * 64) = f2bf(o[d0][r] * rli * siluf_(bf2f(gq[r][d0]))); }
#undef SLOAD
#undef SWRITE
#undef SWAIT
#undef RESC
}
}

__device__ __forceinline__ void attn_phase(const Params& p, int l, char* lds) {
    unsigned char* ws = p.ws;
    const bf16_t* P = (const bf16_t*)(ws + WS_P); bf16_t* Acat = (bf16_t*)(ws + WS_ACAT);
    const int G = gridDim.x, nunits = 512 + (l < DEPTH - 1 ? 16 : 0);
    for (int U = blockIdx.x; U < nunits; U += G) {
        int h, qrow0, seq;
        if (U < 512) { int qb;
            if (G == 256) { const int xcd = U & 7, j = (U >> 3) & 31, r = U >> 8, kvh = xcd >> 1, idx = (xcd & 1) * 64 + r * 32 + j; h = kvh * 4 + (idx & 3); qb = idx >> 2; }
            else { h = U & 15; qb = U >> 4; }
            qrow0 = CTX + qb * 256; seq = ROWS; }
        else { h = U - 512; qrow0 = 0; seq = CTX; }
        const int kvh = h >> 2;
        att::attn_body(P + (size_t)qrow0 * INC + OQ + h * 128, (const bf16_t*)(ws + WS_KC) + (size_t)kvh * ROWS * 128, (const bf16_t*)(ws + WS_VC) + (size_t)kvh * ROWS * 128,
                       Acat + (size_t)qrow0 * CLD + h * 128, P + (size_t)qrow0 * INC + OAG + h * 128, seq, lds);
        __syncthreads();
    }
}

#define XB_TMO      128
#define XB_XCNT(j)  (256  + 64 * (j))
#define XB_XSUB(j)  (1280 + 64 * (j))
#define XB_XGEN(j)  (2304 + 64 * (j))
#define XB_TOP      3328
#define XB_TOPGEN   3392
#define XCD_BAR_WORDS 3456
#define XB_SPIN_CAP (1u << 18)

__device__ __forceinline__ unsigned xb_ld(unsigned* p)              { return __hip_atomic_load(p, __ATOMIC_RELAXED, __HIP_MEMORY_SCOPE_AGENT); }
__device__ __forceinline__ unsigned xb_add(unsigned* p, unsigned v) { return __hip_atomic_fetch_add(p, v, __ATOMIC_RELAXED, __HIP_MEMORY_SCOPE_AGENT); }
__device__ __forceinline__ unsigned xb_xcc_id() { return (unsigned)__builtin_amdgcn_s_getreg((3 << 11) | 20) & 0xFu; }
#define XB_SPIN(cond, bar) do { unsigned _sp = 0; while (cond) { __builtin_amdgcn_s_sleep(1); \
    if ((++_sp & 255u) == 0u) { if (xb_ld(&(bar)[XB_TMO])) break; if (_sp > XB_SPIN_CAP) { atomicAdd(&(bar)[XB_TMO], 1u); break; } } } } while (0)

struct XcdBarrier {
    unsigned* bar; unsigned x;
    volatile LAS unsigned* st;
};

__device__ __forceinline__ XcdBarrier xcd_barrier_post(unsigned* bar, volatile LAS unsigned* st) {
    XcdBarrier b; b.bar = bar; b.x = xb_xcc_id(); b.st = st;
    if (threadIdx.x == 0) (void)xb_add(&bar[XB_XCNT(b.x)], 1u);
    return b;
}
__device__ __forceinline__ void xcd_barrier_complete(unsigned* bar, unsigned x, unsigned& nloc, unsigned& nx) {
    const unsigned G = gridDim.x * gridDim.y * gridDim.z;
    unsigned sum, cnt, mine, sp = 0u;
    for (;;) {
        sum = 0u; cnt = 0u; mine = 0u;
#pragma unroll
        for (unsigned j = 0; j < 16; ++j) { const unsigned c = xb_ld(&bar[XB_XCNT(j)]); sum += c; cnt += (c > 0u) ? 1u : 0u; mine = (j == x) ? c : mine; }
        if (sum == G) break;
        __builtin_amdgcn_s_sleep(1);
        if ((++sp & 255u) == 0u) { if (xb_ld(&bar[XB_TMO])) break; if (sp > XB_SPIN_CAP) { atomicAdd(&bar[XB_TMO], 1u); break; } }
    }
    nloc = mine > 0u ? mine : 1u; nx = cnt > 0u ? cnt : 1u;
}

__device__ __forceinline__ void xcd_barrier(const XcdBarrier& b) {
    asm volatile("s_waitcnt vmcnt(0)" ::: "memory");
    __syncthreads();
    if (threadIdx.x == 0) {
        unsigned* bar = b.bar;
        __builtin_amdgcn_s_waitcnt(0);
        unsigned nloc = b.st[0], nx = b.st[1];
        if (nloc == 0u) { xcd_barrier_complete(bar, b.x, nloc, nx); b.st[0] = nloc; b.st[1] = nx; }
        const unsigned old = xb_add(&bar[XB_XSUB(b.x)], 1u);
        const unsigned gen = old / nloc;
        if (old + 1u == (gen + 1u) * nloc) {
            __builtin_amdgcn_fence(__ATOMIC_RELEASE, "agent");
            asm volatile("s_waitcnt vmcnt(0)" ::: "memory");
            const unsigned og = xb_add(&bar[XB_TOP], 1u);
            const unsigned tg = og / nx;
            if (og + 1u == (tg + 1u) * nx) xb_add(&bar[XB_TOPGEN], 1u);
            else XB_SPIN(xb_ld(&bar[XB_TOPGEN]) == tg, bar);
            __builtin_amdgcn_fence(__ATOMIC_ACQUIRE, "agent");
            xb_add(&bar[XB_XGEN(b.x)], 1u);
            asm volatile("s_waitcnt vmcnt(0)" ::: "memory");
        } else {
            XB_SPIN(xb_ld(&bar[XB_XGEN(b.x)]) == gen, bar);
            __builtin_amdgcn_fence(__ATOMIC_ACQUIRE, "agent");
            asm volatile("s_waitcnt vmcnt(0)" ::: "memory");
        }
    }
    __syncthreads();
}

__global__ void __launch_bounds__(NTHREADS, 2) mega_fwd(Params p0) {
    extern __shared__ __attribute__((aligned(16))) unsigned char lds[];
    cg::grid_group grid = cg::this_grid();
    volatile LAS unsigned* misc = (volatile LAS unsigned*)((LAS unsigned char*)lds + LDS_STAGE);
    if (threadIdx.x < 16) misc[threadIdx.x] = 0u;
    __syncthreads();
    (void)xcd_barrier_post((unsigned*)(p0.ws + WS_BAR), misc);
#ifndef PHASE_MASK
#define PHASE_MASK 0xFFFF
#endif
#define PH(b) if constexpr ((PHASE_MASK >> (b)) & 1)
#ifndef DBL_MASK
#define DBL_MASK 0
#endif
    PH(10) prep_phase(p0, lds);
    __syncthreads();
    if constexpr ((DBL_MASK >> 10) & 1) { prep_phase(p0, lds); __syncthreads(); }
    grid.sync();
#pragma unroll 1
    for (int l = 0; l < DEPTH; ++l) {
#pragma unroll 1
        for (int slot = 0; slot < 12; ++slot) {
            Params p = p0;
            { unsigned char* w = p.ws; asm volatile("" : "+s"(w)); p.ws = w; }
            bool sync = true;
            LAS unsigned char* L = (LAS unsigned char*)lds;
            const int reps = ((DBL_MASK >> slot) & 1) ? 2 : 1;
#pragma unroll 1
            for (int rep = 0; rep < reps; ++rep) {
            if (rep) __syncthreads();
            switch (slot) {
            case 0: rownorm_phase(p, l); sync = false; break;
            case 1: if (l == 0) gemm_phase(L, G_FOLD, l, p.ws); break;
            case 2: gemm_phase(L, G_IN, l, p.ws); sync = false; break;
            case 3: gemm_phase(L, G_XT, l, p.ws); break;
            case 4: gemm_phase(L, G_F1, l, p.ws); sync = false; break;
            case 5: gemm_phase(L, G_DFTC, l, p.ws); break;
            case 6: ew_phase(p, l); break;
            case 7: case 8: sync = false; break;
            case 9: {
                const int cb = (int)blockIdx.x, Gn = (int)gridDim.x;
                unsigned* c2 = (unsigned*)(p.ws + WS_BAR) + 3540;
                const unsigned target = (unsigned)(Gn - 148) * (unsigned)(l + 1);
                if (cb >= 16 && cb < Gn - 132) {
                    gemm_phase(L, G_F2, l, p.ws);
                    __syncthreads();
                    if (threadIdx.x == 0) { __builtin_amdgcn_fence(__ATOMIC_RELEASE, "agent"); asm volatile("s_waitcnt vmcnt(0)" ::: "memory");
                        __hip_atomic_fetch_add(c2, 1u, __ATOMIC_RELAXED, __HIP_MEMORY_SCOPE_AGENT); }
                    __syncthreads();
                }
                attn_phase(p, l, (char*)lds);
                __syncthreads();
                if (cb >= Gn - 132) {
                    if (threadIdx.x == 0) { unsigned sp = 0;
                        while (__hip_atomic_load(c2, __ATOMIC_RELAXED, __HIP_MEMORY_SCOPE_AGENT) < target) { __builtin_amdgcn_s_sleep(1); if (++sp > (1u << 22)) break; }
                        __builtin_amdgcn_fence(__ATOMIC_ACQUIRE, "agent"); asm volatile("s_waitcnt vmcnt(0)" ::: "memory"); }
                    __syncthreads();
                    gemm_phase(L, G_MIX, l, p.ws);
                }
                break; }
            case 10: gemm_phase(L, G_MERGE, l, p.ws); __syncthreads(); gemm_phase(L, G_MERGEC, l, p.ws); break;
            default: {
                const bool hasctx = l < DEPTH - 1;
                unsigned* ccnt = (unsigned*)(p.ws + WS_BAR) + 3500;
                if (hasctx) {
                    int t0_ = threadIdx.x; asm volatile("" : "+v"(t0_));
                    const int idx = (int)blockIdx.x * NTHREADS + t0_, r = idx >> 9, cc = (idx & 511) * 4;
                    const float* mp = (const float*)(p.ws + WS_MP); bf16_t* mb = (bf16_t*)(p.ws + WS_MB);
                    f32x4 s = *(const f32x4*)(mp + (size_t)r * MLD + cc);
#pragma unroll
                    for (int q = 1; q < 8; ++q) s += *(const f32x4*)(mp + ((size_t)q * CTX + r) * MLD + cc);
                    u32x2 w; w.x = cvtpk(s[0], s[1]); w.y = cvtpk(s[2], s[3]); *(u32x2*)(mb + (size_t)r * DM + cc) = w;
                    asm volatile("s_waitcnt vmcnt(0)" ::: "memory"); __syncthreads();
                    if (threadIdx.x == 0) { __builtin_amdgcn_fence(__ATOMIC_RELEASE, "agent"); asm volatile("s_waitcnt vmcnt(0)" ::: "memory");
                        __hip_atomic_fetch_add(ccnt, 1u, __ATOMIC_RELAXED, __HIP_MEMORY_SCOPE_AGENT); }
                }
                const int nv = (hasctx && (int)blockIdx.x >= (int)gridDim.x - 32) ? 2 : 1;
#pragma unroll 1
                for (int v = 0; v < nv; ++v) {
                    if (v) {
                        __syncthreads();
                        if (threadIdx.x == 0) { const unsigned target = (unsigned)(l + 1) * gridDim.x; unsigned sp = 0;
                            while (__hip_atomic_load(ccnt, __ATOMIC_RELAXED, __HIP_MEMORY_SCOPE_AGENT) < target) { __builtin_amdgcn_s_sleep(1); if (++sp > (1u << 22)) break; }
                            __builtin_amdgcn_fence(__ATOMIC_ACQUIRE, "agent"); asm volatile("s_waitcnt vmcnt(0)" ::: "memory"); }
                        __syncthreads();
                    }
                    gemm_phase(L, G_OUT, l | (v << 4), p.ws);
                }
                break; }
            }
            }
            __syncthreads();
            if (sync) { XcdBarrier xb; xb.bar = (unsigned*)(p.ws + WS_BAR); xb.x = xb_xcc_id(); xb.st = (volatile LAS unsigned*)((LAS unsigned char*)lds + LDS_STAGE); xcd_barrier(xb); }
        }
    }
    PH(0) rownorm_phase(p0, DEPTH);
}

extern "C" void kernel_launch(void* const* d_in, const int* in_sizes, int n_in, void* d_out, int out_size, void* d_ws, size_t ws_size, hipStream_t stream) {
    static int grid_blocks = 0;
    if (grid_blocks == 0) {
        if (n_in != 18 || out_size != SEQ * DM || ws_size < WS_END) { fprintf(stderr, "kernel_launch: unexpected shapes: n_in %d out %d ws %zu (need %zu)\n", n_in, out_size, ws_size, (size_t)WS_END); grid_blocks = -1; return; }
        int dev = 0, cus = 0, per_cu = 0;
        hipGetDevice(&dev);
        hipDeviceGetAttribute(&cus, hipDeviceAttributeMultiprocessorCount, dev);
        if (hipFuncSetAttribute((const void*)mega_fwd, hipFuncAttributeMaxDynamicSharedMemorySize, LDS_BYTES) != hipSuccess) { fprintf(stderr, "kernel_launch: hipFuncSetAttribute failed\n"); grid_blocks = -1; return; }
        if (hipOccupancyMaxActiveBlocksPerMultiprocessor(&per_cu, (const void*)mega_fwd, NTHREADS, LDS_BYTES) != hipSuccess || per_cu < 1) { fprintf(stderr, "kernel_launch: occupancy query gave %d\n", per_cu); per_cu = 1; }
        (void)hipGetLastError();
        grid_blocks = cus * (per_cu > 1 ? 1 : per_cu);
        if (grid_blocks > 256) grid_blocks = 256;
        grid_blocks &= ~7;
        if (grid_blocks != 256) { fprintf(stderr, "kernel_launch: this kernel is laid out for 256 resident workgroups, got %d\n", grid_blocks); grid_blocks = -1; return; }
    }
    if (grid_blocks <= 0) return;
    Params p{};
    for (int i = 0; i < 18; ++i) p.in[i] = (const float*)d_in[i];
    p.out = (float*)d_out; p.ws = (unsigned char*)d_ws;
    if (hipMemsetAsync((char*)d_ws + WS_BAR, 0, BAR_BYTES, stream) != hipSuccess) { fprintf(stderr, "kernel_launch: memset of barrier words failed\n"); return; }
    void* args[] = {&p};
    hipError_t e = hipLaunchCooperativeKernel((const void*)mega_fwd, dim3(grid_blocks), dim3(NTHREADS), args, LDS_BYTES, stream);
    if (e != hipSuccess) fprintf(stderr, "cooperative launch failed: %s (grid %d)\n", hipGetErrorString(e), grid_blocks);
}
```

```cpp
#include <hip/hip_runtime.h>
#include <hip/hip_cooperative_groups.h>
#include <cstdio>
#include <cstdint>
namespace cg = cooperative_groups;

#define LAS __attribute__((address_space(3)))
typedef unsigned short bf16_t;
typedef short bf16x8 __attribute__((ext_vector_type(8)));
typedef short s16x4 __attribute__((ext_vector_type(4)));
typedef float f32x4 __attribute__((ext_vector_type(4)));
typedef float f32x16 __attribute__((ext_vector_type(16)));
typedef unsigned u32x4 __attribute__((ext_vector_type(4)));
typedef unsigned u32x2 __attribute__((ext_vector_type(2)));

constexpr int DM = 2048, SEQ = 8192, CTX = 256, ROWS = SEQ + CTX, DEPTH = 4, INC = 17408;
constexpr int OQ = 0, OKK = 2048, OV = 2560, OAG = 3072, OFX = 5120, OFG = 6144, OCX = 7168, OCB = 8192, OCC = 9216, OCG = 10240, OML = 11264;
constexpr float EPS = 1e-6f;
constexpr size_t APL = (size_t)(SEQ + CTX) * 2048, WPL = (size_t)2048 * 2048;
constexpr int CLD = 2048;
constexpr int MLD = 2048 + 64;
constexpr int ZCH = 32768 + 256;
constexpr int LDS_STAGE = 131072, LDS_BYTES = LDS_STAGE + 64;
constexpr int NTHREADS = 512;

constexpr size_t SZ_WINT = (size_t)INC * DM * 2, SZ_WCAT = 3 * WPL * 2, SZ_WOUT = (size_t)DM * DM * 2, SZ_WMIXR = (size_t)1024 * 1024 * 2, SZ_WMIX = (size_t)1024 * 2048 * 2;
constexpr size_t WS_WINT = 0;
constexpr size_t WS_WCAT = WS_WINT + DEPTH * SZ_WINT;
constexpr size_t WS_WOUT = WS_WCAT + DEPTH * SZ_WCAT;
constexpr size_t WS_WMIXR = WS_WOUT + DEPTH * SZ_WOUT;
constexpr size_t WS_WMIX = WS_WMIXR + DEPTH * SZ_WMIXR;
constexpr size_t WS_TCH = WS_WMIX + DEPTH * SZ_WMIX;
constexpr size_t WS_ZT = WS_TCH + 512 * 256 * 2;
constexpr size_t WS_T1 = WS_ZT + (size_t)1024 * ZCH;
constexpr size_t WS_A2 = WS_T1 + 256 * 128 * 2;
constexpr size_t WS_ACTX = WS_A2 + 256 * 256 * 2;
constexpr size_t WS_ROPE = WS_ACTX + 512 * 256 * 2;
constexpr size_t WS_MOD = WS_ROPE + 128 * 32 * 8;
constexpr size_t WS_XS = WS_MOD + 4 * 2 * 6144 * 4;
constexpr size_t WS_H = WS_XS + (size_t)ROWS * DM * 4;
constexpr size_t WS_P = WS_H + (size_t)ROWS * DM * 2;
constexpr size_t WS_XT = WS_P + (size_t)ROWS * INC * 2;
constexpr size_t WS_PQ = WS_XT + (size_t)1024 * ROWS * 2;
constexpr size_t WS_ACAT = WS_PQ + (size_t)ROWS * DM * 2;
constexpr size_t WS_MBUF = WS_ACAT + 3 * APL * 2;
constexpr size_t WS_MB = WS_MBUF + (size_t)ROWS * MLD * 4;
constexpr size_t WS_OUTB = WS_MB + (size_t)ROWS * DM * 2;
constexpr size_t WS_KC = WS_OUTB + (size_t)ROWS * DM * 4;
constexpr size_t WS_VC = WS_KC + (size_t)4 * ROWS * 128 * 2;
constexpr size_t WS_MP = WS_VC + (size_t)4 * ROWS * 128 * 2;
constexpr size_t WS_OUTP = WS_MP + (size_t)8 * CTX * MLD * 4;
constexpr size_t WS_BAR = WS_OUTP + (size_t)4 * CTX * DM * 4;
constexpr size_t BAR_BYTES = 16384;
constexpr size_t WS_END = WS_BAR + BAR_BYTES;

struct Params { const float* in[18]; float* out; unsigned char* ws; };
enum { I_X = 0, I_C, I_CTX, I_CCTX, I_WMOD, I_BMOD, I_GPRE, I_GPOST, I_WIN, I_QN, I_KN, I_WAO, I_WFM, I_WFO, I_CW, I_CB, I_WCO, I_WOUT };

__device__ __forceinline__ unsigned cvtpk(float lo, float hi) { unsigned r; asm volatile("v_cvt_pk_bf16_f32 %0, %1, %2" : "=v"(r) : "v"(lo), "v"(hi)); return r; }
__device__ __forceinline__ float bf2f(unsigned short b) { return __uint_as_float(((unsigned)b) << 16); }
__device__ __forceinline__ float bflo(unsigned w) { return __uint_as_float(w << 16); }
__device__ __forceinline__ float bfhi(unsigned w) { return __uint_as_float(w & 0xffff0000u); }
__device__ __forceinline__ unsigned short f2bf(float f) { return (unsigned short)(cvtpk(f, f) & 0xffffu); }
__device__ __forceinline__ float sigmoidf_(float x) { return __builtin_amdgcn_rcpf(1.0f + __expf(-x)); }
__device__ __forceinline__ float siluf_(float x) { return x * sigmoidf_(x); }
__device__ __forceinline__ float wave_sum(float v) {
#pragma unroll
    for (int o = 32; o >= 1; o >>= 1) v += __shfl_xor(v, o);
    return v;
}

__device__ __forceinline__ void prep_phase(const Params& p, unsigned char* lds_g) {
    int tid_ = threadIdx.x; asm volatile("" : "+v"(tid_));
    const int tid = tid_, G = gridDim.x, bid = blockIdx.x;
    unsigned char* ws = p.ws;
    float* tile = (float*)lds_g;
    constexpr int T_IN = 32 * 272, T_AO = 32 * 32, T_FO = 16 * 32, T_CO = 16 * 32, T_OUT = 32 * 32, T_MIX = 16 * 16;
    constexpr int T_LAYER = T_IN + T_AO + T_FO + T_CO + T_OUT + T_MIX;
    for (int t = bid; t < DEPTH * T_LAYER; t += G) {
        const int l = t / T_LAYER; int r = t % T_LAYER;
        const float* src; int ldsrc; bf16_t* dst; int lddst; int ktiles;
        if (r < T_IN) { src = p.in[I_WIN] + (size_t)l * DM * INC; ldsrc = INC; dst = (bf16_t*)(ws + WS_WINT + l * SZ_WINT); lddst = DM; ktiles = 32; }
        else if ((r -= T_IN) < T_AO) { src = p.in[I_WAO] + (size_t)l * DM * DM; ldsrc = DM; dst = (bf16_t*)(ws + WS_WCAT + l * SZ_WCAT); lddst = CLD; ktiles = 32; }
        else if ((r -= T_AO) < T_FO) { src = p.in[I_WFO] + (size_t)l * 1024 * DM; ldsrc = DM; dst = (bf16_t*)(ws + WS_WCAT + l * SZ_WCAT) + WPL; lddst = CLD; ktiles = 16; }
        else if ((r -= T_FO) < T_CO) { src = p.in[I_WCO] + (size_t)l * 1024 * DM; ldsrc = DM; dst = (bf16_t*)(ws + WS_WCAT + l * SZ_WCAT) + 2 * WPL; lddst = CLD; ktiles = 16; }
        else if ((r -= T_CO) < T_OUT) { src = p.in[I_WOUT] + (size_t)l * DM * DM; ldsrc = DM; dst = (bf16_t*)(ws + WS_WOUT + l * SZ_WOUT); lddst = DM; ktiles = 32; }
        else { r -= T_OUT; src = p.in[I_WFM] + (size_t)l * 1024 * 1024; ldsrc = 1024; dst = (bf16_t*)(ws + WS_WMIXR + l * SZ_WMIXR); lddst = 1024; ktiles = 16; }
        const int k0 = (r % ktiles) * 64, n0 = (r / ktiles) * 64;
        { const int ty = tid >> 4, tx = tid & 15;
#pragma unroll
          for (int ps = 0; ps < 2; ++ps) { const int kk = ty + 32 * ps;
              const f32x4 v = *(const f32x4*)(src + (size_t)(k0 + kk) * ldsrc + n0 + tx * 4);
              tile[kk * 65 + tx * 4 + 0] = v[0]; tile[kk * 65 + tx * 4 + 1] = v[1]; tile[kk * 65 + tx * 4 + 2] = v[2]; tile[kk * 65 + tx * 4 + 3] = v[3]; } }
        __syncthreads();
        { const int n = tid >> 3, kc = (tid & 7) * 8; u32x4 w;
          w.x = cvtpk(tile[(kc + 0) * 65 + n], tile[(kc + 1) * 65 + n]); w.y = cvtpk(tile[(kc + 2) * 65 + n], tile[(kc + 3) * 65 + n]);
          w.z = cvtpk(tile[(kc + 4) * 65 + n], tile[(kc + 5) * 65 + n]); w.w = cvtpk(tile[(kc + 6) * 65 + n], tile[(kc + 7) * 65 + n]);
          *(u32x4*)(dst + (size_t)(n0 + n) * lddst + k0 + kc) = w; }
        __syncthreads();
    }
    {
        float* sc = (float*)lds_g;
        float* red = sc + 4096;
        for (int u = bid; u < 256; u += G) {
            for (int k = tid; k < 4096; k += NTHREADS) { const float cv = (k < 2048) ? p.in[I_C][k] : p.in[I_CCTX][k - 2048]; sc[k] = siluf_(cv); }
            __syncthreads();
            const int l = u >> 6, j0 = (u & 63) * 96;
            if (tid < 504) { const int kg = tid / 24, cq = tid % 24;
                f32x4 al = {0.f, 0.f, 0.f, 0.f}, ac = {0.f, 0.f, 0.f, 0.f};
                const float* wp = p.in[I_WMOD] + (size_t)l * DM * 6144 + j0 + cq * 4;
                for (int k = kg; k < 2048; k += 21) { const f32x4 w = *(const f32x4*)(wp + (size_t)k * 6144); al += sc[k] * w; ac += sc[2048 + k] * w; }
                float* rp = red + (kg * 24 + cq) * 8;
                rp[0] = al[0]; rp[1] = al[1]; rp[2] = al[2]; rp[3] = al[3]; rp[4] = ac[0]; rp[5] = ac[1]; rp[6] = ac[2]; rp[7] = ac[3]; }
            __syncthreads();
            if (tid < 192) { const int v = tid / 96, col = tid % 96, cq = col >> 2, e = col & 3; float s = 0.f;
                for (int kg = 0; kg < 21; ++kg) s += red[(kg * 24 + cq) * 8 + v * 4 + e];
                ((float*)(ws + WS_MOD))[(size_t)(l * 2 + v) * 6144 + j0 + col] = s + p.in[I_BMOD][(size_t)l * 6144 + j0 + col]; }
            __syncthreads();
        }
    }
    const long gt = (long)bid * NTHREADS + tid, gn = (long)G * NTHREADS;
    for (long it = gt; it < 256 * 16; it += gn) { const int r = (int)(it >> 4), s0 = (int)(it & 15) * 8, k1 = r >> 1, ri = r & 1;
        float v[8];
#pragma unroll
        for (int j = 0; j < 8; ++j) { const int ph = (k1 * (s0 + j)) & 127; const float x = (float)ph * (1.0f / 128.0f); v[j] = (ri ? -__builtin_amdgcn_sinf(x) : __builtin_amdgcn_cosf(x)) * 0.08838834764831845f; }
        u32x4 w; w.x = cvtpk(v[0], v[1]); w.y = cvtpk(v[2], v[3]); w.z = cvtpk(v[4], v[5]); w.w = cvtpk(v[6], v[7]);
        *(u32x4*)((bf16_t*)(ws + WS_T1) + (size_t)r * 128 + s0) = w; }
    for (long it = gt; it < 256 * 32; it += gn) { const int rr = (int)(it >> 5), c0 = (int)(it & 31) * 8, kb = rr >> 7, pq = (rr >> 6) & 1, k2 = rr & 63;
        float v[8];
#pragma unroll
        for (int j = 0; j < 8; ++j) { const int cc = c0 + j, s2 = cc >> 2, kbc = (cc >> 1) & 1, ri = cc & 1;     const int ph = (k2 * s2) & 63; const float x = (float)ph * (1.0f / 64.0f);
            const float cs = __builtin_amdgcn_cosf(x), sn = __builtin_amdgcn_sinf(x);
            const float val = pq == 0 ? (ri == 0 ? cs : sn) : (ri == 0 ? sn : -cs);
            v[j] = (kb == kbc) ? val * 0.125f : 0.f; }
        u32x4 w; w.x = cvtpk(v[0], v[1]); w.y = cvtpk(v[2], v[3]); w.z = cvtpk(v[4], v[5]); w.w = cvtpk(v[6], v[7]);
        *(u32x4*)((bf16_t*)(ws + WS_A2) + (size_t)rr * 256 + c0) = w; }
    for (long it = gt; it < 2 * 512 * 32; it += gn) { const int which = (int)(it >> 14), rr = (int)(it & 16383), r = rr >> 5, s0 = (rr & 31) * 8, k = r & 255; const bool isin = r >= 256;
        bf16_t* A = (bf16_t*)(ws + (which ? WS_TCH : WS_ACTX)); const float sgn = (which && isin) ? -0.0625f : 0.0625f;
        float v[8];
#pragma unroll
        for (int j = 0; j < 8; ++j) { const int ph = (k * (s0 + j)) & 255; const float x = (float)ph * (1.0f / 256.0f); v[j] = (isin ? __builtin_amdgcn_sinf(x) : __builtin_amdgcn_cosf(x)) * sgn; }
        u32x4 w; w.x = cvtpk(v[0], v[1]); w.y = cvtpk(v[2], v[3]); w.z = cvtpk(v[4], v[5]); w.w = cvtpk(v[6], v[7]);
        *(u32x4*)(A + (size_t)r * 256 + s0) = w; }
    for (long it = gt; it < 128 * 32; it += gn) { const int pos = (int)(it >> 5), i = (int)(it & 31);
        const float freq = exp2f(-(float)i * (13.287712379549449f / 32.0f));
        const float ang = (float)pos * freq;
        double rev = (double)ang * 0.15915494309189535; rev -= floor(rev);
        const float xr = (float)rev;
        float2 cs; cs.x = __builtin_amdgcn_cosf(xr); cs.y = __builtin_amdgcn_sinf(xr);
        ((float2*)(ws + WS_ROPE))[it] = cs; }
}

__device__ __forceinline__ void rownorm_phase(const Params& p, int l) {
    int tid_ = threadIdx.x; asm volatile("" : "+v"(tid_));
    const int tid = tid_, lane = tid & 63, wid = tid >> 6;
    unsigned char* ws = p.ws;
    const int gw = blockIdx.x * 8 + wid, nw = gridDim.x * 8;
    const float* mod = (const float*)(ws + WS_MOD);
    for (int row = gw; row < ROWS; row += nw) {
        const int isctx = row < CTX ? 1 : 0;
        if (l == 4 && isctx) continue;
        float* xrow = (float*)(ws + WS_XS) + (size_t)row * DM;
        const float* xsrc = (l <= 1) ? (isctx ? p.in[I_CTX] + (size_t)row * DM : p.in[I_X] + (size_t)(row - CTX) * DM) : xrow;
        f32x4 xv[8];
#pragma unroll
        for (int i = 0; i < 8; ++i) xv[i] = __builtin_nontemporal_load((const f32x4*)(xsrc + lane * 4 + i * 256));
        if (l > 0) {
            const bf16_t* orow = (const bf16_t*)(ws + WS_OUTB) + (size_t)row * DM;
            f32x4 ov[8]; float ss = 0.f;
#pragma unroll
            for (int i = 0; i < 8; ++i) {
                if (isctx) { const float* pp = (const float*)(ws + WS_OUTP) + (size_t)row * DM + lane * 4 + i * 256;
                    ov[i] = (*(const f32x4*)pp + *(const f32x4*)(pp + (size_t)CTX * DM)) + (*(const f32x4*)(pp + (size_t)2 * CTX * DM) + *(const f32x4*)(pp + (size_t)3 * CTX * DM)); }
                else { const u32x2 w = __builtin_nontemporal_load((const u32x2*)(orow + lane * 4 + i * 256)); ov[i] = (f32x4){bflo(w.x), bfhi(w.x), bflo(w.y), bfhi(w.y)}; }
                ss += ov[i][0] * ov[i][0] + ov[i][1] * ov[i][1] + ov[i][2] * ov[i][2] + ov[i][3] * ov[i][3]; }
            ss = wave_sum(ss);
            const float rstd = rsqrtf(ss * (1.0f / DM) + EPS);
            const float* gate = mod + (size_t)((l - 1) * 2 + isctx) * 6144 + 4096;
            const float* gpost = p.in[I_GPOST] + (size_t)(l - 1) * DM;
#pragma unroll
            for (int i = 0; i < 8; ++i) { const f32x4 g = *(const f32x4*)(gate + lane * 4 + i * 256), gp = *(const f32x4*)(gpost + lane * 4 + i * 256);
                xv[i] = xv[i] + g * ((ov[i] * rstd) * gp); }
            if (l == 4) { float* orow2 = p.out + (size_t)(row - CTX) * DM;
#pragma unroll
                for (int i = 0; i < 8; ++i) *(f32x4*)(orow2 + lane * 4 + i * 256) = xv[i];
                continue; }
        }
        float ss = 0.f;
#pragma unroll
        for (int i = 0; i < 8; ++i) ss += xv[i][0] * xv[i][0] + xv[i][1] * xv[i][1] + xv[i][2] * xv[i][2] + xv[i][3] * xv[i][3];
        ss = wave_sum(ss);
        const float rstd = rsqrtf(ss * (1.0f / DM) + EPS);
        const float* ml = mod + (size_t)(l * 2 + isctx) * 6144;
        const float* gpre = p.in[I_GPRE] + (size_t)l * DM;
        bf16_t* hrow = (bf16_t*)(ws + WS_H) + (size_t)row * DM;
        f32x4 sh[8], scl[8], gp[8];
#pragma unroll
        for (int i = 0; i < 8; ++i) { const int c = lane * 4 + i * 256; sh[i] = *(const f32x4*)(ml + c); scl[i] = *(const f32x4*)(ml + 2048 + c); gp[i] = *(const f32x4*)(gpre + c); }
        __builtin_amdgcn_sched_barrier(0);
        if (l > 0) {
#pragma unroll
            for (int i = 0; i < 8; ++i) *(f32x4*)(xrow + lane * 4 + i * 256) = xv[i];
        }
#pragma unroll
        for (int i = 0; i < 8; ++i) { const int c = lane * 4 + i * 256;
            const f32x4 hv = ((xv[i] * rstd) * gp[i]) * (1.0f + scl[i]) + sh[i];
            u32x2 w; w.x = cvtpk(hv[0], hv[1]); w.y = cvtpk(hv[2], hv[3]);
            *(u32x2*)(hrow + c) = w; }
    }
}

__device__ __forceinline__ void ew_phase(const Params& p, int l) {
    int tid_ = threadIdx.x; asm volatile("" : "+v"(tid_));
    const int tid = tid_;
    unsigned char* ws = p.ws;
    bf16_t* P = (bf16_t*)(ws + WS_P);
    {
        const int t = tid & 15; const long grp = ((long)blockIdx.x * NTHREADS + tid) >> 4, ngrp = (long)gridDim.x * NTHREADS / 16;
        const float2* rope = (const float2*)(ws + WS_ROPE);
        const int base = ((t & 8) ? 64 : 0) + 4 * (t & 7), fi = 4 * (t & 7);
        bf16_t* KC = (bf16_t*)(ws + WS_KC);
#pragma unroll 2
        for (long it = grp; it < (long)ROWS * 20; it += ngrp) { const int row = (int)(it / 20), head = (int)(it % 20);
            const bf16_t* src_ = P + (size_t)row * INC + (head < 16 ? OQ + head * 128 : OKK + (head - 16) * 128) + base;
            bf16_t* dst_ = (head < 16) ? (P + (size_t)row * INC + OQ + head * 128 + base) : (KC + ((size_t)(head - 16) * ROWS + row) * 128 + base);
            const float* gn = (head < 16 ? p.in[I_QN] : p.in[I_KN]) + (size_t)l * 128 + base;
            const u32x2 wa = *(const u32x2*)src_, wb = *(const u32x2*)(src_ + 32);
            const f32x4 ga = *(const f32x4*)gn, gb = *(const f32x4*)(gn + 32);
            float a[4] = {bflo(wa.x), bfhi(wa.x), bflo(wa.y), bfhi(wa.y)}, b[4] = {bflo(wb.x), bfhi(wb.x), bflo(wb.y), bfhi(wb.y)};
            float ss = 0.f;
#pragma unroll
            for (int q = 0; q < 4; ++q) ss += a[q] * a[q] + b[q] * b[q];
#pragma unroll
            for (int o = 8; o >= 1; o >>= 1) ss += __shfl_xor(ss, o);
            const float rstd = rsqrtf(ss * (1.0f / 128.0f) + EPS);
#pragma unroll
            for (int q = 0; q < 4; ++q) { a[q] = a[q] * rstd * ga[q]; b[q] = b[q] * rstd * gb[q]; }
            if (row >= CTX) { const int tk = row - CTX, pos = (t & 8) ? (tk & 63) : (tk >> 6);
                const f32x4 r01 = *(const f32x4*)(rope + pos * 32 + fi), r23 = *(const f32x4*)(rope + pos * 32 + fi + 2);
                const float cs[4] = {r01[0], r01[2], r23[0], r23[2]}, sn[4] = {r01[1], r01[3], r23[1], r23[3]};
#pragma unroll
                for (int q = 0; q < 4; ++q) { const float x0 = a[q], x1 = b[q]; a[q] = x0 * cs[q] - x1 * sn[q]; b[q] = x0 * sn[q] + x1 * cs[q]; } }
            u32x2 oa, ob; oa.x = cvtpk(a[0], a[1]); oa.y = cvtpk(a[2], a[3]); ob.x = cvtpk(b[0], b[1]); ob.y = cvtpk(b[2], b[3]);
            *(u32x2*)dst_ = oa; *(u32x2*)(dst_ + 32) = ob;
        }
    }
    {
        const long gt = (long)blockIdx.x * NTHREADS + tid, gn = (long)gridDim.x * NTHREADS;
        bf16_t* VC = (bf16_t*)(ws + WS_VC);
        for (long it = gt; it < (long)ROWS * 64; it += gn) { const int row = (int)(it >> 6), c = (int)(it & 63) * 8;
            const u32x4 v = *(const u32x4*)(P + (size_t)row * INC + OV + c);
            *(u32x4*)(VC + ((size_t)(c >> 7) * ROWS + row) * 128 + (c & 127)) = v; }
    }
    {
        const long gt = (long)blockIdx.x * NTHREADS + tid, gn = (long)gridDim.x * NTHREADS;
        bf16_t* Acat = (bf16_t*)(ws + WS_ACAT);
        const float* cw = p.in[I_CW] + (size_t)l * 3 * 1024; const float* cbias = p.in[I_CB] + (size_t)l * 1024;
        for (long it = gt; it < (long)(ROWS / 4) * 128; it += gn) { const int row0 = (int)(it >> 7) * 4, c0 = (int)(it & 127) * 8;
            const bf16_t* pr = P + (size_t)row0 * INC;
            const bool hp = (row0 != 0) && (row0 != CTX), hn = (row0 + 4 != CTX) && (row0 + 4 != ROWS);
            const u32x4 z = {0u, 0u, 0u, 0u};
            u32x4 xv[6], kv[6], bb[4], gg[4];
            xv[0] = hp ? *(const u32x4*)(pr - INC + OCX + c0) : z; kv[0] = hp ? *(const u32x4*)(pr - INC + OCC + c0) : z;
#pragma unroll
            for (int r = 0; r < 4; ++r) { xv[r + 1] = *(const u32x4*)(pr + (size_t)r * INC + OCX + c0); kv[r + 1] = *(const u32x4*)(pr + (size_t)r * INC + OCC + c0);
                bb[r] = *(const u32x4*)(pr + (size_t)r * INC + OCB + c0); gg[r] = *(const u32x4*)(pr + (size_t)r * INC + OCG + c0); }
            xv[5] = hn ? *(const u32x4*)(pr + (size_t)4 * INC + OCX + c0) : z; kv[5] = hn ? *(const u32x4*)(pr + (size_t)4 * INC + OCC + c0) : z;
            float w0[8], w1[8], w2[8], bs[8];
#pragma unroll
            for (int j = 0; j < 8; ++j) { w0[j] = cw[c0 + j]; w1[j] = cw[1024 + c0 + j]; w2[j] = cw[2048 + c0 + j]; bs[j] = cbias[c0 + j]; }
            float uu[6][8];
#pragma unroll
            for (int r = 0; r < 6; ++r)
#pragma unroll
                for (int q = 0; q < 4; ++q) { uu[r][2 * q] = bflo(xv[r][q]) * bflo(kv[r][q]); uu[r][2 * q + 1] = bfhi(xv[r][q]) * bfhi(kv[r][q]); }
#pragma unroll
            for (int r = 0; r < 4; ++r) { float res[8];
#pragma unroll
                for (int q = 0; q < 4; ++q) {
                    { const int j = 2 * q; const float cv = uu[r][j] * w0[j] + uu[r + 1][j] * w1[j] + uu[r + 2][j] * w2[j] + bs[j]; res[j] = bflo(bb[r][q]) * cv * siluf_(bflo(gg[r][q])); }
                    { const int j = 2 * q + 1; const float cv = uu[r][j] * w0[j] + uu[r + 1][j] * w1[j] + uu[r + 2][j] * w2[j] + bs[j]; res[j] = bfhi(bb[r][q]) * cv * siluf_(bfhi(gg[r][q])); } }
                u32x4 w; w.x = cvtpk(res[0], res[1]); w.y = cvtpk(res[2], res[3]); w.z = cvtpk(res[4], res[5]); w.w = cvtpk(res[6], res[7]);
                *(u32x4*)(Acat + 2 * APL + (size_t)(row0 + r) * CLD + c0) = w; }
        }
    }
}

constexpr int BM = 256, BK = 64, HALF = 128, HTB = HALF * BK * 2;
constexpr int BJC = 32;
__device__ __forceinline__ int lds_byte(int r, int c) { const int st = (r >> 4) * 2 + (c >> 5), rr = r & 15, cc = c & 31, ob = rr * 64 + cc * 2; return st * 1024 + (ob ^ (((ob >> 9) & 1) << 5)); }
__device__ __forceinline__ void stage_rc(int b, int& R, int& C) { const int st = b / 1024, sb = b % 1024, swz = sb ^ (((sb >> 9) & 1) << 5); R = (st >> 1) * 16 + swz / 64; C = (st & 1) * 32 + (swz % 64) / 2; }
__device__ __forceinline__ int perm32(int rho) { const int n = rho >> 4, i = rho & 15; return 8 * (i >> 2) + 4 * n + (i & 3); }

enum { G_FOLD = 0, G_IN, G_XT, G_F1, G_F2, G_DFTC, G_MIX, G_MERGE, G_OUT, G_MERGEC };
enum { M_BF16 = 0, M_MIX, M_MERGE0, M_MERGE1, M_MERGE2, M_F32, M_F1, M_F2, M_MG0, M_MG1, M_MG2 };
struct Unit { const char* a; const char* b; char* o; const char* aux; char* m; int nt, mode, ldo; };

__device__ __forceinline__ void static_order(int w, int nM, int nN, int& pm, int& pn) {
    const int nwg = nM * nN, q = nwg / 8, r = nwg % 8, xcd = w % 8, off = w / 8;
    const int wg = (xcd < r ? xcd * (q + 1) : r * (q + 1) + (xcd - r) * q) + off;
    const int nig = 8 * nN, gid = wg / nig, fm = gid * 8, gsz = (nM - fm) < 8 ? (nM - fm) : 8;
    pm = fm + ((wg % nig) % gsz); pn = (wg % nig) / gsz;
}

__device__ __forceinline__ bool get_unit(int gid, int l, int i, unsigned char* ws, Unit& u) {
    const int G = gridDim.x, c = blockIdx.x;
    u.aux = nullptr; u.m = nullptr;
    switch (gid) {
    case G_FOLD: { const int L = i * G + c; if (L >= 128) return false;
        const int ll = L >> 5, g = (L >> 3) & 3, pm = (L >> 1) & 3, pnn = L & 1;
        u.a = (const char*)(ws + WS_WMIXR + ll * SZ_WMIXR) + ((size_t)pm * 256 * 1024 + g * 256) * 2;
        u.b = (const char*)(ws + WS_TCH) + (size_t)pnn * 256 * 256 * 2;
        u.o = (char*)(ws + WS_WMIX + ll * SZ_WMIX) + ((size_t)pm * 256 * 2048 + pnn * 1024 + g * 256) * 2;
        u.nt = 4; u.mode = M_BF16; u.ldo = 2048; return true; }
    case G_IN: { const int L = i * G + c; if (L >= 2116) return false;
        if (L < 2112) { int pm, pn; static_order(L, 33, 64, pm, pn); const int pnp = pn < 20 ? pn : pn + 4;
            u.a = (const char*)(ws + WS_H) + (size_t)pm * 256 * DM * 2;
            u.b = (const char*)(ws + WS_WINT + l * SZ_WINT) + (size_t)pnp * 256 * DM * 2;
            u.o = (char*)(ws + WS_P) + ((size_t)pm * 256 * INC + pnp * 256) * 2; u.ldo = INC; }
        else { const int pm = L - 2112;
            u.a = (const char*)(ws + WS_WINT + l * SZ_WINT) + (size_t)(OFX + pm * 256) * DM * 2;
            u.b = (const char*)(ws + WS_H);
            u.o = (char*)(ws + WS_XT) + (size_t)pm * 256 * ROWS * 2; u.ldo = ROWS; }
        u.nt = 32; u.mode = M_BF16; return true; }
    case G_XT: { const int L = i * G + ((c + G - 68) % G); if (L >= 128) return false; const int pm = L & 3, pn = 1 + (L >> 2);
        u.a = (const char*)(ws + WS_WINT + l * SZ_WINT) + (size_t)(OFX + pm * 256) * DM * 2;
        u.b = (const char*)(ws + WS_H) + (size_t)(CTX + 2 * (pn - 1)) * DM * 2;
        u.o = (char*)(ws + WS_XT) + ((size_t)pm * 256 * ROWS + pn * 256) * 2; u.ldo = ROWS;
        u.nt = 32; u.mode = M_BF16; return true; }
    case G_F1: { const int L = i * G + c; if (L >= 256) return false; const int s2 = L >> 2, ct = L & 3;
        u.a = (const char*)(ws + WS_XT) + ((size_t)ct * 256 * ROWS + CTX + s2 * 128) * 2;
        u.b = (const char*)(ws + WS_T1);
        u.o = (char*)(ws + WS_ZT) + (size_t)ct * 256 * ZCH + s2 * 8;
        u.nt = 2; u.mode = M_F1; u.ldo = s2; return true; }
    case G_F2: { if (c < 16 || c >= G - 132) return false; const int L = i * (G - 148) + (c - 16); if (L >= 256) return false; const int k1p = L >> 2, ct = L & 3;
        u.a = (const char*)(ws + WS_A2);
        u.b = (const char*)(ws + WS_ZT) + (size_t)ct * 256 * ZCH + k1p * 512;
        u.o = (char*)(ws + WS_PQ) + ((size_t)(CTX + 2 * k1p) * 2048 + ct * 256) * 2;
        u.nt = 4; u.mode = M_F2; u.ldo = 2048; return true; }
    case G_DFTC: { const int L = i * G + c; if (L >= 8) return false; const int pm = L >> 2, pn = L & 3;
        u.a = (const char*)(ws + WS_ACTX) + (size_t)pm * 256 * 256 * 2;
        u.b = (const char*)(ws + WS_XT) + (size_t)pn * 256 * ROWS * 2;
        u.o = (char*)(ws + WS_PQ) + ((size_t)pm * 1024 + pn * 256) * 2;
        u.nt = 4; u.mode = M_BF16; u.ldo = 2048; return true; }
    case G_MIX: { const int L = i * G + (G - 1 - c); if (L >= 132) return false; const int pm = L >> 2, pn = L & 3;
        u.a = (const char*)(ws + WS_PQ) + (size_t)pm * 256 * 2048 * 2;
        u.b = (const char*)(ws + WS_WMIX + l * SZ_WMIX) + (size_t)pn * 256 * 2048 * 2;
        u.aux = (const char*)(ws + WS_P) + ((size_t)pm * 256 * INC + OFG + pn * 256) * 2;
        u.o = (char*)(ws + WS_ACAT) + (APL + (size_t)pm * 256 * CLD + pn * 256) * 2;
        u.nt = 32; u.mode = M_MIX; u.ldo = CLD; return true; }
    case G_MERGE: {
        if (i < 3) { const int T = c, sub = i; if (T >= 256) return false;
            int pm, pn; static_order(T, 32, 8, pm, pn); pm += 1;
            u.a = (const char*)(ws + WS_ACAT) + ((size_t)sub * APL + (size_t)pm * 256 * CLD) * 2;
            u.b = (const char*)(ws + WS_WCAT + l * SZ_WCAT) + ((size_t)sub * WPL + (size_t)pn * 256 * CLD) * 2;
            u.aux = (const char*)(ws + WS_P) + ((size_t)pm * 256 * INC + OML + sub * 2048 + pn * 256) * 2;
            u.m = (char*)(ws + WS_MBUF) + ((size_t)pm * 256 * MLD + pn * 256) * 4;
            u.o = (char*)(ws + WS_MB) + ((size_t)pm * 256 * 2048 + pn * 256) * 2;
            u.nt = sub == 0 ? 32 : 16; u.mode = M_MG0 + sub; u.ldo = 2048; return true; }
        return false; }
    case G_MERGEC: {
        if (i == 0 && l < DEPTH - 1 && c >= G - 64) { const int pc = c - (G - 64), pn = pc >> 3, q = pc & 7;
            const int sub = q < 4 ? 0 : (q < 6 ? 1 : 2), kcol = q < 4 ? q * 512 : (q < 6 ? (q - 4) * 512 : (q - 6) * 512);
            u.a = (const char*)(ws + WS_ACAT) + ((size_t)sub * APL + kcol) * 2;
            u.b = (const char*)(ws + WS_WCAT + l * SZ_WCAT) + ((size_t)sub * WPL + (size_t)pn * 256 * CLD + kcol) * 2;
            u.aux = (const char*)(ws + WS_P) + ((size_t)OML + sub * 2048 + pn * 256) * 2;
            u.m = (char*)(ws + WS_MP) + ((size_t)q * CTX * MLD + pn * 256) * 4;
            u.o = nullptr; u.nt = 8; u.mode = M_MERGE0; u.ldo = 2048; return true; }
        return false; }
    case G_OUT: {
        const int piece = l >> 4; l &= 15;
        if (i != 0) return false;
        if (!piece) { if (c >= 256) return false; int pm, pn; static_order(c, 32, 8, pm, pn); pm += 1;
            u.a = (const char*)(ws + WS_MB) + (size_t)pm * 256 * 2048 * 2;
            u.b = (const char*)(ws + WS_WOUT + l * SZ_WOUT) + (size_t)pn * 256 * 2048 * 2;
            u.o = (char*)(ws + WS_OUTB) + ((size_t)pm * 256 * 2048 + pn * 256) * 2;
            u.nt = 32; u.mode = M_BF16; u.ldo = 2048; return true; }
        if (l < DEPTH - 1 && c >= G - 32) { const int pc = c - (G - 32), pn = pc >> 2, kp = pc & 3;
            u.a = (const char*)(ws + WS_MB) + (size_t)kp * 512 * 2;
            u.b = (const char*)(ws + WS_WOUT + l * SZ_WOUT) + ((size_t)pn * 256 * 2048 + kp * 512) * 2;
            u.o = (char*)(ws + WS_OUTP) + ((size_t)kp * CTX * 2048 + pn * 256) * 4;
            u.nt = 8; u.mode = M_F32; u.ldo = 2048; return true; }
        return false; }
    }
    return false;
}

__device__ __forceinline__ void epilogue(const f32x4 (&acc)[2][2][4][2], const Unit& u, int wr, int wc, int fr, int fq) {
    unsigned r0 = wr * 64 + fr, c0 = wc * 64 + 8 * fq;
    asm volatile("" : "+v"(r0), "+v"(c0));
    if (u.mode == M_BF16) {
        const unsigned base = (r0 * (unsigned)u.ldo + c0) * 2u;
#pragma unroll
        for (int ai = 0; ai < 2; ++ai)
#pragma unroll
            for (int m = 0; m < 4; ++m) { char* rowp = u.o + (size_t)(ai * HALF + m * 16) * u.ldo * 2;
#pragma unroll
                for (int bj = 0; bj < 2; ++bj) { const f32x4 v0 = acc[ai][bj][m][0], v1 = acc[ai][bj][m][1];
                    u32x4 w; w.x = cvtpk(v0[0], v0[1]); w.y = cvtpk(v0[2], v0[3]); w.z = cvtpk(v1[0], v1[1]); w.w = cvtpk(v1[2], v1[3]);
                    *(u32x4*)(rowp + base + bj * BJC * 2) = w; } }
    } else if (u.mode == M_MIX) {
        const unsigned base = (r0 * (unsigned)u.ldo + c0) * 2u, abase = (r0 * (unsigned)INC + c0) * 2u;
#pragma unroll
        for (int ai = 0; ai < 2; ++ai) {
            u32x4 g[4][2];
#pragma unroll
            for (int m = 0; m < 4; ++m)
#pragma unroll
                for (int bj = 0; bj < 2; ++bj) g[m][bj] = *(const u32x4*)(u.aux + (size_t)(ai * HALF + m * 16) * INC * 2 + abase + bj * BJC * 2);
            __builtin_amdgcn_sched_barrier(0);
#pragma unroll
            for (int m = 0; m < 4; ++m) { char* rowp = u.o + (size_t)(ai * HALF + m * 16) * u.ldo * 2;
#pragma unroll
                for (int bj = 0; bj < 2; ++bj) { const f32x4 v0 = acc[ai][bj][m][0], v1 = acc[ai][bj][m][1]; const u32x4 gg = g[m][bj];
                    u32x4 w; w.x = cvtpk(v0[0] * siluf_(bflo(gg.x)), v0[1] * siluf_(bfhi(gg.x))); w.y = cvtpk(v0[2] * siluf_(bflo(gg.y)), v0[3] * siluf_(bfhi(gg.y)));
                    w.z = cvtpk(v1[0] * siluf_(bflo(gg.z)), v1[1] * siluf_(bfhi(gg.z))); w.w = cvtpk(v1[2] * siluf_(bflo(gg.w)), v1[3] * siluf_(bfhi(gg.w)));
                    *(u32x4*)(rowp + base + bj * BJC * 2) = w; } }
            __builtin_amdgcn_sched_barrier(0);
        }
    } else if (u.mode == M_F32) {
        const unsigned base = (r0 * (unsigned)u.ldo + c0) * 4u;
#pragma unroll
        for (int ai = 0; ai < 2; ++ai)
#pragma unroll
            for (int m = 0; m < 4; ++m) { char* rowp = u.o + (size_t)(ai * HALF + m * 16) * u.ldo * 4;
#pragma unroll
                for (int bj = 0; bj < 2; ++bj) { *(f32x4*)(rowp + base + bj * BJC * 4) = acc[ai][bj][m][0]; *(f32x4*)(rowp + base + bj * BJC * 4 + 16) = acc[ai][bj][m][1]; } }
    } else if (u.mode == M_MG0 || u.mode == M_MG1) {
    } else if (u.mode == M_MG2) {
        const unsigned abase = (r0 * (unsigned)INC + c0) * 2u, obase = (r0 * 2048u + c0) * 2u;
#pragma unroll
        for (int ai = 0; ai < 2; ++ai) {
            u32x4 g[4][2];
#pragma unroll
            for (int m = 0; m < 4; ++m)
#pragma unroll
                for (int bj = 0; bj < 2; ++bj) g[m][bj] = *(const u32x4*)(u.aux + (size_t)(ai * HALF + m * 16) * INC * 2 + abase + bj * BJC * 2);
            __builtin_amdgcn_sched_barrier(0);
#pragma unroll
            for (int m = 0; m < 4; ++m) { char* rowp = u.o + (size_t)(ai * HALF + m * 16) * 2048 * 2;
#pragma unroll
                for (int bj = 0; bj < 2; ++bj) { f32x4 v0 = acc[ai][bj][m][0], v1 = acc[ai][bj][m][1]; const u32x4 gg = g[m][bj];
                    v0[0] *= sigmoidf_(bflo(gg.x)); v0[1] *= sigmoidf_(bfhi(gg.x)); v0[2] *= sigmoidf_(bflo(gg.y)); v0[3] *= sigmoidf_(bfhi(gg.y));
                    v1[0] *= sigmoidf_(bflo(gg.z)); v1[1] *= sigmoidf_(bfhi(gg.z)); v1[2] *= sigmoidf_(bflo(gg.w)); v1[3] *= sigmoidf_(bfhi(gg.w));
                    u32x4 w; w.x = cvtpk(v0[0], v0[1]); w.y = cvtpk(v0[2], v0[3]); w.z = cvtpk(v1[0], v1[1]); w.w = cvtpk(v1[2], v1[3]); *(u32x4*)(rowp + obase + bj * BJC * 2) = w; } }
            __builtin_amdgcn_sched_barrier(0);
        }
    } else if (u.mode == M_F1) {
        const int s2 = u.ldo;
        const unsigned kb0 = (c0 >> 1);
        float tc[2][4], ts[2][4];
#pragma unroll
        for (int bj = 0; bj < 2; ++bj)
#pragma unroll
            for (int j = 0; j < 4; ++j) { const float x = (float)((bj * 16 + kb0 + j) * s2) * (1.0f / 8192.0f); tc[bj][j] = __builtin_amdgcn_cosf(x); ts[bj][j] = __builtin_amdgcn_sinf(x); }
        const unsigned base = r0 * (unsigned)ZCH + kb0 * 256u;
#pragma unroll
        for (int ai = 0; ai < 2; ++ai)
#pragma unroll
            for (int m = 0; m < 4; ++m) { char* rowp = u.o + (size_t)(ai * HALF + m * 16) * ZCH;
#pragma unroll
                for (int bj = 0; bj < 2; ++bj) { const f32x4 v0 = acc[ai][bj][m][0], v1 = acc[ai][bj][m][1];
                    const float zr[4] = {v0[0], v0[2], v1[0], v1[2]}, zi[4] = {v0[1], v0[3], v1[1], v1[3]};
#pragma unroll
                    for (int jp = 0; jp < 2; ++jp) { u32x2 w;
                        { const int j = 2 * jp; w.x = cvtpk(zr[j] * tc[bj][j] + zi[j] * ts[bj][j], zi[j] * tc[bj][j] - zr[j] * ts[bj][j]); }
                        { const int j = 2 * jp + 1; w.y = cvtpk(zr[j] * tc[bj][j] + zi[j] * ts[bj][j], zi[j] * tc[bj][j] - zr[j] * ts[bj][j]); }
                        *(u32x2*)(rowp + base + (bj * 8 + jp) * 512) = w; } } }
    } else if (u.mode == M_F2) {
        const unsigned fr_ = r0 & 15u, wr_ = r0 >> 6;
        const unsigned base = ((128u * fr_) * 2048u + wr_ * 1024u + c0) * 2u;
#pragma unroll
        for (int ai = 0; ai < 2; ++ai)
#pragma unroll
            for (int m = 0; m < 4; ++m) { char* rowp = u.o + (size_t)(ai + 2048 * m) * 2048 * 2;
#pragma unroll
                for (int bj = 0; bj < 2; ++bj) { const f32x4 v0 = acc[ai][bj][m][0], v1 = acc[ai][bj][m][1];
                    u32x4 w; w.x = cvtpk(v0[0], v0[1]); w.y = cvtpk(v0[2], v0[3]); w.z = cvtpk(v1[0], v1[1]); w.w = cvtpk(v1[2], v1[3]);
                    *(u32x4*)(rowp + base + bj * BJC * 2) = w; } }
    } else {
        const unsigned abase = (r0 * (unsigned)INC + c0) * 2u, mbase = (r0 * (unsigned)MLD + c0) * 4u;
#pragma unroll
        for (int ai = 0; ai < 2; ++ai) {
            u32x4 g[4][2];
#pragma unroll
            for (int m = 0; m < 4; ++m)
#pragma unroll
                for (int bj = 0; bj < 2; ++bj) g[m][bj] = *(const u32x4*)(u.aux + (size_t)(ai * HALF + m * 16) * INC * 2 + abase + bj * BJC * 2);
            __builtin_amdgcn_sched_barrier(0);
#pragma unroll
            for (int m = 0; m < 4; ++m) { char* mp = u.m + (size_t)(ai * HALF + m * 16) * MLD * 4;
#pragma unroll
                for (int bj = 0; bj < 2; ++bj) { f32x4 v0 = acc[ai][bj][m][0], v1 = acc[ai][bj][m][1]; const u32x4 gg = g[m][bj];
                    v0[0] *= sigmoidf_(bflo(gg.x)); v0[1] *= sigmoidf_(bfhi(gg.x)); v0[2] *= sigmoidf_(bflo(gg.y)); v0[3] *= sigmoidf_(bfhi(gg.y));
                    v1[0] *= sigmoidf_(bflo(gg.z)); v1[1] *= sigmoidf_(bfhi(gg.z)); v1[2] *= sigmoidf_(bflo(gg.w)); v1[3] *= sigmoidf_(bfhi(gg.w));
                    *(f32x4*)(mp + mbase + bj * BJC * 4) = v0; *(f32x4*)(mp + mbase + bj * BJC * 4 + 16) = v1; } }
            __builtin_amdgcn_sched_barrier(0);
        }
    }
}

__device__ __forceinline__ void rescale_or_reset(f32x4 (&acc)[2][2][4][2], const Unit& u, int wr, int wc, int fr, int fq) {
    const unsigned msk = (u.mode == M_MG0 || u.mode == M_MG1) ? 0xffffffffu : 0u;
    unsigned r0 = wr * 64 + fr, c0 = wc * 64 + 8 * fq;
    asm volatile("" : "+v"(r0), "+v"(c0));
    const unsigned abase = (r0 * (unsigned)INC + c0) * 2u;
#pragma unroll
    for (int ai = 0; ai < 2; ++ai)
#pragma unroll
        for (int m = 0; m < 4; ++m) { const char* ap = u.aux + (size_t)(ai * HALF + m * 16) * INC * 2;
#pragma unroll
            for (int bj = 0; bj < 2; ++bj) {
                const u32x4 ga = *(const u32x4*)(ap + abase + bj * BJC * 2), gb = *(const u32x4*)(ap + abase + bj * BJC * 2 + 4096);
                const unsigned wa[4] = {ga.x, ga.y, ga.z, ga.w}, wb[4] = {gb.x, gb.y, gb.z, gb.w};
                float f[8];
#pragma unroll
                for (int e = 0; e < 4; ++e) {
                    const float rl = (1.0f + __expf(-bflo(wb[e]))) * __builtin_amdgcn_rcpf(1.0f + __expf(-bflo(wa[e])));
                    const float rh = (1.0f + __expf(-bfhi(wb[e]))) * __builtin_amdgcn_rcpf(1.0f + __expf(-bfhi(wa[e])));
                    f[2 * e] = __uint_as_float(__float_as_uint(rl) & msk); f[2 * e + 1] = __uint_as_float(__float_as_uint(rh) & msk); }
                acc[ai][bj][m][0] *= (f32x4){f[0], f[1], f[2], f[3]}; acc[ai][bj][m][1] *= (f32x4){f[4], f[5], f[6], f[7]};
            }
            if (m & 1) __builtin_amdgcn_sched_barrier(0);
        }
}

__device__ __forceinline__ void gemm_phase(LAS unsigned char* lds, int gid, int l, unsigned char* ws) {
    int tid_ = threadIdx.x; asm volatile("" : "+v"(tid_));
    const int tid = tid_, wid = __builtin_amdgcn_readfirstlane(tid >> 6), lane = tid & 63, wr = wid >> 2, wc = wid & 3, fr = lane & 15, fq = lane >> 4;
    int lda, ldb;
    int ldbv = 0;
    switch (gid) { case G_FOLD: lda = 1024; ldb = 256; break; case G_IN: lda = 2048; ldb = 2048; break; case G_XT: lda = 2048; ldb = 2048; ldbv = 64 * 2048; break;
                   case G_F1: lda = ROWS; ldb = 128; break; case G_F2: lda = 256; ldb = ZCH / 2; break;
                   case G_DFTC: lda = 256; ldb = ROWS; break; case G_MIX: lda = 2048; ldb = 2048; break; case G_MERGE: case G_MERGEC: lda = CLD; ldb = CLD; break; default: lda = 2048; ldb = 2048; break; }
    if (ldbv == 0) ldbv = ldb;
    Unit cur, nxt; int ui = 0;
    if (!get_unit(gid, l, 0, ws, cur)) return;
    unsigned voffA[2], voffB[2];
#pragma unroll
    for (int i = 0; i < 2; ++i) { int R, C; stage_rc(tid * 16 + i * 8192, R, C); const int w_ = R >> 5, ip = perm32(R & 31);
        const int Rb = (gid == G_XT) ? (4096 * (w_ & 1) + 64 * ip + (w_ >> 1)) : (64 * w_ + ip);
        voffA[i] = (unsigned)(R * lda + C) * 2u; voffB[i] = (unsigned)(Rb * ldb + C) * 2u; }
    const size_t kstep = (size_t)(BK * 2);
    const size_t hstepA = (size_t)HALF * lda * 2, hstepB = (gid == G_XT) ? (size_t)2048 * ldb * 2 : (size_t)32 * ldb * 2;
    const unsigned ldsw = (unsigned)wid * 1024u;
    const int aoff = lds_byte(wr * 64 + fr, fq * 8), boff = lds_byte(wc * 32 + fr, fq * 8);
#define PG8_SA(b, h) (((b) * 2 + (h)) * HTB)
#define PG8_SB(b, h) ((4 + (b) * 2 + (h)) * HTB)
#define PG8_STAGE(bufoff, gbase, voff) do { _Pragma("unroll") for (int _i = 0; _i < 2; ++_i) \
        __builtin_amdgcn_global_load_lds((const unsigned*)((const char*)(gbase) + (voff)[_i]), (LAS unsigned*)(lds + (bufoff) + ldsw + _i * 8192), 16, 0, 0); } while (0)
#define PG8_LDA(dst, b, h) do { _Pragma("unroll") for (int m = 0; m < 4; ++m) _Pragma("unroll") for (int k = 0; k < 2; ++k) dst[m][k] = *(const LAS bf16x8*)(lds + PG8_SA(b, h) + aoff + m * 2048 + k * 1024); } while (0)
#define PG8_LDB(dst, b, h) do { _Pragma("unroll") for (int n = 0; n < 2; ++n) _Pragma("unroll") for (int k = 0; k < 2; ++k) dst[n][k] = *(const LAS bf16x8*)(lds + PG8_SB(b, h) + boff + n * 2048 + k * 1024); } while (0)
#define PG8_MMA(ai, bj, At, Bt) do { __builtin_amdgcn_s_setprio(1); _Pragma("unroll") for (int m = 0; m < 4; ++m) _Pragma("unroll") for (int n = 0; n < 2; ++n) _Pragma("unroll") for (int k = 0; k < 2; ++k) \
        acc[ai][bj][m][n] = __builtin_amdgcn_mfma_f32_16x16x32_bf16(Bt[n][k], At[m][k], acc[ai][bj][m][n], 0, 0, 0); __builtin_amdgcn_s_setprio(0); } while (0)
#define PG8_WAIT_V(n) asm volatile("s_waitcnt vmcnt(" #n ")" ::: "memory")
#define PG8_WAIT_L(n) asm volatile("s_waitcnt lgkmcnt(" #n ")" ::: "memory")
#define PG8_BAR __builtin_amdgcn_s_barrier()
#define PG8_SCHED __builtin_amdgcn_sched_barrier(0)
    f32x4 acc[2][2][4][2];
#pragma unroll
    for (int a = 0; a < 2; ++a)
#pragma unroll
        for (int b = 0; b < 2; ++b)
#pragma unroll
            for (int m = 0; m < 4; ++m)
#pragma unroll
                for (int n = 0; n < 2; ++n) acc[a][b][m][n] = (f32x4){0.f, 0.f, 0.f, 0.f};
    bf16x8 At[4][2], B0[2][2], B1[2][2];
    const char* cA = cur.a; const char* cB = cur.b;
    PG8_STAGE(PG8_SB(0, 0), cB, voffB); PG8_STAGE(PG8_SA(0, 0), cA, voffA); PG8_STAGE(PG8_SB(0, 1), cB + hstepB, voffB); PG8_STAGE(PG8_SA(0, 1), cA + hstepA, voffA);
    if (wr == 1) PG8_BAR;
    PG8_WAIT_V(4); PG8_BAR;
    PG8_STAGE(PG8_SB(1, 0), cB + kstep, voffB); PG8_STAGE(PG8_SA(1, 0), cA + kstep, voffA); PG8_STAGE(PG8_SB(1, 1), cB + hstepB + kstep, voffB);
    PG8_WAIT_V(6); PG8_BAR;
    for (;;) {
        const bool has_next = get_unit(gid, l, ui + 1, ws, nxt);
        const char* nA = has_next ? nxt.a : cA; const char* nB = has_next ? nxt.b : cB;
        const int nt = cur.nt;
        for (int t = 0; t < nt; t += 2) {
            const bool last = (t == nt - 2);
            const char* a1 = cA + (size_t)(t + 1) * kstep;
            const char* a2 = last ? nA : cA + (size_t)(t + 2) * kstep; const char* b2 = last ? nB : cB + (size_t)(t + 2) * kstep;
            const char* a3 = a2 + kstep; const char* b3 = b2 + kstep;
            PG8_LDB(B0, 0, 0); PG8_SCHED; PG8_LDA(At, 0, 0); PG8_STAGE(PG8_SA(1, 1), a1 + hstepA, voffA);
            PG8_WAIT_L(8); PG8_BAR; PG8_WAIT_L(0); PG8_MMA(0, 0, At, B0); PG8_BAR; PG8_SCHED;
            PG8_LDB(B1, 0, 1); PG8_STAGE(PG8_SB(0, 0), b2, voffB);
            PG8_BAR; PG8_WAIT_L(0); PG8_MMA(0, 1, At, B1); PG8_BAR;
            PG8_LDA(At, 0, 1); PG8_STAGE(PG8_SA(0, 0), a2, voffA);
            PG8_BAR; PG8_WAIT_L(0); PG8_MMA(1, 0, At, B0); PG8_BAR; PG8_SCHED;
            PG8_STAGE(PG8_SB(0, 1), b2 + hstepB, voffB);
            PG8_WAIT_V(6); PG8_BAR; PG8_MMA(1, 1, At, B1); PG8_BAR;
            PG8_LDB(B0, 1, 0); PG8_SCHED; PG8_LDA(At, 1, 0); PG8_STAGE(PG8_SA(0, 1), a2 + hstepA, voffA);
            PG8_WAIT_L(8); PG8_BAR; PG8_WAIT_L(0); PG8_MMA(0, 0, At, B0); PG8_BAR; PG8_SCHED;
            PG8_LDB(B1, 1, 1); PG8_STAGE(PG8_SB(1, 0), b3, voffB);
            PG8_BAR; PG8_WAIT_L(0); PG8_MMA(0, 1, At, B1); PG8_BAR;
            PG8_LDA(At, 1, 1); PG8_STAGE(PG8_SA(1, 0), a3, voffA);
            PG8_BAR; PG8_WAIT_L(0); PG8_MMA(1, 0, At, B0); PG8_BAR; PG8_SCHED;
            PG8_STAGE(PG8_SB(1, 1), b3 + hstepB, voffB);
            PG8_WAIT_V(6); PG8_BAR; PG8_MMA(1, 1, At, B1); PG8_BAR;
        }
        epilogue(acc, cur, wr, wc, fr, fq);
        if (!has_next) break;
        if (gid == G_MERGE) rescale_or_reset(acc, cur, wr, wc, fr, fq);
        else {
#pragma unroll
            for (int a = 0; a < 2; ++a)
#pragma unroll
                for (int b = 0; b < 2; ++b)
#pragma unroll
                    for (int m = 0; m < 4; ++m)
#pragma unroll
                        for (int n = 0; n < 2; ++n) acc[a][b][m][n] = (f32x4){0.f, 0.f, 0.f, 0.f};
        }
        cur = nxt; cA = nA; cB = nB; ++ui;
    }
    PG8_WAIT_V(0);
    if (wr == 0) PG8_BAR;
    PG8_BAR;
#undef PG8_SA
#undef PG8_SB
#undef PG8_STAGE
#undef PG8_LDA
#undef PG8_LDB
#undef PG8_MMA
#undef PG8_WAIT_V
#undef PG8_WAIT_L
#undef PG8_BAR
#undef PG8_SCHED
}

namespace att {
constexpr int D = 128, NW = 8, QBLK = 32, KVBLK = 64;
constexpr float SCALE = 0.088388347648318440f;
constexpr float THR = 8.f;
constexpr int LDQ = INC, LDK = 128, LDO = CLD;
constexpr size_t SHM_V = KVBLK * D * 2, SHM_K = KVBLK * D * 2, SHM_ATTN = 2 * SHM_V + 2 * SHM_K + NW * 64 * 4;
#define KSWZ(row, colB) ((row) * 256 + ((colB) ^ (((row) & 7) << 4)))
#define SBAR() __builtin_amdgcn_sched_barrier(0)
__device__ __forceinline__ int crow(int r, int hi) { return (r & 3) + 8 * (r >> 2) + 4 * hi; }
__device__ __forceinline__ void partialSM(f32x16& p0, f32x16& p1, float& m_reg, float& mn, float& alpha) {
  constexpr float C = SCALE * 1.4426950408889634f;
  float pmax = p0[0];
#pragma unroll
  for (int r = 1; r < 16; ++r) pmax = fmaxf(pmax, p0[r]);
#pragma unroll
  for (int r = 0; r < 16; ++r) pmax = fmaxf(pmax, p1[r]);
  { auto rr = __builtin_amdgcn_permlane32_swap(__float_as_uint(pmax), __float_as_uint(pmax), false, false);
    pmax = fmaxf(__uint_as_float(rr[0]), __uint_as_float(rr[1])); }
  if (__builtin_expect(__all(pmax - m_reg <= THR / SCALE), 1)) { mn = m_reg; alpha = 1.f; }
  else { mn = fmaxf(m_reg, pmax); alpha = __builtin_amdgcn_exp2f((m_reg - mn) * C); m_reg = mn; }
  float mnC = -mn * C;
#pragma unroll
  for (int r = 0; r < 16; ++r) p0[r] = fmaf(p0[r], C, mnC);
#pragma unroll
  for (int r = 0; r < 16; ++r) p1[r] = fmaf(p1[r], C, mnC);
#pragma unroll
  for (int r = 0; r < 16; ++r) p0[r] = __builtin_amdgcn_exp2f(p0[r]);
}
__device__ __forceinline__ void finishSM(f32x16& p0, f32x16& p1, float alpha, float& l_reg, bf16x8& pa0, bf16x8& pa1, bf16x8& pa2, bf16x8& pa3) {
#pragma unroll
  for (int r = 0; r < 16; ++r) p1[r] = __builtin_amdgcn_exp2f(p1[r]);
  float ps = 0;
#pragma unroll
  for (int r = 0; r < 16; ++r) ps += p0[r];
#pragma unroll
  for (int r = 0; r < 16; ++r) ps += p1[r];
  { auto rr = __builtin_amdgcn_permlane32_swap(__float_as_uint(ps), __float_as_uint(ps), false, false);
    ps = __uint_as_float(rr[0]) + __uint_as_float(rr[1]); }
  l_reg = l_reg * alpha + ps;
#define PK4(P, BASE, OUT) do { unsigned a0 = cvtpk(P[BASE + 0], P[BASE + 1]), a1 = cvtpk(P[BASE + 2], P[BASE + 3]);   \
    unsigned b0 = cvtpk(P[BASE + 4], P[BASE + 5]), b1 = cvtpk(P[BASE + 6], P[BASE + 7]);                              \
    auto r0 = __builtin_amdgcn_permlane32_swap(a0, b0, false, false); auto r1 = __builtin_amdgcn_permlane32_swap(a1, b1, false, false); \
    u32x4 w = {r0[0], r1[0], r0[1], r1[1]}; OUT = *reinterpret_cast<bf16x8*>(&w); } while (0)
  PK4(p0, 0, pa0); PK4(p0, 8, pa1); PK4(p1, 0, pa2); PK4(p1, 8, pa3);
#undef PK4
}
__device__ __forceinline__ void qkt(f32x16& p0, f32x16& p1, const bf16_t* Ks, const bf16x8* qr, int r32, int hi) {
  p0 = f32x16{}; p1 = f32x16{};
#pragma unroll
  for (int d0 = 0; d0 < 8; ++d0) { int cb = (d0 * 16 + hi * 8) * 2;
    bf16x8 b0 = *reinterpret_cast<const bf16x8*>((const char*)Ks + KSWZ(r32, cb));
    bf16x8 b1 = *reinterpret_cast<const bf16x8*>((const char*)Ks + KSWZ(32 + r32, cb));
    p0 = __builtin_amdgcn_mfma_f32_32x32x16_bf16(b0, qr[d0], p0, 0, 0, 0);
    p1 = __builtin_amdgcn_mfma_f32_32x32x16_bf16(b1, qr[d0], p1, 0, 0, 0); }
}
__device__ __forceinline__ int v_st(int k, int c) { const int kk = (k & ~0xC) | ((k & 4) << 1) | ((k & 8) >> 1); return ((kk >> 3) * 4 + (c >> 5)) * 512 + ((kk & 7) * 32 + (c & 31)) * 2; }
__device__ __forceinline__ int v_rd_base(int lane) { return ((lane & 3) << 3) | (((lane >> 2) & 3) << 6) | (((lane >> 4) & 1) << 5) | (((lane >> 5) & 1) << 8); }
constexpr int v_rd_off(int d0, int ks, int half) { return d0 * 512 + ks * 4096 + half * 2048; }
template <int OFF> __device__ __forceinline__ s16x4 tr_read(int vb) {
  s16x4 r; asm volatile("ds_read_b64_tr_b16 %0, %1 offset:%2" : "=&v"(r) : "v"(vb), "i"(OFF) : "memory"); return r;
}
template <int D0> __device__ __forceinline__ void pv_one(f32x16& od, int vb, bf16x8 pa0, bf16x8 pa1, bf16x8 pa2, bf16x8 pa3) {
  const s16x4 l0 = tr_read<v_rd_off(D0, 0, 0)>(vb), h0 = tr_read<v_rd_off(D0, 0, 1)>(vb), l1 = tr_read<v_rd_off(D0, 1, 0)>(vb), h1 = tr_read<v_rd_off(D0, 1, 1)>(vb);
  const s16x4 l2 = tr_read<v_rd_off(D0, 2, 0)>(vb), h2 = tr_read<v_rd_off(D0, 2, 1)>(vb), l3 = tr_read<v_rd_off(D0, 3, 0)>(vb), h3 = tr_read<v_rd_off(D0, 3, 1)>(vb);
  asm volatile("s_waitcnt lgkmcnt(0)" ::: "memory"); SBAR();
#define PK(L, H) (bf16x8){L[0], L[1], L[2], L[3], H[0], H[1], H[2], H[3]}
  od = __builtin_amdgcn_mfma_f32_32x32x16_bf16(pa0, PK(l0, h0), od, 0, 0, 0);
  od = __builtin_amdgcn_mfma_f32_32x32x16_bf16(pa1, PK(l1, h1), od, 0, 0, 0);
  od = __builtin_amdgcn_mfma_f32_32x32x16_bf16(pa2, PK(l2, h2), od, 0, 0, 0);
  od = __builtin_amdgcn_mfma_f32_32x32x16_bf16(pa3, PK(l3, h3), od, 0, 0, 0);
#undef PK
}
__device__ __forceinline__ void pv_d0(f32x16* o, int vb, bf16x8 pa0, bf16x8 pa1, bf16x8 pa2, bf16x8 pa3) {
  pv_one<0>(o[0], vb, pa0, pa1, pa2, pa3); pv_one<1>(o[1], vb, pa0, pa1, pa2, pa3); pv_one<2>(o[2], vb, pa0, pa1, pa2, pa3); pv_one<3>(o[3], vb, pa0, pa1, pa2, pa3);
}
__device__ __forceinline__ void attn_body(const bf16_t* __restrict__ Qb, const bf16_t* __restrict__ Kh, const bf16_t* __restrict__ Vh,
                                          bf16_t* __restrict__ Ob, const bf16_t* __restrict__ AGb, int seq, char* lds) {
  int tid_ = threadIdx.x; asm volatile("" : "+v"(tid_));
  const int tid = tid_, wid = tid >> 6, lane = tid & 63, r32 = lane & 31, hi = lane >> 5;
  bf16_t* V_lds = (bf16_t*)lds; bf16_t* K_lds = (bf16_t*)(lds + 2 * SHM_V);
  float* wsl = (float*)(lds + 2 * SHM_V + 2 * SHM_K) + wid * 64; float* li_l = wsl; float* al_l = wsl + 32;
  float m_reg = -1e30f, l_reg = 0; f32x16 o[4] = {}; bf16x8 qr[8];
  const bf16_t* Qw = Qb + (long)(wid * QBLK + r32) * LDQ + hi * 8;
#pragma unroll
  for (int d0 = 0; d0 < 8; ++d0) qr[d0] = *reinterpret_cast<const bf16x8*>(Qw + d0 * 16);
  const int sr = tid >> 4, sc = (tid & 15) * 8, vst0 = v_st(sr, sc), vst1 = v_st(32 + sr, sc);
  const int vb0 = (int)(uintptr_t)V_lds + v_rd_base(lane);
  const unsigned goff0 = (unsigned)(sr * LDK + sc) * 2u, goff1 = (unsigned)((32 + sr) * LDK + sc) * 2u;
  struct { bf16x8 vs0, vs1, ks0, ks1; } sr_[2];
#define SLOAD(i, k0) do { const char* vt_ = (const char*)Vh + (size_t)(k0) * (LDK * 2); const char* kt_ = (const char*)Kh + (size_t)(k0) * (LDK * 2); \
    sr_[i].vs0 = *reinterpret_cast<const bf16x8*>(vt_ + goff0); sr_[i].vs1 = *reinterpret_cast<const bf16x8*>(vt_ + goff1); \
    sr_[i].ks0 = *reinterpret_cast<const bf16x8*>(kt_ + goff0); sr_[i].ks1 = *reinterpret_cast<const bf16x8*>(kt_ + goff1); } while (0)
#define SWRITE(b, i) do { *(bf16x8*)((char*)V_lds + (b) * SHM_V + vst0) = sr_[i].vs0;          \
    *(bf16x8*)((char*)V_lds + (b) * SHM_V + vst1) = sr_[i].vs1; int kc = sc * 2;               \
    *(bf16x8*)((char*)K_lds + (b) * SHM_K + KSWZ(sr, kc)) = sr_[i].ks0;                       \
    *(bf16x8*)((char*)K_lds + (b) * SHM_K + KSWZ(32 + sr, kc)) = sr_[i].ks1; } while (0)
#define SWAIT() asm volatile("s_waitcnt vmcnt(4)" ::: "memory")
#define RESC(a) do { if (__any((a) < 1.f)) { if (hi == 0) al_l[r32] = (a); asm volatile("s_waitcnt lgkmcnt(0)" ::: "memory"); \
    _Pragma("unroll") for (int d = 0; d < 4; ++d) _Pragma("unroll") for (int r = 0; r < 16; ++r) o[d][r] *= al_l[crow(r, hi)]; } } while (0)
  f32x16 pA0, pA1, pB0, pB1; float mnA, mnB, alA, alB; bf16x8 pa0, pa1, pa2, pa3; const int NT = seq / KVBLK;
  constexpr int SE = 0, SO = 1;
  SLOAD(SE, 0); asm volatile("s_waitcnt vmcnt(0)" ::: "memory"); SWRITE(0, SE); __syncthreads();
  qkt(pA0, pA1, K_lds, qr, r32, hi); partialSM(pA0, pA1, m_reg, mnA, alA);
  SLOAD(SO, KVBLK); if (2 < NT) SLOAD(SE, 2 * KVBLK);
  SWAIT(); SWRITE(1, SO); __syncthreads();
  for (int j = 1; j + 1 < NT; j += 2) {
    SBAR(); qkt(pB0, pB1, (bf16_t*)((char*)K_lds + SHM_K), qr, r32, hi);
    finishSM(pA0, pA1, alA, l_reg, pa0, pa1, pa2, pa3); SBAR();
    SLOAD(SO, (j + 2) * KVBLK); SBAR();
    pv_d0(o, vb0, pa0, pa1, pa2, pa3); partialSM(pB0, pB1, m_reg, mnB, alB);
    __syncthreads(); SWAIT(); SWRITE(0, SE);
    RESC(alB); __syncthreads();
    SBAR(); qkt(pA0, pA1, K_lds, qr, r32, hi);
    finishSM(pB0, pB1, alB, l_reg, pa0, pa1, pa2, pa3); SBAR();
    if (j + 3 < NT) SLOAD(SE, (j + 3) * KVBLK); SBAR();
    pv_d0(o, vb0 + (int)SHM_V, pa0, pa1, pa2, pa3); partialSM(pA0, pA1, m_reg, mnA, alA);
    __syncthreads(); SWAIT(); SWRITE(1, SO);
    RESC(alA); __syncthreads();
  }
  SBAR(); qkt(pB0, pB1, (bf16_t*)((char*)K_lds + SHM_K), qr, r32, hi);
  finishSM(pA0, pA1, alA, l_reg, pa0, pa1, pa2, pa3); SBAR();
  pv_d0(o, vb0, pa0, pa1, pa2, pa3); partialSM(pB0, pB1, m_reg, mnB, alB);
  __syncthreads(); RESC(alB);
  finishSM(pB0, pB1, alB, l_reg, pa0, pa1, pa2, pa3); SBAR();
  pv_d0(o, vb0 + (int)SHM_V, pa0, pa1, pa2, pa3);
  if (hi == 0) li_l[r32] = l_reg; asm volatile("s_waitcnt lgkmcnt(0)" ::: "memory");
  char* Ow = (char*)(Ob + (long)(wid * QBLK) * LDO); const char* Gw = (const char*)(AGb + (long)(wid * QBLK) * LDQ);
  unsigned hv = hi, cv = r32;
  asm volatile("" : "+v"(hv), "+v"(cv));
  const unsigned gbase = (hv * 4u * LDQ + cv) * 2u, obase = (hv * 4u * LDO + cv) * 2u;
  unsigned short gq[16][4];
#pragma unroll
  for (int r = 0; r < 16; ++r) { const int rc = (r & 3) + 8 * (r >> 2); const unsigned go = gbase + (unsigned)(rc * LDQ * 2);
#pragma unroll
    for (int d0 = 0; d0 < 4; ++d0) gq[r][d0] = *(const bf16_t*)(Gw + go + d0 * 64); }
  SBAR();
#pragma unroll
  for (int r = 0; r < 16; ++r) { const int rc = (r & 3) + 8 * (r >> 2); const float rli = __builtin_amdgcn_rcpf(li_l[crow(r, hi)]);
    const unsigned oo = obase + (unsigned)(rc * LDO * 2);
#pragma unroll
    for (int d0 = 0; d0 < 4; ++d0) *(bf16_t*)(Ow + oo + d0 * 64) = f2bf(o[d0][r] * rli * siluf_(bf2f(gq[r][d0]))); }
#undef SLOAD
#undef SWRITE
#undef SWAIT
#undef RESC
}
}

__device__ __forceinline__ void attn_phase(const Params& p, int l, char* lds) {
    unsigned char* ws = p.ws;
    const bf16_t* P = (const bf16_t*)(ws + WS_P); bf16_t* Acat = (bf16_t*)(ws + WS_ACAT);
    const int G = gridDim.x, nunits = 512 + (l < DEPTH - 1 ? 16 : 0);
    for (int U = blockIdx.x; U < nunits; U += G) {
        int h, qrow0, seq;
        if (U < 512) { int qb;
            if (G == 256) { const int xcd = U & 7, j = (U >> 3) & 31, r = U >> 8, kvh = xcd >> 1, idx = (xcd & 1) * 64 + r * 32 + j; h = kvh * 4 + (idx & 3); qb = idx >> 2; }
            else { h = U & 15; qb = U >> 4; }
            qrow0 = CTX + qb * 256; seq = ROWS; }
        else { h = U - 512; qrow0 = 0; seq = CTX; }
        const int kvh = h >> 2;
        att::attn_body(P + (size_t)qrow0 * INC + OQ + h * 128, (const bf16_t*)(ws + WS_KC) + (size_t)kvh * ROWS * 128, (const bf16_t*)(ws + WS_VC) + (size_t)kvh * ROWS * 128,
                       Acat + (size_t)qrow0 * CLD + h * 128, P + (size_t)qrow0 * INC + OAG + h * 128, seq, lds);
        __syncthreads();
    }
}

#define XB_TMO      128
#define XB_XCNT(j)  (256  + 64 * (j))
#define XB_XSUB(j)  (1280 + 64 * (j))
#define XB_XGEN(j)  (2304 + 64 * (j))
#define XB_TOP      3328
#define XB_TOPGEN   3392
#define XCD_BAR_WORDS 3456
#define XB_SPIN_CAP (1u << 18)

__device__ __forceinline__ unsigned xb_ld(unsigned* p)              { return __hip_atomic_load(p, __ATOMIC_RELAXED, __HIP_MEMORY_SCOPE_AGENT); }
__device__ __forceinline__ unsigned xb_add(unsigned* p, unsigned v) { return __hip_atomic_fetch_add(p, v, __ATOMIC_RELAXED, __HIP_MEMORY_SCOPE_AGENT); }
__device__ __forceinline__ unsigned xb_xcc_id() { return (unsigned)__builtin_amdgcn_s_getreg((3 << 11) | 20) & 0xFu; }
#define XB_SPIN(cond, bar) do { unsigned _sp = 0; while (cond) { __builtin_amdgcn_s_sleep(1); \
    if ((++_sp & 255u) == 0u) { if (xb_ld(&(bar)[XB_TMO])) break; if (_sp > XB_SPIN_CAP) { atomicAdd(&(bar)[XB_TMO], 1u); break; } } } } while (0)

struct XcdBarrier {
    unsigned* bar; unsigned x;
    volatile LAS unsigned* st;
};

__device__ __forceinline__ XcdBarrier xcd_barrier_post(unsigned* bar, volatile LAS unsigned* st) {
    XcdBarrier b; b.bar = bar; b.x = xb_xcc_id(); b.st = st;
    if (threadIdx.x == 0) (void)xb_add(&bar[XB_XCNT(b.x)], 1u);
    return b;
}
__device__ __forceinline__ void xcd_barrier_complete(unsigned* bar, unsigned x, unsigned& nloc, unsigned& nx) {
    const unsigned G = gridDim.x * gridDim.y * gridDim.z;
    unsigned sum, cnt, mine, sp = 0u;
    for (;;) {
        sum = 0u; cnt = 0u; mine = 0u;
#pragma unroll
        for (unsigned j = 0; j < 16; ++j) { const unsigned c = xb_ld(&bar[XB_XCNT(j)]); sum += c; cnt += (c > 0u) ? 1u : 0u; mine = (j == x) ? c : mine; }
        if (sum == G) break;
        __builtin_amdgcn_s_sleep(1);
        if ((++sp & 255u) == 0u) { if (xb_ld(&bar[XB_TMO])) break; if (sp > XB_SPIN_CAP) { atomicAdd(&bar[XB_TMO], 1u); break; } }
    }
    nloc = mine > 0u ? mine : 1u; nx = cnt > 0u ? cnt : 1u;
}

__device__ __forceinline__ void xcd_barrier(const XcdBarrier& b) {
    asm volatile("s_waitcnt vmcnt(0)" ::: "memory");
    __syncthreads();
    if (threadIdx.x == 0) {
        unsigned* bar = b.bar;
        __builtin_amdgcn_s_waitcnt(0);
        unsigned nloc = b.st[0], nx = b.st[1];
        if (nloc == 0u) { xcd_barrier_complete(bar, b.x, nloc, nx); b.st[0] = nloc; b.st[1] = nx; }
        const unsigned old = xb_add(&bar[XB_XSUB(b.x)], 1u);
        const unsigned gen = old / nloc;
        if (old + 1u == (gen + 1u) * nloc) {
            __builtin_amdgcn_fence(__ATOMIC_RELEASE, "agent");
            asm volatile("s_waitcnt vmcnt(0)" ::: "memory");
            const unsigned og = xb_add(&bar[XB_TOP], 1u);
            const unsigned tg = og / nx;
            if (og + 1u == (tg + 1u) * nx) xb_add(&bar[XB_TOPGEN], 1u);
            else XB_SPIN(xb_ld(&bar[XB_TOPGEN]) == tg, bar);
            __builtin_amdgcn_fence(__ATOMIC_ACQUIRE, "agent");
            xb_add(&bar[XB_XGEN(b.x)], 1u);
            asm volatile("s_waitcnt vmcnt(0)" ::: "memory");
        } else {
            XB_SPIN(xb_ld(&bar[XB_XGEN(b.x)]) == gen, bar);
            __builtin_amdgcn_fence(__ATOMIC_ACQUIRE, "agent");
            asm volatile("s_waitcnt vmcnt(0)" ::: "memory");
        }
    }
    __syncthreads();
}

__global__ void __launch_bounds__(NTHREADS, 2) mega_fwd(Params p0) {
    extern __shared__ __attribute__((aligned(16))) unsigned char lds[];
    cg::grid_group grid = cg::this_grid();
    volatile LAS unsigned* misc = (volatile LAS unsigned*)((LAS unsigned char*)lds + LDS_STAGE);
    if (threadIdx.x < 16) misc[threadIdx.x] = 0u;
    __syncthreads();
    (void)xcd_barrier_post((unsigned*)(p0.ws + WS_BAR), misc);
#ifndef PHASE_MASK
#define PHASE_MASK 0xFFFF
#endif
#define PH(b) if constexpr ((PHASE_MASK >> (b)) & 1)
#ifndef DBL_MASK
#define DBL_MASK 0
#endif
    PH(10) prep_phase(p0, lds);
    __syncthreads();
    if constexpr ((DBL_MASK >> 10) & 1) { prep_phase(p0, lds); __syncthreads(); }
    grid.sync();
#pragma unroll 1
    for (int l = 0; l < DEPTH; ++l) {
#pragma unroll 1
        for (int slot = 0; slot < 12; ++slot) {
            Params p = p0;
            { unsigned char* w = p.ws; asm volatile("" : "+s"(w)); p.ws = w; }
            bool sync = true;
            LAS unsigned char* L = (LAS unsigned char*)lds;
            const int reps = ((DBL_MASK >> slot) & 1) ? 2 : 1;
#pragma unroll 1
            for (int rep = 0; rep < reps; ++rep) {
            if (rep) __syncthreads();
            switch (slot) {
            case 0: rownorm_phase(p, l); sync = false; break;
            case 1: if (l == 0) gemm_phase(L, G_FOLD, l, p.ws); break;
            case 2: gemm_phase(L, G_IN, l, p.ws); sync = false; break;
            case 3: gemm_phase(L, G_XT, l, p.ws); break;
            case 4: gemm_phase(L, G_F1, l, p.ws); sync = false; break;
            case 5: gemm_phase(L, G_DFTC, l, p.ws); break;
            case 6: ew_phase(p, l); break;
            case 7: case 8: sync = false; break;
            case 9: {
                const int cb = (int)blockIdx.x, Gn = (int)gridDim.x;
                unsigned* c2 = (unsigned*)(p.ws + WS_BAR) + 3540;
                const unsigned target = (unsigned)(Gn - 148) * (unsigned)(l + 1);
                if (cb >= 16 && cb < Gn - 132) {
                    gemm_phase(L, G_F2, l, p.ws);
                    __syncthreads();
                    if (threadIdx.x == 0) { __builtin_amdgcn_fence(__ATOMIC_RELEASE, "agent"); asm volatile("s_waitcnt vmcnt(0)" ::: "memory");
                        __hip_atomic_fetch_add(c2, 1u, __ATOMIC_RELAXED, __HIP_MEMORY_SCOPE_AGENT); }
                    __syncthreads();
                }
                attn_phase(p, l, (char*)lds);
                __syncthreads();
                if (cb >= Gn - 132) {
                    if (threadIdx.x == 0) { unsigned sp = 0;
                        while (__hip_atomic_load(c2, __ATOMIC_RELAXED, __HIP_MEMORY_SCOPE_AGENT) < target) { __builtin_amdgcn_s_sleep(1); if (++sp > (1u << 22)) break; }
                        __builtin_amdgcn_fence(__ATOMIC_ACQUIRE, "agent"); asm volatile("s_waitcnt vmcnt(0)" ::: "memory"); }
                    __syncthreads();
                    gemm_phase(L, G_MIX, l, p.ws);
                }
                break; }
            case 10: gemm_phase(L, G_MERGE, l, p.ws); __syncthreads(); gemm_phase(L, G_MERGEC, l, p.ws); break;
            default: {
                const bool hasctx = l < DEPTH - 1;
                unsigned* ccnt = (unsigned*)(p.ws + WS_BAR) + 3500;
                if (hasctx) {
                    int t0_ = threadIdx.x; asm volatile("" : "+v"(t0_));
                    const int idx = (int)blockIdx.x * NTHREADS + t0_, r = idx >> 9, cc = (idx & 511) * 4;
                    const float* mp = (const float*)(p.ws + WS_MP); bf16_t* mb = (bf16_t*)(p.ws + WS_MB);
                    f32x4 s = *(const f32x4*)(mp + (size_t)r * MLD + cc);
#pragma unroll
                    for (int q = 1; q < 8; ++q) s += *(const f32x4*)(mp + ((size_t)q * CTX + r) * MLD + cc);
                    u32x2 w; w.x = cvtpk(s[0], s[1]); w.y = cvtpk(s[2], s[3]); *(u32x2*)(mb + (size_t)r * DM + cc) = w;
                    asm volatile("s_waitcnt vmcnt(0)" ::: "memory"); __syncthreads();
                    if (threadIdx.x == 0) { __builtin_amdgcn_fence(__ATOMIC_RELEASE, "agent"); asm volatile("s_waitcnt vmcnt(0)" ::: "memory");
                        __hip_atomic_fetch_add(ccnt, 1u, __ATOMIC_RELAXED, __HIP_MEMORY_SCOPE_AGENT); }
                }
                const int nv = (hasctx && (int)blockIdx.x >= (int)gridDim.x - 32) ? 2 : 1;
#pragma unroll 1
                for (int v = 0; v < nv; ++v) {
                    if (v) {
                        __syncthreads();
                        if (threadIdx.x == 0) { const unsigned target = (unsigned)(l + 1) * gridDim.x; unsigned sp = 0;
                            while (__hip_atomic_load(ccnt, __ATOMIC_RELAXED, __HIP_MEMORY_SCOPE_AGENT) < target) { __builtin_amdgcn_s_sleep(1); if (++sp > (1u << 22)) break; }
                            __builtin_amdgcn_fence(__ATOMIC_ACQUIRE, "agent"); asm volatile("s_waitcnt vmcnt(0)" ::: "memory"); }
                        __syncthreads();
                    }
                    gemm_phase(L, G_OUT, l | (v << 4), p.ws);
                }
                break; }
            }
            }
            __syncthreads();
            if (sync) { XcdBarrier xb; xb.bar = (unsigned*)(p.ws + WS_BAR); xb.x = xb_xcc_id(); xb.st = (volatile LAS unsigned*)((LAS unsigned char*)lds + LDS_STAGE); xcd_barrier(xb); }
        }
    }
    PH(0) rownorm_phase(p0, DEPTH);
}

extern "C" void kernel_launch(void* const* d_in, const int* in_sizes, int n_in, void* d_out, int out_size, void* d_ws, size_t ws_size, hipStream_t stream) {
    static int grid_blocks = 0;
    if (grid_blocks == 0) {
        if (n_in != 18 || out_size != SEQ * DM || ws_size < WS_END) { fprintf(stderr, "kernel_launch: unexpected shapes: n_in %d out %d ws %zu (need %zu)\n", n_in, out_size, ws_size, (size_t)WS_END); grid_blocks = -1; return; }
        int dev = 0, cus = 0, per_cu = 0;
        hipGetDevice(&dev);
        hipDeviceGetAttribute(&cus, hipDeviceAttributeMultiprocessorCount, dev);
        if (hipFuncSetAttribute((const void*)mega_fwd, hipFuncAttributeMaxDynamicSharedMemorySize, LDS_BYTES) != hipSuccess) { fprintf(stderr, "kernel_launch: hipFuncSetAttribute failed\n"); grid_blocks = -1; return; }
        if (hipOccupancyMaxActiveBlocksPerMultiprocessor(&per_cu, (const void*)mega_fwd, NTHREADS, LDS_BYTES) != hipSuccess || per_cu < 1) { fprintf(stderr, "kernel_launch: occupancy query gave %d\n", per_cu); per_cu = 1; }
        (void)hipGetLastError();
        grid_blocks = cus * (per_cu > 1 ? 1 : per_cu);
        if (grid_blocks > 256) grid_blocks = 256;
        grid_blocks &= ~7;
        if (grid_blocks != 256) { fprintf(stderr, "kernel_launch: this kernel is laid out for 256 resident workgroups, got %d\n", grid_blocks); grid_blocks = -1; return; }
    }
    if (grid_blocks <= 0) return;
    Params p{};
    for (int i = 0; i < 18; ++i) p.in[i] = (const float*)d_in[i];
    p.out = (float*)d_out; p.ws = (unsigned char*)d_ws;
    if (hipMemsetAsync((char*)d_ws + WS_BAR, 0, BAR_BYTES, stream) != hipSuccess) { fprintf(stderr, "kernel_launch: memset of barrier words failed\n"); return; }
    void* args[] = {&p};
    hipError_t e = hipLaunchCooperativeKernel((const void*)mega_fwd, dim3(grid_blocks), dim3(NTHREADS), args, LDS_BYTES, stream);
    if (e != hipSuccess) fprintf(stderr, "cooperative launch failed: %s (grid %d)\n", hipGetErrorString(e), grid_blocks);
}
```
